# Optimizing an MI355X kernel written in HIP

```python
import math
import jax
import jax.numpy as jnp
from jax import lax
import numpy as np

D_MODEL = 1024
BATCH = 4
SEQ = 4096
DEPTH = 4

GRID_W = 64
CTX_LEN = 256
HEAD_DIM = 64
N_MIXERS = 4
GROUP_W = D_MODEL // N_MIXERS
ROPE_THETA = 10000.0
EPS = 1e-6
NEG_INF = -1e30

SWA_HEADS = GROUP_W // HEAD_DIM
SWA_KV_HEADS = SWA_HEADS // 2
SWA_WINDOW = 128
SWA_BLOCK = 128
GDN_HEADS = GROUP_W // HEAD_DIM
GDN_DK = HEAD_DIM
GDN_DV = HEAD_DIM
GDN_CONV = 5
GDN_CHUNK = 64
MLA_HEADS = GROUP_W // HEAD_DIM
MLA_Q_RANK = D_MODEL // 4
MLA_KV_RANK = D_MODEL // 8
MLA_NOPE = HEAD_DIM
MLA_ROPE = HEAD_DIM // 2
MLA_V = HEAD_DIM
MLA_BLOCK = 128
RET_HEADS = GROUP_W // HEAD_DIM
RET_DK = HEAD_DIM
RET_DV = HEAD_DIM
RET_CHUNK = 64
D_FF = 7 * D_MODEL // 2
N_EXPERTS = 8
TOP_K = 2

PROJ_SIZES = (
    SWA_HEADS * HEAD_DIM,
    SWA_KV_HEADS * HEAD_DIM,
    SWA_KV_HEADS * HEAD_DIM,
    GDN_HEADS * (2 * GDN_DK + GDN_DV),
    GDN_HEADS * GDN_DV,
    4 * GDN_HEADS,
    MLA_Q_RANK,
    MLA_KV_RANK,
    MLA_ROPE,
    RET_HEADS * RET_DK,
    RET_HEADS * RET_DK,
    RET_HEADS * RET_DV,
    RET_HEADS * RET_DV,
)
D_IN = sum(PROJ_SIZES)

kernel_name = 'hybrid_parallel_head_diffusion_trunk'


def rms_norm(x, g):
    xf = x.astype(jnp.float32)
    y = xf * lax.rsqrt(jnp.mean(xf * xf, axis=-1, keepdims=True) + EPS)
    return (y * g.astype(jnp.float32)).astype(x.dtype)


def modulate(x, g, shift, scale):
    return rms_norm(x, g) * (1.0 + scale) + shift


def l2_normalize(t):
    return t * lax.rsqrt(jnp.sum(t * t, axis=-1, keepdims=True) + EPS)


def head_group_norm(o, g):
    mu = jnp.mean(o, axis=-1, keepdims=True)
    var = jnp.mean(jnp.square(o - mu), axis=-1, keepdims=True)
    y = (o - mu) * lax.rsqrt(var + EPS)
    b, l, h, d = o.shape
    return y.reshape(b, l, h * d) * g.astype(jnp.float32)


def heads(t, n):
    return t.reshape(t.shape[0], t.shape[1], n, -1)


def split_proj(p):
    offsets = [int(o) for o in np.cumsum(PROJ_SIZES)[:-1]]
    return jnp.split(p, offsets, axis=-1)


def axial_rope_tables(rows, rot_dim):
    n_freq = rot_dim // 4
    inv_freq = ROPE_THETA ** (-jnp.arange(n_freq, dtype=jnp.float32) / n_freq)
    row = jnp.repeat(jnp.arange(rows, dtype=jnp.float32), GRID_W)
    col = jnp.tile(jnp.arange(GRID_W, dtype=jnp.float32), rows)
    ang_r = row[:, None] * inv_freq
    ang_c = col[:, None] * inv_freq
    ang = jnp.concatenate([ang_r, ang_r, ang_c, ang_c], axis=-1)
    return jnp.cos(ang), jnp.sin(ang)


def apply_rope(x, cos, sin):
    x1, x2, x3, x4 = jnp.split(x, 4, axis=-1)
    rot = jnp.concatenate([-x2, x1, -x4, x3], axis=-1)
    return (x * cos[:, None, :] + rot * sin[:, None, :]).astype(x.dtype)


def joint_softmax(scores, sink=None):
    m = scores[0].max(axis=-1, keepdims=True)
    for s in scores[1:]:
        m = jnp.maximum(m, s.max(axis=-1, keepdims=True))
    if sink is not None:
        m = jnp.maximum(m, sink)
    ps = [jnp.exp(s - m) for s in scores]
    denom = sum(p.sum(axis=-1, keepdims=True) for p in ps)
    if sink is not None:
        denom = denom + jnp.exp(sink - m)
    return [p / denom for p in ps]


def swa_latent(q, k, v, k_c, v_c, sink):
    b, n, hq, d = q.shape
    hkv = k.shape[2]
    rep = hq // hkv
    blk = SWA_BLOCK
    nb = n // blk
    scale = d ** -0.5
    qb = q.reshape(b, nb, blk, hkv, rep, d)

    def band(t):
        tb = t.reshape(b, nb, blk, hkv, d)
        pad = jnp.zeros_like(tb[:, :1])
        prev = jnp.concatenate([pad, tb[:, :-1]], axis=1)
        nxt = jnp.concatenate([tb[:, 1:], pad], axis=1)
        return jnp.concatenate([prev, tb, nxt], axis=2)

    kb, vb = band(k), band(v)
    q_off = jnp.arange(blk)[:, None] + blk
    k_off = jnp.arange(3 * blk)[None, :]
    key_pos = (jnp.arange(nb)[:, None] - 1) * blk + jnp.arange(3 * blk)[None, :]
    valid = (jnp.abs(q_off - k_off) <= SWA_WINDOW)[None] & ((key_pos >= 0) & (key_pos < n))[:, None, :]
    s_loc = jnp.einsum('bnqgrd,bnkgd->bngrqk', qb, kb).astype(jnp.float32) * scale
    s_loc = jnp.where(valid[None, :, None, None], s_loc, NEG_INF)
    s_ctx = jnp.einsum('bnqgrd,bmgd->bngrqm', qb, k_c).astype(jnp.float32) * scale
    sink_b = sink.astype(jnp.float32).reshape(1, 1, hkv, rep, 1, 1)
    p_loc, p_ctx = joint_softmax([s_loc, s_ctx], sink_b)
    o = (jnp.einsum('bngrqk,bnkgd->bnqgrd', p_loc.astype(v.dtype), vb)
         + jnp.einsum('bngrqm,bmgd->bnqgrd', p_ctx.astype(v.dtype), v_c))
    return o.reshape(b, n, hq * d)


def swa_context(q, k, v, sink):
    b, m, hq, d = q.shape
    hkv = k.shape[2]
    rep = hq // hkv
    s = jnp.einsum('bqgrd,bkgd->bgrqk', q.reshape(b, m, hkv, rep, d), k).astype(jnp.float32) * d ** -0.5
    (p,) = joint_softmax([s], sink.astype(jnp.float32).reshape(1, hkv, rep, 1, 1))
    return jnp.einsum('bgrqk,bkgd->bqgrd', p.astype(v.dtype), v).reshape(b, m, hq * d)


def directional_scan(chunked_fn, seqs, consts, s0, reverse):
    if reverse:
        seqs = tuple(jnp.flip(t, axis=1) for t in seqs)
    o, s = chunked_fn(*seqs, *consts, s0)
    if reverse:
        o = jnp.flip(o, axis=1)
    return o, s


def prefix_bidirectional_scan(chunked_fn, seqs_c, seqs_x, consts, state_shape):
    out_c, out_x = 0.0, 0.0
    for d in range(2):
        rev = d == 1
        s0 = jnp.zeros(state_shape, jnp.float32)
        oc, s_ctx = directional_scan(chunked_fn, seqs_c[d], consts[d], s0, rev)
        ox, _ = directional_scan(chunked_fn, seqs_x[d], consts[d], s_ctx, rev)
        out_c = out_c + oc
        out_x = out_x + ox
    return out_c, out_x


def short_conv(x, w):
    k = w.shape[0]
    y = lax.conv_general_dilated(
        x, w[:, None, :].astype(x.dtype), window_strides=(1,), padding=[(k // 2, k // 2)],
        dimension_numbers=('NWC', 'WIO', 'NWC'), feature_group_count=x.shape[-1])
    return jax.nn.silu(y)


def gated_delta_chunked(q, k, v, g, beta, s0):
    b, l, h, _ = q.shape
    dv = v.shape[-1]
    cs = GDN_CHUNK
    nc = l // cs

    def chunks(t):
        return t.reshape(b, nc, cs, h, -1).transpose(1, 0, 3, 2, 4)

    qc, kc, vc = chunks(q), chunks(k), chunks(v)
    gc = jnp.cumsum(chunks(g[..., None])[..., 0], axis=-1)
    bc = chunks(beta[..., None])
    idx = jnp.arange(cs)
    lower = idx[:, None] >= idx[None, :]
    strict = idx[:, None] > idx[None, :]
    decay = jnp.exp(jnp.where(lower, gc[..., :, None] - gc[..., None, :], NEG_INF))
    kb = kc * bc
    lmat = jnp.where(strict, jnp.einsum('nbhid,nbhjd->nbhij', kb, kc) * decay, 0.0)
    a_mat = lmat + jnp.eye(cs, dtype=jnp.float32)
    u = lax.linalg.triangular_solve(a_mat, vc * bc, left_side=True, lower=True)
    w = lax.linalg.triangular_solve(a_mat, kb * jnp.exp(gc)[..., None], left_side=True, lower=True)
    attn = jnp.einsum('nbhid,nbhjd->nbhij', qc, kc) * decay

    def step(s, xs):
        q_i, k_i, u_i, w_i, a_i, g_i = xs
        v_new = u_i - jnp.einsum('bhck,bhkv->bhcv', w_i, s)
        o_i = (jnp.einsum('bhck,bhkv->bhcv', q_i * jnp.exp(g_i)[..., None], s)
               + jnp.einsum('bhij,bhjv->bhiv', a_i, v_new))
        g_last = g_i[..., -1:]
        s = (s * jnp.exp(g_last)[..., None]
             + jnp.einsum('bhck,bhcv->bhkv', k_i * jnp.exp(g_last - g_i)[..., None], v_new))
        return s, o_i

    s_fin, o = lax.scan(step, s0, (qc, kc, u, w, attn, gc))
    return o.transpose(1, 0, 3, 2, 4).reshape(b, l, h, dv), s_fin


def gdn_mixer(parts_c, parts_x, need_ctx, conv_w, a_log, dt_bias, norm_g):
    def prep(qkv, ab):
        b, l, _ = qkv.shape
        qkv = short_conv(qkv, conv_w).astype(jnp.float32)
        q, k, v = jnp.split(qkv, [GDN_HEADS * GDN_DK, 2 * GDN_HEADS * GDN_DK], axis=-1)
        q = l2_normalize(q.reshape(b, l, GDN_HEADS, GDN_DK)) * GDN_DK ** -0.5
        k = l2_normalize(k.reshape(b, l, GDN_HEADS, GDN_DK))
        v = v.reshape(b, l, GDN_HEADS, GDN_DV)
        ab = ab.astype(jnp.float32).reshape(b, l, 2, 2, GDN_HEADS)
        g = -jnp.exp(a_log.astype(jnp.float32)) * jax.nn.softplus(ab[:, :, :, 0] + dt_bias.astype(jnp.float32))
        beta = jax.nn.sigmoid(ab[:, :, :, 1])
        return [(q, k, v, g[:, :, d], beta[:, :, d]) for d in range(2)]

    qkv_c, gate_c, ab_c = parts_c
    qkv_x, gate_x, ab_x = parts_x
    s_shape = (qkv_x.shape[0], GDN_HEADS, GDN_DK, GDN_DV)
    o_c, o_x = prefix_bidirectional_scan(gated_delta_chunked, prep(qkv_c, ab_c), prep(qkv_x, ab_x),
                                         [(), ()], s_shape)

    def gated_out(o, gate):
        b, l = gate.shape[:2]
        y = rms_norm(o, norm_g) * jax.nn.silu(gate.astype(jnp.float32)).reshape(o.shape)
        return y.reshape(b, l, GDN_HEADS * GDN_DV).astype(gate.dtype)

    return (gated_out(o_c, gate_c) if need_ctx else None), gated_out(o_x, gate_x)


def mla_queries(cq, q_norm, w_q_up):
    q = heads(rms_norm(cq, q_norm) @ w_q_up, MLA_HEADS)
    return q[..., :MLA_NOPE], q[..., MLA_NOPE:]


def mla_keys_values(ckv, kv_norm, w_kv_up):
    kv = heads(rms_norm(ckv, kv_norm) @ w_kv_up, MLA_HEADS)
    return kv[..., :MLA_NOPE], kv[..., MLA_NOPE:]


def mla_latent(qn, qr, kn, kr, v, kn_c, kr_c, v_c):
    b, n, h, _ = qn.shape
    nb = n // MLA_BLOCK
    scale = (MLA_NOPE + MLA_ROPE) ** -0.5

    def blocks(t):
        return jnp.moveaxis(t.reshape((b, nb, MLA_BLOCK) + t.shape[2:]), 1, 0)

    def one_block(args):
        qn_i, qr_i = args
        s_lat = (jnp.einsum('bqhd,bkhd->bhqk', qn_i, kn)
                 + jnp.einsum('bqhr,bkr->bhqk', qr_i, kr)).astype(jnp.float32) * scale
        s_ctx = (jnp.einsum('bqhd,bkhd->bhqk', qn_i, kn_c)
                 + jnp.einsum('bqhr,bkr->bhqk', qr_i, kr_c)).astype(jnp.float32) * scale
        p_lat, p_ctx = joint_softmax([s_lat, s_ctx])
        return (jnp.einsum('bhqk,bkhd->bqhd', p_lat.astype(v.dtype), v)
                + jnp.einsum('bhqk,bkhd->bqhd', p_ctx.astype(v.dtype), v_c))

    o = lax.map(one_block, (blocks(qn), blocks(qr)))
    return jnp.moveaxis(o, 0, 1).reshape(b, n, h * MLA_V)


def mla_context(qn, qr, kn, kr, v):
    b, m, h, _ = qn.shape
    scale = (MLA_NOPE + MLA_ROPE) ** -0.5
    s = (jnp.einsum('bqhd,bkhd->bhqk', qn, kn)
         + jnp.einsum('bqhr,bkr->bhqk', qr, kr)).astype(jnp.float32) * scale
    (p,) = joint_softmax([s])
    return jnp.einsum('bhqk,bkhd->bqhd', p.astype(v.dtype), v).reshape(b, m, h * MLA_V)


def retention_chunked(q, k, v, log_gamma, s0):
    b, l, h, _ = q.shape
    dv = v.shape[-1]
    cs = RET_CHUNK
    nc = l // cs

    def chunks(t):
        return t.reshape(b, nc, cs, h, -1).transpose(1, 0, 3, 2, 4)

    qc, kc, vc = chunks(q), chunks(k), chunks(v)
    pos = jnp.arange(cs, dtype=jnp.float32)
    lg = log_gamma[:, None]
    rel = pos[:, None] - pos[None, :]
    decay = jnp.where(rel >= 0, jnp.exp(lg[..., None] * jnp.maximum(rel, 0.0)), 0.0)
    q_decay = jnp.exp(lg * (pos + 1.0))[None, :, :, None]
    k_decay = jnp.exp(lg * (cs - 1.0 - pos))[None, :, :, None]
    chunk_decay = jnp.exp(log_gamma * cs)[None, :, None, None]
    intra = jnp.einsum('nbhij,nbhjv->nbhiv', jnp.einsum('nbhid,nbhjd->nbhij', qc, kc) * decay, vc)

    def step(s, xs):
        q_i, k_i, v_i = xs
        o_i = jnp.einsum('bhck,bhkv->bhcv', q_i * q_decay, s)
        s = s * chunk_decay + jnp.einsum('bhck,bhcv->bhkv', k_i * k_decay, v_i)
        return s, o_i

    s_fin, inter = lax.scan(step, s0, (qc, kc, vc))
    o = intra + inter
    return o.transpose(1, 0, 3, 2, 4).reshape(b, l, h, dv), s_fin


def retention_mixer(parts_c, parts_x, need_ctx, log_decay, norm_g, cos, sin):
    def prep(parts, rotate):
        q, k, v, _ = parts
        q = heads(q, RET_HEADS)
        k = heads(k, RET_HEADS)
        if rotate:
            q = apply_rope(q, cos, sin)
            k = apply_rope(k, cos, sin)
        seq = (q.astype(jnp.float32), k.astype(jnp.float32) * RET_DK ** -0.5,
               heads(v, RET_HEADS).astype(jnp.float32))
        return [seq, seq]

    log_gamma = -jnp.exp(log_decay.astype(jnp.float32))
    consts = [(log_gamma[0],), (log_gamma[1],)]
    s_shape = (parts_x[0].shape[0], RET_HEADS, RET_DK, RET_DV)
    o_c, o_x = prefix_bidirectional_scan(retention_chunked, prep(parts_c, False), prep(parts_x, True),
                                         consts, s_shape)

    def gated_out(o, gate):
        return (head_group_norm(o, norm_g) * jax.nn.silu(gate.astype(jnp.float32))).astype(gate.dtype)

    return (gated_out(o_c, parts_c[3]) if need_ctx else None), gated_out(o_x, parts_x[3])


def token_mixers(u_c, u_x, need_ctx, w_in, w_out, swa_sink, gdn_conv, gdn_a_log, gdn_dt_bias, gdn_norm,
                 mla_q_norm, mla_kv_norm, mla_w_q_up, mla_w_kv_up, ret_log_decay, ret_norm,
                 rope_hd, rope_mla):
    cos_h, sin_h = rope_hd
    cos_r, sin_r = rope_mla
    pc = split_proj(u_c @ w_in)
    px = split_proj(u_x @ w_in)
    ak_c, av_c = heads(pc[1], SWA_KV_HEADS), heads(pc[2], SWA_KV_HEADS)
    aq_x = apply_rope(heads(px[0], SWA_HEADS), cos_h, sin_h)
    ak_x = apply_rope(heads(px[1], SWA_KV_HEADS), cos_h, sin_h)
    out_a_x = swa_latent(aq_x, ak_x, heads(px[2], SWA_KV_HEADS), ak_c, av_c, swa_sink)
    out_b_c, out_b_x = gdn_mixer(pc[3:6], px[3:6], need_ctx, gdn_conv, gdn_a_log, gdn_dt_bias, gdn_norm)
    kn_c, v_c = mla_keys_values(pc[7], mla_kv_norm, mla_w_kv_up)
    kn_x, v_x = mla_keys_values(px[7], mla_kv_norm, mla_w_kv_up)
    qn_x, qr_x = mla_queries(px[6], mla_q_norm, mla_w_q_up)
    qr_x = apply_rope(qr_x, cos_r, sin_r)
    kr_x = apply_rope(px[8][:, :, None, :], cos_r, sin_r)[:, :, 0, :]
    out_c_x = mla_latent(qn_x, qr_x, kn_x, kr_x, v_x, kn_c, pc[8], v_c)
    out_d_c, out_d_x = retention_mixer(pc[9:13], px[9:13], need_ctx, ret_log_decay, ret_norm, cos_h, sin_h)
    mix_x = jnp.concatenate([out_a_x, out_b_x, out_c_x, out_d_x], axis=-1) @ w_out
    if not need_ctx:
        return None, mix_x
    out_a_c = swa_context(heads(pc[0], SWA_HEADS), ak_c, av_c, swa_sink)
    qn_c, qr_c = mla_queries(pc[6], mla_q_norm, mla_w_q_up)
    out_c_c = mla_context(qn_c, qr_c, kn_c, pc[8], v_c)
    mix_c = jnp.concatenate([out_a_c, out_b_c, out_c_c, out_d_c], axis=-1) @ w_out
    return mix_c, mix_x


def swiglu(x, w_gate, w_up, w_down):
    return (jax.nn.silu(x @ w_gate) * (x @ w_up)) @ w_down


def moe_swiglu(x, w_router, w_gate, w_up, w_down):
    logits = (x @ w_router).astype(jnp.float32)
    top_val, top_idx = lax.top_k(logits, TOP_K)
    gates = jax.nn.softmax(top_val, axis=-1)
    combine = jnp.sum(jax.nn.one_hot(top_idx, N_EXPERTS, dtype=jnp.float32) * gates[..., None], axis=1)
    out = jnp.zeros_like(x)
    for e in range(N_EXPERTS):
        out = out + combine[:, e:e + 1].astype(x.dtype) * swiglu(x, w_gate[e], w_up[e], w_down[e])
    return out


def setup_inputs(seed: int = 0) -> dict:
    key = jax.random.key(seed)
    keys = iter(jax.random.split(key, 40))
    f32 = jnp.float32
    d = D_MODEL
    n_dense = (DEPTH + 1) // 2
    n_moe = DEPTH // 2

    def normal(shape, scale):
        return jax.random.normal(next(keys), shape, f32) * scale

    def gain(shape):
        return 1.0 + normal(shape, 0.02)

    ret_base = jnp.log(-jnp.log1p(-(2.0 ** (-5.0 - jnp.arange(RET_HEADS, dtype=f32)))))
    dt = jnp.exp(jax.random.uniform(next(keys), (DEPTH, 2, GDN_HEADS), f32, math.log(1e-3), math.log(1e-1)))
    mix_w = N_MIXERS * GROUP_W
    return {
        'x': normal((BATCH, SEQ, d), 1.0),
        'c': normal((BATCH, d), 1.0),
        'ctx': normal((BATCH, CTX_LEN, d), 1.0),
        'c_ctx': normal((d,), 1.0),
        'w_mod': normal((DEPTH, d, 6 * d), 0.5 * d ** -0.5),
        'b_mod': normal((DEPTH, 6 * d), 0.02),
        'norm1': gain((DEPTH, d)),
        'norm2': gain((DEPTH, d)),
        'w_in': normal((DEPTH, d, D_IN), d ** -0.5),
        'w_out': normal((DEPTH, mix_w, d), mix_w ** -0.5),
        'swa_sink': normal((DEPTH, SWA_HEADS), 0.5),
        'gdn_conv': normal((DEPTH, GDN_CONV, GDN_HEADS * (2 * GDN_DK + GDN_DV)), GDN_CONV ** -0.5),
        'gdn_a_log': jnp.log(jax.random.uniform(next(keys), (DEPTH, 2, GDN_HEADS), f32, 1.0, 16.0)),
        'gdn_dt_bias': dt + jnp.log(-jnp.expm1(-dt)),
        'gdn_norm': gain((DEPTH, GDN_DV)),
        'mla_q_norm': gain((DEPTH, MLA_Q_RANK)),
        'mla_kv_norm': gain((DEPTH, MLA_KV_RANK)),
        'mla_w_q_up': normal((DEPTH, MLA_Q_RANK, MLA_HEADS * (MLA_NOPE + MLA_ROPE)), MLA_Q_RANK ** -0.5),
        'mla_w_kv_up': normal((DEPTH, MLA_KV_RANK, MLA_HEADS * (MLA_NOPE + MLA_V)), MLA_KV_RANK ** -0.5),
        'ret_log_decay': ret_base + normal((DEPTH, 2, RET_HEADS), 0.05),
        'ret_norm': gain((DEPTH, RET_HEADS * RET_DV)),
        'ffn_w_gate': normal((n_dense, d, D_FF), d ** -0.5),
        'ffn_w_up': normal((n_dense, d, D_FF), d ** -0.5),
        'ffn_w_down': normal((n_dense, D_FF, d), D_FF ** -0.5),
        'moe_router': normal((n_moe, d, N_EXPERTS), d ** -0.5),
        'moe_w_gate': normal((n_moe, N_EXPERTS, d, D_FF), d ** -0.5),
        'moe_w_up': normal((n_moe, N_EXPERTS, d, D_FF), d ** -0.5),
        'moe_w_down': normal((n_moe, N_EXPERTS, D_FF, d), D_FF ** -0.5),
        'final_norm': gain((d,)),
    }


def reference(x, c, ctx, c_ctx, w_mod, b_mod, norm1, norm2, w_in, w_out, swa_sink, gdn_conv, gdn_a_log,
              gdn_dt_bias, gdn_norm, mla_q_norm, mla_kv_norm, mla_w_q_up, mla_w_kv_up, ret_log_decay,
              ret_norm, ffn_w_gate, ffn_w_up, ffn_w_down, moe_router, moe_w_gate, moe_w_up, moe_w_down,
              final_norm):
    b, n, _ = x.shape
    m = ctx.shape[1]
    rows = n // GRID_W
    rope_hd = axial_rope_tables(rows, HEAD_DIM)
    rope_mla = axial_rope_tables(rows, MLA_ROPE)
    silu_c = jax.nn.silu(c)
    silu_cc = jax.nn.silu(c_ctx)
    h_x, h_c = x, ctx
    for layer in range(DEPTH):
        need_ctx = layer < DEPTH - 1
        mod_x = (silu_c @ w_mod[layer] + b_mod[layer])[:, None, :]
        mod_c = silu_cc @ w_mod[layer] + b_mod[layer]
        sh1_x, sc1_x, g1_x, sh2_x, sc2_x, g2_x = jnp.split(mod_x, 6, axis=-1)
        sh1_c, sc1_c, g1_c, sh2_c, sc2_c, g2_c = jnp.split(mod_c, 6, axis=-1)
        u_x = modulate(h_x, norm1[layer], sh1_x, sc1_x)
        u_c = modulate(h_c, norm1[layer], sh1_c, sc1_c)
        mix_c, mix_x = token_mixers(
            u_c, u_x, need_ctx, w_in[layer], w_out[layer], swa_sink[layer], gdn_conv[layer],
            gdn_a_log[layer], gdn_dt_bias[layer], gdn_norm[layer], mla_q_norm[layer], mla_kv_norm[layer],
            mla_w_q_up[layer], mla_w_kv_up[layer], ret_log_decay[layer], ret_norm[layer], rope_hd, rope_mla)
        h_x = h_x + g1_x * mix_x
        v_x = modulate(h_x, norm2[layer], sh2_x, sc2_x)
        if need_ctx:
            h_c = h_c + g1_c * mix_c
            tokens = jnp.concatenate([modulate(h_c, norm2[layer], sh2_c, sc2_c), v_x], axis=1)
        else:
            tokens = v_x
        lt = tokens.shape[1]
        flat = tokens.reshape(b * lt, D_MODEL)
        i = layer // 2
        if layer % 2 == 0:
            f = swiglu(flat, ffn_w_gate[i], ffn_w_up[i], ffn_w_down[i])
        else:
            f = moe_swiglu(flat, moe_router[i], moe_w_gate[i], moe_w_up[i], moe_w_down[i])
        f = f.reshape(b, lt, D_MODEL)
        if need_ctx:
            h_c = h_c + g2_c * f[:, :m]
            h_x = h_x + g2_x * f[:, m:]
        else:
            h_x = h_x + g2_x * f
    return rms_norm(h_x, final_norm)
```

```cpp
#include <hip/hip_runtime.h>
#include <cstdio>
#include <cstdint>
#include <cstring>

#ifndef MK_ONE_LAUNCH
#define MK_ONE_LAUNCH 1
#endif

#define LAS __attribute__((address_space(3)))
#define GAS __attribute__((address_space(1)))
typedef unsigned short bf16_t;
typedef short bf16x8 __attribute__((ext_vector_type(8)));
typedef float f32x4 __attribute__((ext_vector_type(4)));
typedef float f32x2 __attribute__((ext_vector_type(2)));
typedef float f32x16 __attribute__((ext_vector_type(16)));
typedef unsigned u32x4 __attribute__((ext_vector_type(4)));
typedef unsigned u32x2 __attribute__((ext_vector_type(2)));

constexpr int D = 1024, NB = 4, SEQ = 4096, CTX = 256, DEPTH = 4;
constexpr int MC = NB * CTX, MX = NB * SEQ, MT = MC + MX;
constexpr int DIN = 2992, DINP = 3072, DFF = 3584, NE = 8;
constexpr int NSU = 2 * NB * 4 * 68;
constexpr int PC_AQ = 0, PC_AK = 256, PC_AV = 384, PC_BQKV = 512, PC_BGATE = 1280, PC_BAB = 1536, PC_CQ = 1552, PC_CKV = 1808, PC_CKR = 1936,
              PC_DQ = 1968, PC_DK = 2224, PC_DV = 2480, PC_DGATE = 2736;
constexpr float EPS = 1e-6f, LOG2E = 1.4426950408889634f;
constexpr int MOE_ROWS = 36864, MOE_TILES = MOE_ROWS / 256;

constexpr size_t MiB = 1u << 20;
constexpr size_t WS_CTL = 0, CTL_BYTES = 1 * MiB;
constexpr int CW_BAR = 4096;
constexpr int CW_CNT = 16384;
constexpr int CW_TILEE = 20480;
constexpr size_t WS_TAB = 1 * MiB;
constexpr size_t WS_MOD = WS_TAB + 65536;
constexpr size_t WS_ROUTE = 2 * MiB;
constexpr size_t WS_DEC = 3 * MiB;
constexpr size_t WS_WIN = 4 * MiB;
constexpr size_t WS_WINV = WS_WIN + 24 * MiB;
constexpr size_t WS_WOUT = WS_WINV + 2 * MiB;
constexpr size_t WS_WUP = WS_WOUT + 8 * MiB;
constexpr size_t WS_WUPV = WS_WUP + 4 * MiB;
constexpr size_t WS_WFF = WS_WUPV + 1 * MiB;
constexpr size_t FFW_BYTES = (size_t)(7168 * 1024 + 1024 * 3584) * 2;
constexpr size_t WS_WMOE = WS_WFF + 42 * MiB;
constexpr size_t WS_H = WS_WMOE + 168 * MiB;
constexpr size_t WS_U = WS_H + 68 * MiB;
constexpr size_t WS_OV = WS_U + 34 * MiB;
constexpr size_t WS_P = WS_OV;
constexpr size_t WS_VTS = WS_P + 102 * MiB;
constexpr size_t WS_AUP = WS_VTS + 9 * MiB;
constexpr size_t WS_QRAW = WS_AUP + 17 * MiB;
constexpr size_t WS_KFULL = WS_QRAW + 13 * MiB;
constexpr size_t WS_VTM = WS_KFULL + 13 * MiB;
constexpr size_t WS_QS = WS_VTM + 9 * MiB;
constexpr size_t WS_KS = WS_QS + 9 * MiB;
constexpr size_t WS_MIX = WS_KS + 5 * MiB;
constexpr size_t WS_REC = WS_MIX + 34 * MiB;
constexpr size_t REC_G_W = 0, REC_G_UT = 8192, REC_G_KDT = 24576, REC_G_QG = 32768, REC_G_ATT = 40960, REC_G_SP = 49152, REC_G_VN = 57344, REC_G_BYTES = 65536;
constexpr size_t REC_R_KV = 0, REC_R_QG = 16384, REC_R_ATT = 24576, REC_R_VF = 32768, REC_R_SP = 40960, REC_R_BYTES = 49152;
constexpr size_t WS_RECG = WS_REC, WS_RECR = WS_REC + (size_t)NSU * REC_G_BYTES;
constexpr size_t WS_OV_END_MIX = WS_RECR + (size_t)NSU * REC_R_BYTES;
constexpr size_t WS_YD = WS_OV + 112 * MiB;
constexpr size_t WS_ASORT = WS_YD + 72 * MiB;
constexpr size_t WS_HD = WS_ASORT + 72 * MiB;
constexpr size_t WS_OV_END_FFN = WS_HD + 252 * MiB;
constexpr size_t WS_END = (WS_OV_END_MIX > WS_OV_END_FFN ? WS_OV_END_MIX : WS_OV_END_FFN);
static_assert(WS_P + (size_t)MT * DINP * 2 <= WS_VTS && WS_VTS + (size_t)256 * MT * 2 <= WS_AUP && WS_AUP + (size_t)MT * 512 * 2 <= WS_QRAW && WS_QRAW + (size_t)MT * 384 * 2 <= WS_KFULL &&
              WS_KFULL + (size_t)MT * 384 * 2 <= WS_VTM && WS_VTM + (size_t)256 * MT * 2 <= WS_QS && WS_QS + (size_t)MT * 256 * 2 <= WS_KS && WS_KS + (size_t)MT * 128 * 2 <= WS_MIX &&
              WS_MIX + (size_t)MT * D * 2 <= WS_REC && WS_YD >= WS_VTS + 9 * MiB && WS_MOD + 491520 <= WS_ROUTE && WS_ROUTE + 417792 <= WS_DEC && WS_DEC + NSU * 4 <= WS_WIN, "ws map");
static_assert(WS_END <= 900 * MiB, "ws budget");

constexpr int LDS_BYTES = 147456;
constexpr int LDS_MISC = 147456 - 256;
constexpr int NWAVES = 8, NTHR = 512;

__device__ __forceinline__ unsigned cvtpk(float lo, float hi) { unsigned r; asm volatile("v_cvt_pk_bf16_f32 %0, %1, %2" : "=v"(r) : "v"(lo), "v"(hi)); return r; }
__device__ __forceinline__ float bf_lo(unsigned u) { return __uint_as_float(u << 16); }
__device__ __forceinline__ float bf_hi(unsigned u) { return __uint_as_float(u & 0xffff0000u); }
__device__ __forceinline__ float bf2f(bf16_t h) { return __uint_as_float((unsigned)h << 16); }
__device__ __forceinline__ bf16_t f2bf(float f) { return (bf16_t)(cvtpk(f, 0.f) & 0xffffu); }
__device__ __forceinline__ float wave_sum(float v) {
#pragma unroll
    for (int o = 1; o < 64; o <<= 1) v += __shfl_xor(v, o);
    return v;
}
__device__ __forceinline__ float silu_f(float x) { return x / (1.f + __expf(-x)); }
__device__ __forceinline__ float sigmoid_f(float x) { return 1.f / (1.f + __expf(-x)); }
__device__ __forceinline__ float softplus_f(float x) { return x > 20.f ? x : log1pf(__expf(x)); }
__device__ __forceinline__ int crow(int r, int hi) { return (r & 3) + 8 * (r >> 2) + 4 * hi; }
__device__ __forceinline__ f32x16 mfma32(bf16x8 a, bf16x8 b, f32x16 c) { return __builtin_amdgcn_mfma_f32_32x32x16_bf16(a, b, c, 0, 0, 0); }
__device__ __forceinline__ bf16x8 mk_frag(u32x2 lo, u32x2 hi) { u32x4 v; v.x = lo.x; v.y = lo.y; v.z = hi.x; v.w = hi.y; return __builtin_bit_cast(bf16x8, v); }
__device__ __forceinline__ bf16x8 mk_frag4(unsigned a, unsigned b, unsigned c, unsigned d) { u32x4 v; v.x = a; v.y = b; v.z = c; v.w = d; return __builtin_bit_cast(bf16x8, v); }
__device__ __forceinline__ int mod_row(int row) { return row < MC ? 4 : ((row - MC) >> 12); }

#define XB_TMO      128
#define XB_XCNT(j)  (256  + 64 * (j))
#define XB_XSUB(j)  (1280 + 64 * (j))
#define XB_XGEN(j)  (2304 + 64 * (j))
#define XB_TOP      3328
#define XB_TOPGEN   3392
#define XCD_BAR_WORDS 3456
#define XB_SPIN_CAP (1u << 18)
__device__ __forceinline__ unsigned xb_ld(unsigned* p)              { return __hip_atomic_load(p, __ATOMIC_RELAXED, __HIP_MEMORY_SCOPE_AGENT); }
__device__ __forceinline__ unsigned xb_add(unsigned* p, unsigned v) { return __hip_atomic_fetch_add(p, v, __ATOMIC_RELAXED, __HIP_MEMORY_SCOPE_AGENT); }
__device__ __forceinline__ unsigned xb_xcc_id() { return (unsigned)__builtin_amdgcn_s_getreg((3 << 11) | 20) & 0xFu; }
#define XB_SPIN(cond, bar) do { unsigned _sp = 0; while (cond) { __builtin_amdgcn_s_sleep(1); \
    if ((++_sp & 255u) == 0u) { if (xb_ld(&(bar)[XB_TMO])) break; if (_sp > XB_SPIN_CAP) { atomicAdd(&(bar)[XB_TMO], 1u); break; } } } } while (0)
struct XcdBarrier { unsigned* bar; unsigned x; volatile LAS unsigned* st; };
__device__ __forceinline__ XcdBarrier xcd_barrier_post(unsigned* bar, volatile LAS unsigned* st) {
    XcdBarrier b; b.bar = bar; b.x = xb_xcc_id(); b.st = st;
    if (threadIdx.x == 0) (void)xb_add(&bar[XB_XCNT(b.x)], 1u);
    return b;
}
__device__ __forceinline__ void xcd_barrier_complete(unsigned* bar, unsigned x, unsigned& nloc, unsigned& nx) {
    const unsigned G = gridDim.x * gridDim.y * gridDim.z;
    unsigned sum, cnt, mine, sp = 0u;
    for (;;) {
        sum = 0u; cnt = 0u; mine = 0u;
#pragma unroll
        for (unsigned j = 0; j < 16; ++j) { const unsigned c = xb_ld(&bar[XB_XCNT(j)]); sum += c; cnt += (c > 0u) ? 1u : 0u; mine = (j == x) ? c : mine; }
        if (sum == G) break;
        __builtin_amdgcn_s_sleep(1);
        if ((++sp & 255u) == 0u) { if (xb_ld(&bar[XB_TMO])) break; if (sp > XB_SPIN_CAP) { atomicAdd(&bar[XB_TMO], 1u); break; } }
    }
    nloc = mine > 0u ? mine : 1u; nx = cnt > 0u ? cnt : 1u;
}
__device__ __forceinline__ void xcd_barrier(const XcdBarrier& b) {
    asm volatile("s_waitcnt vmcnt(0)" ::: "memory");
    __syncthreads();
    if (threadIdx.x == 0) {
        unsigned* bar = b.bar;
        __builtin_amdgcn_s_waitcnt(0);
        unsigned nloc = b.st[0], nx = b.st[1];
        if (nloc == 0u) { xcd_barrier_complete(bar, b.x, nloc, nx); b.st[0] = nloc; b.st[1] = nx; }
        const unsigned old = xb_add(&bar[XB_XSUB(b.x)], 1u);
        const unsigned gen = old / nloc;
        if (old + 1u == (gen + 1u) * nloc) {
            __builtin_amdgcn_fence(__ATOMIC_RELEASE, "agent");
            asm volatile("s_waitcnt vmcnt(0)" ::: "memory");
            const unsigned og = xb_add(&bar[XB_TOP], 1u);
            const unsigned tg = og / nx;
            if (og + 1u == (tg + 1u) * nx) xb_add(&bar[XB_TOPGEN], 1u);
            else XB_SPIN(xb_ld(&bar[XB_TOPGEN]) == tg, bar);
            __builtin_amdgcn_fence(__ATOMIC_ACQUIRE, "agent");
            xb_add(&bar[XB_XGEN(b.x)], 1u);
            asm volatile("s_waitcnt vmcnt(0)" ::: "memory");
        } else {
            XB_SPIN(xb_ld(&bar[XB_XGEN(b.x)]) == gen, bar);
            __builtin_amdgcn_fence(__ATOMIC_ACQUIRE, "agent");
            asm volatile("s_waitcnt vmcnt(0)" ::: "memory");
        }
    }
    __syncthreads();
}
namespace pg8 {
#define PG8_LAS __attribute__((address_space(3)))
typedef unsigned short bf16_t;
typedef short bf16x8 __attribute__((ext_vector_type(8)));
typedef float f32x4 __attribute__((ext_vector_type(4)));
typedef unsigned u32x4 __attribute__((ext_vector_type(4)));
constexpr int BM = 256, BK = 64, HALF = 128, HTB = HALF * BK * 2  , STAGE_BYTES = 8 * HTB, NXCD = 8, WGM = 8;

__host__ __device__ __forceinline__ int lds_byte(int r, int c) { const int st = (r >> 4) * 2 + (c >> 5), rr = r & 15, cc = c & 31, ob = rr * 64 + cc * 2; return st * 1024 + (ob ^ (((ob >> 9) & 1) << 5)); }
__host__ __device__ __forceinline__ void stage_rc(int b, int& R, int& C) { const int st = b / 1024, sb = b % 1024, swz = sb ^ (((sb >> 9) & 1) << 5); R = (st >> 1) * 16 + swz / 64; C = (st & 1) * 32 + (swz % 64) / 2; }
__host__ __device__ __forceinline__ int perm32(int rho) { const int n = rho >> 4, i = rho & 15; return 8 * (i >> 2) + 4 * n + (i & 3); }

struct Unit { int pm, pn; };
struct Gemm { const bf16_t* A; const bf16_t* Bt; int M, N, K; };

struct StaticOrder {
    int nM, nN, nwg, G, c;
    __host__ __device__ void init(int M, int N, int G_, int c_) { nM = M / BM; nN = N / BM; nwg = nM * nN; G = G_; c = c_; }
    __host__ __device__ bool next(int i, Unit& u) const {
        const long L = (long)i * G + c; if (L >= nwg) return false;
        int wgid = (int)L; { const int q = nwg / NXCD, r = nwg % NXCD, xcd = wgid % NXCD, off = wgid / NXCD; wgid = (xcd < r ? xcd * (q + 1) : r * (q + 1) + (xcd - r) * q) + off; }
        const int nig = WGM * nN, gid = wgid / nig, fm = gid * WGM, gsz = (nM - fm) < WGM ? (nM - fm) : WGM;
        u.pm = fm + ((wgid % nig) % gsz); u.pn = (wgid % nig) / gsz; return true;
    }
    __device__ __forceinline__ void a_ready(const Unit&) const {}
    __device__ __forceinline__ void done(const Unit&) const {}
};
__device__ __forceinline__ unsigned cvt_pk_bf16(float lo, float hi) { unsigned r; asm volatile("v_cvt_pk_bf16_f32 %0, %1, %2" : "=v"(r) : "v"(lo), "v"(hi)); return r; }
template <class Epi, class Sched, bool ALIGN_EPI = false, bool SP2 = false>
__device__ __forceinline__ void gemm_phase(PG8_LAS unsigned char* lds, const Gemm g, const Sched& S, const Epi& E) {
    int tid_l = threadIdx.x; asm volatile("" : "+v"(tid_l));
    const int tid = tid_l, wid = __builtin_amdgcn_readfirstlane(tid >> 6), lane = tid & 63, wr = wid >> 2, wc = wid & 3, fr = lane & 15, fq = lane >> 4;
    const int K = g.K, nt = K / BK;
    unsigned voffA[2], voffB[2];
#pragma unroll
    for (int i = 0; i < 2; ++i) { int R, C; stage_rc(tid * 16 + i * 8192, R, C); const int Rb = Epi::PERM ? ((R & ~31) + perm32(R & 31)) : R;
        voffA[i] = (unsigned)(R * K + C) * 2u; voffB[i] = (unsigned)(Rb * K + C) * 2u; }
    const size_t kstep = (size_t)(BK * 2);
    const size_t hstep = (size_t)HALF * K * 2;
    const size_t tstep = 2 * hstep;
    const unsigned ldsw = (unsigned)wid * 1024u;
    const int aoff = lds_byte(wr * 64 + fr, fq * 8), boff = lds_byte(wc * 32 + fr, fq * 8);
#define PG8_SA(b, h) (((b) * 2 + (h)) * HTB)
#define PG8_SB(b, h) ((4 + (b) * 2 + (h)) * HTB)
#define PG8_STAGE(bufoff, gbase, voff) do { _Pragma("unroll") for (int _i = 0; _i < 2; ++_i) \
        __builtin_amdgcn_global_load_lds((const unsigned*)((const char*)(gbase) + (voff)[_i]), (PG8_LAS unsigned*)(lds + (bufoff) + ldsw + _i * 8192), 16, 0, 0); } while (0)
#define PG8_LDA(dst, b, h) do { _Pragma("unroll") for (int m = 0; m < 4; ++m) _Pragma("unroll") for (int k = 0; k < 2; ++k) dst[m][k] = *(const PG8_LAS bf16x8*)(lds + PG8_SA(b, h) + aoff + m * 2048 + k * 1024); } while (0)
#define PG8_LDB(dst, b, h) do { _Pragma("unroll") for (int n = 0; n < 2; ++n) _Pragma("unroll") for (int k = 0; k < 2; ++k) dst[n][k] = *(const PG8_LAS bf16x8*)(lds + PG8_SB(b, h) + boff + n * 2048 + k * 1024); } while (0)
#define PG8_MMA(ai, bj, At, Bt) do { __builtin_amdgcn_s_setprio(1); _Pragma("unroll") for (int m = 0; m < 4; ++m) _Pragma("unroll") for (int n = 0; n < 2; ++n) _Pragma("unroll") for (int k = 0; k < 2; ++k) \
        acc[ai][bj][m][n] = __builtin_amdgcn_mfma_f32_16x16x32_bf16(Bt[n][k], At[m][k], acc[ai][bj][m][n], 0, 0, 0); __builtin_amdgcn_s_setprio(0); } while (0)
#define PG8_WAIT_V(n) asm volatile("s_waitcnt vmcnt(" #n ")" ::: "memory")
#define PG8_WAIT_L(n) asm volatile("s_waitcnt lgkmcnt(" #n ")" ::: "memory")
#define PG8_BAR __builtin_amdgcn_s_barrier()
#define PG8_SCHED __builtin_amdgcn_sched_barrier(0)
    Unit cur, nxt; int ui = 0;
    if (!S.next(0, cur)) return;
    f32x4 acc[2][2][4][2];
#pragma unroll
    for (int a = 0; a < 2; ++a)
#pragma unroll
        for (int b = 0; b < 2; ++b)
#pragma unroll
            for (int m = 0; m < 4; ++m)
#pragma unroll
                for (int n = 0; n < 2; ++n) acc[a][b][m][n] = (f32x4){0.f, 0.f, 0.f, 0.f};
    bf16x8 At[4][2], B0[2][2], B1[2][2];
    const char* cA = (const char*)g.A + (size_t)cur.pm * tstep; const char* cB = (const char*)g.Bt + (size_t)cur.pn * tstep;
    S.a_ready(cur);
    if constexpr (SP2) {
        PG8_STAGE(PG8_SB(0, 0), cB, voffB); PG8_STAGE(PG8_SB(0, 1), cB + hstep, voffB); PG8_STAGE(PG8_SA(0, 0), cA, voffA); PG8_STAGE(PG8_SA(0, 1), cA + hstep, voffA);
        if (wr == 1) PG8_BAR;
        PG8_WAIT_V(2); PG8_BAR;
        PG8_STAGE(PG8_SB(1, 0), cB + kstep, voffB); PG8_STAGE(PG8_SA(1, 0), cA + kstep, voffA); PG8_STAGE(PG8_SB(1, 1), cB + hstep + kstep, voffB);
        PG8_WAIT_V(6); PG8_BAR;
    } else {
        PG8_STAGE(PG8_SB(0, 0), cB, voffB); PG8_STAGE(PG8_SA(0, 0), cA, voffA); PG8_STAGE(PG8_SB(0, 1), cB + hstep, voffB); PG8_STAGE(PG8_SA(0, 1), cA + hstep, voffA);
        if (wr == 1) PG8_BAR;
        PG8_WAIT_V(4); PG8_BAR;
        PG8_STAGE(PG8_SB(1, 0), cB + kstep, voffB); PG8_STAGE(PG8_SA(1, 0), cA + kstep, voffA); PG8_STAGE(PG8_SB(1, 1), cB + hstep + kstep, voffB);
        PG8_WAIT_V(6); PG8_BAR;
    }
    for (;;) {
        const bool has_next = S.next(ui + 1, nxt);
        const char* nA = has_next ? (const char*)g.A + (size_t)nxt.pm * tstep : cA; const char* nB = has_next ? (const char*)g.Bt + (size_t)nxt.pn * tstep : cB;
        for (int t = 0; t < nt; t += 2) {
            const bool last = (t == nt - 2);
            const char* a1 = cA + (size_t)(t + 1) * kstep;
            const char* a2 = last ? nA : cA + (size_t)(t + 2) * kstep; const char* b2 = last ? nB : cB + (size_t)(t + 2) * kstep;
            const char* a3 = a2 + kstep; const char* b3 = b2 + kstep;
            if (last && has_next) S.a_ready(nxt);
            if constexpr (SP2) {
            PG8_LDB(B0, 0, 0); PG8_LDB(B1, 0, 1); PG8_SCHED; PG8_LDA(At, 0, 0); PG8_STAGE(PG8_SA(1, 1), a1 + hstep, voffA);
            PG8_WAIT_V(8); PG8_WAIT_L(0); PG8_BAR; PG8_MMA(0, 0, At, B0); PG8_MMA(0, 1, At, B1); PG8_BAR; PG8_SCHED;
            PG8_LDA(At, 0, 1); PG8_STAGE(PG8_SB(0, 0), b2, voffB); PG8_STAGE(PG8_SB(0, 1), b2 + hstep, voffB); PG8_STAGE(PG8_SA(0, 0), a2, voffA);
            PG8_WAIT_V(8); PG8_WAIT_L(0); PG8_BAR; PG8_MMA(1, 0, At, B0); PG8_MMA(1, 1, At, B1); PG8_BAR; PG8_SCHED;
            PG8_LDB(B0, 1, 0); PG8_LDB(B1, 1, 1); PG8_SCHED; PG8_LDA(At, 1, 0); PG8_STAGE(PG8_SA(0, 1), a2 + hstep, voffA);
            PG8_WAIT_V(8); PG8_WAIT_L(0); PG8_BAR; PG8_MMA(0, 0, At, B0); PG8_MMA(0, 1, At, B1); PG8_BAR; PG8_SCHED;
            PG8_LDA(At, 1, 1); PG8_STAGE(PG8_SB(1, 0), b3, voffB); PG8_STAGE(PG8_SB(1, 1), b3 + hstep, voffB); PG8_STAGE(PG8_SA(1, 0), a3, voffA);
            PG8_WAIT_V(8); PG8_WAIT_L(0); PG8_BAR; PG8_MMA(1, 0, At, B0); PG8_MMA(1, 1, At, B1); PG8_BAR; PG8_SCHED;
            } else {
            PG8_LDB(B0, 0, 0); PG8_SCHED; PG8_LDA(At, 0, 0); PG8_STAGE(PG8_SA(1, 1), a1 + hstep, voffA);
            PG8_WAIT_L(8); PG8_BAR; PG8_WAIT_L(0); PG8_MMA(0, 0, At, B0); PG8_BAR; PG8_SCHED;
            PG8_LDB(B1, 0, 1); PG8_STAGE(PG8_SB(0, 0), b2, voffB);
            PG8_BAR; PG8_WAIT_L(0); PG8_MMA(0, 1, At, B1); PG8_BAR;
            PG8_LDA(At, 0, 1); PG8_STAGE(PG8_SA(0, 0), a2, voffA);
            PG8_BAR; PG8_WAIT_L(0); PG8_MMA(1, 0, At, B0); PG8_BAR; PG8_SCHED;
            PG8_STAGE(PG8_SB(0, 1), b2 + hstep, voffB);
            PG8_WAIT_V(6); PG8_BAR; PG8_MMA(1, 1, At, B1); PG8_BAR;
            PG8_LDB(B0, 1, 0); PG8_SCHED; PG8_LDA(At, 1, 0); PG8_STAGE(PG8_SA(0, 1), a2 + hstep, voffA);
            PG8_WAIT_L(8); PG8_BAR; PG8_WAIT_L(0); PG8_MMA(0, 0, At, B0); PG8_BAR; PG8_SCHED;
            PG8_LDB(B1, 1, 1); PG8_STAGE(PG8_SB(1, 0), b3, voffB);
            PG8_BAR; PG8_WAIT_L(0); PG8_MMA(0, 1, At, B1); PG8_BAR;
            PG8_LDA(At, 1, 1); PG8_STAGE(PG8_SA(1, 0), a3, voffA);
            PG8_BAR; PG8_WAIT_L(0); PG8_MMA(1, 0, At, B0); PG8_BAR; PG8_SCHED;
            PG8_STAGE(PG8_SB(1, 1), b3 + hstep, voffB);
            PG8_WAIT_V(6); PG8_BAR; PG8_MMA(1, 1, At, B1); PG8_BAR;
            }
        }
        if constexpr (ALIGN_EPI) { if (wr == 0) PG8_BAR; }
        if constexpr (!Epi::AFTER_DRAIN) { E(acc, cur, wr, wc, fr, fq); S.done(cur); }
        if (!has_next) break;
#pragma unroll
        for (int a = 0; a < 2; ++a)
#pragma unroll
            for (int b = 0; b < 2; ++b)
#pragma unroll
                for (int m = 0; m < 4; ++m)
#pragma unroll
                    for (int n = 0; n < 2; ++n) acc[a][b][m][n] = (f32x4){0.f, 0.f, 0.f, 0.f};
        cur = nxt; cA = nA; cB = nB; ++ui;
        if constexpr (ALIGN_EPI) { if (wr == 1) PG8_BAR; }
    }
    PG8_WAIT_V(0);
    if constexpr (!ALIGN_EPI) { if (wr == 0) PG8_BAR; }
    PG8_BAR;
    if constexpr (Epi::AFTER_DRAIN) { E.fused(acc, cur, wr, wc, fr, fq, lds, wid, lane); S.done(cur); }
#undef PG8_SA
#undef PG8_SB
#undef PG8_STAGE
#undef PG8_LDA
#undef PG8_LDB
#undef PG8_MMA
#undef PG8_WAIT_V
#undef PG8_WAIT_L
#undef PG8_BAR
#undef PG8_SCHED
}
}

namespace pg8 {
struct OrderPM : StaticOrder {
    int pm0;
    __device__ __forceinline__ bool next(int i, Unit& u) const { if (!StaticOrder::next(i, u)) return false; u.pm += pm0; return true; }
};
struct MoeOrder {
    int nN, G, c, ntiles; const unsigned* tile_e;
    __device__ __forceinline__ bool next(int i, Unit& u) const {
        const long L = (long)i * G + c; if (L >= (long)ntiles * nN) return false;
        const int pm = (int)(L / nN), pl = (int)(L % nN);
        const int e = (int)__hip_atomic_load(tile_e + pm, __ATOMIC_RELAXED, __HIP_MEMORY_SCOPE_AGENT);
        u.pm = pm; u.pn = __builtin_amdgcn_readfirstlane(e) * nN + pl; return true;
    }
    __device__ __forceinline__ void a_ready(const Unit&) const {}
    __device__ __forceinline__ void done(const Unit&) const {}
};

struct EpiStore {
    static constexpr bool PERM = true, AFTER_DRAIN = false;
    bf16_t* O; int ldc; int pn_mod;
    __device__ __forceinline__ void operator()(const f32x4 (&acc)[2][2][4][2], const Unit& u, int wr, int wc, int fr, int fq) const {
        const int row0 = u.pm * BM + wr * 64 + fr, col0 = (u.pn % pn_mod) * BM + wc * 32 + 8 * fq;
#pragma unroll
        for (int ai = 0; ai < 2; ++ai)
#pragma unroll
            for (int m = 0; m < 4; ++m) { bf16_t* rowp = O + (size_t)(row0 + ai * HALF + m * 16) * ldc + col0;
#pragma unroll
                for (int bj = 0; bj < 2; ++bj) { const f32x4 v0 = acc[ai][bj][m][0], v1 = acc[ai][bj][m][1];
                    u32x4 w; w.x = cvt_pk_bf16(v0[0], v0[1]); w.y = cvt_pk_bf16(v0[2], v0[3]); w.z = cvt_pk_bf16(v1[0], v1[1]); w.w = cvt_pk_bf16(v1[2], v1[3]);
                    *(u32x4*)(rowp + bj * HALF) = w; } }
    }
};
struct EpiUp {
    static constexpr bool PERM = true, AFTER_DRAIN = false;
    bf16_t* Q; bf16_t* K;
    __device__ __forceinline__ void operator()(const f32x4 (&acc)[2][2][4][2], const Unit& u, int wr, int wc, int fr, int fq) const {
        const int row0 = u.pm * BM + wr * 64 + fr;
#pragma unroll
        for (int bj = 0; bj < 2; ++bj) {
            const int col = u.pn * BM + bj * HALF + wc * 32 + 8 * fq;
            bf16_t* base;
            if (col < 384) base = Q + col; else if (col < 640) { const int c2 = col - 384; base = K + (c2 >> 6) * 96 + (c2 & 63); } else continue;
#pragma unroll
            for (int ai = 0; ai < 2; ++ai)
#pragma unroll
                for (int m = 0; m < 4; ++m) { const f32x4 v0 = acc[ai][bj][m][0], v1 = acc[ai][bj][m][1];
                    u32x4 w; w.x = cvt_pk_bf16(v0[0], v0[1]); w.y = cvt_pk_bf16(v0[2], v0[3]); w.z = cvt_pk_bf16(v1[0], v1[1]); w.w = cvt_pk_bf16(v1[2], v1[3]);
                    *(u32x4*)(base + (size_t)(row0 + ai * HALF + m * 16) * 384) = w; }
        }
    }
};
struct EpiRes {
    static constexpr bool PERM = false, AFTER_DRAIN = false;
    float* H; const float* gate;
    __device__ __forceinline__ void operator()(const f32x4 (&acc)[2][2][4][2], const Unit& u, int wr, int wc, int fr, int fq) const {
        const int row0 = u.pm * BM + wr * 64 + fr, col0 = u.pn * BM + wc * 32 + 4 * fq;
        const int mb = (u.pm < 4) ? 4 : ((u.pm - 4) >> 4);
        const float* gp = gate + (size_t)mb * 6144 + col0;
        f32x4 gv[2][2];
#pragma unroll
        for (int bj = 0; bj < 2; ++bj)
#pragma unroll
            for (int n = 0; n < 2; ++n) gv[bj][n] = *(const f32x4*)(gp + bj * HALF + n * 16);
#pragma unroll
        for (int ai = 0; ai < 2; ++ai)
#pragma unroll
            for (int m = 0; m < 4; ++m) { float* rowp = H + (size_t)(row0 + ai * HALF + m * 16) * D + col0;
#pragma unroll
                for (int bj = 0; bj < 2; ++bj)
#pragma unroll
                    for (int n = 0; n < 2; ++n) { f32x4* p = (f32x4*)(rowp + bj * HALF + n * 16); *p = *p + gv[bj][n] * acc[ai][bj][m][n]; } }
    }
};
struct EpiSwiGLU {
    static constexpr bool PERM = true, AFTER_DRAIN = false;
    bf16_t* Hd;
    __device__ __forceinline__ void operator()(const f32x4 (&acc)[2][2][4][2], const Unit& u, int wr, int wc, int fr, int fq) const {
        const int row0 = u.pm * BM + wr * 64 + fr, col0 = (u.pn % 28) * HALF + wc * 32 + 8 * fq;
#pragma unroll
        for (int ai = 0; ai < 2; ++ai)
#pragma unroll
            for (int m = 0; m < 4; ++m) {
                float o[8];
#pragma unroll
                for (int n = 0; n < 2; ++n)
#pragma unroll
                    for (int q = 0; q < 4; ++q) { const float g = acc[ai][0][m][n][q], up = acc[ai][1][m][n][q]; o[n * 4 + q] = g / (1.f + __expf(-g)) * up; }
                u32x4 w; w.x = cvt_pk_bf16(o[0], o[1]); w.y = cvt_pk_bf16(o[2], o[3]); w.z = cvt_pk_bf16(o[4], o[5]); w.w = cvt_pk_bf16(o[6], o[7]);
                *(u32x4*)(Hd + (size_t)(row0 + ai * HALF + m * 16) * DFF + col0) = w; }
    }
};
}

enum { I_X = 0, I_C, I_CTX, I_CCTX, I_WMOD, I_BMOD, I_NORM1, I_NORM2, I_WIN, I_WOUT, I_SINK, I_GCONV, I_GALOG, I_GDTB, I_GNORM, I_QNORM, I_KVNORM, I_WQUP, I_WKVUP,
       I_RLOGD, I_RNORM, I_FGATE, I_FUP, I_FDOWN, I_ROUTER, I_MGATE, I_MUP, I_MDOWN, I_FNORM, N_IN };
struct Params { const float* in[N_IN]; float* out; unsigned char* ws; int ph_lo, ph_hi; };
typedef const __attribute__((address_space(4))) Params* KArg;
__device__ __forceinline__ KArg kp_get() { KArg k = (KArg)__builtin_amdgcn_kernarg_segment_ptr(); asm volatile("" : "+s"(k)); return k; }

struct Ctx {
    LAS unsigned char* lds; int tid, lane, wave, bid, G;
};

__device__ __forceinline__ void tr_item(const float* src, int ldsrc, int nvalid, int k0, int c0, bf16_t* dst, int ldd, int drow0, LAS float* scr, int lane) {
    const int n_ = lane & 31, cc = c0 + n_;
#pragma unroll 8
    for (int i = 0; i < 32; ++i) { const int kk = 2 * i + (lane >> 5); scr[kk * 33 + n_] = (cc < nvalid) ? src[(size_t)(k0 + kk) * ldsrc + cc] : 0.f; }
    asm volatile("s_waitcnt lgkmcnt(0)" ::: "memory");
    const int c = lane & 7;
#pragma unroll
    for (int j = 0; j < 4; ++j) { const int n = (lane >> 3) + 8 * j; const LAS float* s = scr + (8 * c) * 33 + n;
        u32x4 o; o.x = cvtpk(s[0 * 33], s[1 * 33]); o.y = cvtpk(s[2 * 33], s[3 * 33]); o.z = cvtpk(s[4 * 33], s[5 * 33]); o.w = cvtpk(s[6 * 33], s[7 * 33]);
        *(u32x4*)(dst + (size_t)(drow0 + n) * ldd + k0 + 8 * c) = o; }
    asm volatile("s_waitcnt lgkmcnt(0)" ::: "memory");
}
__device__ __forceinline__ void ffn_tr_item(const float* g, const float* u, const float* d, bf16_t* gu, bf16_t* dn, int it, LAS float* scr, int lane) {
    if (it < 3584) { const bool up = it >= 1792; const int r = up ? it - 1792 : it; const int kb = r / 112, cb = r % 112, c0 = 32 * cb;
        tr_item(up ? u : g, DFF, DFF, 64 * kb, c0, gu, 1024, 256 * (c0 >> 7) + (up ? 128 : 0) + (c0 & 127), scr, lane); }
    else { const int r = it - 3584; const int kb = r / 32, cb = r % 32; tr_item(d, 1024, 1024, 64 * kb, 32 * cb, dn, DFF, 32 * cb, scr, lane); }
}

__device__ __forceinline__ void prologue_phase(KArg p, const Ctx& C) {
    unsigned char* ws = p->ws;
    const int gw = C.bid * NWAVES + C.wave, NGW = C.G * NWAVES, gt = C.bid * NTHR + C.tid, NGT = C.G * NTHR;
    LAS float* scr = (LAS float*)(C.lds + C.wave * 8704);
    {
        constexpr int I_IN = 16 * 96, I_OUT = 16 * 32, I_FF = 5376;
        constexpr int NIT = 4 * (I_IN + I_OUT) + 2 * I_FF;
        for (int it = gw; it < NIT; it += NGW) {
            int r = it;
            if (r < 4 * I_IN) { const int l = r / I_IN; r %= I_IN; const int kb = r / 96, cb = r % 96;
                tr_item(p->in[I_WIN] + (size_t)l * D * DIN, DIN, DIN, 64 * kb, 32 * cb, (bf16_t*)(ws + WS_WIN) + (size_t)l * DINP * D, D, 32 * cb, scr, C.lane); continue; }
            r -= 4 * I_IN;
            if (r < 4 * I_OUT) { const int l = r / I_OUT; r %= I_OUT; const int kb = r / 32, cb = r % 32;
                tr_item(p->in[I_WOUT] + (size_t)l * D * D, D, D, 64 * kb, 32 * cb, (bf16_t*)(ws + WS_WOUT) + (size_t)l * D * D, D, 32 * cb, scr, C.lane); continue; }
            r -= 4 * I_OUT;
            { const int i = r / I_FF; r %= I_FF; bf16_t* gu = (bf16_t*)(ws + WS_WFF + (size_t)i * FFW_BYTES);
              ffn_tr_item(p->in[I_FGATE] + (size_t)i * D * DFF, p->in[I_FUP] + (size_t)i * D * DFF, p->in[I_FDOWN] + (size_t)i * DFF * D, gu, gu + (size_t)7168 * 1024, r, scr, C.lane); }
        }
    }
    {
        constexpr int PER_L = 256 * 128 + 1024 * 64 + 256 * 64;
        for (int it = gt; it < 4 * PER_L; it += NGT) {
            const int l = it / PER_L; int r = it % PER_L;
            const float* win = p->in[I_WIN] + (size_t)l * D * DIN; const float* qup = p->in[I_WQUP] + (size_t)l * 256 * 384; const float* kvup = p->in[I_WKVUP] + (size_t)l * 128 * 512;
            float v[8]; bf16_t* dst;
            if (r < 256 * 128) { const int n = r % 256, kg = r / 256;
#pragma unroll
                for (int j = 0; j < 8; ++j) v[j] = (n < 128) ? win[(size_t)(8 * kg + j) * DIN + PC_AV + n] : 0.f;
                dst = (bf16_t*)(ws + WS_WINV) + ((size_t)l * 256 + n) * 1024 + 8 * kg; }
            else if ((r -= 256 * 128) < 1024 * 64) { const int n = r % 1024, kg = r / 1024;
#pragma unroll
                for (int j = 0; j < 8; ++j) { const int k = 8 * kg + j; float x = 0.f;
                    if (n < 384) { if (k < 256) x = qup[(size_t)k * 384 + n]; }
                    else if (n < 640) { const int c2 = n - 384; if (k >= 256 && k < 384) x = kvup[(size_t)(k - 256) * 512 + 128 * (c2 >> 6) + (c2 & 63)]; }
                    v[j] = x; }
                dst = (bf16_t*)(ws + WS_WUP) + ((size_t)l * 1024 + n) * 512 + 8 * kg; }
            else { r -= 1024 * 64; const int n = r % 256, kg = r / 256;
#pragma unroll
                for (int j = 0; j < 8; ++j) { const int k = 8 * kg + j; v[j] = (k >= 256 && k < 384) ? kvup[(size_t)(k - 256) * 512 + 128 * (n >> 6) + 64 + (n & 63)] : 0.f; }
                dst = (bf16_t*)(ws + WS_WUPV) + ((size_t)l * 256 + n) * 512 + 8 * kg; }
            u32x4 o; o.x = cvtpk(v[0], v[1]); o.y = cvtpk(v[2], v[3]); o.z = cvtpk(v[4], v[5]); o.w = cvtpk(v[6], v[7]);
            *(u32x4*)dst = o;
        }
    }
    {
        float* tab = (float*)(ws + WS_TAB);
        for (int it = gt; it < 64 * 16 + 64 * 8; it += NGT) {
            if (it < 1024) { const int pos = it >> 4, j = it & 15; const float inv = (float)pow(10000.0, -(double)j / 16.0); const float ang = (float)pos * inv;
                tab[it] = (float)cos((double)ang); tab[1024 + it] = (float)sin((double)ang); }
            else { const int r = it - 1024; const int pos = r >> 3, j = r & 7; const float inv = (float)pow(10000.0, -(double)j / 8.0); const float ang = (float)pos * inv;
                tab[2048 + r] = (float)cos((double)ang); tab[2560 + r] = (float)sin((double)ang); }
        }
    }
    {
        f32x4* H4 = (f32x4*)(ws + WS_H); const f32x4* x4 = (const f32x4*)p->in[I_X]; const f32x4* c4 = (const f32x4*)p->in[I_CTX];
        for (int it = gt; it < MT * 256; it += NGT) H4[it] = (it < MC * 256) ? c4[it] : x4[it - MC * 256];
    }
    __syncthreads();
    if (C.bid < 192) {
        LAS float* sl = (LAS float*)C.lds;
        LAS float* red = (LAS float*)(C.lds + 20480);
        for (int i = C.tid; i < 5 * 1024; i += NTHR) { const int r = i >> 10, k = i & 1023; const float cv = (r < 4) ? p->in[I_C][r * 1024 + k] : p->in[I_CCTX][k]; sl[i] = silu_f(cv); }
        __syncthreads();
        for (int it = C.bid; it < 192; it += C.G) {
            const int l = it / 48, cb = it % 48, cl = C.tid & 127, kq = C.tid >> 7, col = cb * 128 + cl;
            const float* w = p->in[I_WMOD] + (size_t)l * D * 6144 + col;
            float a0 = 0.f, a1 = 0.f, a2 = 0.f, a3 = 0.f, a4 = 0.f;
#pragma unroll 8
            for (int k = 256 * kq; k < 256 * kq + 256; ++k) { const float wv = w[(size_t)k * 6144]; a0 += sl[k] * wv; a1 += sl[1024 + k] * wv; a2 += sl[2048 + k] * wv; a3 += sl[3072 + k] * wv; a4 += sl[4096 + k] * wv; }
            red[(kq * 5 + 0) * 128 + cl] = a0; red[(kq * 5 + 1) * 128 + cl] = a1; red[(kq * 5 + 2) * 128 + cl] = a2; red[(kq * 5 + 3) * 128 + cl] = a3; red[(kq * 5 + 4) * 128 + cl] = a4;
            __syncthreads();
            for (int i = C.tid; i < 5 * 128; i += NTHR) { const int r = i >> 7, c2 = i & 127; const int cc = cb * 128 + c2;
                const float s = red[(0 * 5 + r) * 128 + c2] + red[(1 * 5 + r) * 128 + c2] + red[(2 * 5 + r) * 128 + c2] + red[(3 * 5 + r) * 128 + c2] + p->in[I_BMOD][l * 6144 + cc];
                ((float*)(ws + WS_MOD))[((size_t)l * 5 + r) * 6144 + cc] = s; }
            __syncthreads();
        }
    }
}
__device__ __forceinline__ void moe_convert_phase(KArg p, const Ctx& C, int i) {
    const int gw = C.bid * NWAVES + C.wave, NGW = C.G * NWAVES;
    LAS float* scr = (LAS float*)(C.lds + C.wave * 8704);
    for (int it = gw; it < 8 * 5376; it += NGW) { const int e = it / 5376, r = it % 5376; const size_t eo = (size_t)i * NE + e;
        bf16_t* gu = (bf16_t*)(p->ws + WS_WMOE) + (size_t)e * 7168 * 1024; bf16_t* dn = (bf16_t*)(p->ws + WS_WMOE) + (size_t)8 * 7168 * 1024 + (size_t)e * 1024 * DFF;
        ffn_tr_item(p->in[I_MGATE] + eo * D * DFF, p->in[I_MUP] + eo * D * DFF, p->in[I_MDOWN] + eo * DFF * D, gu, dn, r, scr, C.lane); }
}

template <int MODE>
__device__ __forceinline__ void norm_phase(KArg p, const Ctx& C, int l, bool comb, int lprev, bool moe, int row_min) {
    unsigned char* ws = p->ws;
    float* H = (float*)(ws + WS_H); bf16_t* U = (bf16_t*)(ws + WS_U); const float* MOD = (const float*)(ws + WS_MOD);
    int* RE = (int*)(ws + WS_ROUTE); float* RW = (float*)(ws + WS_ROUTE + (size_t)MT * 8); const int* RP = (const int*)(ws + WS_ROUTE + (size_t)MT * 16);
    const bf16_t* YD = (const bf16_t*)(ws + WS_YD);
    LAS unsigned* lcnt = (LAS unsigned*)C.lds;
    if (MODE == 1 && moe) { if (C.tid < 8) lcnt[C.tid] = 0u; __syncthreads(); }
    const int rbase = (MT / 256) * C.bid;
    for (int ri = C.wave; ri < MT / 256; ri += NWAVES) {
        const int row = rbase + ri; if (row < row_min) continue;
        const int mb = mod_row(row);
        f32x4 v[4];
#pragma unroll
        for (int j = 0; j < 4; ++j) v[j] = *(const f32x4*)(H + (size_t)row * D + 4 * C.lane + 256 * j);
        if (comb) {
            const int p0 = RP[row * 2], p1 = RP[row * 2 + 1]; const float w0 = RW[row * 2], w1 = RW[row * 2 + 1];
            const float* g2 = MOD + ((size_t)lprev * 5 + mb) * 6144 + 5 * 1024;
#pragma unroll
            for (int j = 0; j < 4; ++j) { const int e = 4 * C.lane + 256 * j;
                const u32x2 y0 = *(const u32x2*)(YD + (size_t)p0 * D + e), y1 = *(const u32x2*)(YD + (size_t)p1 * D + e); const f32x4 g = *(const f32x4*)(g2 + e);
                v[j].x += g.x * (w0 * bf_lo(y0.x) + w1 * bf_lo(y1.x)); v[j].y += g.y * (w0 * bf_hi(y0.x) + w1 * bf_hi(y1.x));
                v[j].z += g.z * (w0 * bf_lo(y0.y) + w1 * bf_lo(y1.y)); v[j].w += g.w * (w0 * bf_hi(y0.y) + w1 * bf_hi(y1.y));
                if (MODE != 2) *(f32x4*)(H + (size_t)row * D + e) = v[j]; }
        }
        float ss = 0.f;
#pragma unroll
        for (int j = 0; j < 4; ++j) ss += (v[j].x * v[j].x + v[j].y * v[j].y) + (v[j].z * v[j].z + v[j].w * v[j].w);
        const float rstd = rsqrtf(wave_sum(ss) * (1.f / D) + EPS);
        if (MODE == 2) {
            const float* gam = p->in[I_FNORM];
#pragma unroll
            for (int j = 0; j < 4; ++j) { const int e = 4 * C.lane + 256 * j; const f32x4 g = *(const f32x4*)(gam + e); *(f32x4*)(p->out + (size_t)(row - MC) * D + e) = v[j] * rstd * g; }
        } else {
            const float* gam = p->in[MODE == 0 ? I_NORM1 : I_NORM2] + (size_t)l * D;
            const float* sh = MOD + ((size_t)l * 5 + mb) * 6144 + (MODE == 0 ? 0 : 3) * 1024; const float* sc = sh + 1024;
            f32x4 y[4];
#pragma unroll
            for (int j = 0; j < 4; ++j) { const int e = 4 * C.lane + 256 * j; const f32x4 g = *(const f32x4*)(gam + e), s1 = *(const f32x4*)(sc + e), s0 = *(const f32x4*)(sh + e);
                y[j] = v[j] * rstd * g * (1.f + s1) + s0;
                u32x2 o; o.x = cvtpk(y[j].x, y[j].y); o.y = cvtpk(y[j].z, y[j].w); *(u32x2*)(U + (size_t)row * D + e) = o; }
            if (MODE == 1 && moe) {
                const float* wr = p->in[I_ROUTER] + (size_t)(l >> 1) * D * NE;
                float lg[8];
#pragma unroll
                for (int e = 0; e < 8; ++e) lg[e] = 0.f;
#pragma unroll
                for (int j = 0; j < 4; ++j)
#pragma unroll
                    for (int q = 0; q < 4; ++q) { const int e = 4 * C.lane + 256 * j + q; const f32x4 wa = *(const f32x4*)(wr + (size_t)e * 8), wb = *(const f32x4*)(wr + (size_t)e * 8 + 4); const float yv = y[j][q];
                        lg[0] += yv * wa.x; lg[1] += yv * wa.y; lg[2] += yv * wa.z; lg[3] += yv * wa.w; lg[4] += yv * wb.x; lg[5] += yv * wb.y; lg[6] += yv * wb.z; lg[7] += yv * wb.w; }
#pragma unroll
                for (int e = 0; e < 8; ++e) lg[e] = wave_sum(lg[e]);
                int e0 = 0; float v0 = lg[0];
#pragma unroll
                for (int e = 1; e < 8; ++e) if (lg[e] > v0) { v0 = lg[e]; e0 = e; }
                int e1 = -1; float v1 = -3.0e38f;
#pragma unroll
                for (int e = 0; e < 8; ++e) if (e != e0 && lg[e] > v1) { v1 = lg[e]; e1 = e; }
                const float t = __expf(v1 - v0), w0 = 1.f / (1.f + t), w1 = t * w0;
                if (C.lane == 0) { RE[row * 2] = e0; RE[row * 2 + 1] = e1; RW[row * 2] = w0; RW[row * 2 + 1] = w1; atomicAdd((unsigned*)&lcnt[e0], 1u); atomicAdd((unsigned*)&lcnt[e1], 1u); }
            }
        }
    }
    if (MODE == 1 && moe) { __syncthreads(); if (C.tid < 8) __hip_atomic_store((unsigned*)(ws + WS_CTL) + CW_CNT + C.bid * 8 + C.tid, lcnt[C.tid], __ATOMIC_RELAXED, __HIP_MEMORY_SCOPE_AGENT); }
}

__device__ __forceinline__ void moe_gather_phase(KArg p, const Ctx& C, int row_min) {
    unsigned char* ws = p->ws;
    unsigned* ctl = (unsigned*)(ws + WS_CTL);
    const int* RE = (const int*)(ws + WS_ROUTE); int* RP = (int*)(ws + WS_ROUTE + (size_t)MT * 16);
    const bf16_t* U = (const bf16_t*)(ws + WS_U); bf16_t* AS = (bf16_t*)(ws + WS_ASORT);
    LAS unsigned* cn = (LAS unsigned*)C.lds;
    LAS int* myoff = (LAS int*)(C.lds + 8192);
    LAS int* base = (LAS int*)(C.lds + 8192 + 64);
    LAS int* pos = (LAS int*)(C.lds + 8192 + 128);
    for (int i = C.tid; i < 2048; i += NTHR) cn[i] = __hip_atomic_load(ctl + CW_CNT + i, __ATOMIC_RELAXED, __HIP_MEMORY_SCOPE_AGENT);
    __syncthreads();
    if (C.tid < 8) { int tot = 0, mine = 0; for (int b = 0; b < 256; ++b) { const int c = (int)cn[b * 8 + C.tid]; if (b < C.bid) mine += c; tot += c; } myoff[C.tid] = mine; base[C.tid] = (tot + 255) & ~255; }
    __syncthreads();
    if (C.tid == 0) {
        int b0 = 0; for (int e = 0; e < 8; ++e) { const int t = base[e]; base[e] = b0; myoff[e] += b0; b0 += t; } base[8] = b0;
        const int rbase = (MT / 256) * C.bid;
        for (int ri = 0; ri < MT / 256; ++ri) { const int row = rbase + ri; if (row < row_min) { pos[ri * 2] = -1; pos[ri * 2 + 1] = -1; continue; }
            for (int k = 0; k < 2; ++k) { const int e = RE[row * 2 + k]; const int ps = myoff[e]++; pos[ri * 2 + k] = ps; RP[row * 2 + k] = ps; } }
    }
    __syncthreads();
    if (C.bid == 0) {
        const int ntiles = base[8] >> 8;
        if (C.tid < MOE_TILES) { int e = 0; for (int q = 1; q < 8; ++q) if (C.tid * 256 >= base[q]) e = q; __hip_atomic_store(ctl + CW_TILEE + C.tid, (unsigned)e, __ATOMIC_RELAXED, __HIP_MEMORY_SCOPE_AGENT); }
        if (C.tid == 0) __hip_atomic_store(ctl + CW_TILEE + 160, (unsigned)ntiles, __ATOMIC_RELAXED, __HIP_MEMORY_SCOPE_AGENT);
    }
    const int rbase = (MT / 256) * C.bid;
    for (int it = C.tid; it < (MT / 256) * 2 * 128; it += NTHR) { const int slot = it >> 7, ch = it & 127; const int ps = pos[slot]; if (ps < 0) continue;
        *(u32x4*)(AS + (size_t)ps * D + 8 * ch) = *(const u32x4*)(U + (size_t)(rbase + (slot >> 1)) * D + 8 * ch); }
}

__device__ __forceinline__ void prep_phase(KArg p, const Ctx& C, int l) {
    unsigned char* ws = p->ws;
    const bf16_t* P = (const bf16_t*)(ws + WS_P); bf16_t* QS = (bf16_t*)(ws + WS_QS); bf16_t* KS = (bf16_t*)(ws + WS_KS); bf16_t* AUP = (bf16_t*)(ws + WS_AUP); bf16_t* KF = (bf16_t*)(ws + WS_KFULL);
    const float* tab = (const float*)(ws + WS_TAB);
    const float* qg = p->in[I_QNORM] + (size_t)l * 256; const float* kvg = p->in[I_KVNORM] + (size_t)l * 128;
    const int gw = C.bid * NWAVES + C.wave, NGW = C.G * NWAVES, lane = C.lane;
    for (int row = gw; row < MT; row += NGW) {
        const bf16_t* pr = P + (size_t)row * DINP;
        const bool lat = row >= MC; const int t = (row - MC) & 4095, prow = t >> 6, pcol = t & 63;
        {
            const int hd = lane >> 4, j = lane & 15;
            float c_r = 1.f, s_r = 0.f, c_c = 1.f, s_c = 0.f;
            if (lat) { c_r = tab[prow * 16 + j]; s_r = tab[1024 + prow * 16 + j]; c_c = tab[pcol * 16 + j]; s_c = tab[1024 + pcol * 16 + j]; }
            { const bf16_t* q = pr + PC_AQ + hd * 64; const float x1 = bf2f(q[j]), x2 = bf2f(q[16 + j]), x3 = bf2f(q[32 + j]), x4 = bf2f(q[48 + j]); const float qs = 0.125f * LOG2E;
              bf16_t* o = QS + (size_t)row * 256 + hd * 64;
              o[j] = f2bf((x1 * c_r - x2 * s_r) * qs); o[16 + j] = f2bf((x2 * c_r + x1 * s_r) * qs); o[32 + j] = f2bf((x3 * c_c - x4 * s_c) * qs); o[48 + j] = f2bf((x4 * c_c + x3 * s_c) * qs); }
            if (lane < 32) { const bf16_t* k = pr + PC_AK + hd * 64; const float x1 = bf2f(k[j]), x2 = bf2f(k[16 + j]), x3 = bf2f(k[32 + j]), x4 = bf2f(k[48 + j]);
              bf16_t* o = KS + (size_t)row * 128 + hd * 64;
              o[j] = f2bf(x1 * c_r - x2 * s_r); o[16 + j] = f2bf(x2 * c_r + x1 * s_r); o[32 + j] = f2bf(x3 * c_c - x4 * s_c); o[48 + j] = f2bf(x4 * c_c + x3 * s_c); }
        }
        {
            const u32x2 a = *(const u32x2*)(pr + PC_CQ + 4 * lane); const float q0 = bf_lo(a.x), q1 = bf_hi(a.x), q2 = bf_lo(a.y), q3 = bf_hi(a.y);
            const float rq = rsqrtf(wave_sum(q0 * q0 + q1 * q1 + q2 * q2 + q3 * q3) * (1.f / 256.f) + EPS);
            const f32x4 g = *(const f32x4*)(qg + 4 * lane);
            u32x2 o; o.x = cvtpk(q0 * rq * g.x, q1 * rq * g.y); o.y = cvtpk(q2 * rq * g.z, q3 * rq * g.w); *(u32x2*)(AUP + (size_t)row * 512 + 4 * lane) = o;
            const unsigned b = *(const unsigned*)(pr + PC_CKV + 2 * lane); const float k0 = bf_lo(b), k1 = bf_hi(b);
            const float rk = rsqrtf(wave_sum(k0 * k0 + k1 * k1) * (1.f / 128.f) + EPS);
            const f32x2 g2 = *(const f32x2*)(kvg + 2 * lane);
            *(unsigned*)(AUP + (size_t)row * 512 + 256 + 2 * lane) = cvtpk(k0 * rk * g2.x, k1 * rk * g2.y);
            *(unsigned*)(AUP + (size_t)row * 512 + 384 + 2 * lane) = 0u;
        }
        if (lane < 16) {
            const int part = lane >> 3, j = lane & 7; const float xa = bf2f(pr[PC_CKR + 16 * part + j]), xb = bf2f(pr[PC_CKR + 16 * part + 8 + j]);
            float cs = 1.f, sn = 0.f; if (lat) { const int ps = part ? pcol : prow; cs = tab[2048 + ps * 8 + j]; sn = tab[2560 + ps * 8 + j]; }
            const bf16_t oa = f2bf(xa * cs - xb * sn), ob = f2bf(xb * cs + xa * sn);
#pragma unroll
            for (int h = 0; h < 4; ++h) { bf16_t* o = KF + (size_t)row * 384 + h * 96 + 64 + 16 * part; o[j] = oa; o[8 + j] = ob; }
        }
    }
}

struct AttnArgs {
    const bf16_t* Q; int q_pitch, q_col0, q_row0;
    const bf16_t* K; int k_pitch, k_col0;
    const bf16_t* Vt; int vt_row0;
    int seg_tok0, seg_nt0, seg_tok1, seg_nt1;
    int qpos0, kpos0;
    float m_init, l_init, qscale;
    bf16_t* O; int o_col0;
    const float* tab32; int qt0;
};
template <int DQK, bool MASK, bool ROPEQ>
__device__ __forceinline__ void attn_unit(const Ctx& C, const AttnArgs& a) {
    constexpr int KP = DQK + 8, NCH = DQK / 8, KT_BYTES = 64 * KP * 2, VP = 68, VT_BYTES = 64 * VP * 2, BUF = KT_BYTES + VT_BYTES, NKS = DQK / 16;
    LAS unsigned char* lds = C.lds;
    const int lane = C.lane, c = lane & 31, hi = lane >> 5, w = C.wave, tid = C.tid;
    const int qi = 32 * w + c;
    bf16x8 qf[NKS];
    {
        const bf16_t* qp = a.Q + (size_t)(a.q_row0 + qi) * a.q_pitch + a.q_col0;
#pragma unroll
        for (int ks = 0; ks < NKS; ++ks) {
            const u32x4 raw = *(const u32x4*)(qp + 16 * ks + 8 * hi);
            float f[8] = {bf_lo(raw.x), bf_hi(raw.x), bf_lo(raw.y), bf_hi(raw.y), bf_lo(raw.z), bf_hi(raw.z), bf_lo(raw.w), bf_hi(raw.w)};
            if (ROPEQ && ks >= 4) {
                const u32x4 ro = *(const u32x4*)(qp + 16 * ks + 8 * (1 - hi));
                const float g[8] = {bf_lo(ro.x), bf_hi(ro.x), bf_lo(ro.y), bf_hi(ro.y), bf_lo(ro.z), bf_hi(ro.z), bf_lo(ro.w), bf_hi(ro.w)};
                const int t = a.qt0 + qi, ps = (ks == 4) ? (t >> 6) : (t & 63);
#pragma unroll
                for (int j = 0; j < 8; ++j) { const float cs = a.tab32[ps * 8 + j], sn = a.tab32[512 + ps * 8 + j]; f[j] = hi ? (f[j] * cs + g[j] * sn) : (f[j] * cs - g[j] * sn); }
            }
            qf[ks] = mk_frag4(cvtpk(f[0] * a.qscale, f[1] * a.qscale), cvtpk(f[2] * a.qscale, f[3] * a.qscale), cvtpk(f[4] * a.qscale, f[5] * a.qscale), cvtpk(f[6] * a.qscale, f[7] * a.qscale));
        }
    }
    f32x16 o0, o1;
#pragma unroll
    for (int r = 0; r < 16; ++r) { o0[r] = 0.f; o1[r] = 0.f; }
    float m = a.m_init, l = a.l_init;
    const int NT = a.seg_nt0 + a.seg_nt1;
    u32x4 kst[2]; u32x4 vst;
    auto tile_tok = [&](int t) { return t < a.seg_nt0 ? a.seg_tok0 + 64 * t : a.seg_tok1 + 64 * (t - a.seg_nt0); };
    auto g_load = [&](int t) {
        const int tk = tile_tok(t);
#pragma unroll
        for (int i = 0; i < 2; ++i) { const int ch = tid + 512 * i; if (ch < 64 * NCH) { const int r = ch / NCH, c8 = ch % NCH; kst[i] = *(const u32x4*)(a.K + (size_t)(tk + r) * a.k_pitch + a.k_col0 + 8 * c8); } }
        { const int r = tid >> 3, c8 = tid & 7; vst = *(const u32x4*)(a.Vt + (size_t)(a.vt_row0 + r) * MT + tk + 8 * c8); }
    };
    auto l_store = [&](int b) {
        LAS unsigned char* kb = lds + b * BUF; LAS unsigned char* vb = kb + KT_BYTES;
#pragma unroll
        for (int i = 0; i < 2; ++i) { const int ch = tid + 512 * i; if (ch < 64 * NCH) { const int r = ch / NCH, c8 = ch % NCH; *(LAS u32x4*)(kb + r * (KP * 2) + 16 * c8) = kst[i]; } }
        { const int r = tid >> 3, c8 = tid & 7; LAS u32x2* d = (LAS u32x2*)(vb + r * (VP * 2) + 16 * c8); u32x2 lo, hi2; lo.x = vst.x; lo.y = vst.y; hi2.x = vst.z; hi2.y = vst.w; d[0] = lo; d[1] = hi2; }
    };
    __syncthreads();
    g_load(0); l_store(0);
    __syncthreads();
    for (int t = 0; t < NT; ++t) {
        const int b = t & 1;
        if (t + 1 < NT) g_load(t + 1);
        LAS unsigned char* kb = lds + b * BUF; LAS unsigned char* vb = kb + KT_BYTES;
        f32x16 s0, s1;
#pragma unroll
        for (int r = 0; r < 16; ++r) { s0[r] = 0.f; s1[r] = 0.f; }
#pragma unroll
        for (int ks = 0; ks < NKS; ++ks) {
            const bf16x8 k0 = *(const LAS bf16x8*)(kb + c * (KP * 2) + 32 * ks + 16 * hi);
            const bf16x8 k1 = *(const LAS bf16x8*)(kb + (32 + c) * (KP * 2) + 32 * ks + 16 * hi);
            s0 = mfma32(k0, qf[ks], s0); s1 = mfma32(k1, qf[ks], s1);
        }
        if (MASK && t >= a.seg_nt0) {
            const int qpos = a.qpos0 + qi, kbase = a.kpos0 + 64 * (t - a.seg_nt0);
#pragma unroll
            for (int r = 0; r < 16; ++r) { const int k0p = kbase + crow(r, hi), d0 = qpos - k0p, d1 = d0 - 32;
                if (d0 > 128 || d0 < -128) s0[r] = -1e30f; if (d1 > 128 || d1 < -128) s1[r] = -1e30f; }
        }
        float mx = s0[0];
#pragma unroll
        for (int r = 1; r < 16; ++r) mx = fmaxf(mx, s0[r]);
#pragma unroll
        for (int r = 0; r < 16; ++r) mx = fmaxf(mx, s1[r]);
        mx = fmaxf(mx, __shfl_xor(mx, 32));
        const float mn = fmaxf(m, mx), alpha = exp2f(m - mn); m = mn;
        float ls = 0.f;
#pragma unroll
        for (int r = 0; r < 16; ++r) { s0[r] = exp2f(s0[r] - mn); s1[r] = exp2f(s1[r] - mn); ls += s0[r] + s1[r]; }
        ls += __shfl_xor(ls, 32);
        l = l * alpha + ls;
#pragma unroll
        for (int r = 0; r < 16; ++r) { o0[r] *= alpha; o1[r] *= alpha; }
        bf16x8 pf[2][2];
#pragma unroll
        for (int s2 = 0; s2 < 2; ++s2) {
            pf[0][s2] = mk_frag4(cvtpk(s0[8 * s2 + 0], s0[8 * s2 + 1]), cvtpk(s0[8 * s2 + 2], s0[8 * s2 + 3]), cvtpk(s0[8 * s2 + 4], s0[8 * s2 + 5]), cvtpk(s0[8 * s2 + 6], s0[8 * s2 + 7]));
            pf[1][s2] = mk_frag4(cvtpk(s1[8 * s2 + 0], s1[8 * s2 + 1]), cvtpk(s1[8 * s2 + 2], s1[8 * s2 + 3]), cvtpk(s1[8 * s2 + 4], s1[8 * s2 + 5]), cvtpk(s1[8 * s2 + 6], s1[8 * s2 + 7]));
        }
#pragma unroll
        for (int kt = 0; kt < 2; ++kt)
#pragma unroll
            for (int s2 = 0; s2 < 2; ++s2) {
                const int ko = (32 * kt + 16 * s2 + 4 * hi) * 2;
                const LAS unsigned char* v0p = vb + c * (VP * 2) + ko; const LAS unsigned char* v1p = vb + (32 + c) * (VP * 2) + ko;
                const bf16x8 v0 = mk_frag(*(const LAS u32x2*)v0p, *(const LAS u32x2*)(v0p + 16));
                const bf16x8 v1 = mk_frag(*(const LAS u32x2*)v1p, *(const LAS u32x2*)(v1p + 16));
                o0 = mfma32(v0, pf[kt][s2], o0); o1 = mfma32(v1, pf[kt][s2], o1);
            }
        if (t + 1 < NT) l_store(b ^ 1);
        __syncthreads();
    }
    const float inv = 1.f / l;
    bf16_t* op = a.O + (size_t)(a.q_row0 + qi) * D + a.o_col0;
#pragma unroll
    for (int g = 0; g < 4; ++g) {
        u32x2 w0, w1;
        w0.x = cvtpk(o0[4 * g] * inv, o0[4 * g + 1] * inv); w0.y = cvtpk(o0[4 * g + 2] * inv, o0[4 * g + 3] * inv);
        w1.x = cvtpk(o1[4 * g] * inv, o1[4 * g + 1] * inv); w1.y = cvtpk(o1[4 * g + 2] * inv, o1[4 * g + 3] * inv);
        *(u32x2*)(op + 8 * g + 4 * hi) = w0; *(u32x2*)(op + 32 + 8 * g + 4 * hi) = w1;
    }
}

__device__ __forceinline__ void attn_dispatch(KArg p, const Ctx& C, int l, int u) {
    unsigned char* ws = p->ws;
    AttnArgs a;
    a.tab32 = (const float*)(ws + WS_TAB) + 2048; a.O = (bf16_t*)(ws + WS_MIX);
    if (u < 256 || (u >= 512 && u < 528)) {
        const bool ctxq = u >= 512; const int v = ctxq ? u - 512 : u;
        const int b = ctxq ? (v >> 2) : (v >> 6), h = ctxq ? (v & 3) : ((v >> 4) & 3), qb = ctxq ? 0 : (v & 15);
        a.Q = (const bf16_t*)(ws + WS_QRAW); a.q_pitch = 384; a.q_col0 = 96 * h; a.q_row0 = ctxq ? 256 * b : MC + 4096 * b + 256 * qb;
        a.K = (const bf16_t*)(ws + WS_KFULL); a.k_pitch = 384; a.k_col0 = 96 * h; a.Vt = (const bf16_t*)(ws + WS_VTM); a.vt_row0 = 64 * h;
        a.seg_tok0 = 256 * b; a.seg_nt0 = 4; a.seg_tok1 = MC + 4096 * b; a.seg_nt1 = ctxq ? 0 : 64; a.qpos0 = 0; a.kpos0 = 0;
        a.m_init = -1e30f; a.l_init = 0.f; a.qscale = 0.10206207261596575f * LOG2E; a.o_col0 = 512 + 64 * h; a.qt0 = 256 * qb;
        if (ctxq) attn_unit<96, false, false>(C, a); else attn_unit<96, false, true>(C, a);
    } else {
        const bool ctxq = u >= 528; const int v = ctxq ? u - 528 : u - 256;
        const int b = ctxq ? (v >> 2) : (v >> 6), hq = ctxq ? (v & 3) : ((v >> 4) & 3), qb = ctxq ? 0 : (v & 15), g = hq >> 1;
        a.Q = (const bf16_t*)(ws + WS_QS); a.q_pitch = 256; a.q_col0 = 64 * hq; a.q_row0 = ctxq ? 256 * b : MC + 4096 * b + 256 * qb;
        a.K = (const bf16_t*)(ws + WS_KS); a.k_pitch = 128; a.k_col0 = 64 * g; a.Vt = (const bf16_t*)(ws + WS_VTS); a.vt_row0 = 64 * g;
        const int q0 = 256 * qb, ks = q0 - 128 < 0 ? 0 : q0 - 128, ke = q0 + 384 > SEQ ? SEQ : q0 + 384;
        a.seg_tok0 = 256 * b; a.seg_nt0 = 4; a.seg_tok1 = MC + 4096 * b + ks; a.seg_nt1 = ctxq ? 0 : (ke - ks) >> 6; a.qpos0 = q0; a.kpos0 = ks;
        a.m_init = p->in[I_SINK][l * 4 + hq] * LOG2E; a.l_init = 1.f; a.qscale = 1.f; a.o_col0 = 64 * hq; a.qt0 = 0;
        if (ctxq) attn_unit<64, false, false>(C, a); else attn_unit<64, true, false>(C, a);
    }
}

template <class FA, class FB>
__device__ __forceinline__ f32x16 lds_mma64(int lane, FA fa, FB fb) {
    const int c = lane & 31, hi = lane >> 5;
    f32x16 acc;
#pragma unroll
    for (int r = 0; r < 16; ++r) acc[r] = 0.f;
#pragma unroll
    for (int s = 0; s < 4; ++s) {
        float av[8], bv[8];
#pragma unroll
        for (int j = 0; j < 8; ++j) { const int k = 16 * s + 8 * hi + j; av[j] = fa(c, k); bv[j] = fb(k, c); }
        acc = mfma32(mk_frag4(cvtpk(av[0], av[1]), cvtpk(av[2], av[3]), cvtpk(av[4], av[5]), cvtpk(av[6], av[7])),
                     mk_frag4(cvtpk(bv[0], bv[1]), cvtpk(bv[2], bv[3]), cvtpk(bv[4], bv[5]), cvtpk(bv[6], bv[7])), acc);
    }
    return acc;
}
__device__ __forceinline__ void lds_barrier() { asm volatile("s_waitcnt lgkmcnt(0)" ::: "memory"); __builtin_amdgcn_s_barrier(); asm volatile("" ::: "memory"); }
__device__ __forceinline__ int su_index(int d, int b, int h, int cg) {
    const int s = cg < 4 ? (d ? 3 - cg : cg) : 4 + (d ? 63 - (cg - 4) : (cg - 4));
    return ((d * 4 + b) * 4 + h) * 68 + s;
}
constexpr int XP = 65;

__device__ __forceinline__ void gdn_chunk_unit(KArg p, const Ctx& C, int l, int b, int h, int cg) {
    unsigned char* ws = p->ws; const bf16_t* P = (const bf16_t*)(ws + WS_P);
    int tid_l = C.tid; asm volatile("" : "+v"(tid_l));
    const int tid = tid_l, lane = tid & 63, w = __builtin_amdgcn_readfirstlane(tid >> 6);
    LAS float* xq = (LAS float*)C.lds; LAS float* xk = xq + 64 * XP; LAS float* xv = xk + 64 * XP;
    LAS float* KK = xv + 64 * XP; LAS float* QK = KK + 64 * XP;
    LAS float* Lt = QK + 64 * XP;
    LAS float* gcs = Lt + 2 * 64 * 68; LAS float* bts = gcs + 128; LAS float* egs = bts + 128; LAS float* cw = egs + 128;
    LAS float* raw = KK;
    LAS float* X = xq;
    const int seq0 = cg < 4 ? 256 * b : MC + 4096 * b, seqlen = cg < 4 ? 256 : 4096, t0 = cg < 4 ? 64 * cg : 64 * (cg - 4);
    bf16_t ab_a = 0, ab_b = 0;
    if (w < 2) { const int tau = w ? 63 - lane : lane; const bf16_t* pr = P + (size_t)(seq0 + t0 + tau) * DINP + PC_BAB + w * 8 + h; ab_a = pr[0]; ab_b = pr[4]; }
    lds_barrier();
    for (int it = tid; it < 68 * 24; it += NTHR) { const int r = it / 24, ch = it % 24, t = t0 - 2 + r; const int part = ch >> 3, c8 = ch & 7;
        u32x4 v; v.x = v.y = v.z = v.w = 0u;
        if (t >= 0 && t < seqlen) v = *(const u32x4*)(P + (size_t)(seq0 + t) * DINP + PC_BQKV + 256 * part + 64 * h + 8 * c8);
        LAS float* d = raw + r * 192 + 64 * part + 8 * c8;
        d[0] = bf_lo(v.x); d[1] = bf_hi(v.x); d[2] = bf_lo(v.y); d[3] = bf_hi(v.y); d[4] = bf_lo(v.z); d[5] = bf_hi(v.z); d[6] = bf_lo(v.w); d[7] = bf_hi(v.w); }
    for (int it = tid; it < 5 * 192; it += NTHR) { const int j = it / 192, cc = it % 192; cw[it] = p->in[I_GCONV][((size_t)l * 5 + j) * 768 + 256 * (cc >> 6) + 64 * h + (cc & 63)]; }
    lds_barrier();
    for (int it = tid; it < 64 * 192; it += NTHR) { const int t = it / 192, cc = it % 192; float y = 0.f;
#pragma unroll
        for (int j = 0; j < 5; ++j) y += raw[(t + j) * 192 + cc] * cw[j * 192 + cc];
        y = silu_f(y); LAS float* dst = (cc < 64) ? xq : (cc < 128 ? xk : xv); dst[t * XP + (cc & 63)] = y; }
    lds_barrier();
    {
        const int mat = tid >> 8, r = (tid >> 2) & 63, q4 = tid & 3; LAS float* m = (mat ? xk : xq) + r * XP + 16 * q4; float v[16]; float ss = 0.f;
#pragma unroll
        for (int k = 0; k < 16; ++k) { v[k] = m[k]; ss += v[k] * v[k]; }
        ss += __shfl_xor(ss, 1); ss += __shfl_xor(ss, 2);
        const float sc = rsqrtf(ss + EPS) * (mat ? 1.f : 0.125f);
#pragma unroll
        for (int k = 0; k < 16; ++k) m[k] = v[k] * sc;
    }
    lds_barrier();
    {
        const int mat = w >> 2, rt = (w >> 1) & 1, ct = w & 1; LAS float* Am = mat ? xq : xk;
        const f32x16 acc = lds_mma64(lane, [&](int r, int k) { return Am[(32 * rt + r) * XP + k]; }, [&](int k, int c2) { return xk[(32 * ct + c2) * XP + k]; });
        LAS float* Om = mat ? QK : KK;
#pragma unroll
        for (int r = 0; r < 16; ++r) Om[(32 * rt + crow(r, lane >> 5)) * XP + 32 * ct + (lane & 31)] = acc[r];
    }
    if (w < 2) {
        const int d = w;
        const float a = bf2f(ab_a), bt = bf2f(ab_b);
        float g = -__expf(p->in[I_GALOG][(l * 2 + d) * 4 + h]) * softplus_f(a + p->in[I_GDTB][(l * 2 + d) * 4 + h]);
#pragma unroll
        for (int o = 1; o < 64; o <<= 1) { const float n = __shfl_up(g, o); if (lane >= o) g += n; }
        gcs[d * 64 + lane] = g; bts[d * 64 + lane] = sigmoid_f(bt); egs[d * 64 + lane] = __expf(g);
        if (lane == 63) ((float*)(ws + WS_DEC))[su_index(d, b, h, cg)] = __expf(g);
    }
    lds_barrier();
    for (int it = tid; it < 2 * 64 * 64; it += NTHR) { const int d = it >> 12, j = (it >> 6) & 63, i = it & 63; const int ti = d ? 63 - i : i, tj = d ? 63 - j : j;
        Lt[(d * 64 + j) * 68 + i] = (j < i) ? bts[d * 64 + i] * KK[ti * XP + tj] * __expf(gcs[d * 64 + i] - gcs[d * 64 + j]) : 0.f; }
#pragma unroll
    for (int d = 0; d < 2; ++d) {
        unsigned char* rec = ws + WS_RECG + (size_t)su_index(d, b, h, cg) * REC_G_BYTES; const LAS float* gc = gcs + d * 64;
        const int r = tid >> 3, c8 = tid & 7, it_ = d ? 63 - r : r;
        { float v[8];
#pragma unroll
          for (int j = 0; j < 8; ++j) { const int i = 8 * c8 + j, ti = d ? 63 - i : i; v[j] = xk[ti * XP + r] * __expf(gc[63] - gc[i]); }
          u32x4 o; o.x = cvtpk(v[0], v[1]); o.y = cvtpk(v[2], v[3]); o.z = cvtpk(v[4], v[5]); o.w = cvtpk(v[6], v[7]); *(u32x4*)(rec + REC_G_KDT + (r * 64 + 8 * c8) * 2) = o; }
        { const float e = egs[d * 64 + it_]; float v[8];
#pragma unroll
          for (int j = 0; j < 8; ++j) v[j] = xq[r * XP + 8 * c8 + j] * e;
          u32x4 o; o.x = cvtpk(v[0], v[1]); o.y = cvtpk(v[2], v[3]); o.z = cvtpk(v[4], v[5]); o.w = cvtpk(v[6], v[7]); *(u32x4*)(rec + REC_G_QG + (r * 64 + 8 * c8) * 2) = o; }
        { float v[8];
#pragma unroll
          for (int j = 0; j < 8; ++j) { const int i = 8 * c8 + j, ti = d ? 63 - i : i; v[j] = (it_ >= i) ? QK[r * XP + ti] * __expf(gc[it_] - gc[i]) : 0.f; }
          u32x4 o; o.x = cvtpk(v[0], v[1]); o.y = cvtpk(v[2], v[3]); o.z = cvtpk(v[4], v[5]); o.w = cvtpk(v[6], v[7]); *(u32x4*)(rec + REC_G_ATT + (r * 64 + 8 * c8) * 2) = o; }
    }
    float rhs[64];
    if (tid < 256) {
        const int d = tid >> 7, col = tid & 127; const LAS float* bt = bts + d * 64; const LAS float* eg = egs + d * 64;
        if (col < 64) {
#pragma unroll
            for (int i = 0; i < 64; ++i) { const int ti = d ? 63 - i : i; rhs[i] = bt[i] * xv[ti * XP + col]; }
        } else {
#pragma unroll
            for (int i = 0; i < 64; ++i) { const int ti = d ? 63 - i : i; rhs[i] = bt[i] * eg[i] * xk[ti * XP + col - 64]; }
        }
    }
    lds_barrier();
    if (tid < 256) {
        const int d = tid >> 7, col = tid & 127; LAS float* Xc = X + d * 64 * 128 + col; const LAS float* Ltd = Lt + d * 64 * 68;
#pragma unroll
        for (int i = 0; i < 64; ++i) Xc[i * 128] = rhs[i];
        for (int blk = 0; blk < 4; ++blk) {
            float acc[16];
#pragma unroll
            for (int r = 0; r < 16; ++r) acc[r] = Xc[(16 * blk + r) * 128];
            const LAS float* Lc = Ltd + 16 * blk;
#pragma unroll 2
            for (int j = 0; j < 16 * blk; ++j) {
                const float xj = Xc[j * 128];
                const f32x4 l0 = *(const LAS f32x4*)(Lc + j * 68), l1 = *(const LAS f32x4*)(Lc + j * 68 + 4), l2 = *(const LAS f32x4*)(Lc + j * 68 + 8), l3 = *(const LAS f32x4*)(Lc + j * 68 + 12);
                acc[0] -= l0.x * xj; acc[1] -= l0.y * xj; acc[2] -= l0.z * xj; acc[3] -= l0.w * xj; acc[4] -= l1.x * xj; acc[5] -= l1.y * xj; acc[6] -= l1.z * xj; acc[7] -= l1.w * xj;
                acc[8] -= l2.x * xj; acc[9] -= l2.y * xj; acc[10] -= l2.z * xj; acc[11] -= l2.w * xj; acc[12] -= l3.x * xj; acc[13] -= l3.y * xj; acc[14] -= l3.z * xj; acc[15] -= l3.w * xj;
            }
            const LAS float* Lb = Lc + 16 * blk * 68;
#pragma unroll
            for (int rp = 0; rp < 16; ++rp) {
                const float xr = acc[rp];
                Xc[(16 * blk + rp) * 128] = xr;
#pragma unroll
                for (int q = 0; q < 4; ++q) if (4 * q + 3 > rp) { const f32x4 lv = *(const LAS f32x4*)(Lb + rp * 68 + 4 * q);
                    if (4 * q > rp) acc[4 * q] -= lv.x * xr; if (4 * q + 1 > rp) acc[4 * q + 1] -= lv.y * xr; if (4 * q + 2 > rp) acc[4 * q + 2] -= lv.z * xr; acc[4 * q + 3] -= lv.w * xr; }
            }
        }
    }
    lds_barrier();
#pragma unroll
    for (int d = 0; d < 2; ++d) {
        unsigned char* rec = ws + WS_RECG + (size_t)su_index(d, b, h, cg) * REC_G_BYTES; const LAS float* Xd = X + d * 64 * 128;
        { const int r = tid >> 3, c8 = tid & 7;
          u32x4 o; const LAS float* sp = Xd + r * 128 + 64 + 8 * c8; o.x = cvtpk(sp[0], sp[1]); o.y = cvtpk(sp[2], sp[3]); o.z = cvtpk(sp[4], sp[5]); o.w = cvtpk(sp[6], sp[7]);
          *(u32x4*)(rec + REC_G_W + (r * 64 + 8 * c8) * 2) = o; }
        for (int it = tid; it < 64 * 16; it += NTHR) { const int dv = it >> 4, i4 = it & 15;
            f32x4 o; o.x = Xd[(4 * i4) * 128 + dv]; o.y = Xd[(4 * i4 + 1) * 128 + dv]; o.z = Xd[(4 * i4 + 2) * 128 + dv]; o.w = Xd[(4 * i4 + 3) * 128 + dv];
            *(f32x4*)(rec + REC_G_UT + (dv * 64 + 4 * i4) * 4) = o; }
    }
}

__device__ __forceinline__ void ret_chunk_unit(KArg p, const Ctx& C, int l, int b, int h, int cg) {
    unsigned char* ws = p->ws; const bf16_t* P = (const bf16_t*)(ws + WS_P); const float* tab = (const float*)(ws + WS_TAB);
    int tid_l = C.tid; asm volatile("" : "+v"(tid_l));
    const int tid = tid_l, lane = tid & 63, w = __builtin_amdgcn_readfirstlane(tid >> 6);
    LAS float* xq = (LAS float*)C.lds; LAS float* xk = xq + 64 * XP; LAS float* xv = xk + 64 * XP; LAS float* QK = xv + 64 * XP;
    const bool lat = cg >= 4;
    const int seq0 = lat ? MC + 4096 * b : 256 * b, t0 = lat ? 64 * (cg - 4) : 64 * cg;
    lds_barrier();
    for (int it = tid; it < 2 * 64 * 32; it += NTHR) { const int mat = it >> 11, r = (it >> 5) & 63, part = (it >> 4) & 1, j = it & 15; const int t = t0 + r;
        const bf16_t* pr = P + (size_t)(seq0 + t) * DINP + (mat ? PC_DK : PC_DQ) + 64 * h + 32 * part;
        const float xa = bf2f(pr[j]), xb = bf2f(pr[16 + j]); float cs = 1.f, sn = 0.f;
        if (lat) { const int ps = part ? (t & 63) : (t >> 6); cs = tab[ps * 16 + j]; sn = tab[1024 + ps * 16 + j]; }
        const float sc = mat ? 0.125f : 1.f; LAS float* m = mat ? xk : xq;
        m[r * XP + 32 * part + j] = (xa * cs - xb * sn) * sc; m[r * XP + 32 * part + 16 + j] = (xb * cs + xa * sn) * sc; }
    { const int r = tid >> 3, c8 = tid & 7; const u32x4 v = *(const u32x4*)(P + (size_t)(seq0 + t0 + r) * DINP + PC_DV + 64 * h + 8 * c8); LAS float* d = xv + r * XP + 8 * c8;
      d[0] = bf_lo(v.x); d[1] = bf_hi(v.x); d[2] = bf_lo(v.y); d[3] = bf_hi(v.y); d[4] = bf_lo(v.z); d[5] = bf_hi(v.z); d[6] = bf_lo(v.w); d[7] = bf_hi(v.w); }
    lds_barrier();
    if (w < 4) { const int rt = w >> 1, ct = w & 1;
        const f32x16 acc = lds_mma64(lane, [&](int r, int k) { return xq[(32 * rt + r) * XP + k]; }, [&](int k, int c2) { return xk[(32 * ct + c2) * XP + k]; });
#pragma unroll
        for (int r = 0; r < 16; ++r) QK[(32 * rt + crow(r, lane >> 5)) * XP + 32 * ct + (lane & 31)] = acc[r]; }
    lds_barrier();
    {
        const int d = w >> 2, T = (w >> 1) & 1, ct = w & 1; const float lg = -__expf(p->in[I_RLOGD][(l * 2 + d) * 4 + h]);
        const f32x16 acc = lds_mma64(lane, [&](int r, int k) { const int ti = d ? 63 - k : k; return xk[ti * XP + 32 * T + r] * __expf(lg * (float)(63 - k)); },
                                           [&](int k, int c2) { const int ti = d ? 63 - k : k; return xv[ti * XP + 32 * ct + c2]; });
        float* kv = (float*)(ws + WS_RECR + (size_t)su_index(d, b, h, cg) * REC_R_BYTES + REC_R_KV);
#pragma unroll
        for (int r = 0; r < 16; ++r) kv[(32 * T + crow(r, lane >> 5)) * 64 + 32 * ct + (lane & 31)] = acc[r];
    }
    for (int d = 0; d < 2; ++d) {
        unsigned char* rec = ws + WS_RECR + (size_t)su_index(d, b, h, cg) * REC_R_BYTES; const float lg = -__expf(p->in[I_RLOGD][(l * 2 + d) * 4 + h]);
        const int r = tid >> 3, c8 = tid & 7, it_ = d ? 63 - r : r;
        { const float e = __expf(lg * (float)(it_ + 1)); float v[8];
#pragma unroll
          for (int j = 0; j < 8; ++j) v[j] = xq[r * XP + 8 * c8 + j] * e;
          u32x4 o; o.x = cvtpk(v[0], v[1]); o.y = cvtpk(v[2], v[3]); o.z = cvtpk(v[4], v[5]); o.w = cvtpk(v[6], v[7]); *(u32x4*)(rec + REC_R_QG + (r * 64 + 8 * c8) * 2) = o; }
        { float v[8];
#pragma unroll
          for (int j = 0; j < 8; ++j) { const int i = 8 * c8 + j, ti = d ? 63 - i : i; v[j] = (it_ >= i) ? QK[r * XP + ti] * __expf(lg * (float)(it_ - i)) : 0.f; }
          u32x4 o; o.x = cvtpk(v[0], v[1]); o.y = cvtpk(v[2], v[3]); o.z = cvtpk(v[4], v[5]); o.w = cvtpk(v[6], v[7]); *(u32x4*)(rec + REC_R_ATT + (r * 64 + 8 * c8) * 2) = o; }
        { const int ln = tid & 63, s = (tid >> 6) & 1, T = (tid >> 7) & 1, ct = tid >> 8; float v[8];
#pragma unroll
          for (int j = 0; j < 8; ++j) { const int i = 32 * T + 16 * s + 8 * (j >> 2) + 4 * (ln >> 5) + (j & 3), ti = d ? 63 - i : i; v[j] = xv[ti * XP + 32 * ct + (ln & 31)]; }
          u32x4 o; o.x = cvtpk(v[0], v[1]); o.y = cvtpk(v[2], v[3]); o.z = cvtpk(v[4], v[5]); o.w = cvtpk(v[6], v[7]); *(u32x4*)(rec + REC_R_VF + (size_t)tid * 16) = o; }
    }
}

__device__ __forceinline__ void gdn_scan_chain(KArg p, const Ctx& C, int chain) {
    unsigned char* ws = p->ws; const int tid = C.tid, lane = C.lane, w = C.wave, c = lane & 31, hi = lane >> 5;
    constexpr int WP = 68, UP = 68, SB_W = 0, SB_K = 64 * WP * 2, SB_U = 2 * 64 * WP * 2, SB_D = SB_U + 64 * UP * 4, SBUF = SB_D + 16;
    LAS unsigned char* lds = C.lds;
    const float* DEC = (const float*)(ws + WS_DEC);
    u32x4 st[4]; float dreg = 0.f;
    auto g_load = [&](int s) { if (tid == 0) dreg = DEC[chain * 68 + s]; const unsigned char* rec = ws + WS_RECG + (size_t)(chain * 68 + s) * REC_G_BYTES;
#pragma unroll
        for (int i = 0; i < 4; ++i) st[i] = *(const u32x4*)(rec + (size_t)(tid + 512 * i) * 16); };
    auto l_store = [&](int bsel, int s) { LAS unsigned char* sb = lds + bsel * SBUF;
#pragma unroll
        for (int i = 0; i < 4; ++i) { const int ch = tid + 512 * i; u32x2 lo, h2; lo.x = st[i].x; lo.y = st[i].y; h2.x = st[i].z; h2.y = st[i].w;
            if (ch < 512) { const int r = ch >> 3, c8 = ch & 7; LAS u32x2* d = (LAS u32x2*)(sb + SB_W + r * (WP * 2) + 16 * c8); d[0] = lo; d[1] = h2; }
            else if (ch < 1536) { const int q = ch - 512, r = q >> 4, c4 = q & 15; *(LAS u32x4*)(sb + SB_U + r * (UP * 4) + 16 * c4) = st[i]; }
            else { const int q = ch - 1536, r = q >> 3, c8 = q & 7; LAS u32x2* d = (LAS u32x2*)(sb + SB_K + r * (WP * 2) + 16 * c8); d[0] = lo; d[1] = h2; } }
        if (tid == 0) *(LAS float*)(sb + SB_D) = dreg; (void)s; };
    f32x16 S0, S1;
#pragma unroll
    for (int r = 0; r < 16; ++r) { S0[r] = 0.f; S1[r] = 0.f; }
    __syncthreads();
    g_load(0); l_store(0, 0);
    __syncthreads();
    for (int s = 0; s < 68; ++s) {
        const int bsel = s & 1;
        if (s + 1 < 68) g_load(s + 1);
        if (w < 2) {
            const int ct = w; LAS unsigned char* sb = lds + bsel * SBUF;
            unsigned char* rec = ws + WS_RECG + (size_t)(chain * 68 + s) * REC_G_BYTES;
            bf16x8 sf[2][2];
#pragma unroll
            for (int ks = 0; ks < 2; ++ks) {
                sf[0][ks] = mk_frag4(cvtpk(S0[8 * ks], S0[8 * ks + 1]), cvtpk(S0[8 * ks + 2], S0[8 * ks + 3]), cvtpk(S0[8 * ks + 4], S0[8 * ks + 5]), cvtpk(S0[8 * ks + 6], S0[8 * ks + 7]));
                sf[1][ks] = mk_frag4(cvtpk(S1[8 * ks], S1[8 * ks + 1]), cvtpk(S1[8 * ks + 2], S1[8 * ks + 3]), cvtpk(S1[8 * ks + 4], S1[8 * ks + 5]), cvtpk(S1[8 * ks + 6], S1[8 * ks + 7]));
            }
#pragma unroll
            for (int T = 0; T < 2; ++T)
#pragma unroll
                for (int ks = 0; ks < 2; ++ks) *(bf16x8*)(rec + REC_G_SP + (size_t)((((ct * 2 + T) * 2 + ks) * 64 + lane) * 16)) = sf[T][ks];
            f32x16 vn[2];
#pragma unroll
            for (int Ti = 0; Ti < 2; ++Ti) {
                f32x16 acc;
#pragma unroll
                for (int r = 0; r < 16; ++r) acc[r] = 0.f;
#pragma unroll
                for (int T = 0; T < 2; ++T)
#pragma unroll
                    for (int ks = 0; ks < 2; ++ks) { const LAS unsigned char* ap = sb + SB_W + (32 * Ti + c) * (WP * 2) + (32 * T + 16 * ks + 4 * hi) * 2;
                        acc = mfma32(mk_frag(*(const LAS u32x2*)ap, *(const LAS u32x2*)(ap + 16)), sf[T][ks], acc); }
#pragma unroll
                for (int g = 0; g < 4; ++g) { const f32x4 u = *(const LAS f32x4*)(sb + SB_U + (32 * ct + c) * (UP * 4) + (32 * Ti + 8 * g + 4 * hi) * 4);
                    vn[Ti][4 * g] = u.x - acc[4 * g]; vn[Ti][4 * g + 1] = u.y - acc[4 * g + 1]; vn[Ti][4 * g + 2] = u.z - acc[4 * g + 2]; vn[Ti][4 * g + 3] = u.w - acc[4 * g + 3]; }
            }
            bf16x8 vf[2][2];
#pragma unroll
            for (int Ti = 0; Ti < 2; ++Ti)
#pragma unroll
                for (int ks = 0; ks < 2; ++ks) {
                    vf[Ti][ks] = mk_frag4(cvtpk(vn[Ti][8 * ks], vn[Ti][8 * ks + 1]), cvtpk(vn[Ti][8 * ks + 2], vn[Ti][8 * ks + 3]), cvtpk(vn[Ti][8 * ks + 4], vn[Ti][8 * ks + 5]), cvtpk(vn[Ti][8 * ks + 6], vn[Ti][8 * ks + 7]));
                    *(bf16x8*)(rec + REC_G_VN + (size_t)((((ct * 2 + Ti) * 2 + ks) * 64 + lane) * 16)) = vf[Ti][ks]; }
            const float dec = *(const LAS float*)(sb + SB_D);
#pragma unroll
            for (int r = 0; r < 16; ++r) { S0[r] *= dec; S1[r] *= dec; }
#pragma unroll
            for (int Ti = 0; Ti < 2; ++Ti)
#pragma unroll
                for (int ks = 0; ks < 2; ++ks) {
                    const LAS unsigned char* a0 = sb + SB_K + c * (WP * 2) + (32 * Ti + 16 * ks + 4 * hi) * 2; const LAS unsigned char* a1 = a0 + 32 * (WP * 2);
                    S0 = mfma32(mk_frag(*(const LAS u32x2*)a0, *(const LAS u32x2*)(a0 + 16)), vf[Ti][ks], S0);
                    S1 = mfma32(mk_frag(*(const LAS u32x2*)a1, *(const LAS u32x2*)(a1 + 16)), vf[Ti][ks], S1); }
        }
        if (s + 1 < 68) l_store(bsel ^ 1, s + 1);
        __syncthreads();
    }
}
__device__ __forceinline__ void ret_scan_items(KArg p, const Ctx& C, int l, int item0, int nitems_total, int stride) {
    unsigned char* ws = p->ws;
    for (int it = item0; it < nitems_total; it += stride) {
        const int dbh = it >> 11, q = it & 2047; const int jp = q & 3, ln = (q >> 2) & 63, ks = (q >> 8) & 1, T = (q >> 9) & 1, ct = q >> 10;
        const int d = dbh >> 4, h = dbh & 3;
        const int j0 = 2 * jp, dk0 = 32 * T + 16 * ks + 8 * (j0 >> 2) + 4 * (ln >> 5) + (j0 & 3), dv = 32 * ct + (ln & 31);
        const float g64 = __expf(-__expf(p->in[I_RLOGD][(l * 2 + d) * 4 + h]) * 64.f);
        float s0 = 0.f, s1 = 0.f;
        for (int s = 0; s < 68; ++s) {
            unsigned char* rec = ws + WS_RECR + (size_t)(dbh * 68 + s) * REC_R_BYTES;
            *(unsigned*)(rec + REC_R_SP + (size_t)q * 4) = cvtpk(s0, s1);
            const float* kv = (const float*)(rec + REC_R_KV);
            s0 = s0 * g64 + kv[dk0 * 64 + dv]; s1 = s1 * g64 + kv[(dk0 + 1) * 64 + dv];
        }
    }
}

__device__ __forceinline__ void rec_out_unit(KArg p, const Ctx& C, int l, int b, int h, int cg) {
    unsigned char* ws = p->ws; const int tid = C.tid, lane = C.lane, w = C.wave, c = lane & 31, hi = lane >> 5;
    const int mixer = w >> 2, rt = (w >> 1) & 1, ct = w & 1;
    LAS float* ob = (LAS float*)C.lds;
    f32x16 acc;
#pragma unroll
    for (int r = 0; r < 16; ++r) acc[r] = 0.f;
#pragma unroll
    for (int d = 0; d < 2; ++d) {
        const int su = su_index(d, b, h, cg);
        const unsigned char* rec = mixer ? ws + WS_RECR + (size_t)su * REC_R_BYTES : ws + WS_RECG + (size_t)su * REC_G_BYTES;
        const unsigned char* qg = rec + (mixer ? REC_R_QG : REC_G_QG); const unsigned char* at = rec + (mixer ? REC_R_ATT : REC_G_ATT);
        const unsigned char* sp = rec + (mixer ? REC_R_SP : REC_G_SP); const unsigned char* vn = rec + (mixer ? REC_R_VF : REC_G_VN);
#pragma unroll
        for (int T = 0; T < 2; ++T)
#pragma unroll
            for (int ks = 0; ks < 2; ++ks) {
                const size_t ao = (size_t)((32 * rt + c) * 64 + 32 * T + 16 * ks + 4 * hi) * 2, bo = (size_t)((((ct * 2 + T) * 2 + ks) * 64 + lane) * 16);
                acc = mfma32(mk_frag(*(const u32x2*)(qg + ao), *(const u32x2*)(qg + ao + 16)), *(const bf16x8*)(sp + bo), acc);
                acc = mfma32(mk_frag(*(const u32x2*)(at + ao), *(const u32x2*)(at + ao + 16)), *(const bf16x8*)(vn + bo), acc);
            }
    }
    __syncthreads();
#pragma unroll
    for (int r = 0; r < 16; ++r) ob[(mixer * 64 + 32 * rt + crow(r, hi)) * XP + 32 * ct + c] = acc[r];
    __syncthreads();
    {
        const int rowi = tid >> 2, q4 = tid & 3, mx = rowi >> 6, tau = rowi & 63;
        const int row = (cg < 4 ? 256 * b + 64 * cg : MC + 4096 * b + 64 * (cg - 4)) + tau;
        const LAS float* o = ob + rowi * XP + 16 * q4; float v[16]; float s = 0.f, ss = 0.f;
#pragma unroll
        for (int j = 0; j < 16; ++j) { v[j] = o[j]; s += v[j]; ss += v[j] * v[j]; }
        s += __shfl_xor(s, 1); s += __shfl_xor(s, 2); ss += __shfl_xor(ss, 1); ss += __shfl_xor(ss, 2);
        const bf16_t* P = (const bf16_t*)(ws + WS_P) + (size_t)row * DINP + (mx ? PC_DGATE : PC_BGATE) + 64 * h + 16 * q4;
        const float* gn = mx ? p->in[I_RNORM] + (size_t)l * 256 + 64 * h + 16 * q4 : p->in[I_GNORM] + (size_t)l * 64 + 16 * q4;
        float mu = 0.f, rs;
        if (mx) { mu = s * (1.f / 64.f); const float var = ss * (1.f / 64.f) - mu * mu; rs = rsqrtf(fmaxf(var, 0.f) + EPS); } else rs = rsqrtf(ss * (1.f / 64.f) + EPS);
        unsigned ov[8];
#pragma unroll
        for (int j = 0; j < 16; j += 2) { const float y0 = (v[j] - mu) * rs * gn[j] * silu_f(bf2f(P[j])), y1 = (v[j + 1] - mu) * rs * gn[j + 1] * silu_f(bf2f(P[j + 1])); ov[j >> 1] = cvtpk(y0, y1); }
        bf16_t* dst = (bf16_t*)(ws + WS_MIX) + (size_t)row * D + (mx ? 768 : 256) + 64 * h + 16 * q4;
        u32x4 o0, o1; o0.x = ov[0]; o0.y = ov[1]; o0.z = ov[2]; o0.w = ov[3]; o1.x = ov[4]; o1.y = ov[5]; o1.z = ov[6]; o1.w = ov[7];
        *(u32x4*)dst = o0; *(u32x4*)(dst + 8) = o1;
    }
}

#ifndef ONLY_PHASE
#define ONLY_PHASE -1
#endif
#ifndef SUB3
#define SUB3 31
#endif
#ifndef DUP_K
#define DUP_K -1
#endif
#define NREP(k) ((DUP_K == (k)) ? 2 : 1)
#ifndef DUP2
#define DUP2 0
#endif
#define PH_ON(k) (ONLY_PHASE < 0 || ONLY_PHASE == (k))
constexpr int PH_PER_LAYER = 10, PH_FINAL = 1 + PH_PER_LAYER * DEPTH, N_PHASES = PH_FINAL + 1;
__global__ void __launch_bounds__(NTHR, 2) mega_fwd(Params p_arg) {
    extern __shared__ __attribute__((aligned(16))) unsigned char lds_raw[];
    Ctx C0; C0.lds = (LAS unsigned char*)lds_raw; C0.tid = threadIdx.x; C0.lane = C0.tid & 63; C0.wave = __builtin_amdgcn_readfirstlane(C0.tid >> 6); C0.bid = blockIdx.x; C0.G = gridDim.x;
    const Ctx& C = C0;
    int lo, hi; unsigned* ctl0; { KArg p = kp_get(); lo = p->ph_lo; hi = p->ph_hi; ctl0 = (unsigned*)(p->ws + WS_CTL); }
    const bool fused = (hi - lo) > 1;
    if (C.tid < 64) ((LAS unsigned*)(C.lds + LDS_MISC))[C.tid] = 0u;
    __syncthreads();
    XcdBarrier bar; bar.bar = ctl0 + CW_BAR; bar.x = 0; bar.st = (volatile LAS unsigned*)(C.lds + LDS_MISC);
    if (fused) bar = xcd_barrier_post(ctl0 + CW_BAR, (volatile LAS unsigned*)(C.lds + LDS_MISC));
#define IN(k) (lo <= (k) && (k) < hi)
#define RELAUNDER do { int t_ = C0.tid, b_ = C0.bid, g_ = C0.G; unsigned l_ = (unsigned)(size_t)C0.lds; asm volatile("" : "+v"(t_), "+s"(b_), "+s"(g_), "+s"(l_)); C.tid = t_; C.lane = t_ & 63; C.wave = __builtin_amdgcn_readfirstlane(t_ >> 6); C.bid = b_; C.G = g_; C.lds = (LAS unsigned char*)(size_t)l_; p = kp_get(); ws = p->ws; } while (0)
#define PHASE_VARS Ctx C; { int t_ = C0.tid, b_ = C0.bid, g_ = C0.G; unsigned l_ = (unsigned)(size_t)C0.lds; asm volatile("" : "+v"(t_), "+s"(b_), "+s"(g_), "+s"(l_)); C.tid = t_; C.lane = t_ & 63; C.wave = __builtin_amdgcn_readfirstlane(t_ >> 6); C.bid = b_; C.G = g_; C.lds = (LAS unsigned char*)(size_t)l_; } KArg p = kp_get(); unsigned char* ws = p->ws; unsigned* ctl = (unsigned*)(ws + WS_CTL); const float* MOD = (const float*)(ws + WS_MOD); bf16_t* U = (bf16_t*)(ws + WS_U); (void)ctl; (void)MOD; (void)U;
#define SEAM(k) do { if (IN(k) && IN((k) + 1)) xcd_barrier(bar); } while (0)

    if (PH_ON(10) && IN(0)) { PHASE_VARS prologue_phase(p, C); }
    SEAM(0);

    for (int l = 0; l < DEPTH; ++l) {
        const int base = 1 + PH_PER_LAYER * l;
        const bool moe = (l & 1) != 0, last = (l == DEPTH - 1);
        const int row_min = last ? MC : 0, pm0 = last ? 4 : 0, Meff = last ? MX : MT;

        if (PH_ON(0) && IN(base + 0)) { PHASE_VARS
            if (moe) moe_convert_phase(p, C, l >> 1);
            norm_phase<0>(p, C, l, l == 2, l - 1, false, 0);
        }
        SEAM(base + 0);
        if (PH_ON(1) && IN(base + 1)) { PHASE_VARS
            { pg8::Gemm g{U, (const bf16_t*)(ws + WS_WIN) + (size_t)l * DINP * D, MT, DINP, D}; pg8::OrderPM S; S.init(MT, DINP, C.G, C.bid); S.pm0 = 0;
              pg8::EpiStore E{(bf16_t*)(ws + WS_P), DINP, 1 << 20};
              pg8::gemm_phase<pg8::EpiStore, pg8::OrderPM, true, true>(C.lds, g, S, E); }
            { pg8::Gemm g{(const bf16_t*)(ws + WS_WINV) + (size_t)l * 256 * D, U, 256, MT, D}; pg8::OrderPM S; S.init(256, MT, C.G, (C.bid + 208) & 255); S.pm0 = 0;
              pg8::EpiStore E{(bf16_t*)(ws + WS_VTS), MT, 1 << 20};
              pg8::gemm_phase<pg8::EpiStore, pg8::OrderPM, true, true>(C.lds, g, S, E); }
        }
        SEAM(base + 1);
        if (PH_ON(2) && IN(base + 2)) for (int rep = 0; rep < NREP(2); ++rep) { PHASE_VARS
            for (int r2 = 0; r2 < ((DUP2 & 1) ? 2 : 1); ++r2) prep_phase(p, C, l);
            for (int u = C.bid; u < 2 * 1088; u += C.G) { const int mixer = u / 1088, v = u % 1088, b = v / 272, h = (v / 68) & 3, cg = v % 68;
                if (mixer == 0) { for (int r2 = 0; r2 < ((DUP2 & 2) ? 2 : 1); ++r2) gdn_chunk_unit(p, C, l, b, h, cg); } else { for (int r2 = 0; r2 < ((DUP2 & 4) ? 2 : 1); ++r2) ret_chunk_unit(p, C, l, b, h, cg); } }
        }
        SEAM(base + 2);
        if (PH_ON(3) && IN(base + 3)) for (int rep = 0; rep < NREP(3); ++rep) { PHASE_VARS
            if (SUB3 & 1) { if (C.bid < 32) gdn_scan_chain(p, C, C.bid); }
            RELAUNDER;
            if (C.bid >= 32) {
                const int G2 = C.G - 32, c2 = C.bid - 32;
                if (SUB3 & 2) { pg8::Gemm g{(const bf16_t*)(ws + WS_AUP), (const bf16_t*)(ws + WS_WUP) + (size_t)l * 1024 * 512, MT, 1024, 512}; pg8::OrderPM S; S.init(MT, 1024, G2, c2); S.pm0 = 0;
                  pg8::EpiUp E{(bf16_t*)(ws + WS_QRAW), (bf16_t*)(ws + WS_KFULL)};
                  pg8::gemm_phase<pg8::EpiUp, pg8::OrderPM, true, true>(C.lds, g, S, E); }
                RELAUNDER;
                if (SUB3 & 4) { pg8::Gemm g{(const bf16_t*)(ws + WS_WUPV) + (size_t)l * 256 * 512, (const bf16_t*)(ws + WS_AUP), 256, MT, 512}; pg8::OrderPM S; S.init(256, MT, G2, (c2 + 176) % G2); S.pm0 = 0;
                  pg8::EpiStore E{(bf16_t*)(ws + WS_VTM), MT, 1 << 20};
                  pg8::gemm_phase<pg8::EpiStore, pg8::OrderPM, true, true>(C.lds, g, S, E); }
                RELAUNDER;
                if (SUB3 & 8) ret_scan_items(p, C, l, c2 * NTHR + C.tid, 65536, G2 * NTHR);
                RELAUNDER;
                if (SUB3 & 16) { for (int u = 256 + c2; u < 512; u += G2) attn_dispatch(p, C, l, u);
                if (!last) for (int u = 528 + c2; u < 544; u += G2) attn_dispatch(p, C, l, u); }
            }
        }
        SEAM(base + 3);
        if (PH_ON(4) && IN(base + 4)) for (int rep = 0; rep < NREP(4); ++rep) { PHASE_VARS
            for (int u = C.bid; u < 256; u += C.G) attn_dispatch(p, C, l, u);
            if (!last) for (int u = 512 + C.bid; u < 528; u += C.G) attn_dispatch(p, C, l, u);
            for (int u = C.bid; u < 1088; u += C.G) { const int b = u / 272, h = (u / 68) & 3, cg = u % 68; if (last && cg < 4) continue; rec_out_unit(p, C, l, b, h, cg); }
        }
        SEAM(base + 4);
        if (PH_ON(5) && IN(base + 5)) { PHASE_VARS
            pg8::Gemm g{(const bf16_t*)(ws + WS_MIX), (const bf16_t*)(ws + WS_WOUT) + (size_t)l * D * D, Meff, D, D}; pg8::OrderPM S; S.init(Meff, D, C.G, C.bid); S.pm0 = pm0;
            pg8::EpiRes E{(float*)(ws + WS_H), MOD + (size_t)l * 5 * 6144 + 2 * 1024};
            pg8::gemm_phase<pg8::EpiRes, pg8::OrderPM, true, true>(C.lds, g, S, E);
        }
        SEAM(base + 5);
        if (PH_ON(6) && IN(base + 6)) { PHASE_VARS norm_phase<1>(p, C, l, false, 0, moe, row_min); }
        SEAM(base + 6);
        if (PH_ON(7) && IN(base + 7)) { PHASE_VARS if (moe) moe_gather_phase(p, C, row_min); }
        if (moe) SEAM(base + 7);
        if (PH_ON(8) && IN(base + 8)) { PHASE_VARS
            pg8::EpiSwiGLU E{(bf16_t*)(ws + WS_HD)};
            if (!moe) { pg8::Gemm g{U, (const bf16_t*)(ws + WS_WFF + (size_t)(l >> 1) * FFW_BYTES), MT, 7168, D}; pg8::OrderPM S; S.init(MT, 7168, C.G, C.bid); S.pm0 = 0;
                pg8::gemm_phase<pg8::EpiSwiGLU, pg8::OrderPM, true, true>(C.lds, g, S, E); }
            else { const int nt = (int)__hip_atomic_load(ctl + CW_TILEE + 160, __ATOMIC_RELAXED, __HIP_MEMORY_SCOPE_AGENT);
                pg8::Gemm g{(const bf16_t*)(ws + WS_ASORT), (const bf16_t*)(ws + WS_WMOE), MOE_ROWS, 8 * 7168, D}; pg8::MoeOrder S{28, C.G, C.bid, __builtin_amdgcn_readfirstlane(nt), ctl + CW_TILEE};
                pg8::gemm_phase<pg8::EpiSwiGLU, pg8::MoeOrder, true, true>(C.lds, g, S, E); }
        }
        SEAM(base + 8);
        if (PH_ON(9) && IN(base + 9)) { PHASE_VARS
            if (!moe) { pg8::Gemm g{(const bf16_t*)(ws + WS_HD), (const bf16_t*)(ws + WS_WFF + (size_t)(l >> 1) * FFW_BYTES) + (size_t)7168 * 1024, MT, D, DFF}; pg8::OrderPM S; S.init(MT, D, C.G, C.bid); S.pm0 = 0;
                pg8::EpiRes E{(float*)(ws + WS_H), MOD + (size_t)l * 5 * 6144 + 5 * 1024};
                pg8::gemm_phase<pg8::EpiRes, pg8::OrderPM, true, true>(C.lds, g, S, E); }
            else { const int nt = (int)__hip_atomic_load(ctl + CW_TILEE + 160, __ATOMIC_RELAXED, __HIP_MEMORY_SCOPE_AGENT);
                pg8::Gemm g{(const bf16_t*)(ws + WS_HD), (const bf16_t*)(ws + WS_WMOE) + (size_t)8 * 7168 * 1024, MOE_ROWS, 8 * 1024, DFF}; pg8::MoeOrder S{4, C.G, C.bid, __builtin_amdgcn_readfirstlane(nt), ctl + CW_TILEE};
                pg8::EpiStore E{(bf16_t*)(ws + WS_YD), D, 4};
                pg8::gemm_phase<pg8::EpiStore, pg8::MoeOrder, true, true>(C.lds, g, S, E); }
        }
        SEAM(base + 9);
    }
    if (PH_ON(11) && IN(PH_FINAL)) { PHASE_VARS norm_phase<2>(p, C, DEPTH, true, DEPTH - 1, false, MC); }
#undef IN
#undef SEAM
}

extern "C" void kernel_launch(void* const* d_in, const int* in_sizes, int n_in, void* d_out, int out_size, void* d_ws, size_t ws_size, hipStream_t stream) {
    static int grid = 0;
    if (grid == 0) {
        if (n_in != N_IN || out_size != MX * D || ws_size < WS_END) { fprintf(stderr, "kernel_launch: unexpected shapes (n_in %d out %d ws %zu, need %zu)\n", n_in, out_size, ws_size, (size_t)WS_END); grid = -1; return; }
        int dev = 0, cus = 0, per_cu = 0;
        if (hipGetDevice(&dev) != hipSuccess || hipDeviceGetAttribute(&cus, hipDeviceAttributeMultiprocessorCount, dev) != hipSuccess) { grid = -1; return; }
        if (hipFuncSetAttribute((const void*)mega_fwd, hipFuncAttributeMaxDynamicSharedMemorySize, LDS_BYTES) != hipSuccess) { fprintf(stderr, "kernel_launch: hipFuncSetAttribute failed\n"); grid = -1; return; }
        if (hipOccupancyMaxActiveBlocksPerMultiprocessor(&per_cu, (const void*)mega_fwd, NTHR, LDS_BYTES) != hipSuccess || per_cu < 1) { fprintf(stderr, "kernel_launch: occupancy query says %d\n", per_cu); }
        (void)hipGetLastError();
        grid = (cus == 256) ? 256 : -1;
        if (grid < 0) { fprintf(stderr, "kernel_launch: built for a 256-CU device, found %d\n", cus); return; }
    }
    if (grid < 0) return;
    if (hipMemsetAsync((char*)d_ws + WS_CTL, 0, CTL_BYTES, stream) != hipSuccess) return;
    Params p; memset(&p, 0, sizeof(p));
    for (int i = 0; i < N_IN; ++i) p.in[i] = (const float*)d_in[i];
    p.out = (float*)d_out; p.ws = (unsigned char*)d_ws;
#if MK_ONE_LAUNCH
    p.ph_lo = 0; p.ph_hi = N_PHASES;
    hipLaunchKernelGGL(mega_fwd, dim3(grid), dim3(NTHR), LDS_BYTES, stream, p);
#else
    for (int ph = 0; ph < N_PHASES; ++ph) {
        if (ph >= 1 && ph < PH_FINAL) { const int l = (ph - 1) / PH_PER_LAYER, k = (ph - 1) % PH_PER_LAYER; if (k == 7 && !(l & 1)) continue; }
        p.ph_lo = ph; p.ph_hi = ph + 1;
        hipLaunchKernelGGL(mega_fwd, dim3(grid), dim3(NTHR), LDS_BYTES, stream, p);
    }
#endif
}
```

```cpp
#include <hip/hip_runtime.h>
#include <cstdio>
#include <cstdint>
#include <cstring>

#ifndef MK_ONE_LAUNCH
#define MK_ONE_LAUNCH 1
#endif

#define LAS __attribute__((address_space(3)))
#define GAS __attribute__((address_space(1)))
typedef unsigned short bf16_t;
typedef short bf16x8 __attribute__((ext_vector_type(8)));
typedef float f32x4 __attribute__((ext_vector_type(4)));
typedef float f32x2 __attribute__((ext_vector_type(2)));
typedef float f32x16 __attribute__((ext_vector_type(16)));
typedef unsigned u32x4 __attribute__((ext_vector_type(4)));
typedef unsigned u32x2 __attribute__((ext_vector_type(2)));

constexpr int D = 1024, NB = 4, SEQ = 4096, CTX = 256, DEPTH = 4;
constexpr int MC = NB * CTX, MX = NB * SEQ, MT = MC + MX;
constexpr int DIN = 2992, DINP = 3072, DFF = 3584, NE = 8;
constexpr int NSU = 2 * NB * 4 * 68;
constexpr int PC_AQ = 0, PC_AK = 256, PC_AV = 384, PC_BQKV = 512, PC_BGATE = 1280, PC_BAB = 1536, PC_CQ = 1552, PC_CKV = 1808, PC_CKR = 1936,
              PC_DQ = 1968, PC_DK = 2224, PC_DV = 2480, PC_DGATE = 2736;
constexpr float EPS = 1e-6f, LOG2E = 1.4426950408889634f;
constexpr int MOE_ROWS = 36864, MOE_TILES = MOE_ROWS / 256;

constexpr size_t MiB = 1u << 20;
constexpr size_t WS_CTL = 0, CTL_BYTES = 1 * MiB;
constexpr int CW_BAR = 4096;
constexpr int CW_CNT = 16384;
constexpr int CW_TILEE = 20480;
constexpr size_t WS_TAB = 1 * MiB;
constexpr size_t WS_MOD = WS_TAB + 65536;
constexpr size_t WS_ROUTE = 2 * MiB;
constexpr size_t WS_DEC = 3 * MiB;
constexpr size_t WS_WIN = 4 * MiB;
constexpr size_t WS_WINV = WS_WIN + 24 * MiB;
constexpr size_t WS_WOUT = WS_WINV + 2 * MiB;
constexpr size_t WS_WUP = WS_WOUT + 8 * MiB;
constexpr size_t WS_WUPV = WS_WUP + 4 * MiB;
constexpr size_t WS_WFF = WS_WUPV + 1 * MiB;
constexpr size_t FFW_BYTES = (size_t)(7168 * 1024 + 1024 * 3584) * 2;
constexpr size_t WS_WMOE = WS_WFF + 42 * MiB;
constexpr size_t WS_H = WS_WMOE + 168 * MiB;
constexpr size_t WS_U = WS_H + 68 * MiB;
constexpr size_t WS_OV = WS_U + 34 * MiB;
constexpr size_t WS_P = WS_OV;
constexpr size_t WS_VTS = WS_P + 102 * MiB;
constexpr size_t WS_AUP = WS_VTS + 9 * MiB;
constexpr size_t WS_QRAW = WS_AUP + 17 * MiB;
constexpr size_t WS_KFULL = WS_QRAW + 13 * MiB;
constexpr size_t WS_VTM = WS_KFULL + 13 * MiB;
constexpr size_t WS_QS = WS_VTM + 9 * MiB;
constexpr size_t WS_KS = WS_QS + 9 * MiB;
constexpr size_t WS_MIX = WS_KS + 5 * MiB;
constexpr size_t WS_REC = WS_MIX + 34 * MiB;
constexpr size_t REC_G_W = 0, REC_G_UT = 8192, REC_G_KDT = 24576, REC_G_QG = 32768, REC_G_ATT = 40960, REC_G_SP = 49152, REC_G_VN = 57344, REC_G_BYTES = 65536;
constexpr size_t REC_R_KV = 0, REC_R_QG = 16384, REC_R_ATT = 24576, REC_R_VF = 32768, REC_R_SP = 40960, REC_R_BYTES = 49152;
constexpr size_t WS_RECG = WS_REC, WS_RECR = WS_REC + (size_t)NSU * REC_G_BYTES;
constexpr size_t WS_OV_END_MIX = WS_RECR + (size_t)NSU * REC_R_BYTES;
constexpr size_t WS_YD = WS_OV + 112 * MiB;
constexpr size_t WS_ASORT = WS_YD + 72 * MiB;
constexpr size_t WS_HD = WS_ASORT + 72 * MiB;
constexpr size_t WS_OV_END_FFN = WS_HD + 252 * MiB;
constexpr size_t WS_END = (WS_OV_END_MIX > WS_OV_END_FFN ? WS_OV_END_MIX : WS_OV_END_FFN);
static_assert(WS_P + (size_t)MT * DINP * 2 <= WS_VTS && WS_VTS + (size_t)256 * MT * 2 <= WS_AUP && WS_AUP + (size_t)MT * 512 * 2 <= WS_QRAW && WS_QRAW + (size_t)MT * 384 * 2 <= WS_KFULL &&
              WS_KFULL + (size_t)MT * 384 * 2 <= WS_VTM && WS_VTM + (size_t)256 * MT * 2 <= WS_QS && WS_QS + (size_t)MT * 256 * 2 <= WS_KS && WS_KS + (size_t)MT * 128 * 2 <= WS_MIX &&
              WS_MIX + (size_t)MT * D * 2 <= WS_REC && WS_YD >= WS_VTS + 9 * MiB && WS_MOD + 491520 <= WS_ROUTE && WS_ROUTE + 417792 <= WS_DEC && WS_DEC + NSU * 4 <= WS_WIN, "ws map");
constexpr size_t WS_SLAB = ((WS_END + MiB - 1) / MiB) * MiB;
constexpr size_t WS_TOTAL = WS_SLAB + 28 * MiB;
static_assert(WS_TOTAL <= 900 * MiB, "ws budget");

constexpr int LDS_BYTES = 147456;
constexpr int LDS_MISC = 147456 - 256;
constexpr int NWAVES = 8, NTHR = 512;

__device__ __forceinline__ unsigned cvtpk(float lo, float hi) { unsigned r; asm volatile("v_cvt_pk_bf16_f32 %0, %1, %2" : "=v"(r) : "v"(lo), "v"(hi)); return r; }
__device__ __forceinline__ float bf_lo(unsigned u) { return __uint_as_float(u << 16); }
__device__ __forceinline__ float bf_hi(unsigned u) { return __uint_as_float(u & 0xffff0000u); }
__device__ __forceinline__ float bf2f(bf16_t h) { return __uint_as_float((unsigned)h << 16); }
__device__ __forceinline__ bf16_t f2bf(float f) { return (bf16_t)(cvtpk(f, 0.f) & 0xffffu); }
__device__ __forceinline__ float wave_sum(float v) {
#pragma unroll
    for (int o = 1; o < 64; o <<= 1) v += __shfl_xor(v, o);
    return v;
}
__device__ __forceinline__ float silu_f(float x) { return x / (1.f + __expf(-x)); }
__device__ __forceinline__ float sigmoid_f(float x) { return 1.f / (1.f + __expf(-x)); }
__device__ __forceinline__ float softplus_f(float x) { return x > 20.f ? x : log1pf(__expf(x)); }
__device__ __forceinline__ int crow(int r, int hi) { return (r & 3) + 8 * (r >> 2) + 4 * hi; }
__device__ __forceinline__ f32x16 mfma32(bf16x8 a, bf16x8 b, f32x16 c) { return __builtin_amdgcn_mfma_f32_32x32x16_bf16(a, b, c, 0, 0, 0); }
__device__ __forceinline__ bf16x8 mk_frag(u32x2 lo, u32x2 hi) { u32x4 v; v.x = lo.x; v.y = lo.y; v.z = hi.x; v.w = hi.y; return __builtin_bit_cast(bf16x8, v); }
__device__ __forceinline__ bf16x8 mk_frag4(unsigned a, unsigned b, unsigned c, unsigned d) { u32x4 v; v.x = a; v.y = b; v.z = c; v.w = d; return __builtin_bit_cast(bf16x8, v); }
__device__ __forceinline__ int mod_row(int row) { return row < MC ? 4 : ((row - MC) >> 12); }

#define XB_TMO      128
#define XB_XCNT(j)  (256  + 64 * (j))
#define XB_XSUB(j)  (1280 + 64 * (j))
#define XB_XGEN(j)  (2304 + 64 * (j))
#define XB_TOP      3328
#define XB_TOPGEN   3392
#define XCD_BAR_WORDS 3456
#define XB_SPIN_CAP (1u << 18)
__device__ __forceinline__ unsigned xb_ld(unsigned* p)              { return __hip_atomic_load(p, __ATOMIC_RELAXED, __HIP_MEMORY_SCOPE_AGENT); }
__device__ __forceinline__ unsigned xb_add(unsigned* p, unsigned v) { return __hip_atomic_fetch_add(p, v, __ATOMIC_RELAXED, __HIP_MEMORY_SCOPE_AGENT); }
__device__ __forceinline__ unsigned xb_xcc_id() { return (unsigned)__builtin_amdgcn_s_getreg((3 << 11) | 20) & 0xFu; }
#define XB_SPIN(cond, bar) do { unsigned _sp = 0; while (cond) { __builtin_amdgcn_s_sleep(1); \
    if ((++_sp & 255u) == 0u) { if (xb_ld(&(bar)[XB_TMO])) break; if (_sp > XB_SPIN_CAP) { atomicAdd(&(bar)[XB_TMO], 1u); break; } } } } while (0)
struct XcdBarrier { unsigned* bar; unsigned x; volatile LAS unsigned* st; };
__device__ __forceinline__ XcdBarrier xcd_barrier_post(unsigned* bar, volatile LAS unsigned* st) {
    XcdBarrier b; b.bar = bar; b.x = xb_xcc_id(); b.st = st;
    if (threadIdx.x == 0) (void)xb_add(&bar[XB_XCNT(b.x)], 1u);
    return b;
}
__device__ __forceinline__ void xcd_barrier_complete(unsigned* bar, unsigned x, unsigned& nloc, unsigned& nx) {
    const unsigned G = gridDim.x * gridDim.y * gridDim.z;
    unsigned sum, cnt, mine, sp = 0u;
    for (;;) {
        sum = 0u; cnt = 0u; mine = 0u;
#pragma unroll
        for (unsigned j = 0; j < 16; ++j) { const unsigned c = xb_ld(&bar[XB_XCNT(j)]); sum += c; cnt += (c > 0u) ? 1u : 0u; mine = (j == x) ? c : mine; }
        if (sum == G) break;
        __builtin_amdgcn_s_sleep(1);
        if ((++sp & 255u) == 0u) { if (xb_ld(&bar[XB_TMO])) break; if (sp > XB_SPIN_CAP) { atomicAdd(&bar[XB_TMO], 1u); break; } }
    }
    nloc = mine > 0u ? mine : 1u; nx = cnt > 0u ? cnt : 1u;
}
__device__ __forceinline__ void xcd_barrier(const XcdBarrier& b) {
    asm volatile("s_waitcnt vmcnt(0)" ::: "memory");
    __syncthreads();
    if (threadIdx.x == 0) {
        unsigned* bar = b.bar;
        __builtin_amdgcn_s_waitcnt(0);
        unsigned nloc = b.st[0], nx = b.st[1];
        if (nloc == 0u) { xcd_barrier_complete(bar, b.x, nloc, nx); b.st[0] = nloc; b.st[1] = nx; }
        const unsigned old = xb_add(&bar[XB_XSUB(b.x)], 1u);
        const unsigned gen = old / nloc;
        if (old + 1u == (gen + 1u) * nloc) {
            __builtin_amdgcn_fence(__ATOMIC_RELEASE, "agent");
            asm volatile("s_waitcnt vmcnt(0)" ::: "memory");
            const unsigned og = xb_add(&bar[XB_TOP], 1u);
            const unsigned tg = og / nx;
            if (og + 1u == (tg + 1u) * nx) xb_add(&bar[XB_TOPGEN], 1u);
            else XB_SPIN(xb_ld(&bar[XB_TOPGEN]) == tg, bar);
            __builtin_amdgcn_fence(__ATOMIC_ACQUIRE, "agent");
            xb_add(&bar[XB_XGEN(b.x)], 1u);
            asm volatile("s_waitcnt vmcnt(0)" ::: "memory");
        } else {
            XB_SPIN(xb_ld(&bar[XB_XGEN(b.x)]) == gen, bar);
            __builtin_amdgcn_fence(__ATOMIC_ACQUIRE, "agent");
            asm volatile("s_waitcnt vmcnt(0)" ::: "memory");
        }
    }
    __syncthreads();
}
namespace pg8 {
#define PG8_LAS __attribute__((address_space(3)))
typedef unsigned short bf16_t;
typedef short bf16x8 __attribute__((ext_vector_type(8)));
typedef float f32x4 __attribute__((ext_vector_type(4)));
typedef unsigned u32x4 __attribute__((ext_vector_type(4)));
constexpr int BM = 256, BK = 64, HALF = 128, HTB = HALF * BK * 2  , STAGE_BYTES = 8 * HTB, NXCD = 8, WGM = 8;

__host__ __device__ __forceinline__ int lds_byte(int r, int c) { const int st = (r >> 4) * 2 + (c >> 5), rr = r & 15, cc = c & 31, ob = rr * 64 + cc * 2; return st * 1024 + (ob ^ (((ob >> 9) & 1) << 5)); }
__host__ __device__ __forceinline__ void stage_rc(int b, int& R, int& C) { const int st = b / 1024, sb = b % 1024, swz = sb ^ (((sb >> 9) & 1) << 5); R = (st >> 1) * 16 + swz / 64; C = (st & 1) * 32 + (swz % 64) / 2; }
__host__ __device__ __forceinline__ int perm32(int rho) { const int n = rho >> 4, i = rho & 15; return 8 * (i >> 2) + 4 * n + (i & 3); }

struct Unit { int pm, pn, ko; };
struct Gemm { const bf16_t* A; const bf16_t* Bt; int M, N, K, lda, ldb; };

struct StaticOrder {
    int nM, nN, nwg, G, c;
    __host__ __device__ void init(int M, int N, int G_, int c_) { nM = M / BM; nN = N / BM; nwg = nM * nN; G = G_; c = c_; }
    __host__ __device__ bool next(int i, Unit& u) const {
        const long L = (long)i * G + c; if (L >= nwg) return false;
        int wgid = (int)L; { const int q = nwg / NXCD, r = nwg % NXCD, xcd = wgid % NXCD, off = wgid / NXCD; wgid = (xcd < r ? xcd * (q + 1) : r * (q + 1) + (xcd - r) * q) + off; }
        const int nig = WGM * nN, gid = wgid / nig, fm = gid * WGM, gsz = (nM - fm) < WGM ? (nM - fm) : WGM;
        u.pm = fm + ((wgid % nig) % gsz); u.pn = (wgid % nig) / gsz; u.ko = 0; return true;
    }
    __device__ __forceinline__ void a_ready(const Unit&) const {}
    __device__ __forceinline__ void done(const Unit&) const {}
};
__device__ __forceinline__ unsigned cvt_pk_bf16(float lo, float hi) { unsigned r; asm volatile("v_cvt_pk_bf16_f32 %0, %1, %2" : "=v"(r) : "v"(lo), "v"(hi)); return r; }
template <class Epi, class Sched, bool ALIGN_EPI = false, bool SP2 = false>
__device__ __forceinline__ void gemm_phase(PG8_LAS unsigned char* lds, const Gemm g, const Sched& S, const Epi& E) {
    int tid_l = threadIdx.x; asm volatile("" : "+v"(tid_l));
    const int tid = tid_l, wid = __builtin_amdgcn_readfirstlane(tid >> 6), lane = tid & 63, wr = wid >> 2, wc = wid & 3, fr = lane & 15, fq = lane >> 4;
    const int K = g.K, nt = K / BK;
    unsigned voffA[2], voffB[2];
#pragma unroll
    for (int i = 0; i < 2; ++i) { int R, C; stage_rc(tid * 16 + i * 8192, R, C); const int Rb = Epi::PERM ? ((R & ~31) + perm32(R & 31)) : R;
        voffA[i] = (unsigned)(R * g.lda + C) * 2u; voffB[i] = (unsigned)(Rb * g.ldb + C) * 2u; }
    const size_t kstep = (size_t)(BK * 2);
    const size_t hstepA = (size_t)HALF * g.lda * 2, hstepB = (size_t)HALF * g.ldb * 2;
    const size_t tstepA = 2 * hstepA, tstepB = 2 * hstepB;
    const unsigned ldsw = (unsigned)wid * 1024u;
    const int aoff = lds_byte(wr * 64 + fr, fq * 8), boff = lds_byte(wc * 32 + fr, fq * 8);
#define PG8_SA(b, h) (((b) * 2 + (h)) * HTB)
#define PG8_SB(b, h) ((4 + (b) * 2 + (h)) * HTB)
#define PG8_STAGE(bufoff, gbase, voff) do { _Pragma("unroll") for (int _i = 0; _i < 2; ++_i) \
        __builtin_amdgcn_global_load_lds((const unsigned*)((const char*)(gbase) + (voff)[_i]), (PG8_LAS unsigned*)(lds + (bufoff) + ldsw + _i * 8192), 16, 0, 0); } while (0)
#define PG8_LDA(dst, b, h) do { _Pragma("unroll") for (int m = 0; m < 4; ++m) _Pragma("unroll") for (int k = 0; k < 2; ++k) dst[m][k] = *(const PG8_LAS bf16x8*)(lds + PG8_SA(b, h) + aoff + m * 2048 + k * 1024); } while (0)
#define PG8_LDB(dst, b, h) do { _Pragma("unroll") for (int n = 0; n < 2; ++n) _Pragma("unroll") for (int k = 0; k < 2; ++k) dst[n][k] = *(const PG8_LAS bf16x8*)(lds + PG8_SB(b, h) + boff + n * 2048 + k * 1024); } while (0)
#define PG8_MMA(ai, bj, At, Bt) do { __builtin_amdgcn_s_setprio(1); _Pragma("unroll") for (int m = 0; m < 4; ++m) _Pragma("unroll") for (int n = 0; n < 2; ++n) _Pragma("unroll") for (int k = 0; k < 2; ++k) \
        acc[ai][bj][m][n] = __builtin_amdgcn_mfma_f32_16x16x32_bf16(Bt[n][k], At[m][k], acc[ai][bj][m][n], 0, 0, 0); __builtin_amdgcn_s_setprio(0); } while (0)
#define PG8_WAIT_V(n) asm volatile("s_waitcnt vmcnt(" #n ")" ::: "memory")
#define PG8_WAIT_L(n) asm volatile("s_waitcnt lgkmcnt(" #n ")" ::: "memory")
#define PG8_BAR __builtin_amdgcn_s_barrier()
#define PG8_SCHED __builtin_amdgcn_sched_barrier(0)
    Unit cur, nxt; int ui = 0;
    if (!S.next(0, cur)) return;
    f32x4 acc[2][2][4][2];
#pragma unroll
    for (int a = 0; a < 2; ++a)
#pragma unroll
        for (int b = 0; b < 2; ++b)
#pragma unroll
            for (int m = 0; m < 4; ++m)
#pragma unroll
                for (int n = 0; n < 2; ++n) acc[a][b][m][n] = (f32x4){0.f, 0.f, 0.f, 0.f};
    bf16x8 At[4][2], B0[2][2], B1[2][2];
    const char* cA = (const char*)g.A + (size_t)cur.pm * tstepA + (size_t)cur.ko * 2; const char* cB = (const char*)g.Bt + (size_t)cur.pn * tstepB + (size_t)cur.ko * 2;
    S.a_ready(cur);
    if constexpr (SP2) {
        PG8_STAGE(PG8_SB(0, 0), cB, voffB); PG8_STAGE(PG8_SB(0, 1), cB + hstepB, voffB); PG8_STAGE(PG8_SA(0, 0), cA, voffA); PG8_STAGE(PG8_SA(0, 1), cA + hstepA, voffA);
        if (wr == 1) PG8_BAR;
        PG8_WAIT_V(2); PG8_BAR;
        PG8_STAGE(PG8_SB(1, 0), cB + kstep, voffB); PG8_STAGE(PG8_SA(1, 0), cA + kstep, voffA); PG8_STAGE(PG8_SB(1, 1), cB + hstepB + kstep, voffB);
        PG8_WAIT_V(6); PG8_BAR;
    } else {
        PG8_STAGE(PG8_SB(0, 0), cB, voffB); PG8_STAGE(PG8_SA(0, 0), cA, voffA); PG8_STAGE(PG8_SB(0, 1), cB + hstepB, voffB); PG8_STAGE(PG8_SA(0, 1), cA + hstepA, voffA);
        if (wr == 1) PG8_BAR;
        PG8_WAIT_V(4); PG8_BAR;
        PG8_STAGE(PG8_SB(1, 0), cB + kstep, voffB); PG8_STAGE(PG8_SA(1, 0), cA + kstep, voffA); PG8_STAGE(PG8_SB(1, 1), cB + hstepB + kstep, voffB);
        PG8_WAIT_V(6); PG8_BAR;
    }
    for (;;) {
        const bool has_next = S.next(ui + 1, nxt);
        const char* nA = has_next ? (const char*)g.A + (size_t)nxt.pm * tstepA + (size_t)nxt.ko * 2 : cA; const char* nB = has_next ? (const char*)g.Bt + (size_t)nxt.pn * tstepB + (size_t)nxt.ko * 2 : cB;
        for (int t = 0; t < nt; t += 2) {
            const bool last = (t == nt - 2);
            const char* a1 = cA + (size_t)(t + 1) * kstep;
            const char* a2 = last ? nA : cA + (size_t)(t + 2) * kstep; const char* b2 = last ? nB : cB + (size_t)(t + 2) * kstep;
            const char* a3 = a2 + kstep; const char* b3 = b2 + kstep;
            if (last && has_next) S.a_ready(nxt);
            if constexpr (SP2) {
            PG8_LDB(B0, 0, 0); PG8_LDB(B1, 0, 1); PG8_SCHED; PG8_LDA(At, 0, 0); PG8_STAGE(PG8_SA(1, 1), a1 + hstepA, voffA);
            PG8_WAIT_V(8); PG8_WAIT_L(0); PG8_BAR; PG8_MMA(0, 0, At, B0); PG8_MMA(0, 1, At, B1); PG8_BAR; PG8_SCHED;
            PG8_LDA(At, 0, 1); PG8_STAGE(PG8_SB(0, 0), b2, voffB); PG8_STAGE(PG8_SB(0, 1), b2 + hstepB, voffB); PG8_STAGE(PG8_SA(0, 0), a2, voffA);
            PG8_WAIT_V(8); PG8_WAIT_L(0); PG8_BAR; PG8_MMA(1, 0, At, B0); PG8_MMA(1, 1, At, B1); PG8_BAR; PG8_SCHED;
            PG8_LDB(B0, 1, 0); PG8_LDB(B1, 1, 1); PG8_SCHED; PG8_LDA(At, 1, 0); PG8_STAGE(PG8_SA(0, 1), a2 + hstepA, voffA);
            PG8_WAIT_V(8); PG8_WAIT_L(0); PG8_BAR; PG8_MMA(0, 0, At, B0); PG8_MMA(0, 1, At, B1); PG8_BAR; PG8_SCHED;
            PG8_LDA(At, 1, 1); PG8_STAGE(PG8_SB(1, 0), b3, voffB); PG8_STAGE(PG8_SB(1, 1), b3 + hstepB, voffB); PG8_STAGE(PG8_SA(1, 0), a3, voffA);
            PG8_WAIT_V(8); PG8_WAIT_L(0); PG8_BAR; PG8_MMA(1, 0, At, B0); PG8_MMA(1, 1, At, B1); PG8_BAR; PG8_SCHED;
            } else {
            PG8_LDB(B0, 0, 0); PG8_SCHED; PG8_LDA(At, 0, 0); PG8_STAGE(PG8_SA(1, 1), a1 + hstepA, voffA);
            PG8_WAIT_L(8); PG8_BAR; PG8_WAIT_L(0); PG8_MMA(0, 0, At, B0); PG8_BAR; PG8_SCHED;
            PG8_LDB(B1, 0, 1); PG8_STAGE(PG8_SB(0, 0), b2, voffB);
            PG8_BAR; PG8_WAIT_L(0); PG8_MMA(0, 1, At, B1); PG8_BAR;
            PG8_LDA(At, 0, 1); PG8_STAGE(PG8_SA(0, 0), a2, voffA);
            PG8_BAR; PG8_WAIT_L(0); PG8_MMA(1, 0, At, B0); PG8_BAR; PG8_SCHED;
            PG8_STAGE(PG8_SB(0, 1), b2 + hstepB, voffB);
            PG8_WAIT_V(6); PG8_BAR; PG8_MMA(1, 1, At, B1); PG8_BAR;
            PG8_LDB(B0, 1, 0); PG8_SCHED; PG8_LDA(At, 1, 0); PG8_STAGE(PG8_SA(0, 1), a2 + hstepA, voffA);
            PG8_WAIT_L(8); PG8_BAR; PG8_WAIT_L(0); PG8_MMA(0, 0, At, B0); PG8_BAR; PG8_SCHED;
            PG8_LDB(B1, 1, 1); PG8_STAGE(PG8_SB(1, 0), b3, voffB);
            PG8_BAR; PG8_WAIT_L(0); PG8_MMA(0, 1, At, B1); PG8_BAR;
            PG8_LDA(At, 1, 1); PG8_STAGE(PG8_SA(1, 0), a3, voffA);
            PG8_BAR; PG8_WAIT_L(0); PG8_MMA(1, 0, At, B0); PG8_BAR; PG8_SCHED;
            PG8_STAGE(PG8_SB(1, 1), b3 + hstepB, voffB);
            PG8_WAIT_V(6); PG8_BAR; PG8_MMA(1, 1, At, B1); PG8_BAR;
            }
        }
        if constexpr (ALIGN_EPI) { if (wr == 0) PG8_BAR; }
        if constexpr (!Epi::AFTER_DRAIN) { E(acc, cur, wr, wc, fr, fq); S.done(cur); }
        if (!has_next) break;
#pragma unroll
        for (int a = 0; a < 2; ++a)
#pragma unroll
            for (int b = 0; b < 2; ++b)
#pragma unroll
                for (int m = 0; m < 4; ++m)
#pragma unroll
                    for (int n = 0; n < 2; ++n) acc[a][b][m][n] = (f32x4){0.f, 0.f, 0.f, 0.f};
        cur = nxt; cA = nA; cB = nB; ++ui;
        if constexpr (ALIGN_EPI) { if (wr == 1) PG8_BAR; }
    }
    PG8_WAIT_V(0);
    if constexpr (!ALIGN_EPI) { if (wr == 0) PG8_BAR; }
    PG8_BAR;
    if constexpr (Epi::AFTER_DRAIN) { E.fused(acc, cur, wr, wc, fr, fq, lds, wid, lane); S.done(cur); }
#undef PG8_SA
#undef PG8_SB
#undef PG8_STAGE
#undef PG8_LDA
#undef PG8_LDB
#undef PG8_MMA
#undef PG8_WAIT_V
#undef PG8_WAIT_L
#undef PG8_BAR
#undef PG8_SCHED
}
}

namespace pg8 {
struct OrderPM : StaticOrder {
    int pm0;
    __device__ __forceinline__ bool next(int i, Unit& u) const { if (!StaticOrder::next(i, u)) return false; u.pm += pm0; return true; }
};
struct MoeOrder {
    int nN, G, c, ntiles; const unsigned* tile_e;
    __device__ __forceinline__ bool next(int i, Unit& u) const {
        const long L = (long)i * G + c; if (L >= (long)ntiles * nN) return false;
        const int pm = (int)(L / nN), pl = (int)(L % nN);
        const int e = (int)__hip_atomic_load(tile_e + pm, __ATOMIC_RELAXED, __HIP_MEMORY_SCOPE_AGENT);
        u.pm = pm; u.pn = __builtin_amdgcn_readfirstlane(e) * nN + pl; u.ko = 0; return true;
    }
    __device__ __forceinline__ void a_ready(const Unit&) const {}
    __device__ __forceinline__ void done(const Unit&) const {}
};

struct SplitKOrder {
    int G, c, ns, kslice;
    __device__ __forceinline__ bool next(int i, Unit& u) const { const int L = i * G + c; if (L >= 16 * ns) return false; const int sl = L % ns, t = L / ns; u.pm = t & 3; u.pn = t >> 2; u.ko = sl * kslice; return true; }
    __device__ __forceinline__ void a_ready(const Unit&) const {}
    __device__ __forceinline__ void done(const Unit&) const {}
};
struct EpiStore {
    static constexpr bool PERM = true, AFTER_DRAIN = false;
    bf16_t* O; int ldc; int pn_mod;
    __device__ __forceinline__ void operator()(const f32x4 (&acc)[2][2][4][2], const Unit& u, int wr, int wc, int fr, int fq) const {
        const int row0 = u.pm * BM + wr * 64 + fr, col0 = (u.pn % pn_mod) * BM + wc * 32 + 8 * fq;
#pragma unroll
        for (int ai = 0; ai < 2; ++ai)
#pragma unroll
            for (int m = 0; m < 4; ++m) { bf16_t* rowp = O + (size_t)(row0 + ai * HALF + m * 16) * ldc + col0;
#pragma unroll
                for (int bj = 0; bj < 2; ++bj) { const f32x4 v0 = acc[ai][bj][m][0], v1 = acc[ai][bj][m][1];
                    u32x4 w; w.x = cvt_pk_bf16(v0[0], v0[1]); w.y = cvt_pk_bf16(v0[2], v0[3]); w.z = cvt_pk_bf16(v1[0], v1[1]); w.w = cvt_pk_bf16(v1[2], v1[3]);
                    *(u32x4*)(rowp + bj * HALF) = w; } }
    }
};
struct EpiUp {
    static constexpr bool PERM = true, AFTER_DRAIN = false;
    bf16_t* Q; bf16_t* K;
    __device__ __forceinline__ void operator()(const f32x4 (&acc)[2][2][4][2], const Unit& u, int wr, int wc, int fr, int fq) const {
        const int row0 = u.pm * BM + wr * 64 + fr;
#pragma unroll
        for (int bj = 0; bj < 2; ++bj) {
            const int col = u.pn * BM + bj * HALF + wc * 32 + 8 * fq;
            bf16_t* base;
            if (col < 384) base = Q + col; else if (col < 640) { const int c2 = col - 384; base = K + (c2 >> 6) * 96 + (c2 & 63); } else continue;
#pragma unroll
            for (int ai = 0; ai < 2; ++ai)
#pragma unroll
                for (int m = 0; m < 4; ++m) { const f32x4 v0 = acc[ai][bj][m][0], v1 = acc[ai][bj][m][1];
                    u32x4 w; w.x = cvt_pk_bf16(v0[0], v0[1]); w.y = cvt_pk_bf16(v0[2], v0[3]); w.z = cvt_pk_bf16(v1[0], v1[1]); w.w = cvt_pk_bf16(v1[2], v1[3]);
                    *(u32x4*)(base + (size_t)(row0 + ai * HALF + m * 16) * 384) = w; }
        }
    }
};
template <bool ATOMIC> struct EpiResT {
    static constexpr bool PERM = false, AFTER_DRAIN = false;
    float* H; const float* gate;
    __device__ __forceinline__ void operator()(const f32x4 (&acc)[2][2][4][2], const Unit& u, int wr, int wc, int fr, int fq) const {
        const int row0 = u.pm * BM + wr * 64 + fr, col0 = u.pn * BM + wc * 32 + 4 * fq;
        const int mb = (u.pm < 4) ? 4 : ((u.pm - 4) >> 4);
        const float* gp = gate + (size_t)mb * 6144 + col0;
        f32x4 gv[2][2];
#pragma unroll
        for (int bj = 0; bj < 2; ++bj)
#pragma unroll
            for (int n = 0; n < 2; ++n) gv[bj][n] = *(const f32x4*)(gp + bj * HALF + n * 16);
#pragma unroll
        for (int ai = 0; ai < 2; ++ai)
#pragma unroll
            for (int m = 0; m < 4; ++m) { float* rowp = H + (size_t)(row0 + ai * HALF + m * 16) * D + col0;
#pragma unroll
                for (int bj = 0; bj < 2; ++bj)
#pragma unroll
                    for (int n = 0; n < 2; ++n) { float* pp = rowp + bj * HALF + n * 16; const f32x4 v = gv[bj][n] * acc[ai][bj][m][n];
                        f32x4* p = (f32x4*)pp; *p = *p + v; } }
    }
};
typedef EpiResT<false> EpiRes;
struct EpiSlab {
    static constexpr bool PERM = false, AFTER_DRAIN = false;
    float* slab; const float* gate; int kslice;
    __device__ __forceinline__ void operator()(const f32x4 (&acc)[2][2][4][2], const Unit& u, int wr, int wc, int fr, int fq) const {
        const int row0 = u.pm * BM + wr * 64 + fr, col0 = u.pn * BM + wc * 32 + 4 * fq;
        const float* gp = gate + (size_t)4 * 6144 + col0; float* sb = slab + (size_t)(u.ko / kslice) * MC * D;
        f32x4 gv[2][2];
#pragma unroll
        for (int bj = 0; bj < 2; ++bj)
#pragma unroll
            for (int n = 0; n < 2; ++n) gv[bj][n] = *(const f32x4*)(gp + bj * HALF + n * 16);
#pragma unroll
        for (int ai = 0; ai < 2; ++ai)
#pragma unroll
            for (int m = 0; m < 4; ++m) { float* rowp = sb + (size_t)(row0 + ai * HALF + m * 16) * D + col0;
#pragma unroll
                for (int bj = 0; bj < 2; ++bj)
#pragma unroll
                    for (int n = 0; n < 2; ++n) *(f32x4*)(rowp + bj * HALF + n * 16) = gv[bj][n] * acc[ai][bj][m][n]; }
    }
};
struct EpiSwiGLU {
    static constexpr bool PERM = true, AFTER_DRAIN = false;
    bf16_t* Hd;
    __device__ __forceinline__ void operator()(const f32x4 (&acc)[2][2][4][2], const Unit& u, int wr, int wc, int fr, int fq) const {
        const int row0 = u.pm * BM + wr * 64 + fr, col0 = (u.pn % 28) * HALF + wc * 32 + 8 * fq;
#pragma unroll
        for (int ai = 0; ai < 2; ++ai)
#pragma unroll
            for (int m = 0; m < 4; ++m) {
                float o[8];
#pragma unroll
                for (int n = 0; n < 2; ++n)
#pragma unroll
                    for (int q = 0; q < 4; ++q) { const float g = acc[ai][0][m][n][q], up = acc[ai][1][m][n][q]; o[n * 4 + q] = g / (1.f + __expf(-g)) * up; }
                u32x4 w; w.x = cvt_pk_bf16(o[0], o[1]); w.y = cvt_pk_bf16(o[2], o[3]); w.z = cvt_pk_bf16(o[4], o[5]); w.w = cvt_pk_bf16(o[6], o[7]);
                *(u32x4*)(Hd + (size_t)(row0 + ai * HALF + m * 16) * DFF + col0) = w; }
    }
};
}

enum { I_X = 0, I_C, I_CTX, I_CCTX, I_WMOD, I_BMOD, I_NORM1, I_NORM2, I_WIN, I_WOUT, I_SINK, I_GCONV, I_GALOG, I_GDTB, I_GNORM, I_QNORM, I_KVNORM, I_WQUP, I_WKVUP,
       I_RLOGD, I_RNORM, I_FGATE, I_FUP, I_FDOWN, I_ROUTER, I_MGATE, I_MUP, I_MDOWN, I_FNORM, N_IN };
struct Params { const float* in[N_IN]; float* out; unsigned char* ws; int ph_lo, ph_hi; };
typedef const __attribute__((address_space(4))) Params* KArg;
__device__ __forceinline__ KArg kp_get() { KArg k = (KArg)__builtin_amdgcn_kernarg_segment_ptr(); asm volatile("" : "+s"(k)); return k; }

struct Ctx {
    LAS unsigned char* lds; int tid, lane, wave, bid, G;
};

__device__ __forceinline__ void tr_item(const float* src, int ldsrc, int nvalid, int k0, int c0, bf16_t* dst, int ldd, int drow0, LAS float* scr, int lane) {
    const int n_ = lane & 31, cc = c0 + n_;
#pragma unroll 8
    for (int i = 0; i < 32; ++i) { const int kk = 2 * i + (lane >> 5); scr[kk * 33 + n_] = (cc < nvalid) ? src[(size_t)(k0 + kk) * ldsrc + cc] : 0.f; }
    asm volatile("s_waitcnt lgkmcnt(0)" ::: "memory");
    const int c = lane & 7;
#pragma unroll
    for (int j = 0; j < 4; ++j) { const int n = (lane >> 3) + 8 * j; const LAS float* s = scr + (8 * c) * 33 + n;
        u32x4 o; o.x = cvtpk(s[0 * 33], s[1 * 33]); o.y = cvtpk(s[2 * 33], s[3 * 33]); o.z = cvtpk(s[4 * 33], s[5 * 33]); o.w = cvtpk(s[6 * 33], s[7 * 33]);
        *(u32x4*)(dst + (size_t)(drow0 + n) * ldd + k0 + 8 * c) = o; }
    asm volatile("s_waitcnt lgkmcnt(0)" ::: "memory");
}
__device__ __forceinline__ void ffn_tr_item(const float* g, const float* u, const float* d, bf16_t* gu, bf16_t* dn, int it, LAS float* scr, int lane) {
    if (it < 3584) { const bool up = it >= 1792; const int r = up ? it - 1792 : it; const int kb = r / 112, cb = r % 112, c0 = 32 * cb;
        tr_item(up ? u : g, DFF, DFF, 64 * kb, c0, gu, 1024, 256 * (c0 >> 7) + (up ? 128 : 0) + (c0 & 127), scr, lane); }
    else { const int r = it - 3584; const int kb = r / 32, cb = r % 32; tr_item(d, 1024, 1024, 64 * kb, 32 * cb, dn, DFF, 32 * cb, scr, lane); }
}

__device__ __forceinline__ void convert_layer_weights(KArg p, const Ctx& C, int ln, int gw, int NGW) {
    unsigned char* ws = p->ws; LAS float* scr = (LAS float*)(C.lds + C.wave * 8704);
    constexpr int I_IN = 16 * 96, I_OUT = 16 * 32, I_FF = 5376;
    const bool moe = (ln & 1) != 0; const int i = ln >> 1;
    const int nit = I_IN + I_OUT + (moe ? 8 * I_FF : I_FF);
    for (int it = gw; it < nit; it += NGW) {
        int r = it;
        if (r < I_IN) { const int kb = r / 96, cb = r % 96;
            tr_item(p->in[I_WIN] + (size_t)ln * D * DIN, DIN, DIN, 64 * kb, 32 * cb, (bf16_t*)(ws + WS_WIN) + (size_t)ln * DINP * D, D, 32 * cb, scr, C.lane); continue; }
        r -= I_IN;
        if (r < I_OUT) { const int kb = r / 32, cb = r % 32;
            tr_item(p->in[I_WOUT] + (size_t)ln * D * D, D, D, 64 * kb, 32 * cb, (bf16_t*)(ws + WS_WOUT) + (size_t)ln * D * D, D, 32 * cb, scr, C.lane); continue; }
        r -= I_OUT;
        if (!moe) { bf16_t* gu = (bf16_t*)(ws + WS_WFF + (size_t)i * FFW_BYTES);
            ffn_tr_item(p->in[I_FGATE] + (size_t)i * D * DFF, p->in[I_FUP] + (size_t)i * D * DFF, p->in[I_FDOWN] + (size_t)i * DFF * D, gu, gu + (size_t)7168 * 1024, r, scr, C.lane); }
        else { const int e = r / I_FF; r %= I_FF; const size_t eo = (size_t)i * NE + e;
            bf16_t* gu = (bf16_t*)(ws + WS_WMOE) + (size_t)e * 7168 * 1024; bf16_t* dn = (bf16_t*)(ws + WS_WMOE) + (size_t)8 * 7168 * 1024 + (size_t)e * 1024 * DFF;
            ffn_tr_item(p->in[I_MGATE] + eo * D * DFF, p->in[I_MUP] + eo * D * DFF, p->in[I_MDOWN] + eo * DFF * D, gu, dn, r, scr, C.lane); }
    }
}

__device__ __forceinline__ void prologue_phase(KArg p, const Ctx& C) {
    unsigned char* ws = p->ws;
    const int gw = C.bid * NWAVES + C.wave, NGW = C.G * NWAVES, gt = C.bid * NTHR + C.tid, NGT = C.G * NTHR;
    convert_layer_weights(p, C, 0, gw, NGW);
    {
        constexpr int PER_L = 256 * 128 + 1024 * 64 + 256 * 64;
        for (int it = gt; it < 4 * PER_L; it += NGT) {
            const int l = it / PER_L; int r = it % PER_L;
            const float* win = p->in[I_WIN] + (size_t)l * D * DIN; const float* qup = p->in[I_WQUP] + (size_t)l * 256 * 384; const float* kvup = p->in[I_WKVUP] + (size_t)l * 128 * 512;
            float v[8]; bf16_t* dst;
            if (r < 256 * 128) { const int n = r % 256, kg = r / 256;
#pragma unroll
                for (int j = 0; j < 8; ++j) v[j] = (n < 128) ? win[(size_t)(8 * kg + j) * DIN + PC_AV + n] : 0.f;
                dst = (bf16_t*)(ws + WS_WINV) + ((size_t)l * 256 + n) * 1024 + 8 * kg; }
            else if ((r -= 256 * 128) < 1024 * 64) { const int n = r % 1024, kg = r / 1024;
#pragma unroll
                for (int j = 0; j < 8; ++j) { const int k = 8 * kg + j; float x = 0.f;
                    if (n < 384) { if (k < 256) x = qup[(size_t)k * 384 + n]; }
                    else if (n < 640) { const int c2 = n - 384; if (k >= 256 && k < 384) x = kvup[(size_t)(k - 256) * 512 + 128 * (c2 >> 6) + (c2 & 63)]; }
                    v[j] = x; }
                dst = (bf16_t*)(ws + WS_WUP) + ((size_t)l * 1024 + n) * 512 + 8 * kg; }
            else { r -= 1024 * 64; const int n = r % 256, kg = r / 256;
#pragma unroll
                for (int j = 0; j < 8; ++j) { const int k = 8 * kg + j; v[j] = (k >= 256 && k < 384) ? kvup[(size_t)(k - 256) * 512 + 128 * (n >> 6) + 64 + (n & 63)] : 0.f; }
                dst = (bf16_t*)(ws + WS_WUPV) + ((size_t)l * 256 + n) * 512 + 8 * kg; }
            u32x4 o; o.x = cvtpk(v[0], v[1]); o.y = cvtpk(v[2], v[3]); o.z = cvtpk(v[4], v[5]); o.w = cvtpk(v[6], v[7]);
            *(u32x4*)dst = o;
        }
    }
    {
        float* tab = (float*)(ws + WS_TAB);
        for (int it = gt; it < 64 * 16 + 64 * 8; it += NGT) {
            if (it < 1024) { const int pos = it >> 4, j = it & 15; const float inv = (float)pow(10000.0, -(double)j / 16.0); const float ang = (float)pos * inv;
                tab[it] = (float)cos((double)ang); tab[1024 + it] = (float)sin((double)ang); }
            else { const int r = it - 1024; const int pos = r >> 3, j = r & 7; const float inv = (float)pow(10000.0, -(double)j / 8.0); const float ang = (float)pos * inv;
                tab[2048 + r] = (float)cos((double)ang); tab[2560 + r] = (float)sin((double)ang); }
        }
    }
    {
        f32x4* H4 = (f32x4*)(ws + WS_H); const f32x4* x4 = (const f32x4*)p->in[I_X]; const f32x4* c4 = (const f32x4*)p->in[I_CTX];
        for (int it = gt; it < MT * 256; it += NGT) H4[it] = (it < MC * 256) ? c4[it] : x4[it - MC * 256];
    }
    __syncthreads();
    if (C.bid < 192) {
        LAS float* sl = (LAS float*)C.lds;
        LAS float* red = (LAS float*)(C.lds + 20480);
        for (int i = C.tid; i < 5 * 1024; i += NTHR) { const int r = i >> 10, k = i & 1023; const float cv = (r < 4) ? p->in[I_C][r * 1024 + k] : p->in[I_CCTX][k]; sl[i] = silu_f(cv); }
        __syncthreads();
        for (int it = C.bid; it < 192; it += C.G) {
            const int l = it / 48, cb = it % 48, cl = C.tid & 127, kq = C.tid >> 7, col = cb * 128 + cl;
            const float* w = p->in[I_WMOD] + (size_t)l * D * 6144 + col;
            float a0 = 0.f, a1 = 0.f, a2 = 0.f, a3 = 0.f, a4 = 0.f;
#pragma unroll 8
            for (int k = 256 * kq; k < 256 * kq + 256; ++k) { const float wv = w[(size_t)k * 6144]; a0 += sl[k] * wv; a1 += sl[1024 + k] * wv; a2 += sl[2048 + k] * wv; a3 += sl[3072 + k] * wv; a4 += sl[4096 + k] * wv; }
            red[(kq * 5 + 0) * 128 + cl] = a0; red[(kq * 5 + 1) * 128 + cl] = a1; red[(kq * 5 + 2) * 128 + cl] = a2; red[(kq * 5 + 3) * 128 + cl] = a3; red[(kq * 5 + 4) * 128 + cl] = a4;
            __syncthreads();
            for (int i = C.tid; i < 5 * 128; i += NTHR) { const int r = i >> 7, c2 = i & 127; const int cc = cb * 128 + c2;
                const float s = red[(0 * 5 + r) * 128 + c2] + red[(1 * 5 + r) * 128 + c2] + red[(2 * 5 + r) * 128 + c2] + red[(3 * 5 + r) * 128 + c2] + p->in[I_BMOD][l * 6144 + cc];
                ((float*)(ws + WS_MOD))[((size_t)l * 5 + r) * 6144 + cc] = s; }
            __syncthreads();
        }
    }
}
template <int MODE>
__device__ __forceinline__ void norm_phase(KArg p, const Ctx& C, int l, bool comb, int lprev, bool moe, int row_min, int nslab) {
    unsigned char* ws = p->ws;
    float* H = (float*)(ws + WS_H); bf16_t* U = (bf16_t*)(ws + WS_U); const float* MOD = (const float*)(ws + WS_MOD);
    int* RE = (int*)(ws + WS_ROUTE); float* RW = (float*)(ws + WS_ROUTE + (size_t)MT * 8); const int* RP = (const int*)(ws + WS_ROUTE + (size_t)MT * 16);
    const bf16_t* YD = (const bf16_t*)(ws + WS_YD);
    LAS unsigned* lcnt = (LAS unsigned*)C.lds;
    if (MODE == 1 && moe) { if (C.tid < 8) lcnt[C.tid] = 0u; __syncthreads(); }
    const int rbase = (MT / 256) * C.bid;
    for (int ri = C.wave; ri < MT / 256; ri += NWAVES) {
        const int row = rbase + ri; if (row < row_min) continue;
        const int mb = mod_row(row);
        f32x4 v[4];
#pragma unroll
        for (int j = 0; j < 4; ++j) v[j] = *(const f32x4*)(H + (size_t)row * D + 4 * C.lane + 256 * j);
        if (comb) {
            const int p0 = RP[row * 2], p1 = RP[row * 2 + 1]; const float w0 = RW[row * 2], w1 = RW[row * 2 + 1];
            const float* g2 = MOD + ((size_t)lprev * 5 + mb) * 6144 + 5 * 1024;
#pragma unroll
            for (int j = 0; j < 4; ++j) { const int e = 4 * C.lane + 256 * j;
                const u32x2 y0 = *(const u32x2*)(YD + (size_t)p0 * D + e), y1 = *(const u32x2*)(YD + (size_t)p1 * D + e); const f32x4 g = *(const f32x4*)(g2 + e);
                v[j].x += g.x * (w0 * bf_lo(y0.x) + w1 * bf_lo(y1.x)); v[j].y += g.y * (w0 * bf_hi(y0.x) + w1 * bf_hi(y1.x));
                v[j].z += g.z * (w0 * bf_lo(y0.y) + w1 * bf_lo(y1.y)); v[j].w += g.w * (w0 * bf_hi(y0.y) + w1 * bf_hi(y1.y));
                if (MODE != 2) *(f32x4*)(H + (size_t)row * D + e) = v[j]; }
        }
        if (nslab > 0 && row < MC) {
            const float* sl = (const float*)(ws + WS_SLAB) + (size_t)row * D;
            for (int s = 0; s < nslab; ++s)
#pragma unroll
                for (int j = 0; j < 4; ++j) v[j] += *(const f32x4*)(sl + (size_t)s * MC * D + 4 * C.lane + 256 * j);
#pragma unroll
            for (int j = 0; j < 4; ++j) *(f32x4*)(H + (size_t)row * D + 4 * C.lane + 256 * j) = v[j];
        }
        float ss = 0.f;
#pragma unroll
        for (int j = 0; j < 4; ++j) ss += (v[j].x * v[j].x + v[j].y * v[j].y) + (v[j].z * v[j].z + v[j].w * v[j].w);
        const float rstd = rsqrtf(wave_sum(ss) * (1.f / D) + EPS);
        if (MODE == 2) {
            const float* gam = p->in[I_FNORM];
#pragma unroll
            for (int j = 0; j < 4; ++j) { const int e = 4 * C.lane + 256 * j; const f32x4 g = *(const f32x4*)(gam + e); *(f32x4*)(p->out + (size_t)(row - MC) * D + e) = v[j] * rstd * g; }
        } else {
            const float* gam = p->in[MODE == 0 ? I_NORM1 : I_NORM2] + (size_t)l * D;
            const float* sh = MOD + ((size_t)l * 5 + mb) * 6144 + (MODE == 0 ? 0 : 3) * 1024; const float* sc = sh + 1024;
            f32x4 y[4];
#pragma unroll
            for (int j = 0; j < 4; ++j) { const int e = 4 * C.lane + 256 * j; const f32x4 g = *(const f32x4*)(gam + e), s1 = *(const f32x4*)(sc + e), s0 = *(const f32x4*)(sh + e);
                y[j] = v[j] * rstd * g * (1.f + s1) + s0;
                u32x2 o; o.x = cvtpk(y[j].x, y[j].y); o.y = cvtpk(y[j].z, y[j].w); *(u32x2*)(U + (size_t)row * D + e) = o; }
            if (MODE == 1 && moe) {
                const float* wr = p->in[I_ROUTER] + (size_t)(l >> 1) * D * NE;
                float lg[8];
#pragma unroll
                for (int e = 0; e < 8; ++e) lg[e] = 0.f;
#pragma unroll
                for (int j = 0; j < 4; ++j)
#pragma unroll
                    for (int q = 0; q < 4; ++q) { const int e = 4 * C.lane + 256 * j + q; const f32x4 wa = *(const f32x4*)(wr + (size_t)e * 8), wb = *(const f32x4*)(wr + (size_t)e * 8 + 4); const float yv = y[j][q];
                        lg[0] += yv * wa.x; lg[1] += yv * wa.y; lg[2] += yv * wa.z; lg[3] += yv * wa.w; lg[4] += yv * wb.x; lg[5] += yv * wb.y; lg[6] += yv * wb.z; lg[7] += yv * wb.w; }
#pragma unroll
                for (int e = 0; e < 8; ++e) lg[e] = wave_sum(lg[e]);
                int e0 = 0; float v0 = lg[0];
#pragma unroll
                for (int e = 1; e < 8; ++e) if (lg[e] > v0) { v0 = lg[e]; e0 = e; }
                int e1 = -1; float v1 = -3.0e38f;
#pragma unroll
                for (int e = 0; e < 8; ++e) if (e != e0 && lg[e] > v1) { v1 = lg[e]; e1 = e; }
                const float t = __expf(v1 - v0), w0 = 1.f / (1.f + t), w1 = t * w0;
                if (C.lane == 0) { RE[row * 2] = e0; RE[row * 2 + 1] = e1; RW[row * 2] = w0; RW[row * 2 + 1] = w1; atomicAdd((unsigned*)&lcnt[e0], 1u); atomicAdd((unsigned*)&lcnt[e1], 1u); }
            }
        }
    }
    if (MODE == 1 && moe) { __syncthreads(); if (C.tid < 8) __hip_atomic_store((unsigned*)(ws + WS_CTL) + CW_CNT + C.bid * 8 + C.tid, lcnt[C.tid], __ATOMIC_RELAXED, __HIP_MEMORY_SCOPE_AGENT); }
}

__device__ __forceinline__ void moe_gather_phase(KArg p, const Ctx& C, int row_min) {
    unsigned char* ws = p->ws;
    unsigned* ctl = (unsigned*)(ws + WS_CTL);
    const int* RE = (const int*)(ws + WS_ROUTE); int* RP = (int*)(ws + WS_ROUTE + (size_t)MT * 16);
    const bf16_t* U = (const bf16_t*)(ws + WS_U); bf16_t* AS = (bf16_t*)(ws + WS_ASORT);
    LAS unsigned* cn = (LAS unsigned*)C.lds;
    LAS int* myoff = (LAS int*)(C.lds + 8192);
    LAS int* base = (LAS int*)(C.lds + 8192 + 64);
    LAS int* pos = (LAS int*)(C.lds + 8192 + 128);
    for (int i = C.tid; i < 2048; i += NTHR) cn[i] = __hip_atomic_load(ctl + CW_CNT + i, __ATOMIC_RELAXED, __HIP_MEMORY_SCOPE_AGENT);
    __syncthreads();
    if (C.tid < 8) { int tot = 0, mine = 0; for (int b = 0; b < 256; ++b) { const int c = (int)cn[b * 8 + C.tid]; if (b < C.bid) mine += c; tot += c; } myoff[C.tid] = mine; base[C.tid] = (tot + 255) & ~255; }
    __syncthreads();
    if (C.tid == 0) {
        int b0 = 0; for (int e = 0; e < 8; ++e) { const int t = base[e]; base[e] = b0; myoff[e] += b0; b0 += t; } base[8] = b0;
        const int rbase = (MT / 256) * C.bid;
        for (int ri = 0; ri < MT / 256; ++ri) { const int row = rbase + ri; if (row < row_min) { pos[ri * 2] = -1; pos[ri * 2 + 1] = -1; continue; }
            for (int k = 0; k < 2; ++k) { const int e = RE[row * 2 + k]; const int ps = myoff[e]++; pos[ri * 2 + k] = ps; RP[row * 2 + k] = ps; } }
    }
    __syncthreads();
    if (C.bid == 0) {
        const int ntiles = base[8] >> 8;
        if (C.tid < MOE_TILES) { int e = 0; for (int q = 1; q < 8; ++q) if (C.tid * 256 >= base[q]) e = q; __hip_atomic_store(ctl + CW_TILEE + C.tid, (unsigned)e, __ATOMIC_RELAXED, __HIP_MEMORY_SCOPE_AGENT); }
        if (C.tid == 0) __hip_atomic_store(ctl + CW_TILEE + 160, (unsigned)ntiles, __ATOMIC_RELAXED, __HIP_MEMORY_SCOPE_AGENT);
    }
    const int rbase = (MT / 256) * C.bid;
    for (int it = C.tid; it < (MT / 256) * 2 * 128; it += NTHR) { const int slot = it >> 7, ch = it & 127; const int ps = pos[slot]; if (ps < 0) continue;
        *(u32x4*)(AS + (size_t)ps * D + 8 * ch) = *(const u32x4*)(U + (size_t)(rbase + (slot >> 1)) * D + 8 * ch); }
}

__device__ __forceinline__ void prep_phase(KArg p, const Ctx& C, int l) {
    unsigned char* ws = p->ws;
    const bf16_t* P = (const bf16_t*)(ws + WS_P); bf16_t* QS = (bf16_t*)(ws + WS_QS); bf16_t* KS = (bf16_t*)(ws + WS_KS); bf16_t* AUP = (bf16_t*)(ws + WS_AUP); bf16_t* KF = (bf16_t*)(ws + WS_KFULL);
    const float* tab = (const float*)(ws + WS_TAB);
    const float* qg = p->in[I_QNORM] + (size_t)l * 256; const float* kvg = p->in[I_KVNORM] + (size_t)l * 128;
    const int gw = C.bid * NWAVES + C.wave, NGW = C.G * NWAVES, lane = C.lane;
    for (int row = gw; row < MT; row += NGW) {
        const bf16_t* pr = P + (size_t)row * DINP;
        const bool lat = row >= MC; const int t = (row - MC) & 4095, prow = t >> 6, pcol = t & 63;
        {
            const int hd = lane >> 4, j = lane & 15;
            float c_r = 1.f, s_r = 0.f, c_c = 1.f, s_c = 0.f;
            if (lat) { c_r = tab[prow * 16 + j]; s_r = tab[1024 + prow * 16 + j]; c_c = tab[pcol * 16 + j]; s_c = tab[1024 + pcol * 16 + j]; }
            { const bf16_t* q = pr + PC_AQ + hd * 64; const float x1 = bf2f(q[j]), x2 = bf2f(q[16 + j]), x3 = bf2f(q[32 + j]), x4 = bf2f(q[48 + j]); const float qs = 0.125f * LOG2E;
              bf16_t* o = QS + (size_t)row * 256 + hd * 64;
              o[j] = f2bf((x1 * c_r - x2 * s_r) * qs); o[16 + j] = f2bf((x2 * c_r + x1 * s_r) * qs); o[32 + j] = f2bf((x3 * c_c - x4 * s_c) * qs); o[48 + j] = f2bf((x4 * c_c + x3 * s_c) * qs); }
            if (lane < 32) { const bf16_t* k = pr + PC_AK + hd * 64; const float x1 = bf2f(k[j]), x2 = bf2f(k[16 + j]), x3 = bf2f(k[32 + j]), x4 = bf2f(k[48 + j]);
              bf16_t* o = KS + (size_t)row * 128 + hd * 64;
              o[j] = f2bf(x1 * c_r - x2 * s_r); o[16 + j] = f2bf(x2 * c_r + x1 * s_r); o[32 + j] = f2bf(x3 * c_c - x4 * s_c); o[48 + j] = f2bf(x4 * c_c + x3 * s_c); }
        }
        {
            const u32x2 a = *(const u32x2*)(pr + PC_CQ + 4 * lane); const float q0 = bf_lo(a.x), q1 = bf_hi(a.x), q2 = bf_lo(a.y), q3 = bf_hi(a.y);
            const float rq = rsqrtf(wave_sum(q0 * q0 + q1 * q1 + q2 * q2 + q3 * q3) * (1.f / 256.f) + EPS);
            const f32x4 g = *(const f32x4*)(qg + 4 * lane);
            u32x2 o; o.x = cvtpk(q0 * rq * g.x, q1 * rq * g.y); o.y = cvtpk(q2 * rq * g.z, q3 * rq * g.w); *(u32x2*)(AUP + (size_t)row * 512 + 4 * lane) = o;
            const unsigned b = *(const unsigned*)(pr + PC_CKV + 2 * lane); const float k0 = bf_lo(b), k1 = bf_hi(b);
            const float rk = rsqrtf(wave_sum(k0 * k0 + k1 * k1) * (1.f / 128.f) + EPS);
            const f32x2 g2 = *(const f32x2*)(kvg + 2 * lane);
            *(unsigned*)(AUP + (size_t)row * 512 + 256 + 2 * lane) = cvtpk(k0 * rk * g2.x, k1 * rk * g2.y);
            *(unsigned*)(AUP + (size_t)row * 512 + 384 + 2 * lane) = 0u;
        }
        if (lane < 16) {
            const int part = lane >> 3, j = lane & 7; const float xa = bf2f(pr[PC_CKR + 16 * part + j]), xb = bf2f(pr[PC_CKR + 16 * part + 8 + j]);
            float cs = 1.f, sn = 0.f; if (lat) { const int ps = part ? pcol : prow; cs = tab[2048 + ps * 8 + j]; sn = tab[2560 + ps * 8 + j]; }
            const bf16_t oa = f2bf(xa * cs - xb * sn), ob = f2bf(xb * cs + xa * sn);
#pragma unroll
            for (int h = 0; h < 4; ++h) { bf16_t* o = KF + (size_t)row * 384 + h * 96 + 64 + 16 * part; o[j] = oa; o[8 + j] = ob; }
        }
    }
}

struct AttnArgs {
    const bf16_t* Q; int q_pitch, q_col0, q_row0;
    const bf16_t* K; int k_pitch, k_col0;
    const bf16_t* Vt; int vt_row0;
    int seg_tok0, seg_nt0, seg_tok1, seg_nt1;
    int qpos0, kpos0;
    float m_init, l_init, qscale;
    bf16_t* O; int o_col0;
    const float* tab32; int qt0;
};
template <int DQK, bool MASK, bool ROPEQ>
__device__ __forceinline__ void attn_unit(const Ctx& C, const AttnArgs& a) {
    constexpr int KP = DQK + 8, NCH = DQK / 8, KT_BYTES = 64 * KP * 2, VP = 68, VT_BYTES = 64 * VP * 2, BUF = KT_BYTES + VT_BYTES, NKS = DQK / 16;
    LAS unsigned char* lds = C.lds;
    const int lane = C.lane, c = lane & 31, hi = lane >> 5, w = C.wave, tid = C.tid;
    const int qi = 32 * w + c;
    bf16x8 qf[NKS];
    {
        const bf16_t* qp = a.Q + (size_t)(a.q_row0 + qi) * a.q_pitch + a.q_col0;
#pragma unroll
        for (int ks = 0; ks < NKS; ++ks) {
            const u32x4 raw = *(const u32x4*)(qp + 16 * ks + 8 * hi);
            float f[8] = {bf_lo(raw.x), bf_hi(raw.x), bf_lo(raw.y), bf_hi(raw.y), bf_lo(raw.z), bf_hi(raw.z), bf_lo(raw.w), bf_hi(raw.w)};
            if (ROPEQ && ks >= 4) {
                const u32x4 ro = *(const u32x4*)(qp + 16 * ks + 8 * (1 - hi));
                const float g[8] = {bf_lo(ro.x), bf_hi(ro.x), bf_lo(ro.y), bf_hi(ro.y), bf_lo(ro.z), bf_hi(ro.z), bf_lo(ro.w), bf_hi(ro.w)};
                const int t = a.qt0 + qi, ps = (ks == 4) ? (t >> 6) : (t & 63);
#pragma unroll
                for (int j = 0; j < 8; ++j) { const float cs = a.tab32[ps * 8 + j], sn = a.tab32[512 + ps * 8 + j]; f[j] = hi ? (f[j] * cs + g[j] * sn) : (f[j] * cs - g[j] * sn); }
            }
            qf[ks] = mk_frag4(cvtpk(f[0] * a.qscale, f[1] * a.qscale), cvtpk(f[2] * a.qscale, f[3] * a.qscale), cvtpk(f[4] * a.qscale, f[5] * a.qscale), cvtpk(f[6] * a.qscale, f[7] * a.qscale));
        }
    }
    f32x16 o0, o1;
#pragma unroll
    for (int r = 0; r < 16; ++r) { o0[r] = 0.f; o1[r] = 0.f; }
    float m = a.m_init, l = a.l_init;
    const int NT = a.seg_nt0 + a.seg_nt1;
    u32x4 kst[2]; u32x4 vst;
    auto tile_tok = [&](int t) { return t < a.seg_nt0 ? a.seg_tok0 + 64 * t : a.seg_tok1 + 64 * (t - a.seg_nt0); };
    auto g_load = [&](int t) {
        const int tk = tile_tok(t);
#pragma unroll
        for (int i = 0; i < 2; ++i) { const int ch = tid + 512 * i; if (ch < 64 * NCH) { const int r = ch / NCH, c8 = ch % NCH; kst[i] = *(const u32x4*)(a.K + (size_t)(tk + r) * a.k_pitch + a.k_col0 + 8 * c8); } }
        { const int r = tid >> 3, c8 = tid & 7; vst = *(const u32x4*)(a.Vt + (size_t)(a.vt_row0 + r) * MT + tk + 8 * c8); }
    };
    auto l_store = [&](int b) {
        LAS unsigned char* kb = lds + b * BUF; LAS unsigned char* vb = kb + KT_BYTES;
#pragma unroll
        for (int i = 0; i < 2; ++i) { const int ch = tid + 512 * i; if (ch < 64 * NCH) { const int r = ch / NCH, c8 = ch % NCH; *(LAS u32x4*)(kb + r * (KP * 2) + 16 * c8) = kst[i]; } }
        { const int r = tid >> 3, c8 = tid & 7; LAS u32x2* d = (LAS u32x2*)(vb + r * (VP * 2) + 16 * c8); u32x2 lo, hi2; lo.x = vst.x; lo.y = vst.y; hi2.x = vst.z; hi2.y = vst.w; d[0] = lo; d[1] = hi2; }
    };
    __syncthreads();
    g_load(0); l_store(0);
    __syncthreads();
    for (int t = 0; t < NT; ++t) {
        const int b = t & 1;
        if (t + 1 < NT) g_load(t + 1);
        LAS unsigned char* kb = lds + b * BUF; LAS unsigned char* vb = kb + KT_BYTES;
        f32x16 s0, s1;
#pragma unroll
        for (int r = 0; r < 16; ++r) { s0[r] = 0.f; s1[r] = 0.f; }
#pragma unroll
        for (int ks = 0; ks < NKS; ++ks) {
            const bf16x8 k0 = *(const LAS bf16x8*)(kb + c * (KP * 2) + 32 * ks + 16 * hi);
            const bf16x8 k1 = *(const LAS bf16x8*)(kb + (32 + c) * (KP * 2) + 32 * ks + 16 * hi);
            s0 = mfma32(k0, qf[ks], s0); s1 = mfma32(k1, qf[ks], s1);
        }
        if (MASK && t >= a.seg_nt0) {
            const int qpos = a.qpos0 + qi, kbase = a.kpos0 + 64 * (t - a.seg_nt0);
#pragma unroll
            for (int r = 0; r < 16; ++r) { const int k0p = kbase + crow(r, hi), d0 = qpos - k0p, d1 = d0 - 32;
                if (d0 > 128 || d0 < -128) s0[r] = -1e30f; if (d1 > 128 || d1 < -128) s1[r] = -1e30f; }
        }
        float mx = s0[0];
#pragma unroll
        for (int r = 1; r < 16; ++r) mx = fmaxf(mx, s0[r]);
#pragma unroll
        for (int r = 0; r < 16; ++r) mx = fmaxf(mx, s1[r]);
        mx = fmaxf(mx, __shfl_xor(mx, 32));
        if (__builtin_amdgcn_ballot_w64(mx > m) != 0ull) {
            const float mn = fmaxf(m, mx), alpha = __builtin_amdgcn_exp2f(m - mn); m = mn; l *= alpha;
#pragma unroll
            for (int r = 0; r < 16; ++r) { o0[r] *= alpha; o1[r] *= alpha; }
        }
        float ls = 0.f;
#pragma unroll
        for (int r = 0; r < 16; ++r) { s0[r] = __builtin_amdgcn_exp2f(s0[r] - m); s1[r] = __builtin_amdgcn_exp2f(s1[r] - m); ls += s0[r] + s1[r]; }
        ls += __shfl_xor(ls, 32);
        l += ls;
        bf16x8 pf[2][2];
#pragma unroll
        for (int s2 = 0; s2 < 2; ++s2) {
            pf[0][s2] = mk_frag4(cvtpk(s0[8 * s2 + 0], s0[8 * s2 + 1]), cvtpk(s0[8 * s2 + 2], s0[8 * s2 + 3]), cvtpk(s0[8 * s2 + 4], s0[8 * s2 + 5]), cvtpk(s0[8 * s2 + 6], s0[8 * s2 + 7]));
            pf[1][s2] = mk_frag4(cvtpk(s1[8 * s2 + 0], s1[8 * s2 + 1]), cvtpk(s1[8 * s2 + 2], s1[8 * s2 + 3]), cvtpk(s1[8 * s2 + 4], s1[8 * s2 + 5]), cvtpk(s1[8 * s2 + 6], s1[8 * s2 + 7]));
        }
#pragma unroll
        for (int kt = 0; kt < 2; ++kt)
#pragma unroll
            for (int s2 = 0; s2 < 2; ++s2) {
                const int ko = (32 * kt + 16 * s2 + 4 * hi) * 2;
                const LAS unsigned char* v0p = vb + c * (VP * 2) + ko; const LAS unsigned char* v1p = vb + (32 + c) * (VP * 2) + ko;
                const bf16x8 v0 = mk_frag(*(const LAS u32x2*)v0p, *(const LAS u32x2*)(v0p + 16));
                const bf16x8 v1 = mk_frag(*(const LAS u32x2*)v1p, *(const LAS u32x2*)(v1p + 16));
                o0 = mfma32(v0, pf[kt][s2], o0); o1 = mfma32(v1, pf[kt][s2], o1);
            }
        if (t + 1 < NT) l_store(b ^ 1);
        __syncthreads();
    }
    const float inv = 1.f / l;
    bf16_t* op = a.O + (size_t)(a.q_row0 + qi) * D + a.o_col0;
#pragma unroll
    for (int g = 0; g < 4; ++g) {
        u32x2 w0, w1;
        w0.x = cvtpk(o0[4 * g] * inv, o0[4 * g + 1] * inv); w0.y = cvtpk(o0[4 * g + 2] * inv, o0[4 * g + 3] * inv);
        w1.x = cvtpk(o1[4 * g] * inv, o1[4 * g + 1] * inv); w1.y = cvtpk(o1[4 * g + 2] * inv, o1[4 * g + 3] * inv);
        *(u32x2*)(op + 8 * g + 4 * hi) = w0; *(u32x2*)(op + 32 + 8 * g + 4 * hi) = w1;
    }
}

__device__ __forceinline__ void attn_dispatch(KArg p, const Ctx& C, int l, int u) {
    unsigned char* ws = p->ws;
    AttnArgs a;
    a.tab32 = (const float*)(ws + WS_TAB) + 2048; a.O = (bf16_t*)(ws + WS_MIX);
    if (u < 256 || (u >= 512 && u < 528)) {
        const bool ctxq = u >= 512; const int v = ctxq ? u - 512 : u;
        const int b = ctxq ? (v >> 2) : (v >> 6), h = ctxq ? (v & 3) : ((v >> 4) & 3), qb = ctxq ? 0 : (v & 15);
        a.Q = (const bf16_t*)(ws + WS_QRAW); a.q_pitch = 384; a.q_col0 = 96 * h; a.q_row0 = ctxq ? 256 * b : MC + 4096 * b + 256 * qb;
        a.K = (const bf16_t*)(ws + WS_KFULL); a.k_pitch = 384; a.k_col0 = 96 * h; a.Vt = (const bf16_t*)(ws + WS_VTM); a.vt_row0 = 64 * h;
        a.seg_tok0 = 256 * b; a.seg_nt0 = 4; a.seg_tok1 = MC + 4096 * b; a.seg_nt1 = ctxq ? 0 : 64; a.qpos0 = 0; a.kpos0 = 0;
        a.m_init = -1e30f; a.l_init = 0.f; a.qscale = 0.10206207261596575f * LOG2E; a.o_col0 = 512 + 64 * h; a.qt0 = 256 * qb;
        if (ctxq) attn_unit<96, false, false>(C, a); else attn_unit<96, false, true>(C, a);
    } else {
        const bool ctxq = u >= 528; const int v = ctxq ? u - 528 : u - 256;
        const int b = ctxq ? (v >> 2) : (v >> 6), hq = ctxq ? (v & 3) : ((v >> 4) & 3), qb = ctxq ? 0 : (v & 15), g = hq >> 1;
        a.Q = (const bf16_t*)(ws + WS_QS); a.q_pitch = 256; a.q_col0 = 64 * hq; a.q_row0 = ctxq ? 256 * b : MC + 4096 * b + 256 * qb;
        a.K = (const bf16_t*)(ws + WS_KS); a.k_pitch = 128; a.k_col0 = 64 * g; a.Vt = (const bf16_t*)(ws + WS_VTS); a.vt_row0 = 64 * g;
        const int q0 = 256 * qb, ks = q0 - 128 < 0 ? 0 : q0 - 128, ke = q0 + 384 > SEQ ? SEQ : q0 + 384;
        a.seg_tok0 = 256 * b; a.seg_nt0 = 4; a.seg_tok1 = MC + 4096 * b + ks; a.seg_nt1 = ctxq ? 0 : (ke - ks) >> 6; a.qpos0 = q0; a.kpos0 = ks;
        a.m_init = p->in[I_SINK][l * 4 + hq] * LOG2E; a.l_init = 1.f; a.qscale = 1.f; a.o_col0 = 64 * hq; a.qt0 = 0;
        if (ctxq) attn_unit<64, false, false>(C, a); else attn_unit<64, true, false>(C, a);
    }
}

template <class FA, class FB>
__device__ __forceinline__ f32x16 lds_mma64(int lane, FA fa, FB fb) {
    const int c = lane & 31, hi = lane >> 5;
    f32x16 acc;
#pragma unroll
    for (int r = 0; r < 16; ++r) acc[r] = 0.f;
#pragma unroll
    for (int s = 0; s < 4; ++s) {
        float av[8], bv[8];
#pragma unroll
        for (int j = 0; j < 8; ++j) { const int k = 16 * s + 8 * hi + j; av[j] = fa(c, k); bv[j] = fb(k, c); }
        acc = mfma32(mk_frag4(cvtpk(av[0], av[1]), cvtpk(av[2], av[3]), cvtpk(av[4], av[5]), cvtpk(av[6], av[7])),
                     mk_frag4(cvtpk(bv[0], bv[1]), cvtpk(bv[2], bv[3]), cvtpk(bv[4], bv[5]), cvtpk(bv[6], bv[7])), acc);
    }
    return acc;
}
__device__ __forceinline__ void lds_barrier() { asm volatile("s_waitcnt lgkmcnt(0)" ::: "memory"); __builtin_amdgcn_s_barrier(); asm volatile("" ::: "memory"); }
__device__ __forceinline__ int su_index(int d, int b, int h, int cg) {
    const int s = cg < 4 ? (d ? 3 - cg : cg) : 4 + (d ? 63 - (cg - 4) : (cg - 4));
    return ((d * 4 + b) * 4 + h) * 68 + s;
}
#ifndef GSECT
#define GSECT 0
#endif
constexpr int XP = 65;

template <int I>
__device__ __forceinline__ void solve_rows(float (&x)[64], f32x4 (&Lc)[16], f32x4 (&Ln)[16], const LAS float* Ld) {
    if constexpr (I < 64) {
        if constexpr (I + 1 < 64) {
#pragma unroll
            for (int q = 0; q < 16; ++q) if (4 * q < I + 1) Ln[q] = *(const LAS f32x4*)(Ld + (I + 1) * 68 + 4 * q);
        }
        float s0 = 0.f, s1 = 0.f, s2 = 0.f, s3 = 0.f;
#pragma unroll
        for (int q = 0; q < 16; ++q) if (4 * q < I) { const f32x4 lv = Lc[q];
            s0 += lv.x * x[4 * q]; if (4 * q + 1 < I) s1 += lv.y * x[4 * q + 1]; if (4 * q + 2 < I) s2 += lv.z * x[4 * q + 2]; if (4 * q + 3 < I) s3 += lv.w * x[4 * q + 3]; }
        x[I] -= (s0 + s1) + (s2 + s3);
        solve_rows<I + 1>(x, Ln, Lc, Ld);
    }
}
__device__ __forceinline__ void gdn_chunk_unit(KArg p, const Ctx& C, int l, int b, int h, int cg) {
    unsigned char* ws = p->ws; const bf16_t* P = (const bf16_t*)(ws + WS_P);
    int tid_l = C.tid; asm volatile("" : "+v"(tid_l));
    const int tid = tid_l, lane = tid & 63, w = __builtin_amdgcn_readfirstlane(tid >> 6);
    LAS float* xq = (LAS float*)C.lds; LAS float* xk = xq + 64 * XP; LAS float* xv = xk + 64 * XP;
    LAS float* KK = xv + 64 * XP; LAS float* QK = KK + 64 * XP;
    LAS float* Lm = QK + 64 * XP;
    LAS float* gcs = Lm + 2 * 64 * 68; LAS float* bts = gcs + 128; LAS float* egs = bts + 128; LAS float* cw = egs + 128;
    LAS float* raw = KK;
    LAS float* Wst = KK;
    const int seq0 = cg < 4 ? 256 * b : MC + 4096 * b, seqlen = cg < 4 ? 256 : 4096, t0 = cg < 4 ? 64 * cg : 64 * (cg - 4);
    bf16_t ab_a = 0, ab_b = 0;
    if (w < 2) { const int tau = w ? 63 - lane : lane; const bf16_t* pr = P + (size_t)(seq0 + t0 + tau) * DINP + PC_BAB + w * 8 + h; ab_a = pr[0]; ab_b = pr[4]; }
    lds_barrier();
    for (int rr1 = 0; rr1 < ((GSECT == 1) ? 2 : 1); ++rr1) {
    if (rr1) lds_barrier();
    for (int it = tid; it < 68 * 24; it += NTHR) { const int r = it / 24, ch = it % 24, t = t0 - 2 + r; const int part = ch >> 3, c8 = ch & 7;
        u32x4 v; v.x = v.y = v.z = v.w = 0u;
        if (t >= 0 && t < seqlen) v = *(const u32x4*)(P + (size_t)(seq0 + t) * DINP + PC_BQKV + 256 * part + 64 * h + 8 * c8);
        LAS float* d = raw + r * 192 + 64 * part + 8 * c8;
        d[0] = bf_lo(v.x); d[1] = bf_hi(v.x); d[2] = bf_lo(v.y); d[3] = bf_hi(v.y); d[4] = bf_lo(v.z); d[5] = bf_hi(v.z); d[6] = bf_lo(v.w); d[7] = bf_hi(v.w); }
    for (int it = tid; it < 5 * 192; it += NTHR) { const int j = it / 192, cc = it % 192; cw[it] = p->in[I_GCONV][((size_t)l * 5 + j) * 768 + 256 * (cc >> 6) + 64 * h + (cc & 63)]; }
    lds_barrier();
    for (int it = tid; it < 64 * 192; it += NTHR) { const int t = it / 192, cc = it % 192; float y = 0.f;
#pragma unroll
        for (int j = 0; j < 5; ++j) y += raw[(t + j) * 192 + cc] * cw[j * 192 + cc];
        y = silu_f(y); LAS float* dst = (cc < 64) ? xq : (cc < 128 ? xk : xv); dst[t * XP + (cc & 63)] = y; }
    lds_barrier();
    {
        const int mat = tid >> 8, r = (tid >> 2) & 63, q4 = tid & 3; LAS float* m = (mat ? xk : xq) + r * XP + 16 * q4; float v[16]; float ss = 0.f;
#pragma unroll
        for (int k = 0; k < 16; ++k) { v[k] = m[k]; ss += v[k] * v[k]; }
        ss += __shfl_xor(ss, 1); ss += __shfl_xor(ss, 2);
        const float sc = rsqrtf(ss + EPS) * (mat ? 1.f : 0.125f);
#pragma unroll
        for (int k = 0; k < 16; ++k) m[k] = v[k] * sc;
    }
    lds_barrier();
    {
        const int mat = w >> 2, rt = (w >> 1) & 1, ct = w & 1; LAS float* Am = mat ? xq : xk;
        const f32x16 acc = lds_mma64(lane, [&](int r, int k) { return Am[(32 * rt + r) * XP + k]; }, [&](int k, int c2) { return xk[(32 * ct + c2) * XP + k]; });
        LAS float* Om = mat ? QK : KK;
#pragma unroll
        for (int r = 0; r < 16; ++r) Om[(32 * rt + crow(r, lane >> 5)) * XP + 32 * ct + (lane & 31)] = acc[r];
    }
    }
    for (int rr2 = 0; rr2 < ((GSECT == 2) ? 2 : 1); ++rr2) {
    if (rr2) lds_barrier();
    if (w < 2) {
        const int d = w;
        const float a = bf2f(ab_a), bt = bf2f(ab_b);
        float g = -__expf(p->in[I_GALOG][(l * 2 + d) * 4 + h]) * softplus_f(a + p->in[I_GDTB][(l * 2 + d) * 4 + h]);
#pragma unroll
        for (int o = 1; o < 64; o <<= 1) { const float n = __shfl_up(g, o); if (lane >= o) g += n; }
        gcs[d * 64 + lane] = g; bts[d * 64 + lane] = sigmoid_f(bt); egs[d * 64 + lane] = __expf(g);
        if (lane == 63) ((float*)(ws + WS_DEC))[su_index(d, b, h, cg)] = __expf(g);
    }
    lds_barrier();
    for (int it = tid; it < 2 * 64 * 64; it += NTHR) { const int d = it >> 12, i = (it >> 6) & 63, j = it & 63; const int ti = d ? 63 - i : i, tj = d ? 63 - j : j;
        Lm[(d * 64 + i) * 68 + j] = (j < i) ? bts[d * 64 + i] * KK[ti * XP + tj] * __expf(gcs[d * 64 + i] - gcs[d * 64 + j]) : 0.f; }
#pragma unroll
    for (int d = 0; d < 2; ++d) {
        unsigned char* rec = ws + WS_RECG + (size_t)su_index(d, b, h, cg) * REC_G_BYTES; const LAS float* gc = gcs + d * 64;
        const int r = tid >> 3, c8 = tid & 7, it_ = d ? 63 - r : r;
        { float v[8];
#pragma unroll
          for (int j = 0; j < 8; ++j) { const int i = 8 * c8 + j, ti = d ? 63 - i : i; v[j] = xk[ti * XP + r] * __expf(gc[63] - gc[i]); }
          u32x4 o; o.x = cvtpk(v[0], v[1]); o.y = cvtpk(v[2], v[3]); o.z = cvtpk(v[4], v[5]); o.w = cvtpk(v[6], v[7]); *(u32x4*)(rec + REC_G_KDT + (r * 64 + 8 * c8) * 2) = o; }
        { const float e = egs[d * 64 + it_]; float v[8];
#pragma unroll
          for (int j = 0; j < 8; ++j) v[j] = xq[r * XP + 8 * c8 + j] * e;
          u32x4 o; o.x = cvtpk(v[0], v[1]); o.y = cvtpk(v[2], v[3]); o.z = cvtpk(v[4], v[5]); o.w = cvtpk(v[6], v[7]); *(u32x4*)(rec + REC_G_QG + (r * 64 + 8 * c8) * 2) = o; }
        { float v[8];
#pragma unroll
          for (int j = 0; j < 8; ++j) { const int i = 8 * c8 + j, ti = d ? 63 - i : i; v[j] = (it_ >= i) ? QK[r * XP + ti] * __expf(gc[it_] - gc[i]) : 0.f; }
          u32x4 o; o.x = cvtpk(v[0], v[1]); o.y = cvtpk(v[2], v[3]); o.z = cvtpk(v[4], v[5]); o.w = cvtpk(v[6], v[7]); *(u32x4*)(rec + REC_G_ATT + (r * 64 + 8 * c8) * 2) = o; }
    }
    }
    lds_barrier();
    for (int rr3 = 0; rr3 < ((GSECT == 3) ? 2 : 1); ++rr3) {
    if (tid < 256) {
        const int d = tid >> 7, col = tid & 127; const LAS float* Ld = Lm + d * 64 * 68; const LAS float* bt = bts + d * 64; const LAS float* eg = egs + d * 64;
        float x[64];
        if (col < 64) {
#pragma unroll
            for (int i = 0; i < 64; ++i) { const int ti = d ? 63 - i : i; x[i] = bt[i] * xv[ti * XP + col]; }
        } else {
#pragma unroll
            for (int i = 0; i < 64; ++i) { const int ti = d ? 63 - i : i; x[i] = bt[i] * eg[i] * xk[ti * XP + col - 64]; }
        }
        f32x4 La[16], Lb[16];
        La[0] = *(const LAS f32x4*)(Ld + 1 * 68);
        solve_rows<1>(x, La, Lb, Ld);
        unsigned char* rec = ws + WS_RECG + (size_t)su_index(d, b, h, cg) * REC_G_BYTES;
        if (col < 64) {
#pragma unroll
            for (int i4 = 0; i4 < 16; ++i4) { f32x4 o; o.x = x[4 * i4]; o.y = x[4 * i4 + 1]; o.z = x[4 * i4 + 2]; o.w = x[4 * i4 + 3]; *(f32x4*)(rec + REC_G_UT + (col * 64 + 4 * i4) * 4) = o; }
        } else {
#pragma unroll
            for (int i = 0; i < 64; ++i) Wst[(d * 64 + i) * XP + col - 64] = x[i];
        }
    }
    }
    lds_barrier();
#pragma unroll
    for (int d = 0; d < 2; ++d) { const int r = tid >> 3, c8 = tid & 7;
        unsigned char* rec = ws + WS_RECG + (size_t)su_index(d, b, h, cg) * REC_G_BYTES;
        u32x4 o; const LAS float* s = Wst + (d * 64 + r) * XP + 8 * c8; o.x = cvtpk(s[0], s[1]); o.y = cvtpk(s[2], s[3]); o.z = cvtpk(s[4], s[5]); o.w = cvtpk(s[6], s[7]);
        *(u32x4*)(rec + REC_G_W + (r * 64 + 8 * c8) * 2) = o; }
}

__device__ __forceinline__ void ret_chunk_unit(KArg p, const Ctx& C, int l, int b, int h, int cg) {
    unsigned char* ws = p->ws; const bf16_t* P = (const bf16_t*)(ws + WS_P); const float* tab = (const float*)(ws + WS_TAB);
    int tid_l = C.tid; asm volatile("" : "+v"(tid_l));
    const int tid = tid_l, lane = tid & 63, w = __builtin_amdgcn_readfirstlane(tid >> 6);
    LAS float* xq = (LAS float*)C.lds; LAS float* xk = xq + 64 * XP; LAS float* xv = xk + 64 * XP; LAS float* QK = xv + 64 * XP;
    const bool lat = cg >= 4;
    const int seq0 = lat ? MC + 4096 * b : 256 * b, t0 = lat ? 64 * (cg - 4) : 64 * cg;
    lds_barrier();
    for (int it = tid; it < 2 * 64 * 32; it += NTHR) { const int mat = it >> 11, r = (it >> 5) & 63, part = (it >> 4) & 1, j = it & 15; const int t = t0 + r;
        const bf16_t* pr = P + (size_t)(seq0 + t) * DINP + (mat ? PC_DK : PC_DQ) + 64 * h + 32 * part;
        const float xa = bf2f(pr[j]), xb = bf2f(pr[16 + j]); float cs = 1.f, sn = 0.f;
        if (lat) { const int ps = part ? (t & 63) : (t >> 6); cs = tab[ps * 16 + j]; sn = tab[1024 + ps * 16 + j]; }
        const float sc = mat ? 0.125f : 1.f; LAS float* m = mat ? xk : xq;
        m[r * XP + 32 * part + j] = (xa * cs - xb * sn) * sc; m[r * XP + 32 * part + 16 + j] = (xb * cs + xa * sn) * sc; }
    { const int r = tid >> 3, c8 = tid & 7; const u32x4 v = *(const u32x4*)(P + (size_t)(seq0 + t0 + r) * DINP + PC_DV + 64 * h + 8 * c8); LAS float* d = xv + r * XP + 8 * c8;
      d[0] = bf_lo(v.x); d[1] = bf_hi(v.x); d[2] = bf_lo(v.y); d[3] = bf_hi(v.y); d[4] = bf_lo(v.z); d[5] = bf_hi(v.z); d[6] = bf_lo(v.w); d[7] = bf_hi(v.w); }
    lds_barrier();
    if (w < 4) { const int rt = w >> 1, ct = w & 1;
        const f32x16 acc = lds_mma64(lane, [&](int r, int k) { return xq[(32 * rt + r) * XP + k]; }, [&](int k, int c2) { return xk[(32 * ct + c2) * XP + k]; });
#pragma unroll
        for (int r = 0; r < 16; ++r) QK[(32 * rt + crow(r, lane >> 5)) * XP + 32 * ct + (lane & 31)] = acc[r]; }
    lds_barrier();
    {
        const int d = w >> 2, T = (w >> 1) & 1, ct = w & 1; const float lg = -__expf(p->in[I_RLOGD][(l * 2 + d) * 4 + h]);
        const f32x16 acc = lds_mma64(lane, [&](int r, int k) { const int ti = d ? 63 - k : k; return xk[ti * XP + 32 * T + r] * __expf(lg * (float)(63 - k)); },
                                           [&](int k, int c2) { const int ti = d ? 63 - k : k; return xv[ti * XP + 32 * ct + c2]; });
        float* kv = (float*)(ws + WS_RECR + (size_t)su_index(d, b, h, cg) * REC_R_BYTES + REC_R_KV);
#pragma unroll
        for (int r = 0; r < 16; ++r) kv[(32 * T + crow(r, lane >> 5)) * 64 + 32 * ct + (lane & 31)] = acc[r];
    }
    for (int d = 0; d < 2; ++d) {
        unsigned char* rec = ws + WS_RECR + (size_t)su_index(d, b, h, cg) * REC_R_BYTES; const float lg = -__expf(p->in[I_RLOGD][(l * 2 + d) * 4 + h]);
        const int r = tid >> 3, c8 = tid & 7, it_ = d ? 63 - r : r;
        { const float e = __expf(lg * (float)(it_ + 1)); float v[8];
#pragma unroll
          for (int j = 0; j < 8; ++j) v[j] = xq[r * XP + 8 * c8 + j] * e;
          u32x4 o; o.x = cvtpk(v[0], v[1]); o.y = cvtpk(v[2], v[3]); o.z = cvtpk(v[4], v[5]); o.w = cvtpk(v[6], v[7]); *(u32x4*)(rec + REC_R_QG + (r * 64 + 8 * c8) * 2) = o; }
        { float v[8];
#pragma unroll
          for (int j = 0; j < 8; ++j) { const int i = 8 * c8 + j, ti = d ? 63 - i : i; v[j] = (it_ >= i) ? QK[r * XP + ti] * __expf(lg * (float)(it_ - i)) : 0.f; }
          u32x4 o; o.x = cvtpk(v[0], v[1]); o.y = cvtpk(v[2], v[3]); o.z = cvtpk(v[4], v[5]); o.w = cvtpk(v[6], v[7]); *(u32x4*)(rec + REC_R_ATT + (r * 64 + 8 * c8) * 2) = o; }
        { const int ln = tid & 63, s = (tid >> 6) & 1, T = (tid >> 7) & 1, ct = tid >> 8; float v[8];
#pragma unroll
          for (int j = 0; j < 8; ++j) { const int i = 32 * T + 16 * s + 8 * (j >> 2) + 4 * (ln >> 5) + (j & 3), ti = d ? 63 - i : i; v[j] = xv[ti * XP + 32 * ct + (ln & 31)]; }
          u32x4 o; o.x = cvtpk(v[0], v[1]); o.y = cvtpk(v[2], v[3]); o.z = cvtpk(v[4], v[5]); o.w = cvtpk(v[6], v[7]); *(u32x4*)(rec + REC_R_VF + (size_t)tid * 16) = o; }
    }
}

__device__ __forceinline__ void gdn_scan_chain(KArg p, const Ctx& C, int chain) {
    unsigned char* ws = p->ws; const int tid = C.tid, lane = C.lane, w = C.wave, c = lane & 31, hi = lane >> 5;
    constexpr int WP = 68, UP = 68, SB_W = 0, SB_K = 64 * WP * 2, SB_U = 2 * 64 * WP * 2, SB_D = SB_U + 64 * UP * 4, SBUF = SB_D + 16;
    LAS unsigned char* lds = C.lds;
    const float* DEC = (const float*)(ws + WS_DEC);
    u32x4 st[4]; float dreg = 0.f;
    auto g_load = [&](int s) { if (tid == 0) dreg = DEC[chain * 68 + s]; const unsigned char* rec = ws + WS_RECG + (size_t)(chain * 68 + s) * REC_G_BYTES;
#pragma unroll
        for (int i = 0; i < 4; ++i) st[i] = *(const u32x4*)(rec + (size_t)(tid + 512 * i) * 16); };
    auto l_store = [&](int bsel, int s) { LAS unsigned char* sb = lds + bsel * SBUF;
#pragma unroll
        for (int i = 0; i < 4; ++i) { const int ch = tid + 512 * i; u32x2 lo, h2; lo.x = st[i].x; lo.y = st[i].y; h2.x = st[i].z; h2.y = st[i].w;
            if (ch < 512) { const int r = ch >> 3, c8 = ch & 7; LAS u32x2* d = (LAS u32x2*)(sb + SB_W + r * (WP * 2) + 16 * c8); d[0] = lo; d[1] = h2; }
            else if (ch < 1536) { const int q = ch - 512, r = q >> 4, c4 = q & 15; *(LAS u32x4*)(sb + SB_U + r * (UP * 4) + 16 * c4) = st[i]; }
            else { const int q = ch - 1536, r = q >> 3, c8 = q & 7; LAS u32x2* d = (LAS u32x2*)(sb + SB_K + r * (WP * 2) + 16 * c8); d[0] = lo; d[1] = h2; } }
        if (tid == 0) *(LAS float*)(sb + SB_D) = dreg; (void)s; };
    f32x16 S0, S1;
#pragma unroll
    for (int r = 0; r < 16; ++r) { S0[r] = 0.f; S1[r] = 0.f; }
    __syncthreads();
    g_load(0); l_store(0, 0);
    __syncthreads();
    for (int s = 0; s < 68; ++s) {
        const int bsel = s & 1;
        if (s + 1 < 68) g_load(s + 1);
        if (w < 2) {
            const int ct = w; LAS unsigned char* sb = lds + bsel * SBUF;
            unsigned char* rec = ws + WS_RECG + (size_t)(chain * 68 + s) * REC_G_BYTES;
            bf16x8 sf[2][2];
#pragma unroll
            for (int ks = 0; ks < 2; ++ks) {
                sf[0][ks] = mk_frag4(cvtpk(S0[8 * ks], S0[8 * ks + 1]), cvtpk(S0[8 * ks + 2], S0[8 * ks + 3]), cvtpk(S0[8 * ks + 4], S0[8 * ks + 5]), cvtpk(S0[8 * ks + 6], S0[8 * ks + 7]));
                sf[1][ks] = mk_frag4(cvtpk(S1[8 * ks], S1[8 * ks + 1]), cvtpk(S1[8 * ks + 2], S1[8 * ks + 3]), cvtpk(S1[8 * ks + 4], S1[8 * ks + 5]), cvtpk(S1[8 * ks + 6], S1[8 * ks + 7]));
            }
#pragma unroll
            for (int T = 0; T < 2; ++T)
#pragma unroll
                for (int ks = 0; ks < 2; ++ks) *(bf16x8*)(rec + REC_G_SP + (size_t)((((ct * 2 + T) * 2 + ks) * 64 + lane) * 16)) = sf[T][ks];
            f32x16 vn[2];
#pragma unroll
            for (int Ti = 0; Ti < 2; ++Ti) {
                f32x16 acc;
#pragma unroll
                for (int r = 0; r < 16; ++r) acc[r] = 0.f;
#pragma unroll
                for (int T = 0; T < 2; ++T)
#pragma unroll
                    for (int ks = 0; ks < 2; ++ks) { const LAS unsigned char* ap = sb + SB_W + (32 * Ti + c) * (WP * 2) + (32 * T + 16 * ks + 4 * hi) * 2;
                        acc = mfma32(mk_frag(*(const LAS u32x2*)ap, *(const LAS u32x2*)(ap + 16)), sf[T][ks], acc); }
#pragma unroll
                for (int g = 0; g < 4; ++g) { const f32x4 u = *(const LAS f32x4*)(sb + SB_U + (32 * ct + c) * (UP * 4) + (32 * Ti + 8 * g + 4 * hi) * 4);
                    vn[Ti][4 * g] = u.x - acc[4 * g]; vn[Ti][4 * g + 1] = u.y - acc[4 * g + 1]; vn[Ti][4 * g + 2] = u.z - acc[4 * g + 2]; vn[Ti][4 * g + 3] = u.w - acc[4 * g + 3]; }
            }
            bf16x8 vf[2][2];
#pragma unroll
            for (int Ti = 0; Ti < 2; ++Ti)
#pragma unroll
                for (int ks = 0; ks < 2; ++ks) {
                    vf[Ti][ks] = mk_frag4(cvtpk(vn[Ti][8 * ks], vn[Ti][8 * ks + 1]), cvtpk(vn[Ti][8 * ks + 2], vn[Ti][8 * ks + 3]), cvtpk(vn[Ti][8 * ks + 4], vn[Ti][8 * ks + 5]), cvtpk(vn[Ti][8 * ks + 6], vn[Ti][8 * ks + 7]));
                    *(bf16x8*)(rec + REC_G_VN + (size_t)((((ct * 2 + Ti) * 2 + ks) * 64 + lane) * 16)) = vf[Ti][ks]; }
            const float dec = *(const LAS float*)(sb + SB_D);
#pragma unroll
            for (int r = 0; r < 16; ++r) { S0[r] *= dec; S1[r] *= dec; }
#pragma unroll
            for (int Ti = 0; Ti < 2; ++Ti)
#pragma unroll
                for (int ks = 0; ks < 2; ++ks) {
                    const LAS unsigned char* a0 = sb + SB_K + c * (WP * 2) + (32 * Ti + 16 * ks + 4 * hi) * 2; const LAS unsigned char* a1 = a0 + 32 * (WP * 2);
                    S0 = mfma32(mk_frag(*(const LAS u32x2*)a0, *(const LAS u32x2*)(a0 + 16)), vf[Ti][ks], S0);
                    S1 = mfma32(mk_frag(*(const LAS u32x2*)a1, *(const LAS u32x2*)(a1 + 16)), vf[Ti][ks], S1); }
        }
        if (s + 1 < 68) l_store(bsel ^ 1, s + 1);
        __syncthreads();
    }
}
__device__ __forceinline__ void ret_scan_items(KArg p, const Ctx& C, int l, int item0, int nitems_total, int stride) {
    unsigned char* ws = p->ws;
    for (int it = item0; it < nitems_total; it += stride) {
        const int dbh = it >> 11, q = it & 2047; const int jp = q & 3, ln = (q >> 2) & 63, ks = (q >> 8) & 1, T = (q >> 9) & 1, ct = q >> 10;
        const int d = dbh >> 4, h = dbh & 3;
        const int j0 = 2 * jp, dk0 = 32 * T + 16 * ks + 8 * (j0 >> 2) + 4 * (ln >> 5) + (j0 & 3), dv = 32 * ct + (ln & 31);
        const float g64 = __expf(-__expf(p->in[I_RLOGD][(l * 2 + d) * 4 + h]) * 64.f);
        float s0 = 0.f, s1 = 0.f;
        for (int s = 0; s < 68; ++s) {
            unsigned char* rec = ws + WS_RECR + (size_t)(dbh * 68 + s) * REC_R_BYTES;
            *(unsigned*)(rec + REC_R_SP + (size_t)q * 4) = cvtpk(s0, s1);
            const float* kv = (const float*)(rec + REC_R_KV);
            s0 = s0 * g64 + kv[dk0 * 64 + dv]; s1 = s1 * g64 + kv[(dk0 + 1) * 64 + dv];
        }
    }
}

__device__ __forceinline__ void rec_out_unit(KArg p, const Ctx& C, int l, int b, int h, int cg) {
    unsigned char* ws = p->ws; const int tid = C.tid, lane = C.lane, w = C.wave, c = lane & 31, hi = lane >> 5;
    const int mixer = w >> 2, rt = (w >> 1) & 1, ct = w & 1;
    LAS float* ob = (LAS float*)C.lds;
    f32x16 acc;
#pragma unroll
    for (int r = 0; r < 16; ++r) acc[r] = 0.f;
#pragma unroll
    for (int d = 0; d < 2; ++d) {
        const int su = su_index(d, b, h, cg);
        const unsigned char* rec = mixer ? ws + WS_RECR + (size_t)su * REC_R_BYTES : ws + WS_RECG + (size_t)su * REC_G_BYTES;
        const unsigned char* qg = rec + (mixer ? REC_R_QG : REC_G_QG); const unsigned char* at = rec + (mixer ? REC_R_ATT : REC_G_ATT);
        const unsigned char* sp = rec + (mixer ? REC_R_SP : REC_G_SP); const unsigned char* vn = rec + (mixer ? REC_R_VF : REC_G_VN);
#pragma unroll
        for (int T = 0; T < 2; ++T)
#pragma unroll
            for (int ks = 0; ks < 2; ++ks) {
                const size_t ao = (size_t)((32 * rt + c) * 64 + 32 * T + 16 * ks + 4 * hi) * 2, bo = (size_t)((((ct * 2 + T) * 2 + ks) * 64 + lane) * 16);
                acc = mfma32(mk_frag(*(const u32x2*)(qg + ao), *(const u32x2*)(qg + ao + 16)), *(const bf16x8*)(sp + bo), acc);
                acc = mfma32(mk_frag(*(const u32x2*)(at + ao), *(const u32x2*)(at + ao + 16)), *(const bf16x8*)(vn + bo), acc);
            }
    }
    __syncthreads();
#pragma unroll
    for (int r = 0; r < 16; ++r) ob[(mixer * 64 + 32 * rt + crow(r, hi)) * XP + 32 * ct + c] = acc[r];
    __syncthreads();
    {
        const int rowi = tid >> 2, q4 = tid & 3, mx = rowi >> 6, tau = rowi & 63;
        const int row = (cg < 4 ? 256 * b + 64 * cg : MC + 4096 * b + 64 * (cg - 4)) + tau;
        const LAS float* o = ob + rowi * XP + 16 * q4; float v[16]; float s = 0.f, ss = 0.f;
#pragma unroll
        for (int j = 0; j < 16; ++j) { v[j] = o[j]; s += v[j]; ss += v[j] * v[j]; }
        s += __shfl_xor(s, 1); s += __shfl_xor(s, 2); ss += __shfl_xor(ss, 1); ss += __shfl_xor(ss, 2);
        const bf16_t* P = (const bf16_t*)(ws + WS_P) + (size_t)row * DINP + (mx ? PC_DGATE : PC_BGATE) + 64 * h + 16 * q4;
        const float* gn = mx ? p->in[I_RNORM] + (size_t)l * 256 + 64 * h + 16 * q4 : p->in[I_GNORM] + (size_t)l * 64 + 16 * q4;
        float mu = 0.f, rs;
        if (mx) { mu = s * (1.f / 64.f); const float var = ss * (1.f / 64.f) - mu * mu; rs = rsqrtf(fmaxf(var, 0.f) + EPS); } else rs = rsqrtf(ss * (1.f / 64.f) + EPS);
        unsigned ov[8];
#pragma unroll
        for (int j = 0; j < 16; j += 2) { const float y0 = (v[j] - mu) * rs * gn[j] * silu_f(bf2f(P[j])), y1 = (v[j + 1] - mu) * rs * gn[j + 1] * silu_f(bf2f(P[j + 1])); ov[j >> 1] = cvtpk(y0, y1); }
        bf16_t* dst = (bf16_t*)(ws + WS_MIX) + (size_t)row * D + (mx ? 768 : 256) + 64 * h + 16 * q4;
        u32x4 o0, o1; o0.x = ov[0]; o0.y = ov[1]; o0.z = ov[2]; o0.w = ov[3]; o1.x = ov[4]; o1.y = ov[5]; o1.z = ov[6]; o1.w = ov[7];
        *(u32x4*)dst = o0; *(u32x4*)(dst + 8) = o1;
    }
}

#ifndef ONLY_PHASE
#define ONLY_PHASE -1
#endif
#ifndef SUB3
#define SUB3 31
#endif
#ifndef DUP_K
#define DUP_K -1
#endif
#define NREP(k) ((DUP_K == (k)) ? 2 : 1)
#ifndef DUP2
#define DUP2 0
#endif
#define PH_ON(k) (ONLY_PHASE < 0 || ONLY_PHASE == (k))
constexpr int PH_PER_LAYER = 10, PH_FINAL = 1 + PH_PER_LAYER * DEPTH, N_PHASES = PH_FINAL + 1;
__global__ void __launch_bounds__(NTHR, 2) mega_fwd(Params p_arg) {
    extern __shared__ __attribute__((aligned(16))) unsigned char lds_raw[];
    Ctx C0; C0.lds = (LAS unsigned char*)lds_raw; C0.tid = threadIdx.x; C0.lane = C0.tid & 63; C0.wave = __builtin_amdgcn_readfirstlane(C0.tid >> 6); C0.bid = blockIdx.x; C0.G = gridDim.x;
    const Ctx& C = C0;
    int lo, hi; unsigned* ctl0; { KArg p = kp_get(); lo = p->ph_lo; hi = p->ph_hi; ctl0 = (unsigned*)(p->ws + WS_CTL); }
    const bool fused = (hi - lo) > 1;
    if (C.tid < 64) ((LAS unsigned*)(C.lds + LDS_MISC))[C.tid] = 0u;
    __syncthreads();
    XcdBarrier bar; bar.bar = ctl0 + CW_BAR; bar.x = 0; bar.st = (volatile LAS unsigned*)(C.lds + LDS_MISC);
    if (fused) bar = xcd_barrier_post(ctl0 + CW_BAR, (volatile LAS unsigned*)(C.lds + LDS_MISC));
#define IN(k) (lo <= (k) && (k) < hi)
#define RELAUNDER do { int t_ = C0.tid, b_ = C0.bid, g_ = C0.G; unsigned l_ = (unsigned)(size_t)C0.lds; asm volatile("" : "+v"(t_), "+s"(b_), "+s"(g_), "+s"(l_)); C.tid = t_; C.lane = t_ & 63; C.wave = __builtin_amdgcn_readfirstlane(t_ >> 6); C.bid = b_; C.G = g_; C.lds = (LAS unsigned char*)(size_t)l_; p = kp_get(); ws = p->ws; } while (0)
#define PHASE_VARS Ctx C; { int t_ = C0.tid, b_ = C0.bid, g_ = C0.G; unsigned l_ = (unsigned)(size_t)C0.lds; asm volatile("" : "+v"(t_), "+s"(b_), "+s"(g_), "+s"(l_)); C.tid = t_; C.lane = t_ & 63; C.wave = __builtin_amdgcn_readfirstlane(t_ >> 6); C.bid = b_; C.G = g_; C.lds = (LAS unsigned char*)(size_t)l_; } KArg p = kp_get(); unsigned char* ws = p->ws; unsigned* ctl = (unsigned*)(ws + WS_CTL); const float* MOD = (const float*)(ws + WS_MOD); bf16_t* U = (bf16_t*)(ws + WS_U); (void)ctl; (void)MOD; (void)U;
#define SEAM(k) do { if (IN(k) && IN((k) + 1)) xcd_barrier(bar); } while (0)

    if (PH_ON(10) && IN(0)) { PHASE_VARS prologue_phase(p, C); }
    SEAM(0);

    for (int l = 0; l < DEPTH; ++l) {
        const int base = 1 + PH_PER_LAYER * l;
        const bool moe = (l & 1) != 0, last = (l == DEPTH - 1);
        const int row_min = last ? MC : 0, pm0 = last ? 4 : 0, Meff = last ? MX : MT;

        if (PH_ON(0) && IN(base + 0)) { PHASE_VARS
            norm_phase<0>(p, C, l, l == 2, l - 1, false, 0, (l == 1 || l == 3) ? 7 : 0);
        }
        SEAM(base + 0);
        if (PH_ON(1) && IN(base + 1)) { PHASE_VARS
            { pg8::Gemm g{U, (const bf16_t*)(ws + WS_WIN) + (size_t)l * DINP * D, MT, DINP, D, D, D}; pg8::OrderPM S; S.init(MT, DINP, C.G, C.bid); S.pm0 = 0;
              pg8::EpiStore E{(bf16_t*)(ws + WS_P), DINP, 1 << 20};
              pg8::gemm_phase<pg8::EpiStore, pg8::OrderPM, true, true>(C.lds, g, S, E); }
            { pg8::Gemm g{(const bf16_t*)(ws + WS_WINV) + (size_t)l * 256 * D, U, 256, MT, D, D, D}; pg8::OrderPM S; S.init(256, MT, C.G, (C.bid + 208) & 255); S.pm0 = 0;
              pg8::EpiStore E{(bf16_t*)(ws + WS_VTS), MT, 1 << 20};
              pg8::gemm_phase<pg8::EpiStore, pg8::OrderPM, true, true>(C.lds, g, S, E); }
        }
        SEAM(base + 1);
        if (PH_ON(2) && IN(base + 2)) for (int rep = 0; rep < NREP(2); ++rep) { PHASE_VARS
            for (int r2 = 0; r2 < ((DUP2 & 1) ? 2 : 1); ++r2) prep_phase(p, C, l);
            for (int u = C.bid; u < 2 * 1088; u += C.G) { const int mixer = u / 1088, v = u % 1088, b = v / 272, h = (v / 68) & 3, cg = v % 68;
                if (mixer == 0) { for (int r2 = 0; r2 < ((DUP2 & 2) ? 2 : 1); ++r2) gdn_chunk_unit(p, C, l, b, h, cg); } else { for (int r2 = 0; r2 < ((DUP2 & 4) ? 2 : 1); ++r2) ret_chunk_unit(p, C, l, b, h, cg); } }
        }
        SEAM(base + 2);
        if (PH_ON(3) && IN(base + 3)) for (int rep = 0; rep < NREP(3); ++rep) { PHASE_VARS
            if (SUB3 & 1) { if (C.bid < 32) gdn_scan_chain(p, C, C.bid); }
            RELAUNDER;
            if (C.bid >= 32) {
                const int G2 = C.G - 32, c2 = C.bid - 32;
                if (SUB3 & 2) { pg8::Gemm g{(const bf16_t*)(ws + WS_AUP), (const bf16_t*)(ws + WS_WUP) + (size_t)l * 1024 * 512, MT, 1024, 512, 512, 512}; pg8::OrderPM S; S.init(MT, 1024, G2, c2); S.pm0 = 0;
                  pg8::EpiUp E{(bf16_t*)(ws + WS_QRAW), (bf16_t*)(ws + WS_KFULL)};
                  pg8::gemm_phase<pg8::EpiUp, pg8::OrderPM, true, true>(C.lds, g, S, E); }
                RELAUNDER;
                if (SUB3 & 4) { pg8::Gemm g{(const bf16_t*)(ws + WS_WUPV) + (size_t)l * 256 * 512, (const bf16_t*)(ws + WS_AUP), 256, MT, 512, 512, 512}; pg8::OrderPM S; S.init(256, MT, G2, (c2 + 176) % G2); S.pm0 = 0;
                  pg8::EpiStore E{(bf16_t*)(ws + WS_VTM), MT, 1 << 20};
                  pg8::gemm_phase<pg8::EpiStore, pg8::OrderPM, true, true>(C.lds, g, S, E); }
                RELAUNDER;
                if (SUB3 & 8) ret_scan_items(p, C, l, c2 * NTHR + C.tid, 65536, G2 * NTHR);
                RELAUNDER;
                if (SUB3 & 16) { for (int u = 256 + c2; u < 512; u += G2) attn_dispatch(p, C, l, u);
                if (!last) for (int u = 528 + c2; u < 544; u += G2) attn_dispatch(p, C, l, u); }
                RELAUNDER;
                if (!last) { __syncthreads(); convert_layer_weights(p, C, l + 1, c2 * NWAVES + C.wave, G2 * NWAVES); }
            }
        }
        SEAM(base + 3);
        if (PH_ON(4) && IN(base + 4)) for (int rep = 0; rep < NREP(4); ++rep) { PHASE_VARS
            for (int u = C.bid; u < 256; u += C.G) attn_dispatch(p, C, l, u);
            if (!last) for (int u = 512 + C.bid; u < 528; u += C.G) attn_dispatch(p, C, l, u);
            for (int u = C.bid; u < 1088; u += C.G) { const int b = u / 272, h = (u / 68) & 3, cg = u % 68; if (last && cg < 4) continue; rec_out_unit(p, C, l, b, h, cg); }
        }
        SEAM(base + 4);
        if (PH_ON(5) && IN(base + 5)) { PHASE_VARS
            { pg8::Gemm g{(const bf16_t*)(ws + WS_MIX), (const bf16_t*)(ws + WS_WOUT) + (size_t)l * D * D, MX, D, D, D, D}; pg8::OrderPM S; S.init(MX, D, C.G, C.bid); S.pm0 = 4;
              pg8::EpiRes E{(float*)(ws + WS_H), MOD + (size_t)l * 5 * 6144 + 2 * 1024};
              pg8::gemm_phase<pg8::EpiRes, pg8::OrderPM, true, true>(C.lds, g, S, E); }
            if (!last) { RELAUNDER;
              pg8::Gemm g{(const bf16_t*)(ws + WS_MIX), (const bf16_t*)(ws + WS_WOUT) + (size_t)l * D * D, MC, D, 256, D, D}; pg8::SplitKOrder S{C.G, C.bid, 4, 256};
              pg8::EpiSlab E{(float*)(ws + WS_SLAB), (const float*)(ws + WS_MOD) + (size_t)l * 5 * 6144 + 2 * 1024, 256};
              pg8::gemm_phase<pg8::EpiSlab, pg8::SplitKOrder, true, true>(C.lds, g, S, E); }
        }
        SEAM(base + 5);
        if (PH_ON(6) && IN(base + 6)) { PHASE_VARS norm_phase<1>(p, C, l, false, 0, moe, row_min, last ? 0 : 4); }
        SEAM(base + 6);
        if (PH_ON(7) && IN(base + 7)) { PHASE_VARS if (moe) moe_gather_phase(p, C, row_min); }
        if (moe) SEAM(base + 7);
        if (PH_ON(8) && IN(base + 8)) { PHASE_VARS
            pg8::EpiSwiGLU E{(bf16_t*)(ws + WS_HD)};
            if (!moe) { pg8::Gemm g{U, (const bf16_t*)(ws + WS_WFF + (size_t)(l >> 1) * FFW_BYTES), MT, 7168, D, D, D}; pg8::OrderPM S; S.init(MT, 7168, C.G, C.bid); S.pm0 = 0;
                pg8::gemm_phase<pg8::EpiSwiGLU, pg8::OrderPM, true, true>(C.lds, g, S, E); }
            else { const int nt = (int)__hip_atomic_load(ctl + CW_TILEE + 160, __ATOMIC_RELAXED, __HIP_MEMORY_SCOPE_AGENT);
                pg8::Gemm g{(const bf16_t*)(ws + WS_ASORT), (const bf16_t*)(ws + WS_WMOE), MOE_ROWS, 8 * 7168, D, D, D}; pg8::MoeOrder S{28, C.G, C.bid, __builtin_amdgcn_readfirstlane(nt), ctl + CW_TILEE};
                pg8::gemm_phase<pg8::EpiSwiGLU, pg8::MoeOrder, true, true>(C.lds, g, S, E); }
        }
        SEAM(base + 8);
        if (PH_ON(9) && IN(base + 9)) { PHASE_VARS
            if (!moe) {
                const bf16_t* Wd = (const bf16_t*)(ws + WS_WFF + (size_t)(l >> 1) * FFW_BYTES) + (size_t)7168 * 1024;
                { pg8::Gemm g{(const bf16_t*)(ws + WS_HD), Wd, MX, D, DFF, DFF, DFF}; pg8::OrderPM S; S.init(MX, D, C.G, C.bid); S.pm0 = 4;
                  pg8::EpiRes E{(float*)(ws + WS_H), MOD + (size_t)l * 5 * 6144 + 5 * 1024};
                  pg8::gemm_phase<pg8::EpiRes, pg8::OrderPM, true, true>(C.lds, g, S, E); }
                RELAUNDER;
                { pg8::Gemm g{(const bf16_t*)(ws + WS_HD), (const bf16_t*)(ws + WS_WFF + (size_t)(l >> 1) * FFW_BYTES) + (size_t)7168 * 1024, MC, D, 512, DFF, DFF}; pg8::SplitKOrder S{C.G, C.bid, 7, 512};
                  pg8::EpiSlab E{(float*)(ws + WS_SLAB), (const float*)(ws + WS_MOD) + (size_t)l * 5 * 6144 + 5 * 1024, 512};
                  pg8::gemm_phase<pg8::EpiSlab, pg8::SplitKOrder, true, true>(C.lds, g, S, E); } }
            else { const int nt = (int)__hip_atomic_load(ctl + CW_TILEE + 160, __ATOMIC_RELAXED, __HIP_MEMORY_SCOPE_AGENT);
                pg8::Gemm g{(const bf16_t*)(ws + WS_HD), (const bf16_t*)(ws + WS_WMOE) + (size_t)8 * 7168 * 1024, MOE_ROWS, 8 * 1024, DFF, DFF, DFF}; pg8::MoeOrder S{4, C.G, C.bid, __builtin_amdgcn_readfirstlane(nt), ctl + CW_TILEE};
                pg8::EpiStore E{(bf16_t*)(ws + WS_YD), D, 4};
                pg8::gemm_phase<pg8::EpiStore, pg8::MoeOrder, true, true>(C.lds, g, S, E); }
        }
        SEAM(base + 9);
    }
    if (PH_ON(11) && IN(PH_FINAL)) { PHASE_VARS norm_phase<2>(p, C, DEPTH, true, DEPTH - 1, false, MC, 0); }
#undef IN
#undef SEAM
}

extern "C" void kernel_launch(void* const* d_in, const int* in_sizes, int n_in, void* d_out, int out_size, void* d_ws, size_t ws_size, hipStream_t stream) {
    static int grid = 0;
    if (grid == 0) {
        if (n_in != N_IN || out_size != MX * D || ws_size < WS_TOTAL) { fprintf(stderr, "kernel_launch: unexpected shapes (n_in %d out %d ws %zu, need %zu)\n", n_in, out_size, ws_size, (size_t)WS_TOTAL); grid = -1; return; }
        int dev = 0, cus = 0, per_cu = 0;
        if (hipGetDevice(&dev) != hipSuccess || hipDeviceGetAttribute(&cus, hipDeviceAttributeMultiprocessorCount, dev) != hipSuccess) { grid = -1; return; }
        if (hipFuncSetAttribute((const void*)mega_fwd, hipFuncAttributeMaxDynamicSharedMemorySize, LDS_BYTES) != hipSuccess) { fprintf(stderr, "kernel_launch: hipFuncSetAttribute failed\n"); grid = -1; return; }
        if (hipOccupancyMaxActiveBlocksPerMultiprocessor(&per_cu, (const void*)mega_fwd, NTHR, LDS_BYTES) != hipSuccess || per_cu < 1) { fprintf(stderr, "kernel_launch: occupancy query says %d\n", per_cu); }
        (void)hipGetLastError();
        grid = (cus == 256) ? 256 : -1;
        if (grid < 0) { fprintf(stderr, "kernel_launch: built for a 256-CU device, found %d\n", cus); return; }
    }
    if (grid < 0) return;
    if (hipMemsetAsync((char*)d_ws + WS_CTL, 0, CTL_BYTES, stream) != hipSuccess) return;
    Params p; memset(&p, 0, sizeof(p));
    for (int i = 0; i < N_IN; ++i) p.in[i] = (const float*)d_in[i];
    p.out = (float*)d_out; p.ws = (unsigned char*)d_ws;
#if MK_ONE_LAUNCH
    p.ph_lo = 0; p.ph_hi = N_PHASES;
    hipLaunchKernelGGL(mega_fwd, dim3(grid), dim3(NTHR), LDS_BYTES, stream, p);
#else
    for (int ph = 0; ph < N_PHASES; ++ph) {
        if (ph >= 1 && ph < PH_FINAL) { const int l = (ph - 1) / PH_PER_LAYER, k = (ph - 1) % PH_PER_LAYER; if (k == 7 && !(l & 1)) continue; }
        p.ph_lo = ph; p.ph_hi = ph + 1;
        hipLaunchKernelGGL(mega_fwd, dim3(grid), dim3(NTHR), LDS_BYTES, stream, p);
    }
#endif
}
```

```cpp
#include <hip/hip_runtime.h>
#include <cstdio>
#include <cstdint>
#include <cstring>

#ifndef MK_ONE_LAUNCH
#define MK_ONE_LAUNCH 1
#endif

#define LAS __attribute__((address_space(3)))
#define GAS __attribute__((address_space(1)))
typedef unsigned short bf16_t;
typedef short bf16x8 __attribute__((ext_vector_type(8)));
typedef float f32x4 __attribute__((ext_vector_type(4)));
typedef float f32x2 __attribute__((ext_vector_type(2)));
typedef float f32x16 __attribute__((ext_vector_type(16)));
typedef unsigned u32x4 __attribute__((ext_vector_type(4)));
typedef unsigned u32x2 __attribute__((ext_vector_type(2)));

constexpr int D = 1024, NB = 4, SEQ = 4096, CTX = 256, DEPTH = 4;
constexpr int MC = NB * CTX, MX = NB * SEQ, MT = MC + MX;
constexpr int DIN = 2992, DINP = 3072, DFF = 3584, NE = 8;
constexpr int NSU = 2 * NB * 4 * 68;
constexpr int PC_AQ = 0, PC_AK = 256, PC_AV = 384, PC_BQKV = 512, PC_BGATE = 1280, PC_BAB = 1536, PC_CQ = 1552, PC_CKV = 1808, PC_CKR = 1936,
              PC_DQ = 1968, PC_DK = 2224, PC_DV = 2480, PC_DGATE = 2736;
constexpr float EPS = 1e-6f, LOG2E = 1.4426950408889634f;
constexpr int MOE_ROWS = 36864, MOE_TILES = MOE_ROWS / 256;

constexpr size_t MiB = 1u << 20;
constexpr size_t WS_CTL = 0, CTL_BYTES = 1 * MiB;
constexpr int CW_BAR = 4096;
constexpr int CW_CNT = 16384;
constexpr int CW_TILEE = 20480;
constexpr size_t WS_TAB = 1 * MiB;
constexpr size_t WS_MOD = WS_TAB + 65536;
constexpr size_t WS_ROUTE = 2 * MiB;
constexpr size_t WS_DEC = 3 * MiB;
constexpr size_t WS_WIN = 4 * MiB;
constexpr size_t WS_WINV = WS_WIN + 24 * MiB;
constexpr size_t WS_WOUT = WS_WINV + 2 * MiB;
constexpr size_t WS_WUP = WS_WOUT + 8 * MiB;
constexpr size_t WS_WUPV = WS_WUP + 4 * MiB;
constexpr size_t WS_WFF = WS_WUPV + 1 * MiB;
constexpr size_t FFW_BYTES = (size_t)(7168 * 1024 + 1024 * 3584) * 2;
constexpr size_t WS_WMOE = WS_WFF + 42 * MiB;
constexpr size_t WS_H = WS_WMOE + 168 * MiB;
constexpr size_t WS_U = WS_H + 68 * MiB;
constexpr size_t WS_OV = WS_U + 34 * MiB;
constexpr size_t WS_P = WS_OV;
constexpr size_t WS_VTS = WS_P + 102 * MiB;
constexpr size_t WS_AUP = WS_VTS + 9 * MiB;
constexpr size_t WS_QRAW = WS_AUP + 17 * MiB;
constexpr size_t WS_KFULL = WS_QRAW + 13 * MiB;
constexpr size_t WS_VTM = WS_KFULL + 13 * MiB;
constexpr size_t WS_QS = WS_VTM + 9 * MiB;
constexpr size_t WS_KS = WS_QS + 9 * MiB;
constexpr size_t WS_MIX = WS_KS + 5 * MiB;
constexpr size_t WS_REC = WS_MIX + 34 * MiB;
constexpr size_t REC_G_W = 0, REC_G_UT = 8192, REC_G_KDT = 24576, REC_G_QG = 32768, REC_G_ATT = 40960, REC_G_SP = 49152, REC_G_VN = 57344, REC_G_BYTES = 65536;
constexpr size_t REC_R_KV = 0, REC_R_QG = 16384, REC_R_ATT = 24576, REC_R_VF = 32768, REC_R_SP = 40960, REC_R_BYTES = 49152;
constexpr size_t WS_RECG = WS_REC, WS_RECR = WS_REC + (size_t)NSU * REC_G_BYTES;
constexpr size_t WS_OV_END_MIX = WS_RECR + (size_t)NSU * REC_R_BYTES;
constexpr size_t WS_YD = WS_OV + 112 * MiB;
constexpr size_t WS_ASORT = WS_YD + 72 * MiB;
constexpr size_t WS_HD = WS_ASORT + 72 * MiB;
constexpr size_t WS_OV_END_FFN = WS_HD + 252 * MiB;
constexpr size_t WS_END = (WS_OV_END_MIX > WS_OV_END_FFN ? WS_OV_END_MIX : WS_OV_END_FFN);
static_assert(WS_P + (size_t)MT * DINP * 2 <= WS_VTS && WS_VTS + (size_t)256 * MT * 2 <= WS_AUP && WS_AUP + (size_t)MT * 512 * 2 <= WS_QRAW && WS_QRAW + (size_t)MT * 384 * 2 <= WS_KFULL &&
              WS_KFULL + (size_t)MT * 384 * 2 <= WS_VTM && WS_VTM + (size_t)256 * MT * 2 <= WS_QS && WS_QS + (size_t)MT * 256 * 2 <= WS_KS && WS_KS + (size_t)MT * 128 * 2 <= WS_MIX &&
              WS_MIX + (size_t)MT * D * 2 <= WS_REC && WS_YD >= WS_VTS + 9 * MiB && WS_MOD + 491520 <= WS_ROUTE && WS_ROUTE + 417792 <= WS_DEC && WS_DEC + NSU * 4 <= WS_WIN, "ws map");
constexpr size_t WS_SLAB = ((WS_END + MiB - 1) / MiB) * MiB;
constexpr size_t WS_TOTAL = WS_SLAB + 28 * MiB;
static_assert(WS_TOTAL <= 900 * MiB, "ws budget");

constexpr int LDS_BYTES = 147456;
constexpr int LDS_MISC = 147456 - 256;
constexpr int NWAVES = 8, NTHR = 512;

__device__ __forceinline__ unsigned cvtpk(float lo, float hi) { unsigned r; asm volatile("v_cvt_pk_bf16_f32 %0, %1, %2" : "=v"(r) : "v"(lo), "v"(hi)); return r; }
__device__ __forceinline__ float bf_lo(unsigned u) { return __uint_as_float(u << 16); }
__device__ __forceinline__ float bf_hi(unsigned u) { return __uint_as_float(u & 0xffff0000u); }
__device__ __forceinline__ float bf2f(bf16_t h) { return __uint_as_float((unsigned)h << 16); }
__device__ __forceinline__ bf16_t f2bf(float f) { return (bf16_t)(cvtpk(f, 0.f) & 0xffffu); }
__device__ __forceinline__ float wave_sum(float v) {
#pragma unroll
    for (int o = 1; o < 64; o <<= 1) v += __shfl_xor(v, o);
    return v;
}
__device__ __forceinline__ float silu_f(float x) { return x / (1.f + __expf(-x)); }
__device__ __forceinline__ float sigmoid_f(float x) { return 1.f / (1.f + __expf(-x)); }
__device__ __forceinline__ float softplus_f(float x) { return x > 20.f ? x : log1pf(__expf(x)); }
__device__ __forceinline__ int crow(int r, int hi) { return (r & 3) + 8 * (r >> 2) + 4 * hi; }
__device__ __forceinline__ f32x16 mfma32(bf16x8 a, bf16x8 b, f32x16 c) { return __builtin_amdgcn_mfma_f32_32x32x16_bf16(a, b, c, 0, 0, 0); }
__device__ __forceinline__ bf16x8 mk_frag(u32x2 lo, u32x2 hi) { u32x4 v; v.x = lo.x; v.y = lo.y; v.z = hi.x; v.w = hi.y; return __builtin_bit_cast(bf16x8, v); }
__device__ __forceinline__ bf16x8 mk_frag4(unsigned a, unsigned b, unsigned c, unsigned d) { u32x4 v; v.x = a; v.y = b; v.z = c; v.w = d; return __builtin_bit_cast(bf16x8, v); }
__device__ __forceinline__ int mod_row(int row) { return row < MC ? 4 : ((row - MC) >> 12); }

#define XB_TMO      128
#define XB_XCNT(j)  (256  + 64 * (j))
#define XB_XSUB(j)  (1280 + 64 * (j))
#define XB_XGEN(j)  (2304 + 64 * (j))
#define XB_TOP      3328
#define XB_TOPGEN   3392
#define XCD_BAR_WORDS 3456
#define XB_SPIN_CAP (1u << 18)
__device__ __forceinline__ unsigned xb_ld(unsigned* p)              { return __hip_atomic_load(p, __ATOMIC_RELAXED, __HIP_MEMORY_SCOPE_AGENT); }
__device__ __forceinline__ unsigned xb_add(unsigned* p, unsigned v) { return __hip_atomic_fetch_add(p, v, __ATOMIC_RELAXED, __HIP_MEMORY_SCOPE_AGENT); }
__device__ __forceinline__ unsigned xb_xcc_id() { return (unsigned)__builtin_amdgcn_s_getreg((3 << 11) | 20) & 0xFu; }
#define XB_SPIN(cond, bar) do { unsigned _sp = 0; while (cond) { __builtin_amdgcn_s_sleep(1); \
    if ((++_sp & 255u) == 0u) { if (xb_ld(&(bar)[XB_TMO])) break; if (_sp > XB_SPIN_CAP) { atomicAdd(&(bar)[XB_TMO], 1u); break; } } } } while (0)
struct XcdBarrier { unsigned* bar; unsigned x; volatile LAS unsigned* st; };
__device__ __forceinline__ XcdBarrier xcd_barrier_post(unsigned* bar, volatile LAS unsigned* st) {
    XcdBarrier b; b.bar = bar; b.x = xb_xcc_id(); b.st = st;
    if (threadIdx.x == 0) (void)xb_add(&bar[XB_XCNT(b.x)], 1u);
    return b;
}
__device__ __forceinline__ void xcd_barrier_complete(unsigned* bar, unsigned x, unsigned& nloc, unsigned& nx) {
    const unsigned G = gridDim.x * gridDim.y * gridDim.z;
    unsigned sum, cnt, mine, sp = 0u;
    for (;;) {
        sum = 0u; cnt = 0u; mine = 0u;
#pragma unroll
        for (unsigned j = 0; j < 16; ++j) { const unsigned c = xb_ld(&bar[XB_XCNT(j)]); sum += c; cnt += (c > 0u) ? 1u : 0u; mine = (j == x) ? c : mine; }
        if (sum == G) break;
        __builtin_amdgcn_s_sleep(1);
        if ((++sp & 255u) == 0u) { if (xb_ld(&bar[XB_TMO])) break; if (sp > XB_SPIN_CAP) { atomicAdd(&bar[XB_TMO], 1u); break; } }
    }
    nloc = mine > 0u ? mine : 1u; nx = cnt > 0u ? cnt : 1u;
}
__device__ __forceinline__ void xcd_barrier(const XcdBarrier& b) {
    asm volatile("s_waitcnt vmcnt(0)" ::: "memory");
    __syncthreads();
    if (threadIdx.x == 0) {
        unsigned* bar = b.bar;
        __builtin_amdgcn_s_waitcnt(0);
        unsigned nloc = b.st[0], nx = b.st[1];
        if (nloc == 0u) { xcd_barrier_complete(bar, b.x, nloc, nx); b.st[0] = nloc; b.st[1] = nx; }
        const unsigned old = xb_add(&bar[XB_XSUB(b.x)], 1u);
        const unsigned gen = old / nloc;
        if (old + 1u == (gen + 1u) * nloc) {
            __builtin_amdgcn_fence(__ATOMIC_RELEASE, "agent");
            asm volatile("s_waitcnt vmcnt(0)" ::: "memory");
            const unsigned og = xb_add(&bar[XB_TOP], 1u);
            const unsigned tg = og / nx;
            if (og + 1u == (tg + 1u) * nx) xb_add(&bar[XB_TOPGEN], 1u);
            else XB_SPIN(xb_ld(&bar[XB_TOPGEN]) == tg, bar);
            __builtin_amdgcn_fence(__ATOMIC_ACQUIRE, "agent");
            xb_add(&bar[XB_XGEN(b.x)], 1u);
            asm volatile("s_waitcnt vmcnt(0)" ::: "memory");
        } else {
            XB_SPIN(xb_ld(&bar[XB_XGEN(b.x)]) == gen, bar);
            __builtin_amdgcn_fence(__ATOMIC_ACQUIRE, "agent");
            asm volatile("s_waitcnt vmcnt(0)" ::: "memory");
        }
    }
    __syncthreads();
}
namespace pg8 {
#define PG8_LAS __attribute__((address_space(3)))
typedef unsigned short bf16_t;
typedef short bf16x8 __attribute__((ext_vector_type(8)));
typedef float f32x4 __attribute__((ext_vector_type(4)));
typedef unsigned u32x4 __attribute__((ext_vector_type(4)));
constexpr int BM = 256, BK = 64, HALF = 128, HTB = HALF * BK * 2  , STAGE_BYTES = 8 * HTB, NXCD = 8, WGM = 8;

__host__ __device__ __forceinline__ int lds_byte(int r, int c) { const int st = (r >> 4) * 2 + (c >> 5), rr = r & 15, cc = c & 31, ob = rr * 64 + cc * 2; return st * 1024 + (ob ^ (((ob >> 9) & 1) << 5)); }
__host__ __device__ __forceinline__ void stage_rc(int b, int& R, int& C) { const int st = b / 1024, sb = b % 1024, swz = sb ^ (((sb >> 9) & 1) << 5); R = (st >> 1) * 16 + swz / 64; C = (st & 1) * 32 + (swz % 64) / 2; }
__host__ __device__ __forceinline__ int perm32(int rho) { const int n = rho >> 4, i = rho & 15; return 8 * (i >> 2) + 4 * n + (i & 3); }

struct Unit { int pm, pn, ko; };
struct Gemm { const bf16_t* A; const bf16_t* Bt; int M, N, K, lda, ldb; };

struct StaticOrder {
    int nM, nN, nwg, G, c;
    __host__ __device__ void init(int M, int N, int G_, int c_) { nM = M / BM; nN = N / BM; nwg = nM * nN; G = G_; c = c_; }
    __host__ __device__ bool next(int i, Unit& u) const {
        const long L = (long)i * G + c; if (L >= nwg) return false;
        int wgid = (int)L; { const int q = nwg / NXCD, r = nwg % NXCD, xcd = wgid % NXCD, off = wgid / NXCD; wgid = (xcd < r ? xcd * (q + 1) : r * (q + 1) + (xcd - r) * q) + off; }
        const int nig = WGM * nN, gid = wgid / nig, fm = gid * WGM, gsz = (nM - fm) < WGM ? (nM - fm) : WGM;
        u.pm = fm + ((wgid % nig) % gsz); u.pn = (wgid % nig) / gsz; u.ko = 0; return true;
    }
    __device__ __forceinline__ void a_ready(const Unit&) const {}
    __device__ __forceinline__ void done(const Unit&) const {}
};
__device__ __forceinline__ unsigned cvt_pk_bf16(float lo, float hi) { unsigned r; asm volatile("v_cvt_pk_bf16_f32 %0, %1, %2" : "=v"(r) : "v"(lo), "v"(hi)); return r; }
template <class Epi, class Sched, bool ALIGN_EPI = false, bool SP2 = false>
__device__ __forceinline__ void gemm_phase(PG8_LAS unsigned char* lds, const Gemm g, const Sched& S, const Epi& E) {
    int tid_l = threadIdx.x; asm volatile("" : "+v"(tid_l));
    const int tid = tid_l, wid = __builtin_amdgcn_readfirstlane(tid >> 6), lane = tid & 63, wr = wid >> 2, wc = wid & 3, fr = lane & 15, fq = lane >> 4;
    const int K = g.K, nt = K / BK;
    unsigned voffA[2], voffB[2];
#pragma unroll
    for (int i = 0; i < 2; ++i) { int R, C; stage_rc(tid * 16 + i * 8192, R, C); const int Rb = Epi::PERM ? ((R & ~31) + perm32(R & 31)) : R;
        voffA[i] = (unsigned)(R * g.lda + C) * 2u; voffB[i] = (unsigned)(Rb * g.ldb + C) * 2u; }
    const size_t kstep = (size_t)(BK * 2);
    const size_t hstepA = (size_t)HALF * g.lda * 2, hstepB = (size_t)HALF * g.ldb * 2;
    const size_t tstepA = 2 * hstepA, tstepB = 2 * hstepB;
    const unsigned ldsw = (unsigned)wid * 1024u;
    const int aoff = lds_byte(wr * 64 + fr, fq * 8), boff = lds_byte(wc * 32 + fr, fq * 8);
#define PG8_SA(b, h) (((b) * 2 + (h)) * HTB)
#define PG8_SB(b, h) ((4 + (b) * 2 + (h)) * HTB)
#define PG8_STAGE(bufoff, gbase, voff) do { _Pragma("unroll") for (int _i = 0; _i < 2; ++_i) \
        __builtin_amdgcn_global_load_lds((const unsigned*)((const char*)(gbase) + (voff)[_i]), (PG8_LAS unsigned*)(lds + (bufoff) + ldsw + _i * 8192), 16, 0, 0); } while (0)
#define PG8_LDA(dst, b, h) do { _Pragma("unroll") for (int m = 0; m < 4; ++m) _Pragma("unroll") for (int k = 0; k < 2; ++k) dst[m][k] = *(const PG8_LAS bf16x8*)(lds + PG8_SA(b, h) + aoff + m * 2048 + k * 1024); } while (0)
#define PG8_LDB(dst, b, h) do { _Pragma("unroll") for (int n = 0; n < 2; ++n) _Pragma("unroll") for (int k = 0; k < 2; ++k) dst[n][k] = *(const PG8_LAS bf16x8*)(lds + PG8_SB(b, h) + boff + n * 2048 + k * 1024); } while (0)
#define PG8_MMA(ai, bj, At, Bt) do { __builtin_amdgcn_s_setprio(1); _Pragma("unroll") for (int m = 0; m < 4; ++m) _Pragma("unroll") for (int n = 0; n < 2; ++n) _Pragma("unroll") for (int k = 0; k < 2; ++k) \
        acc[ai][bj][m][n] = __builtin_amdgcn_mfma_f32_16x16x32_bf16(Bt[n][k], At[m][k], acc[ai][bj][m][n], 0, 0, 0); __builtin_amdgcn_s_setprio(0); } while (0)
#define PG8_WAIT_V(n) asm volatile("s_waitcnt vmcnt(" #n ")" ::: "memory")
#define PG8_WAIT_L(n) asm volatile("s_waitcnt lgkmcnt(" #n ")" ::: "memory")
#define PG8_BAR __builtin_amdgcn_s_barrier()
#define PG8_SCHED __builtin_amdgcn_sched_barrier(0)
    Unit cur, nxt; int ui = 0;
    if (!S.next(0, cur)) return;
    f32x4 acc[2][2][4][2];
#pragma unroll
    for (int a = 0; a < 2; ++a)
#pragma unroll
        for (int b = 0; b < 2; ++b)
#pragma unroll
            for (int m = 0; m < 4; ++m)
#pragma unroll
                for (int n = 0; n < 2; ++n) acc[a][b][m][n] = (f32x4){0.f, 0.f, 0.f, 0.f};
    bf16x8 At[4][2], B0[2][2], B1[2][2];
    const char* cA = (const char*)g.A + (size_t)cur.pm * tstepA + (size_t)cur.ko * 2; const char* cB = (const char*)g.Bt + (size_t)cur.pn * tstepB + (size_t)cur.ko * 2;
    S.a_ready(cur);
    if constexpr (SP2) {
        PG8_STAGE(PG8_SB(0, 0), cB, voffB); PG8_STAGE(PG8_SB(0, 1), cB + hstepB, voffB); PG8_STAGE(PG8_SA(0, 0), cA, voffA); PG8_STAGE(PG8_SA(0, 1), cA + hstepA, voffA);
        if (wr == 1) PG8_BAR;
        PG8_WAIT_V(2); PG8_BAR;
        PG8_STAGE(PG8_SB(1, 0), cB + kstep, voffB); PG8_STAGE(PG8_SA(1, 0), cA + kstep, voffA); PG8_STAGE(PG8_SB(1, 1), cB + hstepB + kstep, voffB);
        PG8_WAIT_V(6); PG8_BAR;
    } else {
        PG8_STAGE(PG8_SB(0, 0), cB, voffB); PG8_STAGE(PG8_SA(0, 0), cA, voffA); PG8_STAGE(PG8_SB(0, 1), cB + hstepB, voffB); PG8_STAGE(PG8_SA(0, 1), cA + hstepA, voffA);
        if (wr == 1) PG8_BAR;
        PG8_WAIT_V(4); PG8_BAR;
        PG8_STAGE(PG8_SB(1, 0), cB + kstep, voffB); PG8_STAGE(PG8_SA(1, 0), cA + kstep, voffA); PG8_STAGE(PG8_SB(1, 1), cB + hstepB + kstep, voffB);
        PG8_WAIT_V(6); PG8_BAR;
    }
    for (;;) {
        const bool has_next = S.next(ui + 1, nxt);
        const char* nA = has_next ? (const char*)g.A + (size_t)nxt.pm * tstepA + (size_t)nxt.ko * 2 : cA; const char* nB = has_next ? (const char*)g.Bt + (size_t)nxt.pn * tstepB + (size_t)nxt.ko * 2 : cB;
        for (int t = 0; t < nt; t += 2) {
            const bool last = (t == nt - 2);
            const char* a1 = cA + (size_t)(t + 1) * kstep;
            const char* a2 = last ? nA : cA + (size_t)(t + 2) * kstep; const char* b2 = last ? nB : cB + (size_t)(t + 2) * kstep;
            const char* a3 = a2 + kstep; const char* b3 = b2 + kstep;
            if (last && has_next) S.a_ready(nxt);
            if constexpr (SP2) {
            PG8_LDB(B0, 0, 0); PG8_LDB(B1, 0, 1); PG8_SCHED; PG8_LDA(At, 0, 0); PG8_STAGE(PG8_SA(1, 1), a1 + hstepA, voffA);
            PG8_WAIT_V(8); PG8_WAIT_L(0); PG8_BAR; PG8_MMA(0, 0, At, B0); PG8_MMA(0, 1, At, B1); PG8_BAR; PG8_SCHED;
            PG8_LDA(At, 0, 1); PG8_STAGE(PG8_SB(0, 0), b2, voffB); PG8_STAGE(PG8_SB(0, 1), b2 + hstepB, voffB); PG8_STAGE(PG8_SA(0, 0), a2, voffA);
            PG8_WAIT_V(8); PG8_WAIT_L(0); PG8_BAR; PG8_MMA(1, 0, At, B0); PG8_MMA(1, 1, At, B1); PG8_BAR; PG8_SCHED;
            PG8_LDB(B0, 1, 0); PG8_LDB(B1, 1, 1); PG8_SCHED; PG8_LDA(At, 1, 0); PG8_STAGE(PG8_SA(0, 1), a2 + hstepA, voffA);
            PG8_WAIT_V(8); PG8_WAIT_L(0); PG8_BAR; PG8_MMA(0, 0, At, B0); PG8_MMA(0, 1, At, B1); PG8_BAR; PG8_SCHED;
            PG8_LDA(At, 1, 1); PG8_STAGE(PG8_SB(1, 0), b3, voffB); PG8_STAGE(PG8_SB(1, 1), b3 + hstepB, voffB); PG8_STAGE(PG8_SA(1, 0), a3, voffA);
            PG8_WAIT_V(8); PG8_WAIT_L(0); PG8_BAR; PG8_MMA(1, 0, At, B0); PG8_MMA(1, 1, At, B1); PG8_BAR; PG8_SCHED;
            } else {
            PG8_LDB(B0, 0, 0); PG8_SCHED; PG8_LDA(At, 0, 0); PG8_STAGE(PG8_SA(1, 1), a1 + hstepA, voffA);
            PG8_WAIT_L(8); PG8_BAR; PG8_WAIT_L(0); PG8_MMA(0, 0, At, B0); PG8_BAR; PG8_SCHED;
            PG8_LDB(B1, 0, 1); PG8_STAGE(PG8_SB(0, 0), b2, voffB);
            PG8_BAR; PG8_WAIT_L(0); PG8_MMA(0, 1, At, B1); PG8_BAR;
            PG8_LDA(At, 0, 1); PG8_STAGE(PG8_SA(0, 0), a2, voffA);
            PG8_BAR; PG8_WAIT_L(0); PG8_MMA(1, 0, At, B0); PG8_BAR; PG8_SCHED;
            PG8_STAGE(PG8_SB(0, 1), b2 + hstepB, voffB);
            PG8_WAIT_V(6); PG8_BAR; PG8_MMA(1, 1, At, B1); PG8_BAR;
            PG8_LDB(B0, 1, 0); PG8_SCHED; PG8_LDA(At, 1, 0); PG8_STAGE(PG8_SA(0, 1), a2 + hstepA, voffA);
            PG8_WAIT_L(8); PG8_BAR; PG8_WAIT_L(0); PG8_MMA(0, 0, At, B0); PG8_BAR; PG8_SCHED;
            PG8_LDB(B1, 1, 1); PG8_STAGE(PG8_SB(1, 0), b3, voffB);
            PG8_BAR; PG8_WAIT_L(0); PG8_MMA(0, 1, At, B1); PG8_BAR;
            PG8_LDA(At, 1, 1); PG8_STAGE(PG8_SA(1, 0), a3, voffA);
            PG8_BAR; PG8_WAIT_L(0); PG8_MMA(1, 0, At, B0); PG8_BAR; PG8_SCHED;
            PG8_STAGE(PG8_SB(1, 1), b3 + hstepB, voffB);
            PG8_WAIT_V(6); PG8_BAR; PG8_MMA(1, 1, At, B1); PG8_BAR;
            }
        }
        if constexpr (ALIGN_EPI) { if (wr == 0) PG8_BAR; }
        if constexpr (!Epi::AFTER_DRAIN) { E(acc, cur, wr, wc, fr, fq); S.done(cur); }
        if (!has_next) break;
#pragma unroll
        for (int a = 0; a < 2; ++a)
#pragma unroll
            for (int b = 0; b < 2; ++b)
#pragma unroll
                for (int m = 0; m < 4; ++m)
#pragma unroll
                    for (int n = 0; n < 2; ++n) acc[a][b][m][n] = (f32x4){0.f, 0.f, 0.f, 0.f};
        cur = nxt; cA = nA; cB = nB; ++ui;
        if constexpr (ALIGN_EPI) { if (wr == 1) PG8_BAR; }
    }
    PG8_WAIT_V(0);
    if constexpr (!ALIGN_EPI) { if (wr == 0) PG8_BAR; }
    PG8_BAR;
    if constexpr (Epi::AFTER_DRAIN) { E.fused(acc, cur, wr, wc, fr, fq, lds, wid, lane); S.done(cur); }
#undef PG8_SA
#undef PG8_SB
#undef PG8_STAGE
#undef PG8_LDA
#undef PG8_LDB
#undef PG8_MMA
#undef PG8_WAIT_V
#undef PG8_WAIT_L
#undef PG8_BAR
#undef PG8_SCHED
}
}

namespace pg8 {
struct OrderPM : StaticOrder {
    int pm0;
    __device__ __forceinline__ bool next(int i, Unit& u) const { if (!StaticOrder::next(i, u)) return false; u.pm += pm0; return true; }
};
struct MoeOrder {
    int nN, G, c, ntiles; const unsigned* tile_e;
    __device__ __forceinline__ bool next(int i, Unit& u) const {
        const long L = (long)i * G + c; if (L >= (long)ntiles * nN) return false;
        const int pm = (int)(L / nN), pl = (int)(L % nN);
        const int e = (int)__hip_atomic_load(tile_e + pm, __ATOMIC_RELAXED, __HIP_MEMORY_SCOPE_AGENT);
        u.pm = pm; u.pn = __builtin_amdgcn_readfirstlane(e) * nN + pl; u.ko = 0; return true;
    }
    __device__ __forceinline__ void a_ready(const Unit&) const {}
    __device__ __forceinline__ void done(const Unit&) const {}
};

struct SplitKOrder {
    int G, c, ns, kslice;
    __device__ __forceinline__ bool next(int i, Unit& u) const { const int L = i * G + c; if (L >= 16 * ns) return false; const int sl = L % ns, t = L / ns; u.pm = t & 3; u.pn = t >> 2; u.ko = sl * kslice; return true; }
    __device__ __forceinline__ void a_ready(const Unit&) const {}
    __device__ __forceinline__ void done(const Unit&) const {}
};
struct EpiStore {
    static constexpr bool PERM = true, AFTER_DRAIN = false;
    bf16_t* O; int ldc; int pn_mod;
    __device__ __forceinline__ void operator()(const f32x4 (&acc)[2][2][4][2], const Unit& u, int wr, int wc, int fr, int fq) const {
        const int row0 = u.pm * BM + wr * 64 + fr, col0 = (u.pn % pn_mod) * BM + wc * 32 + 8 * fq;
#pragma unroll
        for (int ai = 0; ai < 2; ++ai)
#pragma unroll
            for (int m = 0; m < 4; ++m) { bf16_t* rowp = O + (size_t)(row0 + ai * HALF + m * 16) * ldc + col0;
#pragma unroll
                for (int bj = 0; bj < 2; ++bj) { const f32x4 v0 = acc[ai][bj][m][0], v1 = acc[ai][bj][m][1];
                    u32x4 w; w.x = cvt_pk_bf16(v0[0], v0[1]); w.y = cvt_pk_bf16(v0[2], v0[3]); w.z = cvt_pk_bf16(v1[0], v1[1]); w.w = cvt_pk_bf16(v1[2], v1[3]);
                    *(u32x4*)(rowp + bj * HALF) = w; } }
    }
};
struct EpiUp {
    static constexpr bool PERM = true, AFTER_DRAIN = false;
    bf16_t* Q; bf16_t* K;
    __device__ __forceinline__ void operator()(const f32x4 (&acc)[2][2][4][2], const Unit& u, int wr, int wc, int fr, int fq) const {
        const int row0 = u.pm * BM + wr * 64 + fr;
#pragma unroll
        for (int bj = 0; bj < 2; ++bj) {
            const int col = u.pn * BM + bj * HALF + wc * 32 + 8 * fq;
            bf16_t* base;
            if (col < 384) base = Q + col; else if (col < 640) { const int c2 = col - 384; base = K + (c2 >> 6) * 96 + (c2 & 63); } else continue;
#pragma unroll
            for (int ai = 0; ai < 2; ++ai)
#pragma unroll
                for (int m = 0; m < 4; ++m) { const f32x4 v0 = acc[ai][bj][m][0], v1 = acc[ai][bj][m][1];
                    u32x4 w; w.x = cvt_pk_bf16(v0[0], v0[1]); w.y = cvt_pk_bf16(v0[2], v0[3]); w.z = cvt_pk_bf16(v1[0], v1[1]); w.w = cvt_pk_bf16(v1[2], v1[3]);
                    *(u32x4*)(base + (size_t)(row0 + ai * HALF + m * 16) * 384) = w; }
        }
    }
};
template <bool ATOMIC> struct EpiResT {
    static constexpr bool PERM = false, AFTER_DRAIN = false;
    float* H; const float* gate;
    __device__ __forceinline__ void operator()(const f32x4 (&acc)[2][2][4][2], const Unit& u, int wr, int wc, int fr, int fq) const {
        const int row0 = u.pm * BM + wr * 64 + fr, col0 = u.pn * BM + wc * 32 + 4 * fq;
        const int mb = (u.pm < 4) ? 4 : ((u.pm - 4) >> 4);
        const float* gp = gate + (size_t)mb * 6144 + col0;
        f32x4 gv[2][2];
#pragma unroll
        for (int bj = 0; bj < 2; ++bj)
#pragma unroll
            for (int n = 0; n < 2; ++n) gv[bj][n] = *(const f32x4*)(gp + bj * HALF + n * 16);
#pragma unroll
        for (int ai = 0; ai < 2; ++ai)
#pragma unroll
            for (int m = 0; m < 4; ++m) { float* rowp = H + (size_t)(row0 + ai * HALF + m * 16) * D + col0;
#pragma unroll
                for (int bj = 0; bj < 2; ++bj)
#pragma unroll
                    for (int n = 0; n < 2; ++n) { float* pp = rowp + bj * HALF + n * 16; const f32x4 v = gv[bj][n] * acc[ai][bj][m][n];
                        f32x4* p = (f32x4*)pp; *p = *p + v; } }
    }
};
typedef EpiResT<false> EpiRes;
struct EpiSlab {
    static constexpr bool PERM = false, AFTER_DRAIN = false;
    float* slab; const float* gate; int kslice;
    __device__ __forceinline__ void operator()(const f32x4 (&acc)[2][2][4][2], const Unit& u, int wr, int wc, int fr, int fq) const {
        const int row0 = u.pm * BM + wr * 64 + fr, col0 = u.pn * BM + wc * 32 + 4 * fq;
        const float* gp = gate + (size_t)4 * 6144 + col0; float* sb = slab + (size_t)(u.ko / kslice) * MC * D;
        f32x4 gv[2][2];
#pragma unroll
        for (int bj = 0; bj < 2; ++bj)
#pragma unroll
            for (int n = 0; n < 2; ++n) gv[bj][n] = *(const f32x4*)(gp + bj * HALF + n * 16);
#pragma unroll
        for (int ai = 0; ai < 2; ++ai)
#pragma unroll
            for (int m = 0; m < 4; ++m) { float* rowp = sb + (size_t)(row0 + ai * HALF + m * 16) * D + col0;
#pragma unroll
                for (int bj = 0; bj < 2; ++bj)
#pragma unroll
                    for (int n = 0; n < 2; ++n) *(f32x4*)(rowp + bj * HALF + n * 16) = gv[bj][n] * acc[ai][bj][m][n]; }
    }
};
struct EpiSwiGLU {
    static constexpr bool PERM = true, AFTER_DRAIN = false;
    bf16_t* Hd;
    __device__ __forceinline__ void operator()(const f32x4 (&acc)[2][2][4][2], const Unit& u, int wr, int wc, int fr, int fq) const {
        const int row0 = u.pm * BM + wr * 64 + fr, col0 = (u.pn % 28) * HALF + wc * 32 + 8 * fq;
#pragma unroll
        for (int ai = 0; ai < 2; ++ai)
#pragma unroll
            for (int m = 0; m < 4; ++m) {
                float o[8];
#pragma unroll
                for (int n = 0; n < 2; ++n)
#pragma unroll
                    for (int q = 0; q < 4; ++q) { const float g = acc[ai][0][m][n][q], up = acc[ai][1][m][n][q]; o[n * 4 + q] = g / (1.f + __expf(-g)) * up; }
                u32x4 w; w.x = cvt_pk_bf16(o[0], o[1]); w.y = cvt_pk_bf16(o[2], o[3]); w.z = cvt_pk_bf16(o[4], o[5]); w.w = cvt_pk_bf16(o[6], o[7]);
                *(u32x4*)(Hd + (size_t)(row0 + ai * HALF + m * 16) * DFF + col0) = w; }
    }
};
}

enum { I_X = 0, I_C, I_CTX, I_CCTX, I_WMOD, I_BMOD, I_NORM1, I_NORM2, I_WIN, I_WOUT, I_SINK, I_GCONV, I_GALOG, I_GDTB, I_GNORM, I_QNORM, I_KVNORM, I_WQUP, I_WKVUP,
       I_RLOGD, I_RNORM, I_FGATE, I_FUP, I_FDOWN, I_ROUTER, I_MGATE, I_MUP, I_MDOWN, I_FNORM, N_IN };
struct Params { const float* in[N_IN]; float* out; unsigned char* ws; int ph_lo, ph_hi; };
typedef const __attribute__((address_space(4))) Params* KArg;
__device__ __forceinline__ KArg kp_get() { KArg k = (KArg)__builtin_amdgcn_kernarg_segment_ptr(); asm volatile("" : "+s"(k)); return k; }

struct Ctx {
    LAS unsigned char* lds; int tid, lane, wave, bid, G;
};

__device__ __forceinline__ void tr_item(const float* src, int ldsrc, int nvalid, int k0, int c0, bf16_t* dst, int ldd, int drow0, LAS float* scr, int lane) {
    const int n_ = lane & 31, cc = c0 + n_;
#pragma unroll 8
    for (int i = 0; i < 32; ++i) { const int kk = 2 * i + (lane >> 5); scr[kk * 33 + n_] = (cc < nvalid) ? src[(size_t)(k0 + kk) * ldsrc + cc] : 0.f; }
    asm volatile("s_waitcnt lgkmcnt(0)" ::: "memory");
    const int c = lane & 7;
#pragma unroll
    for (int j = 0; j < 4; ++j) { const int n = (lane >> 3) + 8 * j; const LAS float* s = scr + (8 * c) * 33 + n;
        u32x4 o; o.x = cvtpk(s[0 * 33], s[1 * 33]); o.y = cvtpk(s[2 * 33], s[3 * 33]); o.z = cvtpk(s[4 * 33], s[5 * 33]); o.w = cvtpk(s[6 * 33], s[7 * 33]);
        *(u32x4*)(dst + (size_t)(drow0 + n) * ldd + k0 + 8 * c) = o; }
    asm volatile("s_waitcnt lgkmcnt(0)" ::: "memory");
}
__device__ __forceinline__ void ffn_tr_item(const float* g, const float* u, const float* d, bf16_t* gu, bf16_t* dn, int it, LAS float* scr, int lane) {
    if (it < 3584) { const bool up = it >= 1792; const int r = up ? it - 1792 : it; const int kb = r / 112, cb = r % 112, c0 = 32 * cb;
        tr_item(up ? u : g, DFF, DFF, 64 * kb, c0, gu, 1024, 256 * (c0 >> 7) + (up ? 128 : 0) + (c0 & 127), scr, lane); }
    else { const int r = it - 3584; const int kb = r / 32, cb = r % 32; tr_item(d, 1024, 1024, 64 * kb, 32 * cb, dn, DFF, 32 * cb, scr, lane); }
}

__device__ __forceinline__ void convert_layer_weights(KArg p, const Ctx& C, int ln, int gw, int NGW) {
    unsigned char* ws = p->ws; LAS float* scr = (LAS float*)(C.lds + C.wave * 8704);
    constexpr int I_IN = 16 * 96, I_OUT = 16 * 32, I_FF = 5376;
    const bool moe = (ln & 1) != 0; const int i = ln >> 1;
    const int nit = I_IN + I_OUT + (moe ? 8 * I_FF : I_FF);
    for (int it = gw; it < nit; it += NGW) {
        int r = it;
        if (r < I_IN) { const int kb = r / 96, cb = r % 96;
            tr_item(p->in[I_WIN] + (size_t)ln * D * DIN, DIN, DIN, 64 * kb, 32 * cb, (bf16_t*)(ws + WS_WIN) + (size_t)ln * DINP * D, D, 32 * cb, scr, C.lane); continue; }
        r -= I_IN;
        if (r < I_OUT) { const int kb = r / 32, cb = r % 32;
            tr_item(p->in[I_WOUT] + (size_t)ln * D * D, D, D, 64 * kb, 32 * cb, (bf16_t*)(ws + WS_WOUT) + (size_t)ln * D * D, D, 32 * cb, scr, C.lane); continue; }
        r -= I_OUT;
        if (!moe) { bf16_t* gu = (bf16_t*)(ws + WS_WFF + (size_t)i * FFW_BYTES);
            ffn_tr_item(p->in[I_FGATE] + (size_t)i * D * DFF, p->in[I_FUP] + (size_t)i * D * DFF, p->in[I_FDOWN] + (size_t)i * DFF * D, gu, gu + (size_t)7168 * 1024, r, scr, C.lane); }
        else { const int e = r / I_FF; r %= I_FF; const size_t eo = (size_t)i * NE + e;
            bf16_t* gu = (bf16_t*)(ws + WS_WMOE) + (size_t)e * 7168 * 1024; bf16_t* dn = (bf16_t*)(ws + WS_WMOE) + (size_t)8 * 7168 * 1024 + (size_t)e * 1024 * DFF;
            ffn_tr_item(p->in[I_MGATE] + eo * D * DFF, p->in[I_MUP] + eo * D * DFF, p->in[I_MDOWN] + eo * DFF * D, gu, dn, r, scr, C.lane); }
    }
}

__device__ __forceinline__ void prologue_phase(KArg p, const Ctx& C) {
    unsigned char* ws = p->ws;
    const int gw = C.bid * NWAVES + C.wave, NGW = C.G * NWAVES, gt = C.bid * NTHR + C.tid, NGT = C.G * NTHR;
    convert_layer_weights(p, C, 0, gw, NGW);
    {
        constexpr int PER_L = 256 * 128 + 1024 * 64 + 256 * 64;
        for (int it = gt; it < 4 * PER_L; it += NGT) {
            const int l = it / PER_L; int r = it % PER_L;
            const float* win = p->in[I_WIN] + (size_t)l * D * DIN; const float* qup = p->in[I_WQUP] + (size_t)l * 256 * 384; const float* kvup = p->in[I_WKVUP] + (size_t)l * 128 * 512;
            float v[8]; bf16_t* dst;
            if (r < 256 * 128) { const int n = r % 256, kg = r / 256;
#pragma unroll
                for (int j = 0; j < 8; ++j) v[j] = (n < 128) ? win[(size_t)(8 * kg + j) * DIN + PC_AV + n] : 0.f;
                dst = (bf16_t*)(ws + WS_WINV) + ((size_t)l * 256 + n) * 1024 + 8 * kg; }
            else if ((r -= 256 * 128) < 1024 * 64) { const int n = r % 1024, kg = r / 1024;
#pragma unroll
                for (int j = 0; j < 8; ++j) { const int k = 8 * kg + j; float x = 0.f;
                    if (n < 384) { if (k < 256) x = qup[(size_t)k * 384 + n]; }
                    else if (n < 640) { const int c2 = n - 384; if (k >= 256 && k < 384) x = kvup[(size_t)(k - 256) * 512 + 128 * (c2 >> 6) + (c2 & 63)]; }
                    v[j] = x; }
                dst = (bf16_t*)(ws + WS_WUP) + ((size_t)l * 1024 + n) * 512 + 8 * kg; }
            else { r -= 1024 * 64; const int n = r % 256, kg = r / 256;
#pragma unroll
                for (int j = 0; j < 8; ++j) { const int k = 8 * kg + j; v[j] = (k >= 256 && k < 384) ? kvup[(size_t)(k - 256) * 512 + 128 * (n >> 6) + 64 + (n & 63)] : 0.f; }
                dst = (bf16_t*)(ws + WS_WUPV) + ((size_t)l * 256 + n) * 512 + 8 * kg; }
            u32x4 o; o.x = cvtpk(v[0], v[1]); o.y = cvtpk(v[2], v[3]); o.z = cvtpk(v[4], v[5]); o.w = cvtpk(v[6], v[7]);
            *(u32x4*)dst = o;
        }
    }
    {
        float* tab = (float*)(ws + WS_TAB);
        for (int it = gt; it < 64 * 16 + 64 * 8; it += NGT) {
            if (it < 1024) { const int pos = it >> 4, j = it & 15; const float inv = (float)pow(10000.0, -(double)j / 16.0); const float ang = (float)pos * inv;
                tab[it] = (float)cos((double)ang); tab[1024 + it] = (float)sin((double)ang); }
            else { const int r = it - 1024; const int pos = r >> 3, j = r & 7; const float inv = (float)pow(10000.0, -(double)j / 8.0); const float ang = (float)pos * inv;
                tab[2048 + r] = (float)cos((double)ang); tab[2560 + r] = (float)sin((double)ang); }
        }
    }
    {
        f32x4* H4 = (f32x4*)(ws + WS_H); const f32x4* x4 = (const f32x4*)p->in[I_X]; const f32x4* c4 = (const f32x4*)p->in[I_CTX];
        for (int it = gt; it < MT * 256; it += NGT) H4[it] = (it < MC * 256) ? c4[it] : x4[it - MC * 256];
    }
    __syncthreads();
    if (C.bid < 192) {
        LAS float* sl = (LAS float*)C.lds;
        LAS float* red = (LAS float*)(C.lds + 20480);
        for (int i = C.tid; i < 5 * 1024; i += NTHR) { const int r = i >> 10, k = i & 1023; const float cv = (r < 4) ? p->in[I_C][r * 1024 + k] : p->in[I_CCTX][k]; sl[i] = silu_f(cv); }
        __syncthreads();
        for (int it = C.bid; it < 192; it += C.G) {
            const int l = it / 48, cb = it % 48, cl = C.tid & 127, kq = C.tid >> 7, col = cb * 128 + cl;
            const float* w = p->in[I_WMOD] + (size_t)l * D * 6144 + col;
            float a0 = 0.f, a1 = 0.f, a2 = 0.f, a3 = 0.f, a4 = 0.f;
#pragma unroll 8
            for (int k = 256 * kq; k < 256 * kq + 256; ++k) { const float wv = w[(size_t)k * 6144]; a0 += sl[k] * wv; a1 += sl[1024 + k] * wv; a2 += sl[2048 + k] * wv; a3 += sl[3072 + k] * wv; a4 += sl[4096 + k] * wv; }
            red[(kq * 5 + 0) * 128 + cl] = a0; red[(kq * 5 + 1) * 128 + cl] = a1; red[(kq * 5 + 2) * 128 + cl] = a2; red[(kq * 5 + 3) * 128 + cl] = a3; red[(kq * 5 + 4) * 128 + cl] = a4;
            __syncthreads();
            for (int i = C.tid; i < 5 * 128; i += NTHR) { const int r = i >> 7, c2 = i & 127; const int cc = cb * 128 + c2;
                const float s = red[(0 * 5 + r) * 128 + c2] + red[(1 * 5 + r) * 128 + c2] + red[(2 * 5 + r) * 128 + c2] + red[(3 * 5 + r) * 128 + c2] + p->in[I_BMOD][l * 6144 + cc];
                ((float*)(ws + WS_MOD))[((size_t)l * 5 + r) * 6144 + cc] = s; }
            __syncthreads();
        }
    }
}
template <int MODE>
__device__ __forceinline__ void norm_phase(KArg p, const Ctx& C, int l, bool comb, int lprev, bool moe, int row_min, int nslab) {
    unsigned char* ws = p->ws;
    float* H = (float*)(ws + WS_H); bf16_t* U = (bf16_t*)(ws + WS_U); const float* MOD = (const float*)(ws + WS_MOD);
    int* RE = (int*)(ws + WS_ROUTE); float* RW = (float*)(ws + WS_ROUTE + (size_t)MT * 8); const int* RP = (const int*)(ws + WS_ROUTE + (size_t)MT * 16);
    const bf16_t* YD = (const bf16_t*)(ws + WS_YD);
    LAS unsigned* lcnt = (LAS unsigned*)C.lds;
    if (MODE == 1 && moe) { if (C.tid < 8) lcnt[C.tid] = 0u; __syncthreads(); }
    const int rbase = (MT / 256) * C.bid;
    for (int ri = C.wave; ri < MT / 256; ri += NWAVES) {
        const int row = rbase + ri; if (row < row_min) continue;
        const int mb = mod_row(row);
        f32x4 v[4];
#pragma unroll
        for (int j = 0; j < 4; ++j) v[j] = *(const f32x4*)(H + (size_t)row * D + 4 * C.lane + 256 * j);
        if (comb) {
            const int p0 = RP[row * 2], p1 = RP[row * 2 + 1]; const float w0 = RW[row * 2], w1 = RW[row * 2 + 1];
            const float* g2 = MOD + ((size_t)lprev * 5 + mb) * 6144 + 5 * 1024;
#pragma unroll
            for (int j = 0; j < 4; ++j) { const int e = 4 * C.lane + 256 * j;
                const u32x2 y0 = *(const u32x2*)(YD + (size_t)p0 * D + e), y1 = *(const u32x2*)(YD + (size_t)p1 * D + e); const f32x4 g = *(const f32x4*)(g2 + e);
                v[j].x += g.x * (w0 * bf_lo(y0.x) + w1 * bf_lo(y1.x)); v[j].y += g.y * (w0 * bf_hi(y0.x) + w1 * bf_hi(y1.x));
                v[j].z += g.z * (w0 * bf_lo(y0.y) + w1 * bf_lo(y1.y)); v[j].w += g.w * (w0 * bf_hi(y0.y) + w1 * bf_hi(y1.y));
                if (MODE != 2) *(f32x4*)(H + (size_t)row * D + e) = v[j]; }
        }
        if (nslab > 0 && row < MC) {
            const float* sl = (const float*)(ws + WS_SLAB) + (size_t)row * D;
            for (int s = 0; s < nslab; ++s)
#pragma unroll
                for (int j = 0; j < 4; ++j) v[j] += *(const f32x4*)(sl + (size_t)s * MC * D + 4 * C.lane + 256 * j);
#pragma unroll
            for (int j = 0; j < 4; ++j) *(f32x4*)(H + (size_t)row * D + 4 * C.lane + 256 * j) = v[j];
        }
        float ss = 0.f;
#pragma unroll
        for (int j = 0; j < 4; ++j) ss += (v[j].x * v[j].x + v[j].y * v[j].y) + (v[j].z * v[j].z + v[j].w * v[j].w);
        const float rstd = rsqrtf(wave_sum(ss) * (1.f / D) + EPS);
        if (MODE == 2) {
            const float* gam = p->in[I_FNORM];
#pragma unroll
            for (int j = 0; j < 4; ++j) { const int e = 4 * C.lane + 256 * j; const f32x4 g = *(const f32x4*)(gam + e); *(f32x4*)(p->out + (size_t)(row - MC) * D + e) = v[j] * rstd * g; }
        } else {
            const float* gam = p->in[MODE == 0 ? I_NORM1 : I_NORM2] + (size_t)l * D;
            const float* sh = MOD + ((size_t)l * 5 + mb) * 6144 + (MODE == 0 ? 0 : 3) * 1024; const float* sc = sh + 1024;
            f32x4 y[4];
#pragma unroll
            for (int j = 0; j < 4; ++j) { const int e = 4 * C.lane + 256 * j; const f32x4 g = *(const f32x4*)(gam + e), s1 = *(const f32x4*)(sc + e), s0 = *(const f32x4*)(sh + e);
                y[j] = v[j] * rstd * g * (1.f + s1) + s0;
                u32x2 o; o.x = cvtpk(y[j].x, y[j].y); o.y = cvtpk(y[j].z, y[j].w); *(u32x2*)(U + (size_t)row * D + e) = o; }
            if (MODE == 1 && moe) {
                const float* wr = p->in[I_ROUTER] + (size_t)(l >> 1) * D * NE;
                float lg[8];
#pragma unroll
                for (int e = 0; e < 8; ++e) lg[e] = 0.f;
#pragma unroll
                for (int j = 0; j < 4; ++j)
#pragma unroll
                    for (int q = 0; q < 4; ++q) { const int e = 4 * C.lane + 256 * j + q; const f32x4 wa = *(const f32x4*)(wr + (size_t)e * 8), wb = *(const f32x4*)(wr + (size_t)e * 8 + 4); const float yv = y[j][q];
                        lg[0] += yv * wa.x; lg[1] += yv * wa.y; lg[2] += yv * wa.z; lg[3] += yv * wa.w; lg[4] += yv * wb.x; lg[5] += yv * wb.y; lg[6] += yv * wb.z; lg[7] += yv * wb.w; }
#pragma unroll
                for (int e = 0; e < 8; ++e) lg[e] = wave_sum(lg[e]);
                int e0 = 0; float v0 = lg[0];
#pragma unroll
                for (int e = 1; e < 8; ++e) if (lg[e] > v0) { v0 = lg[e]; e0 = e; }
                int e1 = -1; float v1 = -3.0e38f;
#pragma unroll
                for (int e = 0; e < 8; ++e) if (e != e0 && lg[e] > v1) { v1 = lg[e]; e1 = e; }
                const float t = __expf(v1 - v0), w0 = 1.f / (1.f + t), w1 = t * w0;
                if (C.lane == 0) { RE[row * 2] = e0; RE[row * 2 + 1] = e1; RW[row * 2] = w0; RW[row * 2 + 1] = w1; atomicAdd((unsigned*)&lcnt[e0], 1u); atomicAdd((unsigned*)&lcnt[e1], 1u); }
            }
        }
    }
    if (MODE == 1 && moe) { __syncthreads(); if (C.tid < 8) __hip_atomic_store((unsigned*)(ws + WS_CTL) + CW_CNT + C.bid * 8 + C.tid, lcnt[C.tid], __ATOMIC_RELAXED, __HIP_MEMORY_SCOPE_AGENT); }
}

__device__ __forceinline__ void moe_gather_phase(KArg p, const Ctx& C, int row_min) {
    unsigned char* ws = p->ws;
    unsigned* ctl = (unsigned*)(ws + WS_CTL);
    const int* RE = (const int*)(ws + WS_ROUTE); int* RP = (int*)(ws + WS_ROUTE + (size_t)MT * 16);
    const bf16_t* U = (const bf16_t*)(ws + WS_U); bf16_t* AS = (bf16_t*)(ws + WS_ASORT);
    LAS unsigned* cn = (LAS unsigned*)C.lds;
    LAS int* myoff = (LAS int*)(C.lds + 8192);
    LAS int* base = (LAS int*)(C.lds + 8192 + 64);
    LAS int* pos = (LAS int*)(C.lds + 8192 + 128);
    for (int i = C.tid; i < 2048; i += NTHR) cn[i] = __hip_atomic_load(ctl + CW_CNT + i, __ATOMIC_RELAXED, __HIP_MEMORY_SCOPE_AGENT);
    __syncthreads();
    if (C.tid < 8) { int tot = 0, mine = 0; for (int b = 0; b < 256; ++b) { const int c = (int)cn[b * 8 + C.tid]; if (b < C.bid) mine += c; tot += c; } myoff[C.tid] = mine; base[C.tid] = (tot + 255) & ~255; }
    __syncthreads();
    if (C.tid == 0) {
        int b0 = 0; for (int e = 0; e < 8; ++e) { const int t = base[e]; base[e] = b0; myoff[e] += b0; b0 += t; } base[8] = b0;
        const int rbase = (MT / 256) * C.bid;
        for (int ri = 0; ri < MT / 256; ++ri) { const int row = rbase + ri; if (row < row_min) { pos[ri * 2] = -1; pos[ri * 2 + 1] = -1; continue; }
            for (int k = 0; k < 2; ++k) { const int e = RE[row * 2 + k]; const int ps = myoff[e]++; pos[ri * 2 + k] = ps; RP[row * 2 + k] = ps; } }
    }
    __syncthreads();
    if (C.bid == 0) {
        const int ntiles = base[8] >> 8;
        if (C.tid < MOE_TILES) { int e = 0; for (int q = 1; q < 8; ++q) if (C.tid * 256 >= base[q]) e = q; __hip_atomic_store(ctl + CW_TILEE + C.tid, (unsigned)e, __ATOMIC_RELAXED, __HIP_MEMORY_SCOPE_AGENT); }
        if (C.tid == 0) __hip_atomic_store(ctl + CW_TILEE + 160, (unsigned)ntiles, __ATOMIC_RELAXED, __HIP_MEMORY_SCOPE_AGENT);
    }
    const int rbase = (MT / 256) * C.bid;
    for (int it = C.tid; it < (MT / 256) * 2 * 128; it += NTHR) { const int slot = it >> 7, ch = it & 127; const int ps = pos[slot]; if (ps < 0) continue;
        *(u32x4*)(AS + (size_t)ps * D + 8 * ch) = *(const u32x4*)(U + (size_t)(rbase + (slot >> 1)) * D + 8 * ch); }
}

__device__ __forceinline__ void prep_phase(KArg p, const Ctx& C, int l) {
    unsigned char* ws = p->ws;
    const bf16_t* P = (const bf16_t*)(ws + WS_P); bf16_t* QS = (bf16_t*)(ws + WS_QS); bf16_t* KS = (bf16_t*)(ws + WS_KS); bf16_t* AUP = (bf16_t*)(ws + WS_AUP); bf16_t* KF = (bf16_t*)(ws + WS_KFULL);
    const float* tab = (const float*)(ws + WS_TAB);
    const float* qg = p->in[I_QNORM] + (size_t)l * 256; const float* kvg = p->in[I_KVNORM] + (size_t)l * 128;
    const int gw = C.bid * NWAVES + C.wave, NGW = C.G * NWAVES, lane = C.lane;
    for (int row = gw; row < MT; row += NGW) {
        const bf16_t* pr = P + (size_t)row * DINP;
        const bool lat = row >= MC; const int t = (row - MC) & 4095, prow = t >> 6, pcol = t & 63;
        {
            const int hd = lane >> 4, j = lane & 15;
            float c_r = 1.f, s_r = 0.f, c_c = 1.f, s_c = 0.f;
            if (lat) { c_r = tab[prow * 16 + j]; s_r = tab[1024 + prow * 16 + j]; c_c = tab[pcol * 16 + j]; s_c = tab[1024 + pcol * 16 + j]; }
            { const bf16_t* q = pr + PC_AQ + hd * 64; const float x1 = bf2f(q[j]), x2 = bf2f(q[16 + j]), x3 = bf2f(q[32 + j]), x4 = bf2f(q[48 + j]); const float qs = 0.125f * LOG2E;
              bf16_t* o = QS + (size_t)row * 256 + hd * 64;
              o[j] = f2bf((x1 * c_r - x2 * s_r) * qs); o[16 + j] = f2bf((x2 * c_r + x1 * s_r) * qs); o[32 + j] = f2bf((x3 * c_c - x4 * s_c) * qs); o[48 + j] = f2bf((x4 * c_c + x3 * s_c) * qs); }
            if (lane < 32) { const bf16_t* k = pr + PC_AK + hd * 64; const float x1 = bf2f(k[j]), x2 = bf2f(k[16 + j]), x3 = bf2f(k[32 + j]), x4 = bf2f(k[48 + j]);
              bf16_t* o = KS + (size_t)row * 128 + hd * 64;
              o[j] = f2bf(x1 * c_r - x2 * s_r); o[16 + j] = f2bf(x2 * c_r + x1 * s_r); o[32 + j] = f2bf(x3 * c_c - x4 * s_c); o[48 + j] = f2bf(x4 * c_c + x3 * s_c); }
        }
        {
            const u32x2 a = *(const u32x2*)(pr + PC_CQ + 4 * lane); const float q0 = bf_lo(a.x), q1 = bf_hi(a.x), q2 = bf_lo(a.y), q3 = bf_hi(a.y);
            const float rq = rsqrtf(wave_sum(q0 * q0 + q1 * q1 + q2 * q2 + q3 * q3) * (1.f / 256.f) + EPS);
            const f32x4 g = *(const f32x4*)(qg + 4 * lane);
            u32x2 o; o.x = cvtpk(q0 * rq * g.x, q1 * rq * g.y); o.y = cvtpk(q2 * rq * g.z, q3 * rq * g.w); *(u32x2*)(AUP + (size_t)row * 512 + 4 * lane) = o;
            const unsigned b = *(const unsigned*)(pr + PC_CKV + 2 * lane); const float k0 = bf_lo(b), k1 = bf_hi(b);
            const float rk = rsqrtf(wave_sum(k0 * k0 + k1 * k1) * (1.f / 128.f) + EPS);
            const f32x2 g2 = *(const f32x2*)(kvg + 2 * lane);
            *(unsigned*)(AUP + (size_t)row * 512 + 256 + 2 * lane) = cvtpk(k0 * rk * g2.x, k1 * rk * g2.y);
            *(unsigned*)(AUP + (size_t)row * 512 + 384 + 2 * lane) = 0u;
        }
        if (lane < 16) {
            const int part = lane >> 3, j = lane & 7; const float xa = bf2f(pr[PC_CKR + 16 * part + j]), xb = bf2f(pr[PC_CKR + 16 * part + 8 + j]);
            float cs = 1.f, sn = 0.f; if (lat) { const int ps = part ? pcol : prow; cs = tab[2048 + ps * 8 + j]; sn = tab[2560 + ps * 8 + j]; }
            const bf16_t oa = f2bf(xa * cs - xb * sn), ob = f2bf(xb * cs + xa * sn);
#pragma unroll
            for (int h = 0; h < 4; ++h) { bf16_t* o = KF + (size_t)row * 384 + h * 96 + 64 + 16 * part; o[j] = oa; o[8 + j] = ob; }
        }
    }
}

struct AttnArgs {
    const bf16_t* Q; int q_pitch, q_col0, q_row0;
    const bf16_t* K; int k_pitch, k_col0;
    const bf16_t* Vt; int vt_row0;
    int seg_tok0, seg_nt0, seg_tok1, seg_nt1;
    int qpos0, kpos0;
    float m_init, l_init, qscale;
    bf16_t* O; int o_col0;
    const float* tab32; int qt0;
};
template <int DQK, bool MASK, bool ROPEQ>
__device__ __forceinline__ void attn_unit(const Ctx& C, const AttnArgs& a) {
    constexpr int KP = DQK + 8, NCH = DQK / 8, KT_BYTES = 64 * KP * 2, VP = 68, VT_BYTES = 64 * VP * 2, BUF = KT_BYTES + VT_BYTES, NKS = DQK / 16;
    LAS unsigned char* lds = C.lds;
    const int lane = C.lane, c = lane & 31, hi = lane >> 5, w = C.wave, tid = C.tid;
    const int qi = 32 * w + c;
    bf16x8 qf[NKS];
    {
        const bf16_t* qp = a.Q + (size_t)(a.q_row0 + qi) * a.q_pitch + a.q_col0;
#pragma unroll
        for (int ks = 0; ks < NKS; ++ks) {
            const u32x4 raw = *(const u32x4*)(qp + 16 * ks + 8 * hi);
            float f[8] = {bf_lo(raw.x), bf_hi(raw.x), bf_lo(raw.y), bf_hi(raw.y), bf_lo(raw.z), bf_hi(raw.z), bf_lo(raw.w), bf_hi(raw.w)};
            if (ROPEQ && ks >= 4) {
                const u32x4 ro = *(const u32x4*)(qp + 16 * ks + 8 * (1 - hi));
                const float g[8] = {bf_lo(ro.x), bf_hi(ro.x), bf_lo(ro.y), bf_hi(ro.y), bf_lo(ro.z), bf_hi(ro.z), bf_lo(ro.w), bf_hi(ro.w)};
                const int t = a.qt0 + qi, ps = (ks == 4) ? (t >> 6) : (t & 63);
#pragma unroll
                for (int j = 0; j < 8; ++j) { const float cs = a.tab32[ps * 8 + j], sn = a.tab32[512 + ps * 8 + j]; f[j] = hi ? (f[j] * cs + g[j] * sn) : (f[j] * cs - g[j] * sn); }
            }
            qf[ks] = mk_frag4(cvtpk(f[0] * a.qscale, f[1] * a.qscale), cvtpk(f[2] * a.qscale, f[3] * a.qscale), cvtpk(f[4] * a.qscale, f[5] * a.qscale), cvtpk(f[6] * a.qscale, f[7] * a.qscale));
        }
    }
    f32x16 o0, o1;
#pragma unroll
    for (int r = 0; r < 16; ++r) { o0[r] = 0.f; o1[r] = 0.f; }
    float m = a.m_init, l = a.l_init;
    const int NT = a.seg_nt0 + a.seg_nt1;
    u32x4 kst[2]; u32x4 vst;
    auto tile_tok = [&](int t) { return t < a.seg_nt0 ? a.seg_tok0 + 64 * t : a.seg_tok1 + 64 * (t - a.seg_nt0); };
    auto g_load = [&](int t) {
        const int tk = tile_tok(t);
#pragma unroll
        for (int i = 0; i < 2; ++i) { const int ch = tid + 512 * i; if (ch < 64 * NCH) { const int r = ch / NCH, c8 = ch % NCH; kst[i] = *(const u32x4*)(a.K + (size_t)(tk + r) * a.k_pitch + a.k_col0 + 8 * c8); } }
        { const int r = tid >> 3, c8 = tid & 7; vst = *(const u32x4*)(a.Vt + (size_t)(a.vt_row0 + r) * MT + tk + 8 * c8); }
    };
    auto l_store = [&](int b) {
        LAS unsigned char* kb = lds + b * BUF; LAS unsigned char* vb = kb + KT_BYTES;
#pragma unroll
        for (int i = 0; i < 2; ++i) { const int ch = tid + 512 * i; if (ch < 64 * NCH) { const int r = ch / NCH, c8 = ch % NCH; *(LAS u32x4*)(kb + r * (KP * 2) + 16 * c8) = kst[i]; } }
        { const int r = tid >> 3, c8 = tid & 7; LAS u32x2* d = (LAS u32x2*)(vb + r * (VP * 2) + 16 * c8); u32x2 lo, hi2; lo.x = vst.x; lo.y = vst.y; hi2.x = vst.z; hi2.y = vst.w; d[0] = lo; d[1] = hi2; }
    };
    __syncthreads();
    g_load(0); l_store(0);
    __syncthreads();
    for (int t = 0; t < NT; ++t) {
        const int b = t & 1;
        if (t + 1 < NT) g_load(t + 1);
        LAS unsigned char* kb = lds + b * BUF; LAS unsigned char* vb = kb + KT_BYTES;
        f32x16 s0, s1;
#pragma unroll
        for (int r = 0; r < 16; ++r) { s0[r] = 0.f; s1[r] = 0.f; }
#pragma unroll
        for (int ks = 0; ks < NKS; ++ks) {
            const bf16x8 k0 = *(const LAS bf16x8*)(kb + c * (KP * 2) + 32 * ks + 16 * hi);
            const bf16x8 k1 = *(const LAS bf16x8*)(kb + (32 + c) * (KP * 2) + 32 * ks + 16 * hi);
            s0 = mfma32(k0, qf[ks], s0); s1 = mfma32(k1, qf[ks], s1);
        }
        if (MASK && t >= a.seg_nt0) {
            const int qpos = a.qpos0 + qi, kbase = a.kpos0 + 64 * (t - a.seg_nt0);
#pragma unroll
            for (int r = 0; r < 16; ++r) { const int k0p = kbase + crow(r, hi), d0 = qpos - k0p, d1 = d0 - 32;
                if (d0 > 128 || d0 < -128) s0[r] = -1e30f; if (d1 > 128 || d1 < -128) s1[r] = -1e30f; }
        }
        float mx = s0[0];
#pragma unroll
        for (int r = 1; r < 16; ++r) mx = fmaxf(mx, s0[r]);
#pragma unroll
        for (int r = 0; r < 16; ++r) mx = fmaxf(mx, s1[r]);
        mx = fmaxf(mx, __shfl_xor(mx, 32));
        const float mn = fmaxf(m, mx), alpha = __builtin_amdgcn_exp2f(m - mn); m = mn;
        float ls = 0.f;
#pragma unroll
        for (int r = 0; r < 16; ++r) { s0[r] = __builtin_amdgcn_exp2f(s0[r] - mn); s1[r] = __builtin_amdgcn_exp2f(s1[r] - mn); ls += s0[r] + s1[r]; }
        ls += __shfl_xor(ls, 32);
        l = l * alpha + ls;
#pragma unroll
        for (int r = 0; r < 16; ++r) { o0[r] *= alpha; o1[r] *= alpha; }
        bf16x8 pf[2][2];
#pragma unroll
        for (int s2 = 0; s2 < 2; ++s2) {
            pf[0][s2] = mk_frag4(cvtpk(s0[8 * s2 + 0], s0[8 * s2 + 1]), cvtpk(s0[8 * s2 + 2], s0[8 * s2 + 3]), cvtpk(s0[8 * s2 + 4], s0[8 * s2 + 5]), cvtpk(s0[8 * s2 + 6], s0[8 * s2 + 7]));
            pf[1][s2] = mk_frag4(cvtpk(s1[8 * s2 + 0], s1[8 * s2 + 1]), cvtpk(s1[8 * s2 + 2], s1[8 * s2 + 3]), cvtpk(s1[8 * s2 + 4], s1[8 * s2 + 5]), cvtpk(s1[8 * s2 + 6], s1[8 * s2 + 7]));
        }
#pragma unroll
        for (int kt = 0; kt < 2; ++kt)
#pragma unroll
            for (int s2 = 0; s2 < 2; ++s2) {
                const int ko = (32 * kt + 16 * s2 + 4 * hi) * 2;
                const LAS unsigned char* v0p = vb + c * (VP * 2) + ko; const LAS unsigned char* v1p = vb + (32 + c) * (VP * 2) + ko;
                const bf16x8 v0 = mk_frag(*(const LAS u32x2*)v0p, *(const LAS u32x2*)(v0p + 16));
                const bf16x8 v1 = mk_frag(*(const LAS u32x2*)v1p, *(const LAS u32x2*)(v1p + 16));
                o0 = mfma32(v0, pf[kt][s2], o0); o1 = mfma32(v1, pf[kt][s2], o1);
            }
        if (t + 1 < NT) l_store(b ^ 1);
        __syncthreads();
    }
    const float inv = 1.f / l;
    bf16_t* op = a.O + (size_t)(a.q_row0 + qi) * D + a.o_col0;
#pragma unroll
    for (int g = 0; g < 4; ++g) {
        u32x2 w0, w1;
        w0.x = cvtpk(o0[4 * g] * inv, o0[4 * g + 1] * inv); w0.y = cvtpk(o0[4 * g + 2] * inv, o0[4 * g + 3] * inv);
        w1.x = cvtpk(o1[4 * g] * inv, o1[4 * g + 1] * inv); w1.y = cvtpk(o1[4 * g + 2] * inv, o1[4 * g + 3] * inv);
        *(u32x2*)(op + 8 * g + 4 * hi) = w0; *(u32x2*)(op + 32 + 8 * g + 4 * hi) = w1;
    }
}

__device__ __forceinline__ void attn_dispatch(KArg p, const Ctx& C, int l, int u) {
    unsigned char* ws = p->ws;
    AttnArgs a;
    a.tab32 = (const float*)(ws + WS_TAB) + 2048; a.O = (bf16_t*)(ws + WS_MIX);
    if (u < 256 || (u >= 512 && u < 528)) {
        const bool ctxq = u >= 512; const int v = ctxq ? u - 512 : u;
        const int b = ctxq ? (v >> 2) : (v >> 6), h = ctxq ? (v & 3) : ((v >> 4) & 3), qb = ctxq ? 0 : (v & 15);
        a.Q = (const bf16_t*)(ws + WS_QRAW); a.q_pitch = 384; a.q_col0 = 96 * h; a.q_row0 = ctxq ? 256 * b : MC + 4096 * b + 256 * qb;
        a.K = (const bf16_t*)(ws + WS_KFULL); a.k_pitch = 384; a.k_col0 = 96 * h; a.Vt = (const bf16_t*)(ws + WS_VTM); a.vt_row0 = 64 * h;
        a.seg_tok0 = 256 * b; a.seg_nt0 = 4; a.seg_tok1 = MC + 4096 * b; a.seg_nt1 = ctxq ? 0 : 64; a.qpos0 = 0; a.kpos0 = 0;
        a.m_init = -1e30f; a.l_init = 0.f; a.qscale = 0.10206207261596575f * LOG2E; a.o_col0 = 512 + 64 * h; a.qt0 = 256 * qb;
        if (ctxq) attn_unit<96, false, false>(C, a); else attn_unit<96, false, true>(C, a);
    } else {
        const bool ctxq = u >= 528; const int v = ctxq ? u - 528 : u - 256;
        const int b = ctxq ? (v >> 2) : (v >> 6), hq = ctxq ? (v & 3) : ((v >> 4) & 3), qb = ctxq ? 0 : (v & 15), g = hq >> 1;
        a.Q = (const bf16_t*)(ws + WS_QS); a.q_pitch = 256; a.q_col0 = 64 * hq; a.q_row0 = ctxq ? 256 * b : MC + 4096 * b + 256 * qb;
        a.K = (const bf16_t*)(ws + WS_KS); a.k_pitch = 128; a.k_col0 = 64 * g; a.Vt = (const bf16_t*)(ws + WS_VTS); a.vt_row0 = 64 * g;
        const int q0 = 256 * qb, ks = q0 - 128 < 0 ? 0 : q0 - 128, ke = q0 + 384 > SEQ ? SEQ : q0 + 384;
        a.seg_tok0 = 256 * b; a.seg_nt0 = 4; a.seg_tok1 = MC + 4096 * b + ks; a.seg_nt1 = ctxq ? 0 : (ke - ks) >> 6; a.qpos0 = q0; a.kpos0 = ks;
        a.m_init = p->in[I_SINK][l * 4 + hq] * LOG2E; a.l_init = 1.f; a.qscale = 1.f; a.o_col0 = 64 * hq; a.qt0 = 0;
        if (ctxq) attn_unit<64, false, false>(C, a); else attn_unit<64, true, false>(C, a);
    }
}

template <class FA, class FB>
__device__ __forceinline__ f32x16 lds_mma64(int lane, FA fa, FB fb) {
    const int c = lane & 31, hi = lane >> 5;
    f32x16 acc;
#pragma unroll
    for (int r = 0; r < 16; ++r) acc[r] = 0.f;
#pragma unroll
    for (int s = 0; s < 4; ++s) {
        float av[8], bv[8];
#pragma unroll
        for (int j = 0; j < 8; ++j) { const int k = 16 * s + 8 * hi + j; av[j] = fa(c, k); bv[j] = fb(k, c); }
        acc = mfma32(mk_frag4(cvtpk(av[0], av[1]), cvtpk(av[2], av[3]), cvtpk(av[4], av[5]), cvtpk(av[6], av[7])),
                     mk_frag4(cvtpk(bv[0], bv[1]), cvtpk(bv[2], bv[3]), cvtpk(bv[4], bv[5]), cvtpk(bv[6], bv[7])), acc);
    }
    return acc;
}
__device__ __forceinline__ void lds_barrier() { asm volatile("s_waitcnt lgkmcnt(0)" ::: "memory"); __builtin_amdgcn_s_barrier(); asm volatile("" ::: "memory"); }
__device__ __forceinline__ int su_index(int d, int b, int h, int cg) {
    const int s = cg < 4 ? (d ? 3 - cg : cg) : 4 + (d ? 63 - (cg - 4) : (cg - 4));
    return ((d * 4 + b) * 4 + h) * 68 + s;
}
#ifndef GSECT
#define GSECT 0
#endif
constexpr int XP = 65;

template <int I>
__device__ __forceinline__ void solve_rows(float (&x)[64], f32x4 (&Lc)[16], f32x4 (&Ln)[16], const LAS float* Ld) {
    if constexpr (I < 64) {
        if constexpr (I + 1 < 64) {
#pragma unroll
            for (int q = 0; q < 16; ++q) if (4 * q < I + 1) Ln[q] = *(const LAS f32x4*)(Ld + (I + 1) * 68 + 4 * q);
        }
        float s0 = 0.f, s1 = 0.f, s2 = 0.f, s3 = 0.f;
#pragma unroll
        for (int q = 0; q < 16; ++q) if (4 * q < I) { const f32x4 lv = Lc[q];
            s0 += lv.x * x[4 * q]; if (4 * q + 1 < I) s1 += lv.y * x[4 * q + 1]; if (4 * q + 2 < I) s2 += lv.z * x[4 * q + 2]; if (4 * q + 3 < I) s3 += lv.w * x[4 * q + 3]; }
        x[I] -= (s0 + s1) + (s2 + s3);
        solve_rows<I + 1>(x, Ln, Lc, Ld);
    }
}
__device__ __forceinline__ void gdn_chunk_unit(KArg p, const Ctx& C, int l, int b, int h, int cg) {
    unsigned char* ws = p->ws; const bf16_t* P = (const bf16_t*)(ws + WS_P);
    int tid_l = C.tid; asm volatile("" : "+v"(tid_l));
    const int tid = tid_l, lane = tid & 63, w = __builtin_amdgcn_readfirstlane(tid >> 6);
    LAS float* xq = (LAS float*)C.lds; LAS float* xk = xq + 64 * XP; LAS float* xv = xk + 64 * XP;
    LAS float* KK = xv + 64 * XP; LAS float* QK = KK + 64 * XP;
    LAS float* Lm = QK + 64 * XP;
    LAS float* gcs = Lm + 2 * 64 * 68; LAS float* bts = gcs + 128; LAS float* egs = bts + 128; LAS float* cw = egs + 128;
    LAS float* raw = KK;
    LAS float* Wst = KK;
    const int seq0 = cg < 4 ? 256 * b : MC + 4096 * b, seqlen = cg < 4 ? 256 : 4096, t0 = cg < 4 ? 64 * cg : 64 * (cg - 4);
    bf16_t ab_a = 0, ab_b = 0;
    if (w < 2) { const int tau = w ? 63 - lane : lane; const bf16_t* pr = P + (size_t)(seq0 + t0 + tau) * DINP + PC_BAB + w * 8 + h; ab_a = pr[0]; ab_b = pr[4]; }
    lds_barrier();
    for (int rr1 = 0; rr1 < ((GSECT == 1) ? 2 : 1); ++rr1) {
    if (rr1) lds_barrier();
    for (int it = tid; it < 68 * 24; it += NTHR) { const int r = it / 24, ch = it % 24, t = t0 - 2 + r; const int part = ch >> 3, c8 = ch & 7;
        u32x4 v; v.x = v.y = v.z = v.w = 0u;
        if (t >= 0 && t < seqlen) v = *(const u32x4*)(P + (size_t)(seq0 + t) * DINP + PC_BQKV + 256 * part + 64 * h + 8 * c8);
        LAS float* d = raw + r * 192 + 64 * part + 8 * c8;
        d[0] = bf_lo(v.x); d[1] = bf_hi(v.x); d[2] = bf_lo(v.y); d[3] = bf_hi(v.y); d[4] = bf_lo(v.z); d[5] = bf_hi(v.z); d[6] = bf_lo(v.w); d[7] = bf_hi(v.w); }
    for (int it = tid; it < 5 * 192; it += NTHR) { const int j = it / 192, cc = it % 192; cw[it] = p->in[I_GCONV][((size_t)l * 5 + j) * 768 + 256 * (cc >> 6) + 64 * h + (cc & 63)]; }
    lds_barrier();
    for (int it = tid; it < 64 * 192; it += NTHR) { const int t = it / 192, cc = it % 192; float y = 0.f;
#pragma unroll
        for (int j = 0; j < 5; ++j) y += raw[(t + j) * 192 + cc] * cw[j * 192 + cc];
        y = silu_f(y); LAS float* dst = (cc < 64) ? xq : (cc < 128 ? xk : xv); dst[t * XP + (cc & 63)] = y; }
    lds_barrier();
    {
        const int mat = tid >> 8, r = (tid >> 2) & 63, q4 = tid & 3; LAS float* m = (mat ? xk : xq) + r * XP + 16 * q4; float v[16]; float ss = 0.f;
#pragma unroll
        for (int k = 0; k < 16; ++k) { v[k] = m[k]; ss += v[k] * v[k]; }
        ss += __shfl_xor(ss, 1); ss += __shfl_xor(ss, 2);
        const float sc = rsqrtf(ss + EPS) * (mat ? 1.f : 0.125f);
#pragma unroll
        for (int k = 0; k < 16; ++k) m[k] = v[k] * sc;
    }
    lds_barrier();
    {
        const int mat = w >> 2, rt = (w >> 1) & 1, ct = w & 1; LAS float* Am = mat ? xq : xk;
        const f32x16 acc = lds_mma64(lane, [&](int r, int k) { return Am[(32 * rt + r) * XP + k]; }, [&](int k, int c2) { return xk[(32 * ct + c2) * XP + k]; });
        LAS float* Om = mat ? QK : KK;
#pragma unroll
        for (int r = 0; r < 16; ++r) Om[(32 * rt + crow(r, lane >> 5)) * XP + 32 * ct + (lane & 31)] = acc[r];
    }
    }
    for (int rr2 = 0; rr2 < ((GSECT == 2) ? 2 : 1); ++rr2) {
    if (rr2) lds_barrier();
    if (w < 2) {
        const int d = w;
        const float a = bf2f(ab_a), bt = bf2f(ab_b);
        float g = -__expf(p->in[I_GALOG][(l * 2 + d) * 4 + h]) * softplus_f(a + p->in[I_GDTB][(l * 2 + d) * 4 + h]);
#pragma unroll
        for (int o = 1; o < 64; o <<= 1) { const float n = __shfl_up(g, o); if (lane >= o) g += n; }
        gcs[d * 64 + lane] = g; bts[d * 64 + lane] = sigmoid_f(bt); egs[d * 64 + lane] = __expf(g);
        if (lane == 63) ((float*)(ws + WS_DEC))[su_index(d, b, h, cg)] = __expf(g);
    }
    lds_barrier();
    for (int it = tid; it < 2 * 64 * 64; it += NTHR) { const int d = it >> 12, i = (it >> 6) & 63, j = it & 63; const int ti = d ? 63 - i : i, tj = d ? 63 - j : j;
        Lm[(d * 64 + i) * 68 + j] = (j < i) ? bts[d * 64 + i] * KK[ti * XP + tj] * __expf(gcs[d * 64 + i] - gcs[d * 64 + j]) : 0.f; }
#pragma unroll
    for (int d = 0; d < 2; ++d) {
        unsigned char* rec = ws + WS_RECG + (size_t)su_index(d, b, h, cg) * REC_G_BYTES; const LAS float* gc = gcs + d * 64;
        const int r = tid >> 3, c8 = tid & 7, it_ = d ? 63 - r : r;
        { float v[8];
#pragma unroll
          for (int j = 0; j < 8; ++j) { const int i = 8 * c8 + j, ti = d ? 63 - i : i; v[j] = xk[ti * XP + r] * __expf(gc[63] - gc[i]); }
          u32x4 o; o.x = cvtpk(v[0], v[1]); o.y = cvtpk(v[2], v[3]); o.z = cvtpk(v[4], v[5]); o.w = cvtpk(v[6], v[7]); *(u32x4*)(rec + REC_G_KDT + (r * 64 + 8 * c8) * 2) = o; }
        { const float e = egs[d * 64 + it_]; float v[8];
#pragma unroll
          for (int j = 0; j < 8; ++j) v[j] = xq[r * XP + 8 * c8 + j] * e;
          u32x4 o; o.x = cvtpk(v[0], v[1]); o.y = cvtpk(v[2], v[3]); o.z = cvtpk(v[4], v[5]); o.w = cvtpk(v[6], v[7]); *(u32x4*)(rec + REC_G_QG + (r * 64 + 8 * c8) * 2) = o; }
        { float v[8];
#pragma unroll
          for (int j = 0; j < 8; ++j) { const int i = 8 * c8 + j, ti = d ? 63 - i : i; v[j] = (it_ >= i) ? QK[r * XP + ti] * __expf(gc[it_] - gc[i]) : 0.f; }
          u32x4 o; o.x = cvtpk(v[0], v[1]); o.y = cvtpk(v[2], v[3]); o.z = cvtpk(v[4], v[5]); o.w = cvtpk(v[6], v[7]); *(u32x4*)(rec + REC_G_ATT + (r * 64 + 8 * c8) * 2) = o; }
    }
    }
    lds_barrier();
    for (int rr3 = 0; rr3 < ((GSECT == 3) ? 2 : 1); ++rr3) {
    if (tid < 256) {
        const int d = tid >> 7, col = tid & 127; const LAS float* Ld = Lm + d * 64 * 68; const LAS float* bt = bts + d * 64; const LAS float* eg = egs + d * 64;
        float x[64];
        if (col < 64) {
#pragma unroll
            for (int i = 0; i < 64; ++i) { const int ti = d ? 63 - i : i; x[i] = bt[i] * xv[ti * XP + col]; }
        } else {
#pragma unroll
            for (int i = 0; i < 64; ++i) { const int ti = d ? 63 - i : i; x[i] = bt[i] * eg[i] * xk[ti * XP + col - 64]; }
        }
        f32x4 La[16], Lb[16];
        La[0] = *(const LAS f32x4*)(Ld + 1 * 68);
        solve_rows<1>(x, La, Lb, Ld);
        unsigned char* rec = ws + WS_RECG + (size_t)su_index(d, b, h, cg) * REC_G_BYTES;
        if (col < 64) {
#pragma unroll
            for (int i4 = 0; i4 < 16; ++i4) { f32x4 o; o.x = x[4 * i4]; o.y = x[4 * i4 + 1]; o.z = x[4 * i4 + 2]; o.w = x[4 * i4 + 3]; *(f32x4*)(rec + REC_G_UT + (col * 64 + 4 * i4) * 4) = o; }
        } else {
#pragma unroll
            for (int i = 0; i < 64; ++i) Wst[(d * 64 + i) * XP + col - 64] = x[i];
        }
    }
    }
    lds_barrier();
#pragma unroll
    for (int d = 0; d < 2; ++d) { const int r = tid >> 3, c8 = tid & 7;
        unsigned char* rec = ws + WS_RECG + (size_t)su_index(d, b, h, cg) * REC_G_BYTES;
        u32x4 o; const LAS float* s = Wst + (d * 64 + r) * XP + 8 * c8; o.x = cvtpk(s[0], s[1]); o.y = cvtpk(s[2], s[3]); o.z = cvtpk(s[4], s[5]); o.w = cvtpk(s[6], s[7]);
        *(u32x4*)(rec + REC_G_W + (r * 64 + 8 * c8) * 2) = o; }
}

__device__ __forceinline__ void ret_chunk_unit(KArg p, const Ctx& C, int l, int b, int h, int cg) {
    unsigned char* ws = p->ws; const bf16_t* P = (const bf16_t*)(ws + WS_P); const float* tab = (const float*)(ws + WS_TAB);
    int tid_l = C.tid; asm volatile("" : "+v"(tid_l));
    const int tid = tid_l, lane = tid & 63, w = __builtin_amdgcn_readfirstlane(tid >> 6);
    LAS float* xq = (LAS float*)C.lds; LAS float* xk = xq + 64 * XP; LAS float* xv = xk + 64 * XP; LAS float* QK = xv + 64 * XP;
    const bool lat = cg >= 4;
    const int seq0 = lat ? MC + 4096 * b : 256 * b, t0 = lat ? 64 * (cg - 4) : 64 * cg;
    lds_barrier();
    for (int it = tid; it < 2 * 64 * 32; it += NTHR) { const int mat = it >> 11, r = (it >> 5) & 63, part = (it >> 4) & 1, j = it & 15; const int t = t0 + r;
        const bf16_t* pr = P + (size_t)(seq0 + t) * DINP + (mat ? PC_DK : PC_DQ) + 64 * h + 32 * part;
        const float xa = bf2f(pr[j]), xb = bf2f(pr[16 + j]); float cs = 1.f, sn = 0.f;
        if (lat) { const int ps = part ? (t & 63) : (t >> 6); cs = tab[ps * 16 + j]; sn = tab[1024 + ps * 16 + j]; }
        const float sc = mat ? 0.125f : 1.f; LAS float* m = mat ? xk : xq;
        m[r * XP + 32 * part + j] = (xa * cs - xb * sn) * sc; m[r * XP + 32 * part + 16 + j] = (xb * cs + xa * sn) * sc; }
    { const int r = tid >> 3, c8 = tid & 7; const u32x4 v = *(const u32x4*)(P + (size_t)(seq0 + t0 + r) * DINP + PC_DV + 64 * h + 8 * c8); LAS float* d = xv + r * XP + 8 * c8;
      d[0] = bf_lo(v.x); d[1] = bf_hi(v.x); d[2] = bf_lo(v.y); d[3] = bf_hi(v.y); d[4] = bf_lo(v.z); d[5] = bf_hi(v.z); d[6] = bf_lo(v.w); d[7] = bf_hi(v.w); }
    lds_barrier();
    if (w < 4) { const int rt = w >> 1, ct = w & 1;
        const f32x16 acc = lds_mma64(lane, [&](int r, int k) { return xq[(32 * rt + r) * XP + k]; }, [&](int k, int c2) { return xk[(32 * ct + c2) * XP + k]; });
#pragma unroll
        for (int r = 0; r < 16; ++r) QK[(32 * rt + crow(r, lane >> 5)) * XP + 32 * ct + (lane & 31)] = acc[r]; }
    lds_barrier();
    {
        const int d = w >> 2, T = (w >> 1) & 1, ct = w & 1; const float lg = -__expf(p->in[I_RLOGD][(l * 2 + d) * 4 + h]);
        const f32x16 acc = lds_mma64(lane, [&](int r, int k) { const int ti = d ? 63 - k : k; return xk[ti * XP + 32 * T + r] * __expf(lg * (float)(63 - k)); },
                                           [&](int k, int c2) { const int ti = d ? 63 - k : k; return xv[ti * XP + 32 * ct + c2]; });
        float* kv = (float*)(ws + WS_RECR + (size_t)su_index(d, b, h, cg) * REC_R_BYTES + REC_R_KV);
#pragma unroll
        for (int r = 0; r < 16; ++r) kv[(32 * T + crow(r, lane >> 5)) * 64 + 32 * ct + (lane & 31)] = acc[r];
    }
    for (int d = 0; d < 2; ++d) {
        unsigned char* rec = ws + WS_RECR + (size_t)su_index(d, b, h, cg) * REC_R_BYTES; const float lg = -__expf(p->in[I_RLOGD][(l * 2 + d) * 4 + h]);
        const int r = tid >> 3, c8 = tid & 7, it_ = d ? 63 - r : r;
        { const float e = __expf(lg * (float)(it_ + 1)); float v[8];
#pragma unroll
          for (int j = 0; j < 8; ++j) v[j] = xq[r * XP + 8 * c8 + j] * e;
          u32x4 o; o.x = cvtpk(v[0], v[1]); o.y = cvtpk(v[2], v[3]); o.z = cvtpk(v[4], v[5]); o.w = cvtpk(v[6], v[7]); *(u32x4*)(rec + REC_R_QG + (r * 64 + 8 * c8) * 2) = o; }
        { float v[8];
#pragma unroll
          for (int j = 0; j < 8; ++j) { const int i = 8 * c8 + j, ti = d ? 63 - i : i; v[j] = (it_ >= i) ? QK[r * XP + ti] * __expf(lg * (float)(it_ - i)) : 0.f; }
          u32x4 o; o.x = cvtpk(v[0], v[1]); o.y = cvtpk(v[2], v[3]); o.z = cvtpk(v[4], v[5]); o.w = cvtpk(v[6], v[7]); *(u32x4*)(rec + REC_R_ATT + (r * 64 + 8 * c8) * 2) = o; }
        { const int ln = tid & 63, s = (tid >> 6) & 1, T = (tid >> 7) & 1, ct = tid >> 8; float v[8];
#pragma unroll
          for (int j = 0; j < 8; ++j) { const int i = 32 * T + 16 * s + 8 * (j >> 2) + 4 * (ln >> 5) + (j & 3), ti = d ? 63 - i : i; v[j] = xv[ti * XP + 32 * ct + (ln & 31)]; }
          u32x4 o; o.x = cvtpk(v[0], v[1]); o.y = cvtpk(v[2], v[3]); o.z = cvtpk(v[4], v[5]); o.w = cvtpk(v[6], v[7]); *(u32x4*)(rec + REC_R_VF + (size_t)tid * 16) = o; }
    }
}

__device__ __forceinline__ void gdn_scan_chain(KArg p, const Ctx& C, int chain) {
    unsigned char* ws = p->ws; const int tid = C.tid, lane = C.lane, w = C.wave, c = lane & 31, hi = lane >> 5;
    constexpr int WP = 68, UP = 68, SB_W = 0, SB_K = 64 * WP * 2, SB_U = 2 * 64 * WP * 2, SB_D = SB_U + 64 * UP * 4, SBUF = SB_D + 16;
    LAS unsigned char* lds = C.lds;
    const float* DEC = (const float*)(ws + WS_DEC);
    u32x4 st[4]; float dreg = 0.f;
    auto g_load = [&](int s) { if (tid == 0) dreg = DEC[chain * 68 + s]; const unsigned char* rec = ws + WS_RECG + (size_t)(chain * 68 + s) * REC_G_BYTES;
#pragma unroll
        for (int i = 0; i < 4; ++i) st[i] = *(const u32x4*)(rec + (size_t)(tid + 512 * i) * 16); };
    auto l_store = [&](int bsel, int s) { LAS unsigned char* sb = lds + bsel * SBUF;
#pragma unroll
        for (int i = 0; i < 4; ++i) { const int ch = tid + 512 * i; u32x2 lo, h2; lo.x = st[i].x; lo.y = st[i].y; h2.x = st[i].z; h2.y = st[i].w;
            if (ch < 512) { const int r = ch >> 3, c8 = ch & 7; LAS u32x2* d = (LAS u32x2*)(sb + SB_W + r * (WP * 2) + 16 * c8); d[0] = lo; d[1] = h2; }
            else if (ch < 1536) { const int q = ch - 512, r = q >> 4, c4 = q & 15; *(LAS u32x4*)(sb + SB_U + r * (UP * 4) + 16 * c4) = st[i]; }
            else { const int q = ch - 1536, r = q >> 3, c8 = q & 7; LAS u32x2* d = (LAS u32x2*)(sb + SB_K + r * (WP * 2) + 16 * c8); d[0] = lo; d[1] = h2; } }
        if (tid == 0) *(LAS float*)(sb + SB_D) = dreg; (void)s; };
    f32x16 S0, S1;
#pragma unroll
    for (int r = 0; r < 16; ++r) { S0[r] = 0.f; S1[r] = 0.f; }
    __syncthreads();
    g_load(0); l_store(0, 0);
    __syncthreads();
    for (int s = 0; s < 68; ++s) {
        const int bsel = s & 1;
        if (s + 1 < 68) g_load(s + 1);
        if (w < 2) {
            const int ct = w; LAS unsigned char* sb = lds + bsel * SBUF;
            unsigned char* rec = ws + WS_RECG + (size_t)(chain * 68 + s) * REC_G_BYTES;
            bf16x8 sf[2][2];
#pragma unroll
            for (int ks = 0; ks < 2; ++ks) {
                sf[0][ks] = mk_frag4(cvtpk(S0[8 * ks], S0[8 * ks + 1]), cvtpk(S0[8 * ks + 2], S0[8 * ks + 3]), cvtpk(S0[8 * ks + 4], S0[8 * ks + 5]), cvtpk(S0[8 * ks + 6], S0[8 * ks + 7]));
                sf[1][ks] = mk_frag4(cvtpk(S1[8 * ks], S1[8 * ks + 1]), cvtpk(S1[8 * ks + 2], S1[8 * ks + 3]), cvtpk(S1[8 * ks + 4], S1[8 * ks + 5]), cvtpk(S1[8 * ks + 6], S1[8 * ks + 7]));
            }
#pragma unroll
            for (int T = 0; T < 2; ++T)
#pragma unroll
                for (int ks = 0; ks < 2; ++ks) *(bf16x8*)(rec + REC_G_SP + (size_t)((((ct * 2 + T) * 2 + ks) * 64 + lane) * 16)) = sf[T][ks];
            f32x16 vn[2];
#pragma unroll
            for (int Ti = 0; Ti < 2; ++Ti) {
                f32x16 acc;
#pragma unroll
                for (int r = 0; r < 16; ++r) acc[r] = 0.f;
#pragma unroll
                for (int T = 0; T < 2; ++T)
#pragma unroll
                    for (int ks = 0; ks < 2; ++ks) { const LAS unsigned char* ap = sb + SB_W + (32 * Ti + c) * (WP * 2) + (32 * T + 16 * ks + 4 * hi) * 2;
                        acc = mfma32(mk_frag(*(const LAS u32x2*)ap, *(const LAS u32x2*)(ap + 16)), sf[T][ks], acc); }
#pragma unroll
                for (int g = 0; g < 4; ++g) { const f32x4 u = *(const LAS f32x4*)(sb + SB_U + (32 * ct + c) * (UP * 4) + (32 * Ti + 8 * g + 4 * hi) * 4);
                    vn[Ti][4 * g] = u.x - acc[4 * g]; vn[Ti][4 * g + 1] = u.y - acc[4 * g + 1]; vn[Ti][4 * g + 2] = u.z - acc[4 * g + 2]; vn[Ti][4 * g + 3] = u.w - acc[4 * g + 3]; }
            }
            bf16x8 vf[2][2];
#pragma unroll
            for (int Ti = 0; Ti < 2; ++Ti)
#pragma unroll
                for (int ks = 0; ks < 2; ++ks) {
                    vf[Ti][ks] = mk_frag4(cvtpk(vn[Ti][8 * ks], vn[Ti][8 * ks + 1]), cvtpk(vn[Ti][8 * ks + 2], vn[Ti][8 * ks + 3]), cvtpk(vn[Ti][8 * ks + 4], vn[Ti][8 * ks + 5]), cvtpk(vn[Ti][8 * ks + 6], vn[Ti][8 * ks + 7]));
                    *(bf16x8*)(rec + REC_G_VN + (size_t)((((ct * 2 + Ti) * 2 + ks) * 64 + lane) * 16)) = vf[Ti][ks]; }
            const float dec = *(const LAS float*)(sb + SB_D);
#pragma unroll
            for (int r = 0; r < 16; ++r) { S0[r] *= dec; S1[r] *= dec; }
#pragma unroll
            for (int Ti = 0; Ti < 2; ++Ti)
#pragma unroll
                for (int ks = 0; ks < 2; ++ks) {
                    const LAS unsigned char* a0 = sb + SB_K + c * (WP * 2) + (32 * Ti + 16 * ks + 4 * hi) * 2; const LAS unsigned char* a1 = a0 + 32 * (WP * 2);
                    S0 = mfma32(mk_frag(*(const LAS u32x2*)a0, *(const LAS u32x2*)(a0 + 16)), vf[Ti][ks], S0);
                    S1 = mfma32(mk_frag(*(const LAS u32x2*)a1, *(const LAS u32x2*)(a1 + 16)), vf[Ti][ks], S1); }
        }
        if (s + 1 < 68) l_store(bsel ^ 1, s + 1);
        __syncthreads();
    }
}
__device__ __forceinline__ void ret_scan_items(KArg p, const Ctx& C, int l, int item0, int nitems_total, int stride) {
    unsigned char* ws = p->ws;
    for (int it = item0; it < nitems_total; it += stride) {
        const int dbh = it >> 11, q = it & 2047; const int jp = q & 3, ln = (q >> 2) & 63, ks = (q >> 8) & 1, T = (q >> 9) & 1, ct = q >> 10;
        const int d = dbh >> 4, h = dbh & 3;
        const int j0 = 2 * jp, dk0 = 32 * T + 16 * ks + 8 * (j0 >> 2) + 4 * (ln >> 5) + (j0 & 3), dv = 32 * ct + (ln & 31);
        const float g64 = __expf(-__expf(p->in[I_RLOGD][(l * 2 + d) * 4 + h]) * 64.f);
        float s0 = 0.f, s1 = 0.f;
        for (int s = 0; s < 68; ++s) {
            unsigned char* rec = ws + WS_RECR + (size_t)(dbh * 68 + s) * REC_R_BYTES;
            *(unsigned*)(rec + REC_R_SP + (size_t)q * 4) = cvtpk(s0, s1);
            const float* kv = (const float*)(rec + REC_R_KV);
            s0 = s0 * g64 + kv[dk0 * 64 + dv]; s1 = s1 * g64 + kv[(dk0 + 1) * 64 + dv];
        }
    }
}

__device__ __forceinline__ void rec_out_unit(KArg p, const Ctx& C, int l, int b, int h, int cg) {
    unsigned char* ws = p->ws; const int tid = C.tid, lane = C.lane, w = C.wave, c = lane & 31, hi = lane >> 5;
    const int mixer = w >> 2, rt = (w >> 1) & 1, ct = w & 1;
    LAS float* ob = (LAS float*)C.lds;
    f32x16 acc;
#pragma unroll
    for (int r = 0; r < 16; ++r) acc[r] = 0.f;
#pragma unroll
    for (int d = 0; d < 2; ++d) {
        const int su = su_index(d, b, h, cg);
        const unsigned char* rec = mixer ? ws + WS_RECR + (size_t)su * REC_R_BYTES : ws + WS_RECG + (size_t)su * REC_G_BYTES;
        const unsigned char* qg = rec + (mixer ? REC_R_QG : REC_G_QG); const unsigned char* at = rec + (mixer ? REC_R_ATT : REC_G_ATT);
        const unsigned char* sp = rec + (mixer ? REC_R_SP : REC_G_SP); const unsigned char* vn = rec + (mixer ? REC_R_VF : REC_G_VN);
#pragma unroll
        for (int T = 0; T < 2; ++T)
#pragma unroll
            for (int ks = 0; ks < 2; ++ks) {
                const size_t ao = (size_t)((32 * rt + c) * 64 + 32 * T + 16 * ks + 4 * hi) * 2, bo = (size_t)((((ct * 2 + T) * 2 + ks) * 64 + lane) * 16);
                acc = mfma32(mk_frag(*(const u32x2*)(qg + ao), *(const u32x2*)(qg + ao + 16)), *(const bf16x8*)(sp + bo), acc);
                acc = mfma32(mk_frag(*(const u32x2*)(at + ao), *(const u32x2*)(at + ao + 16)), *(const bf16x8*)(vn + bo), acc);
            }
    }
    __syncthreads();
#pragma unroll
    for (int r = 0; r < 16; ++r) ob[(mixer * 64 + 32 * rt + crow(r, hi)) * XP + 32 * ct + c] = acc[r];
    __syncthreads();
    {
        const int rowi = tid >> 2, q4 = tid & 3, mx = rowi >> 6, tau = rowi & 63;
        const int row = (cg < 4 ? 256 * b + 64 * cg : MC + 4096 * b + 64 * (cg - 4)) + tau;
        const LAS float* o = ob + rowi * XP + 16 * q4; float v[16]; float s = 0.f, ss = 0.f;
#pragma unroll
        for (int j = 0; j < 16; ++j) { v[j] = o[j]; s += v[j]; ss += v[j] * v[j]; }
        s += __shfl_xor(s, 1); s += __shfl_xor(s, 2); ss += __shfl_xor(ss, 1); ss += __shfl_xor(ss, 2);
        const bf16_t* P = (const bf16_t*)(ws + WS_P) + (size_t)row * DINP + (mx ? PC_DGATE : PC_BGATE) + 64 * h + 16 * q4;
        const float* gn = mx ? p->in[I_RNORM] + (size_t)l * 256 + 64 * h + 16 * q4 : p->in[I_GNORM] + (size_t)l * 64 + 16 * q4;
        float mu = 0.f, rs;
        if (mx) { mu = s * (1.f / 64.f); const float var = ss * (1.f / 64.f) - mu * mu; rs = rsqrtf(fmaxf(var, 0.f) + EPS); } else rs = rsqrtf(ss * (1.f / 64.f) + EPS);
        unsigned ov[8];
#pragma unroll
        for (int j = 0; j < 16; j += 2) { const float y0 = (v[j] - mu) * rs * gn[j] * silu_f(bf2f(P[j])), y1 = (v[j + 1] - mu) * rs * gn[j + 1] * silu_f(bf2f(P[j + 1])); ov[j >> 1] = cvtpk(y0, y1); }
        bf16_t* dst = (bf16_t*)(ws + WS_MIX) + (size_t)row * D + (mx ? 768 : 256) + 64 * h + 16 * q4;
        u32x4 o0, o1; o0.x = ov[0]; o0.y = ov[1]; o0.z = ov[2]; o0.w = ov[3]; o1.x = ov[4]; o1.y = ov[5]; o1.z = ov[6]; o1.w = ov[7];
        *(u32x4*)dst = o0; *(u32x4*)(dst + 8) = o1;
    }
}

#ifndef ONLY_PHASE
#define ONLY_PHASE -1
#endif
#ifndef SUB3
#define SUB3 31
#endif
#ifndef DUP_K
#define DUP_K -1
#endif
#define NREP(k) ((DUP_K == (k)) ? 2 : 1)
#ifndef DUP2
#define DUP2 0
#endif
#define PH_ON(k) (ONLY_PHASE < 0 || ONLY_PHASE == (k))
constexpr int PH_PER_LAYER = 10, PH_FINAL = 1 + PH_PER_LAYER * DEPTH, N_PHASES = PH_FINAL + 1;
__global__ void __launch_bounds__(NTHR, 2) mega_fwd(Params p_arg) {
    extern __shared__ __attribute__((aligned(16))) unsigned char lds_raw[];
    Ctx C0; C0.lds = (LAS unsigned char*)lds_raw; C0.tid = threadIdx.x; C0.lane = C0.tid & 63; C0.wave = __builtin_amdgcn_readfirstlane(C0.tid >> 6); C0.bid = blockIdx.x; C0.G = gridDim.x;
    const Ctx& C = C0;
    int lo, hi; unsigned* ctl0; { KArg p = kp_get(); lo = p->ph_lo; hi = p->ph_hi; ctl0 = (unsigned*)(p->ws + WS_CTL); }
    const bool fused = (hi - lo) > 1;
    if (C.tid < 64) ((LAS unsigned*)(C.lds + LDS_MISC))[C.tid] = 0u;
    __syncthreads();
    XcdBarrier bar; bar.bar = ctl0 + CW_BAR; bar.x = 0; bar.st = (volatile LAS unsigned*)(C.lds + LDS_MISC);
    if (fused) bar = xcd_barrier_post(ctl0 + CW_BAR, (volatile LAS unsigned*)(C.lds + LDS_MISC));
#define IN(k) (lo <= (k) && (k) < hi)
#define RELAUNDER do { int t_ = C0.tid, b_ = C0.bid, g_ = C0.G; unsigned l_ = (unsigned)(size_t)C0.lds; asm volatile("" : "+v"(t_), "+s"(b_), "+s"(g_), "+s"(l_)); C.tid = t_; C.lane = t_ & 63; C.wave = __builtin_amdgcn_readfirstlane(t_ >> 6); C.bid = b_; C.G = g_; C.lds = (LAS unsigned char*)(size_t)l_; p = kp_get(); ws = p->ws; } while (0)
#define PHASE_VARS Ctx C; { int t_ = C0.tid, b_ = C0.bid, g_ = C0.G; unsigned l_ = (unsigned)(size_t)C0.lds; asm volatile("" : "+v"(t_), "+s"(b_), "+s"(g_), "+s"(l_)); C.tid = t_; C.lane = t_ & 63; C.wave = __builtin_amdgcn_readfirstlane(t_ >> 6); C.bid = b_; C.G = g_; C.lds = (LAS unsigned char*)(size_t)l_; } KArg p = kp_get(); unsigned char* ws = p->ws; unsigned* ctl = (unsigned*)(ws + WS_CTL); const float* MOD = (const float*)(ws + WS_MOD); bf16_t* U = (bf16_t*)(ws + WS_U); (void)ctl; (void)MOD; (void)U;
#define SEAM(k) do { if (IN(k) && IN((k) + 1)) xcd_barrier(bar); } while (0)

    if (PH_ON(10) && IN(0)) { PHASE_VARS prologue_phase(p, C); }
    SEAM(0);

    for (int l = 0; l < DEPTH; ++l) {
        const int base = 1 + PH_PER_LAYER * l;
        const bool moe = (l & 1) != 0, last = (l == DEPTH - 1);
        const int row_min = last ? MC : 0, pm0 = last ? 4 : 0, Meff = last ? MX : MT;

        if (PH_ON(0) && IN(base + 0)) { PHASE_VARS
            norm_phase<0>(p, C, l, l == 2, l - 1, false, 0, (l == 1 || l == 3) ? 7 : 0);
        }
        SEAM(base + 0);
        if (PH_ON(1) && IN(base + 1)) { PHASE_VARS
            { pg8::Gemm g{U, (const bf16_t*)(ws + WS_WIN) + (size_t)l * DINP * D, MT, DINP, D, D, D}; pg8::OrderPM S; S.init(MT, DINP, C.G, C.bid); S.pm0 = 0;
              pg8::EpiStore E{(bf16_t*)(ws + WS_P), DINP, 1 << 20};
              pg8::gemm_phase<pg8::EpiStore, pg8::OrderPM, true, true>(C.lds, g, S, E); }
            { pg8::Gemm g{(const bf16_t*)(ws + WS_WINV) + (size_t)l * 256 * D, U, 256, MT, D, D, D}; pg8::OrderPM S; S.init(256, MT, C.G, (C.bid + 208) & 255); S.pm0 = 0;
              pg8::EpiStore E{(bf16_t*)(ws + WS_VTS), MT, 1 << 20};
              pg8::gemm_phase<pg8::EpiStore, pg8::OrderPM, true, true>(C.lds, g, S, E); }
        }
        SEAM(base + 1);
        if (PH_ON(2) && IN(base + 2)) for (int rep = 0; rep < NREP(2); ++rep) { PHASE_VARS
            for (int r2 = 0; r2 < ((DUP2 & 1) ? 2 : 1); ++r2) prep_phase(p, C, l);
            for (int u = C.bid; u < 2 * 1088; u += C.G) { const int mixer = u / 1088, v = u % 1088, b = v / 272, h = (v / 68) & 3, cg = v % 68;
                if (mixer == 0) { for (int r2 = 0; r2 < ((DUP2 & 2) ? 2 : 1); ++r2) gdn_chunk_unit(p, C, l, b, h, cg); } else { for (int r2 = 0; r2 < ((DUP2 & 4) ? 2 : 1); ++r2) ret_chunk_unit(p, C, l, b, h, cg); } }
        }
        SEAM(base + 2);
        if (PH_ON(3) && IN(base + 3)) for (int rep = 0; rep < NREP(3); ++rep) { PHASE_VARS
            if (SUB3 & 1) { if (C.bid < 32) gdn_scan_chain(p, C, C.bid); }
            RELAUNDER;
            if (C.bid >= 32) {
                const int G2 = C.G - 32, c2 = C.bid - 32;
                if (SUB3 & 2) { pg8::Gemm g{(const bf16_t*)(ws + WS_AUP), (const bf16_t*)(ws + WS_WUP) + (size_t)l * 1024 * 512, MT, 1024, 512, 512, 512}; pg8::OrderPM S; S.init(MT, 1024, G2, c2); S.pm0 = 0;
                  pg8::EpiUp E{(bf16_t*)(ws + WS_QRAW), (bf16_t*)(ws + WS_KFULL)};
                  pg8::gemm_phase<pg8::EpiUp, pg8::OrderPM, true, true>(C.lds, g, S, E); }
                RELAUNDER;
                if (SUB3 & 4) { pg8::Gemm g{(const bf16_t*)(ws + WS_WUPV) + (size_t)l * 256 * 512, (const bf16_t*)(ws + WS_AUP), 256, MT, 512, 512, 512}; pg8::OrderPM S; S.init(256, MT, G2, (c2 + 176) % G2); S.pm0 = 0;
                  pg8::EpiStore E{(bf16_t*)(ws + WS_VTM), MT, 1 << 20};
                  pg8::gemm_phase<pg8::EpiStore, pg8::OrderPM, true, true>(C.lds, g, S, E); }
                RELAUNDER;
                if (SUB3 & 8) ret_scan_items(p, C, l, c2 * NTHR + C.tid, 65536, G2 * NTHR);
                RELAUNDER;
                if (SUB3 & 16) { for (int u = 256 + c2; u < 512; u += G2) attn_dispatch(p, C, l, u);
                if (!last) for (int u = 528 + c2; u < 544; u += G2) attn_dispatch(p, C, l, u); }
                RELAUNDER;
                if (!last) { __syncthreads(); convert_layer_weights(p, C, l + 1, c2 * NWAVES + C.wave, G2 * NWAVES); }
            }
        }
        SEAM(base + 3);
        if (PH_ON(4) && IN(base + 4)) for (int rep = 0; rep < NREP(4); ++rep) { PHASE_VARS
            for (int u = C.bid; u < 256; u += C.G) attn_dispatch(p, C, l, u);
            if (!last) for (int u = 512 + C.bid; u < 528; u += C.G) attn_dispatch(p, C, l, u);
            for (int u = C.bid; u < 1088; u += C.G) { const int b = u / 272, h = (u / 68) & 3, cg = u % 68; if (last && cg < 4) continue; rec_out_unit(p, C, l, b, h, cg); }
        }
        SEAM(base + 4);
        if (PH_ON(5) && IN(base + 5)) { PHASE_VARS
            { pg8::Gemm g{(const bf16_t*)(ws + WS_MIX), (const bf16_t*)(ws + WS_WOUT) + (size_t)l * D * D, MX, D, D, D, D}; pg8::OrderPM S; S.init(MX, D, C.G, C.bid); S.pm0 = 4;
              pg8::EpiRes E{(float*)(ws + WS_H), MOD + (size_t)l * 5 * 6144 + 2 * 1024};
              pg8::gemm_phase<pg8::EpiRes, pg8::OrderPM, true, true>(C.lds, g, S, E); }
            if (!last) { RELAUNDER;
              pg8::Gemm g{(const bf16_t*)(ws + WS_MIX), (const bf16_t*)(ws + WS_WOUT) + (size_t)l * D * D, MC, D, 256, D, D}; pg8::SplitKOrder S{C.G, C.bid, 4, 256};
              pg8::EpiSlab E{(float*)(ws + WS_SLAB), (const float*)(ws + WS_MOD) + (size_t)l * 5 * 6144 + 2 * 1024, 256};
              pg8::gemm_phase<pg8::EpiSlab, pg8::SplitKOrder, true, true>(C.lds, g, S, E); }
        }
        SEAM(base + 5);
        if (PH_ON(6) && IN(base + 6)) { PHASE_VARS norm_phase<1>(p, C, l, false, 0, moe, row_min, last ? 0 : 4); }
        SEAM(base + 6);
        if (PH_ON(7) && IN(base + 7)) { PHASE_VARS if (moe) moe_gather_phase(p, C, row_min); }
        if (moe) SEAM(base + 7);
        if (PH_ON(8) && IN(base + 8)) { PHASE_VARS
            pg8::EpiSwiGLU E{(bf16_t*)(ws + WS_HD)};
            if (!moe) { pg8::Gemm g{U, (const bf16_t*)(ws + WS_WFF + (size_t)(l >> 1) * FFW_BYTES), MT, 7168, D, D, D}; pg8::OrderPM S; S.init(MT, 7168, C.G, C.bid); S.pm0 = 0;
                pg8::gemm_phase<pg8::EpiSwiGLU, pg8::OrderPM, true, true>(C.lds, g, S, E); }
            else { const int nt = (int)__hip_atomic_load(ctl + CW_TILEE + 160, __ATOMIC_RELAXED, __HIP_MEMORY_SCOPE_AGENT);
                pg8::Gemm g{(const bf16_t*)(ws + WS_ASORT), (const bf16_t*)(ws + WS_WMOE), MOE_ROWS, 8 * 7168, D, D, D}; pg8::MoeOrder S{28, C.G, C.bid, __builtin_amdgcn_readfirstlane(nt), ctl + CW_TILEE};
                pg8::gemm_phase<pg8::EpiSwiGLU, pg8::MoeOrder, true, true>(C.lds, g, S, E); }
        }
        SEAM(base + 8);
        if (PH_ON(9) && IN(base + 9)) { PHASE_VARS
            if (!moe) {
                const bf16_t* Wd = (const bf16_t*)(ws + WS_WFF + (size_t)(l >> 1) * FFW_BYTES) + (size_t)7168 * 1024;
                { pg8::Gemm g{(const bf16_t*)(ws + WS_HD), Wd, MX, D, DFF, DFF, DFF}; pg8::OrderPM S; S.init(MX, D, C.G, C.bid); S.pm0 = 4;
                  pg8::EpiRes E{(float*)(ws + WS_H), MOD + (size_t)l * 5 * 6144 + 5 * 1024};
                  pg8::gemm_phase<pg8::EpiRes, pg8::OrderPM, true, true>(C.lds, g, S, E); }
                RELAUNDER;
                { pg8::Gemm g{(const bf16_t*)(ws + WS_HD), (const bf16_t*)(ws + WS_WFF + (size_t)(l >> 1) * FFW_BYTES) + (size_t)7168 * 1024, MC, D, 512, DFF, DFF}; pg8::SplitKOrder S{C.G, C.bid, 7, 512};
                  pg8::EpiSlab E{(float*)(ws + WS_SLAB), (const float*)(ws + WS_MOD) + (size_t)l * 5 * 6144 + 5 * 1024, 512};
                  pg8::gemm_phase<pg8::EpiSlab, pg8::SplitKOrder, true, true>(C.lds, g, S, E); } }
            else { const int nt = (int)__hip_atomic_load(ctl + CW_TILEE + 160, __ATOMIC_RELAXED, __HIP_MEMORY_SCOPE_AGENT);
                pg8::Gemm g{(const bf16_t*)(ws + WS_HD), (const bf16_t*)(ws + WS_WMOE) + (size_t)8 * 7168 * 1024, MOE_ROWS, 8 * 1024, DFF, DFF, DFF}; pg8::MoeOrder S{4, C.G, C.bid, __builtin_amdgcn_readfirstlane(nt), ctl + CW_TILEE};
                pg8::EpiStore E{(bf16_t*)(ws + WS_YD), D, 4};
                pg8::gemm_phase<pg8::EpiStore, pg8::MoeOrder, true, true>(C.lds, g, S, E); }
        }
        SEAM(base + 9);
    }
    if (PH_ON(11) && IN(PH_FINAL)) { PHASE_VARS norm_phase<2>(p, C, DEPTH, true, DEPTH - 1, false, MC, 0); }
#undef IN
#undef SEAM
}

extern "C" void kernel_launch(void* const* d_in, const int* in_sizes, int n_in, void* d_out, int out_size, void* d_ws, size_t ws_size, hipStream_t stream) {
    static int grid = 0;
    if (grid == 0) {
        if (n_in != N_IN || out_size != MX * D || ws_size < WS_TOTAL) { fprintf(stderr, "kernel_launch: unexpected shapes (n_in %d out %d ws %zu, need %zu)\n", n_in, out_size, ws_size, (size_t)WS_TOTAL); grid = -1; return; }
        int dev = 0, cus = 0, per_cu = 0;
        if (hipGetDevice(&dev) != hipSuccess || hipDeviceGetAttribute(&cus, hipDeviceAttributeMultiprocessorCount, dev) != hipSuccess) { grid = -1; return; }
        if (hipFuncSetAttribute((const void*)mega_fwd, hipFuncAttributeMaxDynamicSharedMemorySize, LDS_BYTES) != hipSuccess) { fprintf(stderr, "kernel_launch: hipFuncSetAttribute failed\n"); grid = -1; return; }
        if (hipOccupancyMaxActiveBlocksPerMultiprocessor(&per_cu, (const void*)mega_fwd, NTHR, LDS_BYTES) != hipSuccess || per_cu < 1) { fprintf(stderr, "kernel_launch: occupancy query says %d\n", per_cu); }
        (void)hipGetLastError();
        grid = (cus == 256) ? 256 : -1;
        if (grid < 0) { fprintf(stderr, "kernel_launch: built for a 256-CU device, found %d\n", cus); return; }
    }
    if (grid < 0) return;
    if (hipMemsetAsync((char*)d_ws + WS_CTL, 0, CTL_BYTES, stream) != hipSuccess) return;
    Params p; memset(&p, 0, sizeof(p));
    for (int i = 0; i < N_IN; ++i) p.in[i] = (const float*)d_in[i];
    p.out = (float*)d_out; p.ws = (unsigned char*)d_ws;
#if MK_ONE_LAUNCH
    p.ph_lo = 0; p.ph_hi = N_PHASES;
    hipLaunchKernelGGL(mega_fwd, dim3(grid), dim3(NTHR), LDS_BYTES, stream, p);
#else
    for (int ph = 0; ph < N_PHASES; ++ph) {
        if (ph >= 1 && ph < PH_FINAL) { const int l = (ph - 1) / PH_PER_LAYER, k = (ph - 1) % PH_PER_LAYER; if (k == 7 && !(l & 1)) continue; }
        p.ph_lo = ph; p.ph_hi = ph + 1;
        hipLaunchKernelGGL(mega_fwd, dim3(grid), dim3(NTHR), LDS_BYTES, stream, p);
    }
#endif
}
```

```cpp
#include <hip/hip_runtime.h>
#include <cstdio>
#include <cstdint>
#include <cstring>

#ifndef MK_ONE_LAUNCH
#define MK_ONE_LAUNCH 1
#endif

#define LAS __attribute__((address_space(3)))
#define GAS __attribute__((address_space(1)))
typedef unsigned short bf16_t;
typedef short bf16x8 __attribute__((ext_vector_type(8)));
typedef float f32x4 __attribute__((ext_vector_type(4)));
typedef float f32x2 __attribute__((ext_vector_type(2)));
typedef float f32x16 __attribute__((ext_vector_type(16)));
typedef unsigned u32x4 __attribute__((ext_vector_type(4)));
typedef unsigned u32x2 __attribute__((ext_vector_type(2)));

constexpr int D = 1024, NB = 4, SEQ = 4096, CTX = 256, DEPTH = 4;
constexpr int MC = NB * CTX, MX = NB * SEQ, MT = MC + MX;
constexpr int DIN = 2992, DINP = 3072, DFF = 3584, NE = 8;
constexpr int NSU = 2 * NB * 4 * 68;
constexpr int PC_AQ = 0, PC_AK = 256, PC_AV = 384, PC_BQKV = 512, PC_BGATE = 1280, PC_BAB = 1536, PC_CQ = 1552, PC_CKV = 1808, PC_CKR = 1936,
              PC_DQ = 1968, PC_DK = 2224, PC_DV = 2480, PC_DGATE = 2736;
constexpr float EPS = 1e-6f, LOG2E = 1.4426950408889634f;
constexpr int MOE_ROWS = 36864, MOE_TILES = MOE_ROWS / 256;

constexpr size_t MiB = 1u << 20;
constexpr size_t WS_CTL = 0, CTL_BYTES = 1 * MiB;
constexpr int CW_BAR = 4096;
constexpr int CW_CNT = 16384;
constexpr int CW_TILEE = 20480;
constexpr size_t WS_TAB = 1 * MiB;
constexpr size_t WS_MOD = WS_TAB + 65536;
constexpr size_t WS_ROUTE = 2 * MiB;
constexpr size_t WS_DEC = 3 * MiB;
constexpr size_t WS_WIN = 4 * MiB;
constexpr size_t WS_WINV = WS_WIN + 24 * MiB;
constexpr size_t WS_WOUT = WS_WINV + 2 * MiB;
constexpr size_t WS_WUP = WS_WOUT + 8 * MiB;
constexpr size_t WS_WUPV = WS_WUP + 4 * MiB;
constexpr size_t WS_WFF = WS_WUPV + 1 * MiB;
constexpr size_t FFW_BYTES = (size_t)(7168 * 1024 + 1024 * 3584) * 2;
constexpr size_t WS_WMOE = WS_WFF + 42 * MiB;
constexpr size_t WS_H = WS_WMOE + 168 * MiB;
constexpr size_t WS_U = WS_H + 68 * MiB;
constexpr size_t WS_OV = WS_U + 34 * MiB;
constexpr size_t WS_P = WS_OV;
constexpr size_t WS_VTS = WS_P + 102 * MiB;
constexpr size_t WS_AUP = WS_VTS + 9 * MiB;
constexpr size_t WS_QRAW = WS_AUP + 17 * MiB;
constexpr size_t WS_KFULL = WS_QRAW + 13 * MiB;
constexpr size_t WS_VTM = WS_KFULL + 13 * MiB;
constexpr size_t WS_QS = WS_VTM + 9 * MiB;
constexpr size_t WS_KS = WS_QS + 9 * MiB;
constexpr size_t WS_MIX = WS_KS + 5 * MiB;
constexpr size_t WS_REC = WS_MIX + 34 * MiB;
constexpr size_t REC_G_W = 0, REC_G_UT = 8192, REC_G_KDT = 24576, REC_G_QG = 32768, REC_G_ATT = 40960, REC_G_SP = 49152, REC_G_VN = 57344, REC_G_BYTES = 65536;
constexpr size_t REC_R_KV = 0, REC_R_QG = 16384, REC_R_ATT = 24576, REC_R_VF = 32768, REC_R_SP = 40960, REC_R_BYTES = 49152;
constexpr size_t WS_RECG = WS_REC, WS_RECR = WS_REC + (size_t)NSU * REC_G_BYTES;
constexpr size_t WS_OV_END_MIX = WS_RECR + (size_t)NSU * REC_R_BYTES;
constexpr size_t WS_YD = WS_OV + 112 * MiB;
constexpr size_t WS_ASORT = WS_YD + 72 * MiB;
constexpr size_t WS_HD = WS_ASORT + 72 * MiB;
constexpr size_t WS_OV_END_FFN = WS_HD + 252 * MiB;
constexpr size_t WS_END = (WS_OV_END_MIX > WS_OV_END_FFN ? WS_OV_END_MIX : WS_OV_END_FFN);
static_assert(WS_P + (size_t)MT * DINP * 2 <= WS_VTS && WS_VTS + (size_t)256 * MT * 2 <= WS_AUP && WS_AUP + (size_t)MT * 512 * 2 <= WS_QRAW && WS_QRAW + (size_t)MT * 384 * 2 <= WS_KFULL &&
              WS_KFULL + (size_t)MT * 384 * 2 <= WS_VTM && WS_VTM + (size_t)256 * MT * 2 <= WS_QS && WS_QS + (size_t)MT * 256 * 2 <= WS_KS && WS_KS + (size_t)MT * 128 * 2 <= WS_MIX &&
              WS_MIX + (size_t)MT * D * 2 <= WS_REC && WS_YD >= WS_VTS + 9 * MiB && WS_MOD + 491520 <= WS_ROUTE && WS_ROUTE + 417792 <= WS_DEC && WS_DEC + NSU * 4 <= WS_WIN, "ws map");
constexpr size_t WS_SLAB = ((WS_END + MiB - 1) / MiB) * MiB;
constexpr size_t WS_TOTAL = WS_SLAB + 28 * MiB;
static_assert(WS_TOTAL <= 900 * MiB, "ws budget");

constexpr int LDS_BYTES = 147456;
constexpr int LDS_MISC = 147456 - 256;
constexpr int NWAVES = 8, NTHR = 512;

__device__ __forceinline__ unsigned cvtpk(float lo, float hi) { unsigned r; asm volatile("v_cvt_pk_bf16_f32 %0, %1, %2" : "=v"(r) : "v"(lo), "v"(hi)); return r; }
__device__ __forceinline__ float bf_lo(unsigned u) { return __uint_as_float(u << 16); }
__device__ __forceinline__ float bf_hi(unsigned u) { return __uint_as_float(u & 0xffff0000u); }
__device__ __forceinline__ float bf2f(bf16_t h) { return __uint_as_float((unsigned)h << 16); }
__device__ __forceinline__ bf16_t f2bf(float f) { return (bf16_t)(cvtpk(f, 0.f) & 0xffffu); }
__device__ __forceinline__ float wave_sum(float v) {
#pragma unroll
    for (int o = 1; o < 64; o <<= 1) v += __shfl_xor(v, o);
    return v;
}
__device__ __forceinline__ float silu_f(float x) { return x / (1.f + __expf(-x)); }
__device__ __forceinline__ float sigmoid_f(float x) { return 1.f / (1.f + __expf(-x)); }
__device__ __forceinline__ float softplus_f(float x) { return x > 20.f ? x : log1pf(__expf(x)); }
__device__ __forceinline__ int crow(int r, int hi) { return (r & 3) + 8 * (r >> 2) + 4 * hi; }
__device__ __forceinline__ f32x16 mfma32(bf16x8 a, bf16x8 b, f32x16 c) { return __builtin_amdgcn_mfma_f32_32x32x16_bf16(a, b, c, 0, 0, 0); }
__device__ __forceinline__ bf16x8 mk_frag(u32x2 lo, u32x2 hi) { u32x4 v; v.x = lo.x; v.y = lo.y; v.z = hi.x; v.w = hi.y; return __builtin_bit_cast(bf16x8, v); }
__device__ __forceinline__ bf16x8 mk_frag4(unsigned a, unsigned b, unsigned c, unsigned d) { u32x4 v; v.x = a; v.y = b; v.z = c; v.w = d; return __builtin_bit_cast(bf16x8, v); }
__device__ __forceinline__ int mod_row(int row) { return row < MC ? 4 : ((row - MC) >> 12); }

#define XB_TMO      128
#define XB_XCNT(j)  (256  + 64 * (j))
#define XB_XSUB(j)  (1280 + 64 * (j))
#define XB_XGEN(j)  (2304 + 64 * (j))
#define XB_TOP      3328
#define XB_TOPGEN   3392
#define XCD_BAR_WORDS 3456
#define XB_SPIN_CAP (1u << 18)
__device__ __forceinline__ unsigned xb_ld(unsigned* p)              { return __hip_atomic_load(p, __ATOMIC_RELAXED, __HIP_MEMORY_SCOPE_AGENT); }
__device__ __forceinline__ unsigned xb_add(unsigned* p, unsigned v) { return __hip_atomic_fetch_add(p, v, __ATOMIC_RELAXED, __HIP_MEMORY_SCOPE_AGENT); }
__device__ __forceinline__ unsigned xb_xcc_id() { return (unsigned)__builtin_amdgcn_s_getreg((3 << 11) | 20) & 0xFu; }
#define XB_SPIN(cond, bar) do { unsigned _sp = 0; while (cond) { __builtin_amdgcn_s_sleep(1); \
    if ((++_sp & 255u) == 0u) { if (xb_ld(&(bar)[XB_TMO])) break; if (_sp > XB_SPIN_CAP) { atomicAdd(&(bar)[XB_TMO], 1u); break; } } } } while (0)
struct XcdBarrier { unsigned* bar; unsigned x; volatile LAS unsigned* st; };
__device__ __forceinline__ XcdBarrier xcd_barrier_post(unsigned* bar, volatile LAS unsigned* st) {
    XcdBarrier b; b.bar = bar; b.x = xb_xcc_id(); b.st = st;
    if (threadIdx.x == 0) (void)xb_add(&bar[XB_XCNT(b.x)], 1u);
    return b;
}
__device__ __forceinline__ void xcd_barrier_complete(unsigned* bar, unsigned x, unsigned& nloc, unsigned& nx) {
    const unsigned G = gridDim.x * gridDim.y * gridDim.z;
    unsigned sum, cnt, mine, sp = 0u;
    for (;;) {
        sum = 0u; cnt = 0u; mine = 0u;
#pragma unroll
        for (unsigned j = 0; j < 16; ++j) { const unsigned c = xb_ld(&bar[XB_XCNT(j)]); sum += c; cnt += (c > 0u) ? 1u : 0u; mine = (j == x) ? c : mine; }
        if (sum == G) break;
        __builtin_amdgcn_s_sleep(1);
        if ((++sp & 255u) == 0u) { if (xb_ld(&bar[XB_TMO])) break; if (sp > XB_SPIN_CAP) { atomicAdd(&bar[XB_TMO], 1u); break; } }
    }
    nloc = mine > 0u ? mine : 1u; nx = cnt > 0u ? cnt : 1u;
}
__device__ __forceinline__ void xcd_barrier(const XcdBarrier& b) {
    asm volatile("s_waitcnt vmcnt(0)" ::: "memory");
    __syncthreads();
    if (threadIdx.x == 0) {
        unsigned* bar = b.bar;
        __builtin_amdgcn_s_waitcnt(0);
        unsigned nloc = b.st[0], nx = b.st[1];
        if (nloc == 0u) { xcd_barrier_complete(bar, b.x, nloc, nx); b.st[0] = nloc; b.st[1] = nx; }
        const unsigned old = xb_add(&bar[XB_XSUB(b.x)], 1u);
        const unsigned gen = old / nloc;
        if (old + 1u == (gen + 1u) * nloc) {
            __builtin_amdgcn_fence(__ATOMIC_RELEASE, "agent");
            asm volatile("s_waitcnt vmcnt(0)" ::: "memory");
            const unsigned og = xb_add(&bar[XB_TOP], 1u);
            const unsigned tg = og / nx;
            if (og + 1u == (tg + 1u) * nx) xb_add(&bar[XB_TOPGEN], 1u);
            else XB_SPIN(xb_ld(&bar[XB_TOPGEN]) == tg, bar);
            __builtin_amdgcn_fence(__ATOMIC_ACQUIRE, "agent");
            xb_add(&bar[XB_XGEN(b.x)], 1u);
            asm volatile("s_waitcnt vmcnt(0)" ::: "memory");
        } else {
            XB_SPIN(xb_ld(&bar[XB_XGEN(b.x)]) == gen, bar);
            __builtin_amdgcn_fence(__ATOMIC_ACQUIRE, "agent");
            asm volatile("s_waitcnt vmcnt(0)" ::: "memory");
        }
    }
    __syncthreads();
}
namespace pg8 {
#define PG8_LAS __attribute__((address_space(3)))
typedef unsigned short bf16_t;
typedef short bf16x8 __attribute__((ext_vector_type(8)));
typedef float f32x4 __attribute__((ext_vector_type(4)));
typedef unsigned u32x4 __attribute__((ext_vector_type(4)));
constexpr int BM = 256, BK = 64, HALF = 128, HTB = HALF * BK * 2  , STAGE_BYTES = 8 * HTB, NXCD = 8, WGM = 8;

__host__ __device__ __forceinline__ int lds_byte(int r, int c) { const int st = (r >> 4) * 2 + (c >> 5), rr = r & 15, cc = c & 31, ob = rr * 64 + cc * 2; return st * 1024 + (ob ^ (((ob >> 9) & 1) << 5)); }
__host__ __device__ __forceinline__ void stage_rc(int b, int& R, int& C) { const int st = b / 1024, sb = b % 1024, swz = sb ^ (((sb >> 9) & 1) << 5); R = (st >> 1) * 16 + swz / 64; C = (st & 1) * 32 + (swz % 64) / 2; }
__host__ __device__ __forceinline__ int perm32(int rho) { const int n = rho >> 4, i = rho & 15; return 8 * (i >> 2) + 4 * n + (i & 3); }

struct Unit { int pm, pn, ko; };
struct Gemm { const bf16_t* A; const bf16_t* Bt; int M, N, K, lda, ldb; };

struct StaticOrder {
    int nM, nN, nwg, G, c;
    __host__ __device__ void init(int M, int N, int G_, int c_) { nM = M / BM; nN = N / BM; nwg = nM * nN; G = G_; c = c_; }
    __host__ __device__ bool next(int i, Unit& u) const {
        const long L = (long)i * G + c; if (L >= nwg) return false;
        int wgid = (int)L; { const int q = nwg / NXCD, r = nwg % NXCD, xcd = wgid % NXCD, off = wgid / NXCD; wgid = (xcd < r ? xcd * (q + 1) : r * (q + 1) + (xcd - r) * q) + off; }
        const int nig = WGM * nN, gid = wgid / nig, fm = gid * WGM, gsz = (nM - fm) < WGM ? (nM - fm) : WGM;
        u.pm = fm + ((wgid % nig) % gsz); u.pn = (wgid % nig) / gsz; u.ko = 0; return true;
    }
    __device__ __forceinline__ void a_ready(const Unit&) const {}
    __device__ __forceinline__ void done(const Unit&) const {}
};
__device__ __forceinline__ unsigned cvt_pk_bf16(float lo, float hi) { unsigned r; asm volatile("v_cvt_pk_bf16_f32 %0, %1, %2" : "=v"(r) : "v"(lo), "v"(hi)); return r; }
template <class Epi, class Sched, bool ALIGN_EPI = false, bool SP2 = false>
__device__ __forceinline__ void gemm_phase(PG8_LAS unsigned char* lds, const Gemm g, const Sched& S, const Epi& E) {
    int tid_l = threadIdx.x; asm volatile("" : "+v"(tid_l));
    const int tid = tid_l, wid = __builtin_amdgcn_readfirstlane(tid >> 6), lane = tid & 63, wr = wid >> 2, wc = wid & 3, fr = lane & 15, fq = lane >> 4;
    const int K = g.K, nt = K / BK;
    unsigned voffA[2], voffB[2];
#pragma unroll
    for (int i = 0; i < 2; ++i) { int R, C; stage_rc(tid * 16 + i * 8192, R, C); const int Rb = Epi::PERM ? ((R & ~31) + perm32(R & 31)) : R;
        voffA[i] = (unsigned)(R * g.lda + C) * 2u; voffB[i] = (unsigned)(Rb * g.ldb + C) * 2u; }
    const size_t kstep = (size_t)(BK * 2);
    const size_t hstepA = (size_t)HALF * g.lda * 2, hstepB = (size_t)HALF * g.ldb * 2;
    const size_t tstepA = 2 * hstepA, tstepB = 2 * hstepB;
    const unsigned ldsw = (unsigned)wid * 1024u;
    const int aoff = lds_byte(wr * 64 + fr, fq * 8), boff = lds_byte(wc * 32 + fr, fq * 8);
#define PG8_SA(b, h) (((b) * 2 + (h)) * HTB)
#define PG8_SB(b, h) ((4 + (b) * 2 + (h)) * HTB)
#define PG8_STAGE(bufoff, gbase, voff) do { _Pragma("unroll") for (int _i = 0; _i < 2; ++_i) \
        __builtin_amdgcn_global_load_lds((const unsigned*)((const char*)(gbase) + (voff)[_i]), (PG8_LAS unsigned*)(lds + (bufoff) + ldsw + _i * 8192), 16, 0, 0); } while (0)
#define PG8_LDA(dst, b, h) do { _Pragma("unroll") for (int m = 0; m < 4; ++m) _Pragma("unroll") for (int k = 0; k < 2; ++k) dst[m][k] = *(const PG8_LAS bf16x8*)(lds + PG8_SA(b, h) + aoff + m * 2048 + k * 1024); } while (0)
#define PG8_LDB(dst, b, h) do { _Pragma("unroll") for (int n = 0; n < 2; ++n) _Pragma("unroll") for (int k = 0; k < 2; ++k) dst[n][k] = *(const PG8_LAS bf16x8*)(lds + PG8_SB(b, h) + boff + n * 2048 + k * 1024); } while (0)
#define PG8_MMA(ai, bj, At, Bt) do { __builtin_amdgcn_s_setprio(1); _Pragma("unroll") for (int m = 0; m < 4; ++m) _Pragma("unroll") for (int n = 0; n < 2; ++n) _Pragma("unroll") for (int k = 0; k < 2; ++k) \
        acc[ai][bj][m][n] = __builtin_amdgcn_mfma_f32_16x16x32_bf16(Bt[n][k], At[m][k], acc[ai][bj][m][n], 0, 0, 0); __builtin_amdgcn_s_setprio(0); } while (0)
#define PG8_WAIT_V(n) asm volatile("s_waitcnt vmcnt(" #n ")" ::: "memory")
#define PG8_WAIT_L(n) asm volatile("s_waitcnt lgkmcnt(" #n ")" ::: "memory")
#define PG8_BAR __builtin_amdgcn_s_barrier()
#define PG8_SCHED __builtin_amdgcn_sched_barrier(0)
    Unit cur, nxt; int ui = 0;
    if (!S.next(0, cur)) return;
    f32x4 acc[2][2][4][2];
#pragma unroll
    for (int a = 0; a < 2; ++a)
#pragma unroll
        for (int b = 0; b < 2; ++b)
#pragma unroll
            for (int m = 0; m < 4; ++m)
#pragma unroll
                for (int n = 0; n < 2; ++n) acc[a][b][m][n] = (f32x4){0.f, 0.f, 0.f, 0.f};
    bf16x8 At[4][2], B0[2][2], B1[2][2];
    const char* cA = (const char*)g.A + (size_t)cur.pm * tstepA + (size_t)cur.ko * 2; const char* cB = (const char*)g.Bt + (size_t)cur.pn * tstepB + (size_t)cur.ko * 2;
    S.a_ready(cur);
    if constexpr (SP2) {
        PG8_STAGE(PG8_SB(0, 0), cB, voffB); PG8_STAGE(PG8_SB(0, 1), cB + hstepB, voffB); PG8_STAGE(PG8_SA(0, 0), cA, voffA); PG8_STAGE(PG8_SA(0, 1), cA + hstepA, voffA);
        if (wr == 1) PG8_BAR;
        PG8_WAIT_V(2); PG8_BAR;
        PG8_STAGE(PG8_SB(1, 0), cB + kstep, voffB); PG8_STAGE(PG8_SA(1, 0), cA + kstep, voffA); PG8_STAGE(PG8_SB(1, 1), cB + hstepB + kstep, voffB);
        PG8_WAIT_V(6); PG8_BAR;
    } else {
        PG8_STAGE(PG8_SB(0, 0), cB, voffB); PG8_STAGE(PG8_SA(0, 0), cA, voffA); PG8_STAGE(PG8_SB(0, 1), cB + hstepB, voffB); PG8_STAGE(PG8_SA(0, 1), cA + hstepA, voffA);
        if (wr == 1) PG8_BAR;
        PG8_WAIT_V(4); PG8_BAR;
        PG8_STAGE(PG8_SB(1, 0), cB + kstep, voffB); PG8_STAGE(PG8_SA(1, 0), cA + kstep, voffA); PG8_STAGE(PG8_SB(1, 1), cB + hstepB + kstep, voffB);
        PG8_WAIT_V(6); PG8_BAR;
    }
    for (;;) {
        const bool has_next = S.next(ui + 1, nxt);
        const char* nA = has_next ? (const char*)g.A + (size_t)nxt.pm * tstepA + (size_t)nxt.ko * 2 : cA; const char* nB = has_next ? (const char*)g.Bt + (size_t)nxt.pn * tstepB + (size_t)nxt.ko * 2 : cB;
        for (int t = 0; t < nt; t += 2) {
            const bool last = (t == nt - 2);
            const char* a1 = cA + (size_t)(t + 1) * kstep;
            const char* a2 = last ? nA : cA + (size_t)(t + 2) * kstep; const char* b2 = last ? nB : cB + (size_t)(t + 2) * kstep;
            const char* a3 = a2 + kstep; const char* b3 = b2 + kstep;
            if (last && has_next) S.a_ready(nxt);
            if constexpr (SP2) {
            PG8_LDB(B0, 0, 0); PG8_LDB(B1, 0, 1); PG8_SCHED; PG8_LDA(At, 0, 0); PG8_STAGE(PG8_SA(1, 1), a1 + hstepA, voffA);
            PG8_WAIT_V(8); PG8_WAIT_L(0); PG8_BAR; PG8_MMA(0, 0, At, B0); PG8_MMA(0, 1, At, B1); PG8_BAR; PG8_SCHED;
            PG8_LDA(At, 0, 1); PG8_STAGE(PG8_SB(0, 0), b2, voffB); PG8_STAGE(PG8_SB(0, 1), b2 + hstepB, voffB); PG8_STAGE(PG8_SA(0, 0), a2, voffA);
            PG8_WAIT_V(8); PG8_WAIT_L(0); PG8_BAR; PG8_MMA(1, 0, At, B0); PG8_MMA(1, 1, At, B1); PG8_BAR; PG8_SCHED;
            PG8_LDB(B0, 1, 0); PG8_LDB(B1, 1, 1); PG8_SCHED; PG8_LDA(At, 1, 0); PG8_STAGE(PG8_SA(0, 1), a2 + hstepA, voffA);
            PG8_WAIT_V(8); PG8_WAIT_L(0); PG8_BAR; PG8_MMA(0, 0, At, B0); PG8_MMA(0, 1, At, B1); PG8_BAR; PG8_SCHED;
            PG8_LDA(At, 1, 1); PG8_STAGE(PG8_SB(1, 0), b3, voffB); PG8_STAGE(PG8_SB(1, 1), b3 + hstepB, voffB); PG8_STAGE(PG8_SA(1, 0), a3, voffA);
            PG8_WAIT_V(8); PG8_WAIT_L(0); PG8_BAR; PG8_MMA(1, 0, At, B0); PG8_MMA(1, 1, At, B1); PG8_BAR; PG8_SCHED;
            } else {
            PG8_LDB(B0, 0, 0); PG8_SCHED; PG8_LDA(At, 0, 0); PG8_STAGE(PG8_SA(1, 1), a1 + hstepA, voffA);
            PG8_WAIT_L(8); PG8_BAR; PG8_WAIT_L(0); PG8_MMA(0, 0, At, B0); PG8_BAR; PG8_SCHED;
            PG8_LDB(B1, 0, 1); PG8_STAGE(PG8_SB(0, 0), b2, voffB);
            PG8_BAR; PG8_WAIT_L(0); PG8_MMA(0, 1, At, B1); PG8_BAR;
            PG8_LDA(At, 0, 1); PG8_STAGE(PG8_SA(0, 0), a2, voffA);
            PG8_BAR; PG8_WAIT_L(0); PG8_MMA(1, 0, At, B0); PG8_BAR; PG8_SCHED;
            PG8_STAGE(PG8_SB(0, 1), b2 + hstepB, voffB);
            PG8_WAIT_V(6); PG8_BAR; PG8_MMA(1, 1, At, B1); PG8_BAR;
            PG8_LDB(B0, 1, 0); PG8_SCHED; PG8_LDA(At, 1, 0); PG8_STAGE(PG8_SA(0, 1), a2 + hstepA, voffA);
            PG8_WAIT_L(8); PG8_BAR; PG8_WAIT_L(0); PG8_MMA(0, 0, At, B0); PG8_BAR; PG8_SCHED;
            PG8_LDB(B1, 1, 1); PG8_STAGE(PG8_SB(1, 0), b3, voffB);
            PG8_BAR; PG8_WAIT_L(0); PG8_MMA(0, 1, At, B1); PG8_BAR;
            PG8_LDA(At, 1, 1); PG8_STAGE(PG8_SA(1, 0), a3, voffA);
            PG8_BAR; PG8_WAIT_L(0); PG8_MMA(1, 0, At, B0); PG8_BAR; PG8_SCHED;
            PG8_STAGE(PG8_SB(1, 1), b3 + hstepB, voffB);
            PG8_WAIT_V(6); PG8_BAR; PG8_MMA(1, 1, At, B1); PG8_BAR;
            }
        }
        if constexpr (ALIGN_EPI) { if (wr == 0) PG8_BAR; }
        if constexpr (!Epi::AFTER_DRAIN) { E(acc, cur, wr, wc, fr, fq); S.done(cur); }
        if (!has_next) break;
#pragma unroll
        for (int a = 0; a < 2; ++a)
#pragma unroll
            for (int b = 0; b < 2; ++b)
#pragma unroll
                for (int m = 0; m < 4; ++m)
#pragma unroll
                    for (int n = 0; n < 2; ++n) acc[a][b][m][n] = (f32x4){0.f, 0.f, 0.f, 0.f};
        cur = nxt; cA = nA; cB = nB; ++ui;
        if constexpr (ALIGN_EPI) { if (wr == 1) PG8_BAR; }
    }
    PG8_WAIT_V(0);
    if constexpr (!ALIGN_EPI) { if (wr == 0) PG8_BAR; }
    PG8_BAR;
    if constexpr (Epi::AFTER_DRAIN) { E.fused(acc, cur, wr, wc, fr, fq, lds, wid, lane); S.done(cur); }
#undef PG8_SA
#undef PG8_SB
#undef PG8_STAGE
#undef PG8_LDA
#undef PG8_LDB
#undef PG8_MMA
#undef PG8_WAIT_V
#undef PG8_WAIT_L
#undef PG8_BAR
#undef PG8_SCHED
}
}

namespace pg8 {
struct OrderPM : StaticOrder {
    int pm0;
    __device__ __forceinline__ bool next(int i, Unit& u) const { if (!StaticOrder::next(i, u)) return false; u.pm += pm0; return true; }
};
struct MoeOrder {
    int nN, G, c, ntiles; const unsigned* tile_e;
    __device__ __forceinline__ bool next(int i, Unit& u) const {
        const long L = (long)i * G + c; if (L >= (long)ntiles * nN) return false;
        const int pm = (int)(L / nN), pl = (int)(L % nN);
        const int e = (int)__hip_atomic_load(tile_e + pm, __ATOMIC_RELAXED, __HIP_MEMORY_SCOPE_AGENT);
        u.pm = pm; u.pn = __builtin_amdgcn_readfirstlane(e) * nN + pl; u.ko = 0; return true;
    }
    __device__ __forceinline__ void a_ready(const Unit&) const {}
    __device__ __forceinline__ void done(const Unit&) const {}
};

struct SplitKOrder {
    int G, c, ns, kslice;
    __device__ __forceinline__ bool next(int i, Unit& u) const { const int L = i * G + c; if (L >= 16 * ns) return false; const int sl = L % ns, t = L / ns; u.pm = t & 3; u.pn = t >> 2; u.ko = sl * kslice; return true; }
    __device__ __forceinline__ void a_ready(const Unit&) const {}
    __device__ __forceinline__ void done(const Unit&) const {}
};
struct EpiStore {
    static constexpr bool PERM = true, AFTER_DRAIN = false;
    bf16_t* O; int ldc; int pn_mod;
    __device__ __forceinline__ void operator()(const f32x4 (&acc)[2][2][4][2], const Unit& u, int wr, int wc, int fr, int fq) const {
        const int row0 = u.pm * BM + wr * 64 + fr, col0 = (u.pn % pn_mod) * BM + wc * 32 + 8 * fq;
#pragma unroll
        for (int ai = 0; ai < 2; ++ai)
#pragma unroll
            for (int m = 0; m < 4; ++m) { bf16_t* rowp = O + (size_t)(row0 + ai * HALF + m * 16) * ldc + col0;
#pragma unroll
                for (int bj = 0; bj < 2; ++bj) { const f32x4 v0 = acc[ai][bj][m][0], v1 = acc[ai][bj][m][1];
                    u32x4 w; w.x = cvt_pk_bf16(v0[0], v0[1]); w.y = cvt_pk_bf16(v0[2], v0[3]); w.z = cvt_pk_bf16(v1[0], v1[1]); w.w = cvt_pk_bf16(v1[2], v1[3]);
                    *(u32x4*)(rowp + bj * HALF) = w; } }
    }
};
struct EpiUp {
    static constexpr bool PERM = true, AFTER_DRAIN = false;
    bf16_t* Q; bf16_t* K;
    __device__ __forceinline__ void operator()(const f32x4 (&acc)[2][2][4][2], const Unit& u, int wr, int wc, int fr, int fq) const {
        const int row0 = u.pm * BM + wr * 64 + fr;
#pragma unroll
        for (int bj = 0; bj < 2; ++bj) {
            const int col = u.pn * BM + bj * HALF + wc * 32 + 8 * fq;
            bf16_t* base;
            if (col < 384) base = Q + col; else if (col < 640) { const int c2 = col - 384; base = K + (c2 >> 6) * 96 + (c2 & 63); } else continue;
#pragma unroll
            for (int ai = 0; ai < 2; ++ai)
#pragma unroll
                for (int m = 0; m < 4; ++m) { const f32x4 v0 = acc[ai][bj][m][0], v1 = acc[ai][bj][m][1];
                    u32x4 w; w.x = cvt_pk_bf16(v0[0], v0[1]); w.y = cvt_pk_bf16(v0[2], v0[3]); w.z = cvt_pk_bf16(v1[0], v1[1]); w.w = cvt_pk_bf16(v1[2], v1[3]);
                    *(u32x4*)(base + (size_t)(row0 + ai * HALF + m * 16) * 384) = w; }
        }
    }
};
template <bool ATOMIC> struct EpiResT {
    static constexpr bool PERM = false, AFTER_DRAIN = false;
    float* H; const float* gate;
    __device__ __forceinline__ void operator()(const f32x4 (&acc)[2][2][4][2], const Unit& u, int wr, int wc, int fr, int fq) const {
        const int row0 = u.pm * BM + wr * 64 + fr, col0 = u.pn * BM + wc * 32 + 4 * fq;
        const int mb = (u.pm < 4) ? 4 : ((u.pm - 4) >> 4);
        const float* gp = gate + (size_t)mb * 6144 + col0;
        f32x4 gv[2][2];
#pragma unroll
        for (int bj = 0; bj < 2; ++bj)
#pragma unroll
            for (int n = 0; n < 2; ++n) gv[bj][n] = *(const f32x4*)(gp + bj * HALF + n * 16);
#pragma unroll
        for (int ai = 0; ai < 2; ++ai)
#pragma unroll
            for (int m = 0; m < 4; ++m) { float* rowp = H + (size_t)(row0 + ai * HALF + m * 16) * D + col0;
#pragma unroll
                for (int bj = 0; bj < 2; ++bj)
#pragma unroll
                    for (int n = 0; n < 2; ++n) { float* pp = rowp + bj * HALF + n * 16; const f32x4 v = gv[bj][n] * acc[ai][bj][m][n];
                        f32x4* p = (f32x4*)pp; *p = *p + v; } }
    }
};
typedef EpiResT<false> EpiRes;
struct EpiSlab {
    static constexpr bool PERM = false, AFTER_DRAIN = false;
    float* slab; const float* gate; int kslice;
    __device__ __forceinline__ void operator()(const f32x4 (&acc)[2][2][4][2], const Unit& u, int wr, int wc, int fr, int fq) const {
        const int row0 = u.pm * BM + wr * 64 + fr, col0 = u.pn * BM + wc * 32 + 4 * fq;
        const float* gp = gate + (size_t)4 * 6144 + col0; float* sb = slab + (size_t)(u.ko / kslice) * MC * D;
        f32x4 gv[2][2];
#pragma unroll
        for (int bj = 0; bj < 2; ++bj)
#pragma unroll
            for (int n = 0; n < 2; ++n) gv[bj][n] = *(const f32x4*)(gp + bj * HALF + n * 16);
#pragma unroll
        for (int ai = 0; ai < 2; ++ai)
#pragma unroll
            for (int m = 0; m < 4; ++m) { float* rowp = sb + (size_t)(row0 + ai * HALF + m * 16) * D + col0;
#pragma unroll
                for (int bj = 0; bj < 2; ++bj)
#pragma unroll
                    for (int n = 0; n < 2; ++n) *(f32x4*)(rowp + bj * HALF + n * 16) = gv[bj][n] * acc[ai][bj][m][n]; }
    }
};
struct EpiSwiGLU {
    static constexpr bool PERM = true, AFTER_DRAIN = false;
    bf16_t* Hd;
    __device__ __forceinline__ void operator()(const f32x4 (&acc)[2][2][4][2], const Unit& u, int wr, int wc, int fr, int fq) const {
        const int row0 = u.pm * BM + wr * 64 + fr, col0 = (u.pn % 28) * HALF + wc * 32 + 8 * fq;
#pragma unroll
        for (int ai = 0; ai < 2; ++ai)
#pragma unroll
            for (int m = 0; m < 4; ++m) {
                float o[8];
#pragma unroll
                for (int n = 0; n < 2; ++n)
#pragma unroll
                    for (int q = 0; q < 4; ++q) { const float g = acc[ai][0][m][n][q], up = acc[ai][1][m][n][q]; o[n * 4 + q] = g / (1.f + __expf(-g)) * up; }
                u32x4 w; w.x = cvt_pk_bf16(o[0], o[1]); w.y = cvt_pk_bf16(o[2], o[3]); w.z = cvt_pk_bf16(o[4], o[5]); w.w = cvt_pk_bf16(o[6], o[7]);
                *(u32x4*)(Hd + (size_t)(row0 + ai * HALF + m * 16) * DFF + col0) = w; }
    }
};
}

enum { I_X = 0, I_C, I_CTX, I_CCTX, I_WMOD, I_BMOD, I_NORM1, I_NORM2, I_WIN, I_WOUT, I_SINK, I_GCONV, I_GALOG, I_GDTB, I_GNORM, I_QNORM, I_KVNORM, I_WQUP, I_WKVUP,
       I_RLOGD, I_RNORM, I_FGATE, I_FUP, I_FDOWN, I_ROUTER, I_MGATE, I_MUP, I_MDOWN, I_FNORM, N_IN };
struct Params { const float* in[N_IN]; float* out; unsigned char* ws; int ph_lo, ph_hi; };
typedef const __attribute__((address_space(4))) Params* KArg;
__device__ __forceinline__ KArg kp_get() { KArg k = (KArg)__builtin_amdgcn_kernarg_segment_ptr(); asm volatile("" : "+s"(k)); return k; }

struct Ctx {
    LAS unsigned char* lds; int tid, lane, wave, bid, G;
};

__device__ __forceinline__ void tr_item(const float* src, int ldsrc, int nvalid, int k0, int c0, bf16_t* dst, int ldd, int drow0, LAS float* scr, int lane) {
    const int cl = 4 * (lane & 15), rr = lane >> 4, cc = c0 + cl; const bool ok = cc < nvalid;
    f32x4 v[16];
#pragma unroll
    for (int i = 0; i < 16; ++i) v[i] = ok ? *(const f32x4*)(src + (size_t)(k0 + 4 * i + rr) * ldsrc + cc) : (f32x4){0.f, 0.f, 0.f, 0.f};
#pragma unroll
    for (int i = 0; i < 16; ++i) { LAS float* d = scr + (4 * i + rr) * 65 + cl; d[0] = v[i].x; d[1] = v[i].y; d[2] = v[i].z; d[3] = v[i].w; }
    asm volatile("s_waitcnt lgkmcnt(0)" ::: "memory");
    const int c = lane & 7;
#pragma unroll
    for (int j = 0; j < 8; ++j) { const int n = (lane >> 3) + 8 * j; const LAS float* s = scr + (8 * c) * 65 + n;
        u32x4 o; o.x = cvtpk(s[0 * 65], s[1 * 65]); o.y = cvtpk(s[2 * 65], s[3 * 65]); o.z = cvtpk(s[4 * 65], s[5 * 65]); o.w = cvtpk(s[6 * 65], s[7 * 65]);
        *(u32x4*)(dst + (size_t)(drow0 + n) * ldd + k0 + 8 * c) = o; }
    asm volatile("s_waitcnt lgkmcnt(0)" ::: "memory");
}
__device__ __forceinline__ void ffn_tr_item(const float* g, const float* u, const float* d, bf16_t* gu, bf16_t* dn, int it, LAS float* scr, int lane) {
    if (it < 1792) { const bool up = it >= 896; const int r = up ? it - 896 : it; const int kb = r / 56, cb = r % 56, c0 = 64 * cb;
        tr_item(up ? u : g, DFF, DFF, 64 * kb, c0, gu, 1024, 256 * (c0 >> 7) + (up ? 128 : 0) + (c0 & 127), scr, lane); }
    else { const int r = it - 1792; const int kb = r / 16, cb = r % 16; tr_item(d, 1024, 1024, 64 * kb, 64 * cb, dn, DFF, 64 * cb, scr, lane); }
}

__device__ __forceinline__ void convert_layer_weights(KArg p, const Ctx& C, int ln, int gw, int NGW) {
    unsigned char* ws = p->ws; LAS float* scr = (LAS float*)(C.lds + C.wave * 16640);
    constexpr int I_IN = 16 * 48, I_OUT = 16 * 16, I_FF = 2688;
    const bool moe = (ln & 1) != 0; const int i = ln >> 1;
    const int nit = I_IN + I_OUT + (moe ? 8 * I_FF : I_FF);
    for (int it = gw; it < nit; it += NGW) {
        int r = it;
        if (r < I_IN) { const int kb = r / 48, cb = r % 48;
            tr_item(p->in[I_WIN] + (size_t)ln * D * DIN, DIN, DIN, 64 * kb, 64 * cb, (bf16_t*)(ws + WS_WIN) + (size_t)ln * DINP * D, D, 64 * cb, scr, C.lane); continue; }
        r -= I_IN;
        if (r < I_OUT) { const int kb = r / 16, cb = r % 16;
            tr_item(p->in[I_WOUT] + (size_t)ln * D * D, D, D, 64 * kb, 64 * cb, (bf16_t*)(ws + WS_WOUT) + (size_t)ln * D * D, D, 64 * cb, scr, C.lane); continue; }
        r -= I_OUT;
        if (!moe) { bf16_t* gu = (bf16_t*)(ws + WS_WFF + (size_t)i * FFW_BYTES);
            ffn_tr_item(p->in[I_FGATE] + (size_t)i * D * DFF, p->in[I_FUP] + (size_t)i * D * DFF, p->in[I_FDOWN] + (size_t)i * DFF * D, gu, gu + (size_t)7168 * 1024, r, scr, C.lane); }
        else { const int e = r / I_FF; r %= I_FF; const size_t eo = (size_t)i * NE + e;
            bf16_t* gu = (bf16_t*)(ws + WS_WMOE) + (size_t)e * 7168 * 1024; bf16_t* dn = (bf16_t*)(ws + WS_WMOE) + (size_t)8 * 7168 * 1024 + (size_t)e * 1024 * DFF;
            ffn_tr_item(p->in[I_MGATE] + eo * D * DFF, p->in[I_MUP] + eo * D * DFF, p->in[I_MDOWN] + eo * DFF * D, gu, dn, r, scr, C.lane); }
    }
}

__device__ __forceinline__ void prologue_phase(KArg p, const Ctx& C) {
    unsigned char* ws = p->ws;
    const int gw = C.bid * NWAVES + C.wave, NGW = C.G * NWAVES, gt = C.bid * NTHR + C.tid, NGT = C.G * NTHR;
    convert_layer_weights(p, C, 0, gw, NGW);
    {
        constexpr int PER_L = 256 * 128 + 1024 * 64 + 256 * 64;
        for (int it = gt; it < 4 * PER_L; it += NGT) {
            const int l = it / PER_L; int r = it % PER_L;
            const float* win = p->in[I_WIN] + (size_t)l * D * DIN; const float* qup = p->in[I_WQUP] + (size_t)l * 256 * 384; const float* kvup = p->in[I_WKVUP] + (size_t)l * 128 * 512;
            float v[8]; bf16_t* dst;
            if (r < 256 * 128) { const int n = r % 256, kg = r / 256;
#pragma unroll
                for (int j = 0; j < 8; ++j) v[j] = (n < 128) ? win[(size_t)(8 * kg + j) * DIN + PC_AV + n] : 0.f;
                dst = (bf16_t*)(ws + WS_WINV) + ((size_t)l * 256 + n) * 1024 + 8 * kg; }
            else if ((r -= 256 * 128) < 1024 * 64) { const int n = r % 1024, kg = r / 1024;
#pragma unroll
                for (int j = 0; j < 8; ++j) { const int k = 8 * kg + j; float x = 0.f;
                    if (n < 384) { if (k < 256) x = qup[(size_t)k * 384 + n]; }
                    else if (n < 640) { const int c2 = n - 384; if (k >= 256 && k < 384) x = kvup[(size_t)(k - 256) * 512 + 128 * (c2 >> 6) + (c2 & 63)]; }
                    v[j] = x; }
                dst = (bf16_t*)(ws + WS_WUP) + ((size_t)l * 1024 + n) * 512 + 8 * kg; }
            else { r -= 1024 * 64; const int n = r % 256, kg = r / 256;
#pragma unroll
                for (int j = 0; j < 8; ++j) { const int k = 8 * kg + j; v[j] = (k >= 256 && k < 384) ? kvup[(size_t)(k - 256) * 512 + 128 * (n >> 6) + 64 + (n & 63)] : 0.f; }
                dst = (bf16_t*)(ws + WS_WUPV) + ((size_t)l * 256 + n) * 512 + 8 * kg; }
            u32x4 o; o.x = cvtpk(v[0], v[1]); o.y = cvtpk(v[2], v[3]); o.z = cvtpk(v[4], v[5]); o.w = cvtpk(v[6], v[7]);
            *(u32x4*)dst = o;
        }
    }
    {
        float* tab = (float*)(ws + WS_TAB);
        for (int it = gt; it < 64 * 16 + 64 * 8; it += NGT) {
            if (it < 1024) { const int pos = it >> 4, j = it & 15; const float inv = (float)pow(10000.0, -(double)j / 16.0); const float ang = (float)pos * inv;
                tab[it] = (float)cos((double)ang); tab[1024 + it] = (float)sin((double)ang); }
            else { const int r = it - 1024; const int pos = r >> 3, j = r & 7; const float inv = (float)pow(10000.0, -(double)j / 8.0); const float ang = (float)pos * inv;
                tab[2048 + r] = (float)cos((double)ang); tab[2560 + r] = (float)sin((double)ang); }
        }
    }
    {
        f32x4* H4 = (f32x4*)(ws + WS_H); const f32x4* x4 = (const f32x4*)p->in[I_X]; const f32x4* c4 = (const f32x4*)p->in[I_CTX];
        for (int it = gt; it < MT * 256; it += NGT) H4[it] = (it < MC * 256) ? c4[it] : x4[it - MC * 256];
    }
    __syncthreads();
    if (C.bid < 192) {
        LAS float* sl = (LAS float*)C.lds;
        LAS float* red = (LAS float*)(C.lds + 20480);
        for (int i = C.tid; i < 5 * 1024; i += NTHR) { const int r = i >> 10, k = i & 1023; const float cv = (r < 4) ? p->in[I_C][r * 1024 + k] : p->in[I_CCTX][k]; sl[i] = silu_f(cv); }
        __syncthreads();
        for (int it = C.bid; it < 192; it += C.G) {
            const int l = it / 48, cb = it % 48, cl = C.tid & 127, kq = C.tid >> 7, col = cb * 128 + cl;
            const float* w = p->in[I_WMOD] + (size_t)l * D * 6144 + col;
            float a0 = 0.f, a1 = 0.f, a2 = 0.f, a3 = 0.f, a4 = 0.f;
#pragma unroll 8
            for (int k = 256 * kq; k < 256 * kq + 256; ++k) { const float wv = w[(size_t)k * 6144]; a0 += sl[k] * wv; a1 += sl[1024 + k] * wv; a2 += sl[2048 + k] * wv; a3 += sl[3072 + k] * wv; a4 += sl[4096 + k] * wv; }
            red[(kq * 5 + 0) * 128 + cl] = a0; red[(kq * 5 + 1) * 128 + cl] = a1; red[(kq * 5 + 2) * 128 + cl] = a2; red[(kq * 5 + 3) * 128 + cl] = a3; red[(kq * 5 + 4) * 128 + cl] = a4;
            __syncthreads();
            for (int i = C.tid; i < 5 * 128; i += NTHR) { const int r = i >> 7, c2 = i & 127; const int cc = cb * 128 + c2;
                const float s = red[(0 * 5 + r) * 128 + c2] + red[(1 * 5 + r) * 128 + c2] + red[(2 * 5 + r) * 128 + c2] + red[(3 * 5 + r) * 128 + c2] + p->in[I_BMOD][l * 6144 + cc];
                ((float*)(ws + WS_MOD))[((size_t)l * 5 + r) * 6144 + cc] = s; }
            __syncthreads();
        }
    }
}
template <int MODE>
__device__ __forceinline__ void norm_phase(KArg p, const Ctx& C, int l, bool comb, int lprev, bool moe, int row_min, int nslab) {
    unsigned char* ws = p->ws;
    float* H = (float*)(ws + WS_H); bf16_t* U = (bf16_t*)(ws + WS_U); const float* MOD = (const float*)(ws + WS_MOD);
    int* RE = (int*)(ws + WS_ROUTE); float* RW = (float*)(ws + WS_ROUTE + (size_t)MT * 8); const int* RP = (const int*)(ws + WS_ROUTE + (size_t)MT * 16);
    const bf16_t* YD = (const bf16_t*)(ws + WS_YD);
    LAS unsigned* lcnt = (LAS unsigned*)C.lds;
    if (MODE == 1 && moe) { if (C.tid < 8) lcnt[C.tid] = 0u; __syncthreads(); }
    const int rbase = (MT / 256) * C.bid;
    for (int ri = C.wave; ri < MT / 256; ri += NWAVES) {
        const int row = rbase + ri; if (row < row_min) continue;
        const int mb = mod_row(row);
        f32x4 v[4];
#pragma unroll
        for (int j = 0; j < 4; ++j) v[j] = *(const f32x4*)(H + (size_t)row * D + 4 * C.lane + 256 * j);
        if (comb) {
            const int p0 = RP[row * 2], p1 = RP[row * 2 + 1]; const float w0 = RW[row * 2], w1 = RW[row * 2 + 1];
            const float* g2 = MOD + ((size_t)lprev * 5 + mb) * 6144 + 5 * 1024;
#pragma unroll
            for (int j = 0; j < 4; ++j) { const int e = 4 * C.lane + 256 * j;
                const u32x2 y0 = *(const u32x2*)(YD + (size_t)p0 * D + e), y1 = *(const u32x2*)(YD + (size_t)p1 * D + e); const f32x4 g = *(const f32x4*)(g2 + e);
                v[j].x += g.x * (w0 * bf_lo(y0.x) + w1 * bf_lo(y1.x)); v[j].y += g.y * (w0 * bf_hi(y0.x) + w1 * bf_hi(y1.x));
                v[j].z += g.z * (w0 * bf_lo(y0.y) + w1 * bf_lo(y1.y)); v[j].w += g.w * (w0 * bf_hi(y0.y) + w1 * bf_hi(y1.y));
                if (MODE != 2) *(f32x4*)(H + (size_t)row * D + e) = v[j]; }
        }
        if (nslab > 0 && row < MC) {
            const float* sl = (const float*)(ws + WS_SLAB) + (size_t)row * D;
            for (int s = 0; s < nslab; ++s)
#pragma unroll
                for (int j = 0; j < 4; ++j) v[j] += *(const f32x4*)(sl + (size_t)s * MC * D + 4 * C.lane + 256 * j);
#pragma unroll
            for (int j = 0; j < 4; ++j) *(f32x4*)(H + (size_t)row * D + 4 * C.lane + 256 * j) = v[j];
        }
        float ss = 0.f;
#pragma unroll
        for (int j = 0; j < 4; ++j) ss += (v[j].x * v[j].x + v[j].y * v[j].y) + (v[j].z * v[j].z + v[j].w * v[j].w);
        const float rstd = rsqrtf(wave_sum(ss) * (1.f / D) + EPS);
        if (MODE == 2) {
            const float* gam = p->in[I_FNORM];
#pragma unroll
            for (int j = 0; j < 4; ++j) { const int e = 4 * C.lane + 256 * j; const f32x4 g = *(const f32x4*)(gam + e); *(f32x4*)(p->out + (size_t)(row - MC) * D + e) = v[j] * rstd * g; }
        } else {
            const float* gam = p->in[MODE == 0 ? I_NORM1 : I_NORM2] + (size_t)l * D;
            const float* sh = MOD + ((size_t)l * 5 + mb) * 6144 + (MODE == 0 ? 0 : 3) * 1024; const float* sc = sh + 1024;
            f32x4 y[4];
#pragma unroll
            for (int j = 0; j < 4; ++j) { const int e = 4 * C.lane + 256 * j; const f32x4 g = *(const f32x4*)(gam + e), s1 = *(const f32x4*)(sc + e), s0 = *(const f32x4*)(sh + e);
                y[j] = v[j] * rstd * g * (1.f + s1) + s0;
                u32x2 o; o.x = cvtpk(y[j].x, y[j].y); o.y = cvtpk(y[j].z, y[j].w); *(u32x2*)(U + (size_t)row * D + e) = o; }
            if (MODE == 1 && moe) {
                const float* wr = p->in[I_ROUTER] + (size_t)(l >> 1) * D * NE;
                float lg[8];
#pragma unroll
                for (int e = 0; e < 8; ++e) lg[e] = 0.f;
#pragma unroll
                for (int j = 0; j < 4; ++j)
#pragma unroll
                    for (int q = 0; q < 4; ++q) { const int e = 4 * C.lane + 256 * j + q; const f32x4 wa = *(const f32x4*)(wr + (size_t)e * 8), wb = *(const f32x4*)(wr + (size_t)e * 8 + 4); const float yv = y[j][q];
                        lg[0] += yv * wa.x; lg[1] += yv * wa.y; lg[2] += yv * wa.z; lg[3] += yv * wa.w; lg[4] += yv * wb.x; lg[5] += yv * wb.y; lg[6] += yv * wb.z; lg[7] += yv * wb.w; }
#pragma unroll
                for (int e = 0; e < 8; ++e) lg[e] = wave_sum(lg[e]);
                int e0 = 0; float v0 = lg[0];
#pragma unroll
                for (int e = 1; e < 8; ++e) if (lg[e] > v0) { v0 = lg[e]; e0 = e; }
                int e1 = -1; float v1 = -3.0e38f;
#pragma unroll
                for (int e = 0; e < 8; ++e) if (e != e0 && lg[e] > v1) { v1 = lg[e]; e1 = e; }
                const float t = __expf(v1 - v0), w0 = 1.f / (1.f + t), w1 = t * w0;
                if (C.lane == 0) { RE[row * 2] = e0; RE[row * 2 + 1] = e1; RW[row * 2] = w0; RW[row * 2 + 1] = w1; atomicAdd((unsigned*)&lcnt[e0], 1u); atomicAdd((unsigned*)&lcnt[e1], 1u); }
            }
        }
    }
    if (MODE == 1 && moe) { __syncthreads(); if (C.tid < 8) __hip_atomic_store((unsigned*)(ws + WS_CTL) + CW_CNT + C.bid * 8 + C.tid, lcnt[C.tid], __ATOMIC_RELAXED, __HIP_MEMORY_SCOPE_AGENT); }
}

__device__ __forceinline__ void moe_gather_phase(KArg p, const Ctx& C, int row_min) {
    unsigned char* ws = p->ws;
    unsigned* ctl = (unsigned*)(ws + WS_CTL);
    const int* RE = (const int*)(ws + WS_ROUTE); int* RP = (int*)(ws + WS_ROUTE + (size_t)MT * 16);
    const bf16_t* U = (const bf16_t*)(ws + WS_U); bf16_t* AS = (bf16_t*)(ws + WS_ASORT);
    LAS unsigned* cn = (LAS unsigned*)C.lds;
    LAS int* myoff = (LAS int*)(C.lds + 8192);
    LAS int* base = (LAS int*)(C.lds + 8192 + 64);
    LAS int* pos = (LAS int*)(C.lds + 8192 + 128);
    for (int i = C.tid; i < 2048; i += NTHR) cn[i] = __hip_atomic_load(ctl + CW_CNT + i, __ATOMIC_RELAXED, __HIP_MEMORY_SCOPE_AGENT);
    __syncthreads();
    if (C.tid < 8) { int tot = 0, mine = 0; for (int b = 0; b < 256; ++b) { const int c = (int)cn[b * 8 + C.tid]; if (b < C.bid) mine += c; tot += c; } myoff[C.tid] = mine; base[C.tid] = (tot + 255) & ~255; }
    __syncthreads();
    if (C.tid == 0) {
        int b0 = 0; for (int e = 0; e < 8; ++e) { const int t = base[e]; base[e] = b0; myoff[e] += b0; b0 += t; } base[8] = b0;
        const int rbase = (MT / 256) * C.bid;
        for (int ri = 0; ri < MT / 256; ++ri) { const int row = rbase + ri; if (row < row_min) { pos[ri * 2] = -1; pos[ri * 2 + 1] = -1; continue; }
            for (int k = 0; k < 2; ++k) { const int e = RE[row * 2 + k]; const int ps = myoff[e]++; pos[ri * 2 + k] = ps; RP[row * 2 + k] = ps; } }
    }
    __syncthreads();
    if (C.bid == 0) {
        const int ntiles = base[8] >> 8;
        if (C.tid < MOE_TILES) { int e = 0; for (int q = 1; q < 8; ++q) if (C.tid * 256 >= base[q]) e = q; __hip_atomic_store(ctl + CW_TILEE + C.tid, (unsigned)e, __ATOMIC_RELAXED, __HIP_MEMORY_SCOPE_AGENT); }
        if (C.tid == 0) __hip_atomic_store(ctl + CW_TILEE + 160, (unsigned)ntiles, __ATOMIC_RELAXED, __HIP_MEMORY_SCOPE_AGENT);
    }
    const int rbase = (MT / 256) * C.bid;
    for (int it = C.tid; it < (MT / 256) * 2 * 128; it += NTHR) { const int slot = it >> 7, ch = it & 127; const int ps = pos[slot]; if (ps < 0) continue;
        *(u32x4*)(AS + (size_t)ps * D + 8 * ch) = *(const u32x4*)(U + (size_t)(rbase + (slot >> 1)) * D + 8 * ch); }
}

__device__ __forceinline__ void prep_phase(KArg p, const Ctx& C, int l) {
    unsigned char* ws = p->ws;
    const bf16_t* P = (const bf16_t*)(ws + WS_P); bf16_t* QS = (bf16_t*)(ws + WS_QS); bf16_t* KS = (bf16_t*)(ws + WS_KS); bf16_t* AUP = (bf16_t*)(ws + WS_AUP); bf16_t* KF = (bf16_t*)(ws + WS_KFULL);
    const float* tab = (const float*)(ws + WS_TAB);
    const float* qg = p->in[I_QNORM] + (size_t)l * 256; const float* kvg = p->in[I_KVNORM] + (size_t)l * 128;
    const int gw = C.bid * NWAVES + C.wave, NGW = C.G * NWAVES, lane = C.lane;
    for (int row = gw; row < MT; row += NGW) {
        const bf16_t* pr = P + (size_t)row * DINP;
        const bool lat = row >= MC; const int t = (row - MC) & 4095, prow = t >> 6, pcol = t & 63;
        {
            const int hd = lane >> 4, j = lane & 15;
            float c_r = 1.f, s_r = 0.f, c_c = 1.f, s_c = 0.f;
            if (lat) { c_r = tab[prow * 16 + j]; s_r = tab[1024 + prow * 16 + j]; c_c = tab[pcol * 16 + j]; s_c = tab[1024 + pcol * 16 + j]; }
            { const bf16_t* q = pr + PC_AQ + hd * 64; const float x1 = bf2f(q[j]), x2 = bf2f(q[16 + j]), x3 = bf2f(q[32 + j]), x4 = bf2f(q[48 + j]); const float qs = 0.125f * LOG2E;
              bf16_t* o = QS + (size_t)row * 256 + hd * 64;
              o[j] = f2bf((x1 * c_r - x2 * s_r) * qs); o[16 + j] = f2bf((x2 * c_r + x1 * s_r) * qs); o[32 + j] = f2bf((x3 * c_c - x4 * s_c) * qs); o[48 + j] = f2bf((x4 * c_c + x3 * s_c) * qs); }
            if (lane < 32) { const bf16_t* k = pr + PC_AK + hd * 64; const float x1 = bf2f(k[j]), x2 = bf2f(k[16 + j]), x3 = bf2f(k[32 + j]), x4 = bf2f(k[48 + j]);
              bf16_t* o = KS + (size_t)row * 128 + hd * 64;
              o[j] = f2bf(x1 * c_r - x2 * s_r); o[16 + j] = f2bf(x2 * c_r + x1 * s_r); o[32 + j] = f2bf(x3 * c_c - x4 * s_c); o[48 + j] = f2bf(x4 * c_c + x3 * s_c); }
        }
        {
            const u32x2 a = *(const u32x2*)(pr + PC_CQ + 4 * lane); const float q0 = bf_lo(a.x), q1 = bf_hi(a.x), q2 = bf_lo(a.y), q3 = bf_hi(a.y);
            const float rq = rsqrtf(wave_sum(q0 * q0 + q1 * q1 + q2 * q2 + q3 * q3) * (1.f / 256.f) + EPS);
            const f32x4 g = *(const f32x4*)(qg + 4 * lane);
            u32x2 o; o.x = cvtpk(q0 * rq * g.x, q1 * rq * g.y); o.y = cvtpk(q2 * rq * g.z, q3 * rq * g.w); *(u32x2*)(AUP + (size_t)row * 512 + 4 * lane) = o;
            const unsigned b = *(const unsigned*)(pr + PC_CKV + 2 * lane); const float k0 = bf_lo(b), k1 = bf_hi(b);
            const float rk = rsqrtf(wave_sum(k0 * k0 + k1 * k1) * (1.f / 128.f) + EPS);
            const f32x2 g2 = *(const f32x2*)(kvg + 2 * lane);
            *(unsigned*)(AUP + (size_t)row * 512 + 256 + 2 * lane) = cvtpk(k0 * rk * g2.x, k1 * rk * g2.y);
            *(unsigned*)(AUP + (size_t)row * 512 + 384 + 2 * lane) = 0u;
        }
        if (lane < 16) {
            const int part = lane >> 3, j = lane & 7; const float xa = bf2f(pr[PC_CKR + 16 * part + j]), xb = bf2f(pr[PC_CKR + 16 * part + 8 + j]);
            float cs = 1.f, sn = 0.f; if (lat) { const int ps = part ? pcol : prow; cs = tab[2048 + ps * 8 + j]; sn = tab[2560 + ps * 8 + j]; }
            const bf16_t oa = f2bf(xa * cs - xb * sn), ob = f2bf(xb * cs + xa * sn);
#pragma unroll
            for (int h = 0; h < 4; ++h) { bf16_t* o = KF + (size_t)row * 384 + h * 96 + 64 + 16 * part; o[j] = oa; o[8 + j] = ob; }
        }
    }
}

struct AttnArgs {
    const bf16_t* Q; int q_pitch, q_col0, q_row0;
    const bf16_t* K; int k_pitch, k_col0;
    const bf16_t* Vt; int vt_row0;
    int seg_tok0, seg_nt0, seg_tok1, seg_nt1;
    int qpos0, kpos0;
    float m_init, l_init, qscale;
    bf16_t* O; int o_col0;
    const float* tab32; int qt0;
};
template <int DQK, bool MASK, bool ROPEQ>
__device__ __forceinline__ void attn_unit(const Ctx& C, const AttnArgs& a) {
    constexpr int KP = DQK + 8, NCH = DQK / 8, KT_BYTES = 64 * KP * 2, VP = 68, VT_BYTES = 64 * VP * 2, BUF = KT_BYTES + VT_BYTES, NKS = DQK / 16;
    LAS unsigned char* lds = C.lds;
    const int lane = C.lane, c = lane & 31, hi = lane >> 5, w = C.wave, tid = C.tid;
    const int qi = 32 * w + c;
    bf16x8 qf[NKS];
    {
        const bf16_t* qp = a.Q + (size_t)(a.q_row0 + qi) * a.q_pitch + a.q_col0;
#pragma unroll
        for (int ks = 0; ks < NKS; ++ks) {
            const u32x4 raw = *(const u32x4*)(qp + 16 * ks + 8 * hi);
            float f[8] = {bf_lo(raw.x), bf_hi(raw.x), bf_lo(raw.y), bf_hi(raw.y), bf_lo(raw.z), bf_hi(raw.z), bf_lo(raw.w), bf_hi(raw.w)};
            if (ROPEQ && ks >= 4) {
                const u32x4 ro = *(const u32x4*)(qp + 16 * ks + 8 * (1 - hi));
                const float g[8] = {bf_lo(ro.x), bf_hi(ro.x), bf_lo(ro.y), bf_hi(ro.y), bf_lo(ro.z), bf_hi(ro.z), bf_lo(ro.w), bf_hi(ro.w)};
                const int t = a.qt0 + qi, ps = (ks == 4) ? (t >> 6) : (t & 63);
#pragma unroll
                for (int j = 0; j < 8; ++j) { const float cs = a.tab32[ps * 8 + j], sn = a.tab32[512 + ps * 8 + j]; f[j] = hi ? (f[j] * cs + g[j] * sn) : (f[j] * cs - g[j] * sn); }
            }
            qf[ks] = mk_frag4(cvtpk(f[0] * a.qscale, f[1] * a.qscale), cvtpk(f[2] * a.qscale, f[3] * a.qscale), cvtpk(f[4] * a.qscale, f[5] * a.qscale), cvtpk(f[6] * a.qscale, f[7] * a.qscale));
        }
    }
    f32x16 o0, o1;
#pragma unroll
    for (int r = 0; r < 16; ++r) { o0[r] = 0.f; o1[r] = 0.f; }
    float m = a.m_init, l = a.l_init;
    const int NT = a.seg_nt0 + a.seg_nt1;
    u32x4 kst[2]; u32x4 vst;
    auto tile_tok = [&](int t) { return t < a.seg_nt0 ? a.seg_tok0 + 64 * t : a.seg_tok1 + 64 * (t - a.seg_nt0); };
    auto g_load = [&](int t) {
        const int tk = tile_tok(t);
#pragma unroll
        for (int i = 0; i < 2; ++i) { const int ch = tid + 512 * i; if (ch < 64 * NCH) { const int r = ch / NCH, c8 = ch % NCH; kst[i] = *(const u32x4*)(a.K + (size_t)(tk + r) * a.k_pitch + a.k_col0 + 8 * c8); } }
        { const int r = tid >> 3, c8 = tid & 7; vst = *(const u32x4*)(a.Vt + (size_t)(a.vt_row0 + r) * MT + tk + 8 * c8); }
    };
    auto l_store = [&](int b) {
        LAS unsigned char* kb = lds + b * BUF; LAS unsigned char* vb = kb + KT_BYTES;
#pragma unroll
        for (int i = 0; i < 2; ++i) { const int ch = tid + 512 * i; if (ch < 64 * NCH) { const int r = ch / NCH, c8 = ch % NCH; *(LAS u32x4*)(kb + r * (KP * 2) + 16 * c8) = kst[i]; } }
        { const int r = tid >> 3, c8 = tid & 7; LAS u32x2* d = (LAS u32x2*)(vb + r * (VP * 2) + 16 * c8); u32x2 lo, hi2; lo.x = vst.x; lo.y = vst.y; hi2.x = vst.z; hi2.y = vst.w; d[0] = lo; d[1] = hi2; }
    };
    __syncthreads();
    g_load(0); l_store(0);
    __syncthreads();
    for (int t = 0; t < NT; ++t) {
        const int b = t & 1;
        if (t + 1 < NT) g_load(t + 1);
        LAS unsigned char* kb = lds + b * BUF; LAS unsigned char* vb = kb + KT_BYTES;
        f32x16 s0, s1;
#pragma unroll
        for (int r = 0; r < 16; ++r) { s0[r] = 0.f; s1[r] = 0.f; }
#pragma unroll
        for (int ks = 0; ks < NKS; ++ks) {
            const bf16x8 k0 = *(const LAS bf16x8*)(kb + c * (KP * 2) + 32 * ks + 16 * hi);
            const bf16x8 k1 = *(const LAS bf16x8*)(kb + (32 + c) * (KP * 2) + 32 * ks + 16 * hi);
            s0 = mfma32(k0, qf[ks], s0); s1 = mfma32(k1, qf[ks], s1);
        }
        if (MASK && t >= a.seg_nt0) {
            const int qpos = a.qpos0 + qi, kbase = a.kpos0 + 64 * (t - a.seg_nt0);
#pragma unroll
            for (int r = 0; r < 16; ++r) { const int k0p = kbase + crow(r, hi), d0 = qpos - k0p, d1 = d0 - 32;
                if (d0 > 128 || d0 < -128) s0[r] = -1e30f; if (d1 > 128 || d1 < -128) s1[r] = -1e30f; }
        }
        float mx = s0[0];
#pragma unroll
        for (int r = 1; r < 16; ++r) mx = fmaxf(mx, s0[r]);
#pragma unroll
        for (int r = 0; r < 16; ++r) mx = fmaxf(mx, s1[r]);
        mx = fmaxf(mx, __shfl_xor(mx, 32));
        const float mn = fmaxf(m, mx), alpha = __builtin_amdgcn_exp2f(m - mn); m = mn;
        float ls = 0.f;
#pragma unroll
        for (int r = 0; r < 16; ++r) { s0[r] = __builtin_amdgcn_exp2f(s0[r] - mn); s1[r] = __builtin_amdgcn_exp2f(s1[r] - mn); ls += s0[r] + s1[r]; }
        ls += __shfl_xor(ls, 32);
        l = l * alpha + ls;
#pragma unroll
        for (int r = 0; r < 16; ++r) { o0[r] *= alpha; o1[r] *= alpha; }
        bf16x8 pf[2][2];
#pragma unroll
        for (int s2 = 0; s2 < 2; ++s2) {
            pf[0][s2] = mk_frag4(cvtpk(s0[8 * s2 + 0], s0[8 * s2 + 1]), cvtpk(s0[8 * s2 + 2], s0[8 * s2 + 3]), cvtpk(s0[8 * s2 + 4], s0[8 * s2 + 5]), cvtpk(s0[8 * s2 + 6], s0[8 * s2 + 7]));
            pf[1][s2] = mk_frag4(cvtpk(s1[8 * s2 + 0], s1[8 * s2 + 1]), cvtpk(s1[8 * s2 + 2], s1[8 * s2 + 3]), cvtpk(s1[8 * s2 + 4], s1[8 * s2 + 5]), cvtpk(s1[8 * s2 + 6], s1[8 * s2 + 7]));
        }
#pragma unroll
        for (int kt = 0; kt < 2; ++kt)
#pragma unroll
            for (int s2 = 0; s2 < 2; ++s2) {
                const int ko = (32 * kt + 16 * s2 + 4 * hi) * 2;
                const LAS unsigned char* v0p = vb + c * (VP * 2) + ko; const LAS unsigned char* v1p = vb + (32 + c) * (VP * 2) + ko;
                const bf16x8 v0 = mk_frag(*(const LAS u32x2*)v0p, *(const LAS u32x2*)(v0p + 16));
                const bf16x8 v1 = mk_frag(*(const LAS u32x2*)v1p, *(const LAS u32x2*)(v1p + 16));
                o0 = mfma32(v0, pf[kt][s2], o0); o1 = mfma32(v1, pf[kt][s2], o1);
            }
        if (t + 1 < NT) l_store(b ^ 1);
        __syncthreads();
    }
    const float inv = 1.f / l;
    bf16_t* op = a.O + (size_t)(a.q_row0 + qi) * D + a.o_col0;
#pragma unroll
    for (int g = 0; g < 4; ++g) {
        u32x2 w0, w1;
        w0.x = cvtpk(o0[4 * g] * inv, o0[4 * g + 1] * inv); w0.y = cvtpk(o0[4 * g + 2] * inv, o0[4 * g + 3] * inv);
        w1.x = cvtpk(o1[4 * g] * inv, o1[4 * g + 1] * inv); w1.y = cvtpk(o1[4 * g + 2] * inv, o1[4 * g + 3] * inv);
        *(u32x2*)(op + 8 * g + 4 * hi) = w0; *(u32x2*)(op + 32 + 8 * g + 4 * hi) = w1;
    }
}

__device__ __forceinline__ void attn_dispatch(KArg p, const Ctx& C, int l, int u) {
    unsigned char* ws = p->ws;
    AttnArgs a;
    a.tab32 = (const float*)(ws + WS_TAB) + 2048; a.O = (bf16_t*)(ws + WS_MIX);
    if (u < 256 || (u >= 512 && u < 528)) {
        const bool ctxq = u >= 512; const int v = ctxq ? u - 512 : u;
        const int b = ctxq ? (v >> 2) : (v >> 6), h = ctxq ? (v & 3) : ((v >> 4) & 3), qb = ctxq ? 0 : (v & 15);
        a.Q = (const bf16_t*)(ws + WS_QRAW); a.q_pitch = 384; a.q_col0 = 96 * h; a.q_row0 = ctxq ? 256 * b : MC + 4096 * b + 256 * qb;
        a.K = (const bf16_t*)(ws + WS_KFULL); a.k_pitch = 384; a.k_col0 = 96 * h; a.Vt = (const bf16_t*)(ws + WS_VTM); a.vt_row0 = 64 * h;
        a.seg_tok0 = 256 * b; a.seg_nt0 = 4; a.seg_tok1 = MC + 4096 * b; a.seg_nt1 = ctxq ? 0 : 64; a.qpos0 = 0; a.kpos0 = 0;
        a.m_init = -1e30f; a.l_init = 0.f; a.qscale = 0.10206207261596575f * LOG2E; a.o_col0 = 512 + 64 * h; a.qt0 = 256 * qb;
        if (ctxq) attn_unit<96, false, false>(C, a); else attn_unit<96, false, true>(C, a);
    } else {
        const bool ctxq = u >= 528; const int v = ctxq ? u - 528 : u - 256;
        const int b = ctxq ? (v >> 2) : (v >> 6), hq = ctxq ? (v & 3) : ((v >> 4) & 3), qb = ctxq ? 0 : (v & 15), g = hq >> 1;
        a.Q = (const bf16_t*)(ws + WS_QS); a.q_pitch = 256; a.q_col0 = 64 * hq; a.q_row0 = ctxq ? 256 * b : MC + 4096 * b + 256 * qb;
        a.K = (const bf16_t*)(ws + WS_KS); a.k_pitch = 128; a.k_col0 = 64 * g; a.Vt = (const bf16_t*)(ws + WS_VTS); a.vt_row0 = 64 * g;
        const int q0 = 256 * qb, ks = q0 - 128 < 0 ? 0 : q0 - 128, ke = q0 + 384 > SEQ ? SEQ : q0 + 384;
        a.seg_tok0 = 256 * b; a.seg_nt0 = 4; a.seg_tok1 = MC + 4096 * b + ks; a.seg_nt1 = ctxq ? 0 : (ke - ks) >> 6; a.qpos0 = q0; a.kpos0 = ks;
        a.m_init = p->in[I_SINK][l * 4 + hq] * LOG2E; a.l_init = 1.f; a.qscale = 1.f; a.o_col0 = 64 * hq; a.qt0 = 0;
        if (ctxq) attn_unit<64, false, false>(C, a); else attn_unit<64, true, false>(C, a);
    }
}

template <class FA, class FB>
__device__ __forceinline__ f32x16 lds_mma64(int lane, FA fa, FB fb) {
    const int c = lane & 31, hi = lane >> 5;
    f32x16 acc;
#pragma unroll
    for (int r = 0; r < 16; ++r) acc[r] = 0.f;
#pragma unroll
    for (int s = 0; s < 4; ++s) {
        float av[8], bv[8];
#pragma unroll
        for (int j = 0; j < 8; ++j) { const int k = 16 * s + 8 * hi + j; av[j] = fa(c, k); bv[j] = fb(k, c); }
        acc = mfma32(mk_frag4(cvtpk(av[0], av[1]), cvtpk(av[2], av[3]), cvtpk(av[4], av[5]), cvtpk(av[6], av[7])),
                     mk_frag4(cvtpk(bv[0], bv[1]), cvtpk(bv[2], bv[3]), cvtpk(bv[4], bv[5]), cvtpk(bv[6], bv[7])), acc);
    }
    return acc;
}
__device__ __forceinline__ void lds_barrier() { asm volatile("s_waitcnt lgkmcnt(0)" ::: "memory"); __builtin_amdgcn_s_barrier(); asm volatile("" ::: "memory"); }
__device__ __forceinline__ int su_index(int d, int b, int h, int cg) {
    const int s = cg < 4 ? (d ? 3 - cg : cg) : 4 + (d ? 63 - (cg - 4) : (cg - 4));
    return ((d * 4 + b) * 4 + h) * 68 + s;
}
#ifndef GSECT
#define GSECT 0
#endif
constexpr int XP = 65;

template <int I>
__device__ __forceinline__ void solve_rows(float (&x)[64], f32x4 (&Lc)[16], f32x4 (&Ln)[16], const LAS float* Ld) {
    if constexpr (I < 64) {
        if constexpr (I + 1 < 64) {
#pragma unroll
            for (int q = 0; q < 16; ++q) if (4 * q < I + 1) Ln[q] = *(const LAS f32x4*)(Ld + (I + 1) * 68 + 4 * q);
        }
        float s0 = 0.f, s1 = 0.f, s2 = 0.f, s3 = 0.f;
#pragma unroll
        for (int q = 0; q < 16; ++q) if (4 * q < I) { const f32x4 lv = Lc[q];
            s0 += lv.x * x[4 * q]; if (4 * q + 1 < I) s1 += lv.y * x[4 * q + 1]; if (4 * q + 2 < I) s2 += lv.z * x[4 * q + 2]; if (4 * q + 3 < I) s3 += lv.w * x[4 * q + 3]; }
        x[I] -= (s0 + s1) + (s2 + s3);
        solve_rows<I + 1>(x, Ln, Lc, Ld);
    }
}
__device__ __forceinline__ void gdn_chunk_unit(KArg p, const Ctx& C, int l, int b, int h, int cg) {
    unsigned char* ws = p->ws; const bf16_t* P = (const bf16_t*)(ws + WS_P);
    int tid_l = C.tid; asm volatile("" : "+v"(tid_l));
    const int tid = tid_l, lane = tid & 63, w = __builtin_amdgcn_readfirstlane(tid >> 6);
    LAS float* xq = (LAS float*)C.lds; LAS float* xk = xq + 64 * XP; LAS float* xv = xk + 64 * XP;
    LAS float* KK = xv + 64 * XP; LAS float* QK = KK + 64 * XP;
    LAS float* Lm = QK + 64 * XP;
    LAS float* gcs = Lm + 2 * 64 * 68; LAS float* bts = gcs + 128; LAS float* egs = bts + 128; LAS float* cw = egs + 128;
    LAS float* raw = KK;
    LAS float* Wst = KK;
    const int seq0 = cg < 4 ? 256 * b : MC + 4096 * b, seqlen = cg < 4 ? 256 : 4096, t0 = cg < 4 ? 64 * cg : 64 * (cg - 4);
    bf16_t ab_a = 0, ab_b = 0;
    if (w < 2) { const int tau = w ? 63 - lane : lane; const bf16_t* pr = P + (size_t)(seq0 + t0 + tau) * DINP + PC_BAB + w * 8 + h; ab_a = pr[0]; ab_b = pr[4]; }
    lds_barrier();
    for (int rr1 = 0; rr1 < ((GSECT == 1) ? 2 : 1); ++rr1) {
    if (rr1) lds_barrier();
    for (int it = tid; it < 68 * 24; it += NTHR) { const int r = it / 24, ch = it % 24, t = t0 - 2 + r; const int part = ch >> 3, c8 = ch & 7;
        u32x4 v; v.x = v.y = v.z = v.w = 0u;
        if (t >= 0 && t < seqlen) v = *(const u32x4*)(P + (size_t)(seq0 + t) * DINP + PC_BQKV + 256 * part + 64 * h + 8 * c8);
        LAS float* d = raw + r * 192 + 64 * part + 8 * c8;
        d[0] = bf_lo(v.x); d[1] = bf_hi(v.x); d[2] = bf_lo(v.y); d[3] = bf_hi(v.y); d[4] = bf_lo(v.z); d[5] = bf_hi(v.z); d[6] = bf_lo(v.w); d[7] = bf_hi(v.w); }
    for (int it = tid; it < 5 * 192; it += NTHR) { const int j = it / 192, cc = it % 192; cw[it] = p->in[I_GCONV][((size_t)l * 5 + j) * 768 + 256 * (cc >> 6) + 64 * h + (cc & 63)]; }
    lds_barrier();
    for (int it = tid; it < 64 * 192; it += NTHR) { const int t = it / 192, cc = it % 192; float y = 0.f;
#pragma unroll
        for (int j = 0; j < 5; ++j) y += raw[(t + j) * 192 + cc] * cw[j * 192 + cc];
        y = silu_f(y); LAS float* dst = (cc < 64) ? xq : (cc < 128 ? xk : xv); dst[t * XP + (cc & 63)] = y; }
    lds_barrier();
    {
        const int mat = tid >> 8, r = (tid >> 2) & 63, q4 = tid & 3; LAS float* m = (mat ? xk : xq) + r * XP + 16 * q4; float v[16]; float ss = 0.f;
#pragma unroll
        for (int k = 0; k < 16; ++k) { v[k] = m[k]; ss += v[k] * v[k]; }
        ss += __shfl_xor(ss, 1); ss += __shfl_xor(ss, 2);
        const float sc = rsqrtf(ss + EPS) * (mat ? 1.f : 0.125f);
#pragma unroll
        for (int k = 0; k < 16; ++k) m[k] = v[k] * sc;
    }
    lds_barrier();
    {
        const int mat = w >> 2, rt = (w >> 1) & 1, ct = w & 1; LAS float* Am = mat ? xq : xk;
        const f32x16 acc = lds_mma64(lane, [&](int r, int k) { return Am[(32 * rt + r) * XP + k]; }, [&](int k, int c2) { return xk[(32 * ct + c2) * XP + k]; });
        LAS float* Om = mat ? QK : KK;
#pragma unroll
        for (int r = 0; r < 16; ++r) Om[(32 * rt + crow(r, lane >> 5)) * XP + 32 * ct + (lane & 31)] = acc[r];
    }
    }
    for (int rr2 = 0; rr2 < ((GSECT == 2) ? 2 : 1); ++rr2) {
    if (rr2) lds_barrier();
    if (w < 2) {
        const int d = w;
        const float a = bf2f(ab_a), bt = bf2f(ab_b);
        float g = -__expf(p->in[I_GALOG][(l * 2 + d) * 4 + h]) * softplus_f(a + p->in[I_GDTB][(l * 2 + d) * 4 + h]);
#pragma unroll
        for (int o = 1; o < 64; o <<= 1) { const float n = __shfl_up(g, o); if (lane >= o) g += n; }
        gcs[d * 64 + lane] = g; bts[d * 64 + lane] = sigmoid_f(bt); egs[d * 64 + lane] = __expf(g);
        if (lane == 63) ((float*)(ws + WS_DEC))[su_index(d, b, h, cg)] = __expf(g);
    }
    lds_barrier();
    for (int it = tid; it < 2 * 64 * 64; it += NTHR) { const int d = it >> 12, i = (it >> 6) & 63, j = it & 63; const int ti = d ? 63 - i : i, tj = d ? 63 - j : j;
        Lm[(d * 64 + i) * 68 + j] = (j < i) ? bts[d * 64 + i] * KK[ti * XP + tj] * __expf(gcs[d * 64 + i] - gcs[d * 64 + j]) : 0.f; }
#pragma unroll
    for (int d = 0; d < 2; ++d) {
        unsigned char* rec = ws + WS_RECG + (size_t)su_index(d, b, h, cg) * REC_G_BYTES; const LAS float* gc = gcs + d * 64;
        const int r = tid >> 3, c8 = tid & 7, it_ = d ? 63 - r : r;
        { float v[8];
#pragma unroll
          for (int j = 0; j < 8; ++j) { const int i = 8 * c8 + j, ti = d ? 63 - i : i; v[j] = xk[ti * XP + r] * __expf(gc[63] - gc[i]); }
          u32x4 o; o.x = cvtpk(v[0], v[1]); o.y = cvtpk(v[2], v[3]); o.z = cvtpk(v[4], v[5]); o.w = cvtpk(v[6], v[7]); *(u32x4*)(rec + REC_G_KDT + (r * 64 + 8 * c8) * 2) = o; }
        { const float e = egs[d * 64 + it_]; float v[8];
#pragma unroll
          for (int j = 0; j < 8; ++j) v[j] = xq[r * XP + 8 * c8 + j] * e;
          u32x4 o; o.x = cvtpk(v[0], v[1]); o.y = cvtpk(v[2], v[3]); o.z = cvtpk(v[4], v[5]); o.w = cvtpk(v[6], v[7]); *(u32x4*)(rec + REC_G_QG + (r * 64 + 8 * c8) * 2) = o; }
        { float v[8];
#pragma unroll
          for (int j = 0; j < 8; ++j) { const int i = 8 * c8 + j, ti = d ? 63 - i : i; v[j] = (it_ >= i) ? QK[r * XP + ti] * __expf(gc[it_] - gc[i]) : 0.f; }
          u32x4 o; o.x = cvtpk(v[0], v[1]); o.y = cvtpk(v[2], v[3]); o.z = cvtpk(v[4], v[5]); o.w = cvtpk(v[6], v[7]); *(u32x4*)(rec + REC_G_ATT + (r * 64 + 8 * c8) * 2) = o; }
    }
    }
    lds_barrier();
    for (int rr3 = 0; rr3 < ((GSECT == 3) ? 2 : 1); ++rr3) {
    if (tid < 256) {
        const int d = tid >> 7, col = tid & 127; const LAS float* Ld = Lm + d * 64 * 68; const LAS float* bt = bts + d * 64; const LAS float* eg = egs + d * 64;
        float x[64];
        if (col < 64) {
#pragma unroll
            for (int i = 0; i < 64; ++i) { const int ti = d ? 63 - i : i; x[i] = bt[i] * xv[ti * XP + col]; }
        } else {
#pragma unroll
            for (int i = 0; i < 64; ++i) { const int ti = d ? 63 - i : i; x[i] = bt[i] * eg[i] * xk[ti * XP + col - 64]; }
        }
        f32x4 La[16], Lb[16];
        La[0] = *(const LAS f32x4*)(Ld + 1 * 68);
        solve_rows<1>(x, La, Lb, Ld);
        unsigned char* rec = ws + WS_RECG + (size_t)su_index(d, b, h, cg) * REC_G_BYTES;
        if (col < 64) {
#pragma unroll
            for (int i4 = 0; i4 < 16; ++i4) { f32x4 o; o.x = x[4 * i4]; o.y = x[4 * i4 + 1]; o.z = x[4 * i4 + 2]; o.w = x[4 * i4 + 3]; *(f32x4*)(rec + REC_G_UT + (col * 64 + 4 * i4) * 4) = o; }
        } else {
#pragma unroll
            for (int i = 0; i < 64; ++i) Wst[(d * 64 + i) * XP + col - 64] = x[i];
        }
    }
    }
    lds_barrier();
#pragma unroll
    for (int d = 0; d < 2; ++d) { const int r = tid >> 3, c8 = tid & 7;
        unsigned char* rec = ws + WS_RECG + (size_t)su_index(d, b, h, cg) * REC_G_BYTES;
        u32x4 o; const LAS float* s = Wst + (d * 64 + r) * XP + 8 * c8; o.x = cvtpk(s[0], s[1]); o.y = cvtpk(s[2], s[3]); o.z = cvtpk(s[4], s[5]); o.w = cvtpk(s[6], s[7]);
        *(u32x4*)(rec + REC_G_W + (r * 64 + 8 * c8) * 2) = o; }
}

__device__ __forceinline__ void ret_chunk_unit(KArg p, const Ctx& C, int l, int b, int h, int cg) {
    unsigned char* ws = p->ws; const bf16_t* P = (const bf16_t*)(ws + WS_P); const float* tab = (const float*)(ws + WS_TAB);
    int tid_l = C.tid; asm volatile("" : "+v"(tid_l));
    const int tid = tid_l, lane = tid & 63, w = __builtin_amdgcn_readfirstlane(tid >> 6);
    LAS float* xq = (LAS float*)C.lds; LAS float* xk = xq + 64 * XP; LAS float* xv = xk + 64 * XP; LAS float* QK = xv + 64 * XP;
    const bool lat = cg >= 4;
    const int seq0 = lat ? MC + 4096 * b : 256 * b, t0 = lat ? 64 * (cg - 4) : 64 * cg;
    lds_barrier();
    for (int it = tid; it < 2 * 64 * 32; it += NTHR) { const int mat = it >> 11, r = (it >> 5) & 63, part = (it >> 4) & 1, j = it & 15; const int t = t0 + r;
        const bf16_t* pr = P + (size_t)(seq0 + t) * DINP + (mat ? PC_DK : PC_DQ) + 64 * h + 32 * part;
        const float xa = bf2f(pr[j]), xb = bf2f(pr[16 + j]); float cs = 1.f, sn = 0.f;
        if (lat) { const int ps = part ? (t & 63) : (t >> 6); cs = tab[ps * 16 + j]; sn = tab[1024 + ps * 16 + j]; }
        const float sc = mat ? 0.125f : 1.f; LAS float* m = mat ? xk : xq;
        m[r * XP + 32 * part + j] = (xa * cs - xb * sn) * sc; m[r * XP + 32 * part + 16 + j] = (xb * cs + xa * sn) * sc; }
    { const int r = tid >> 3, c8 = tid & 7; const u32x4 v = *(const u32x4*)(P + (size_t)(seq0 + t0 + r) * DINP + PC_DV + 64 * h + 8 * c8); LAS float* d = xv + r * XP + 8 * c8;
      d[0] = bf_lo(v.x); d[1] = bf_hi(v.x); d[2] = bf_lo(v.y); d[3] = bf_hi(v.y); d[4] = bf_lo(v.z); d[5] = bf_hi(v.z); d[6] = bf_lo(v.w); d[7] = bf_hi(v.w); }
    lds_barrier();
    if (w < 4) { const int rt = w >> 1, ct = w & 1;
        const f32x16 acc = lds_mma64(lane, [&](int r, int k) { return xq[(32 * rt + r) * XP + k]; }, [&](int k, int c2) { return xk[(32 * ct + c2) * XP + k]; });
#pragma unroll
        for (int r = 0; r < 16; ++r) QK[(32 * rt + crow(r, lane >> 5)) * XP + 32 * ct + (lane & 31)] = acc[r]; }
    lds_barrier();
    {
        const int d = w >> 2, T = (w >> 1) & 1, ct = w & 1; const float lg = -__expf(p->in[I_RLOGD][(l * 2 + d) * 4 + h]);
        const f32x16 acc = lds_mma64(lane, [&](int r, int k) { const int ti = d ? 63 - k : k; return xk[ti * XP + 32 * T + r] * __expf(lg * (float)(63 - k)); },
                                           [&](int k, int c2) { const int ti = d ? 63 - k : k; return xv[ti * XP + 32 * ct + c2]; });
        float* kv = (float*)(ws + WS_RECR + (size_t)su_index(d, b, h, cg) * REC_R_BYTES + REC_R_KV);
#pragma unroll
        for (int r = 0; r < 16; ++r) kv[(32 * T + crow(r, lane >> 5)) * 64 + 32 * ct + (lane & 31)] = acc[r];
    }
    for (int d = 0; d < 2; ++d) {
        unsigned char* rec = ws + WS_RECR + (size_t)su_index(d, b, h, cg) * REC_R_BYTES; const float lg = -__expf(p->in[I_RLOGD][(l * 2 + d) * 4 + h]);
        const int r = tid >> 3, c8 = tid & 7, it_ = d ? 63 - r : r;
        { const float e = __expf(lg * (float)(it_ + 1)); float v[8];
#pragma unroll
          for (int j = 0; j < 8; ++j) v[j] = xq[r * XP + 8 * c8 + j] * e;
          u32x4 o; o.x = cvtpk(v[0], v[1]); o.y = cvtpk(v[2], v[3]); o.z = cvtpk(v[4], v[5]); o.w = cvtpk(v[6], v[7]); *(u32x4*)(rec + REC_R_QG + (r * 64 + 8 * c8) * 2) = o; }
        { float v[8];
#pragma unroll
          for (int j = 0; j < 8; ++j) { const int i = 8 * c8 + j, ti = d ? 63 - i : i; v[j] = (it_ >= i) ? QK[r * XP + ti] * __expf(lg * (float)(it_ - i)) : 0.f; }
          u32x4 o; o.x = cvtpk(v[0], v[1]); o.y = cvtpk(v[2], v[3]); o.z = cvtpk(v[4], v[5]); o.w = cvtpk(v[6], v[7]); *(u32x4*)(rec + REC_R_ATT + (r * 64 + 8 * c8) * 2) = o; }
        { const int ln = tid & 63, s = (tid >> 6) & 1, T = (tid >> 7) & 1, ct = tid >> 8; float v[8];
#pragma unroll
          for (int j = 0; j < 8; ++j) { const int i = 32 * T + 16 * s + 8 * (j >> 2) + 4 * (ln >> 5) + (j & 3), ti = d ? 63 - i : i; v[j] = xv[ti * XP + 32 * ct + (ln & 31)]; }
          u32x4 o; o.x = cvtpk(v[0], v[1]); o.y = cvtpk(v[2], v[3]); o.z = cvtpk(v[4], v[5]); o.w = cvtpk(v[6], v[7]); *(u32x4*)(rec + REC_R_VF + (size_t)tid * 16) = o; }
    }
}

__device__ __forceinline__ void gdn_scan_chain(KArg p, const Ctx& C, int chain) {
    unsigned char* ws = p->ws; const int tid = C.tid, lane = C.lane, w = C.wave, c = lane & 31, hi = lane >> 5;
    constexpr int WP = 68, UP = 68, SB_W = 0, SB_K = 64 * WP * 2, SB_U = 2 * 64 * WP * 2, SB_D = SB_U + 64 * UP * 4, SBUF = SB_D + 16;
    LAS unsigned char* lds = C.lds;
    const float* DEC = (const float*)(ws + WS_DEC);
    u32x4 st[4]; float dreg = 0.f;
    auto g_load = [&](int s) { if (tid == 0) dreg = DEC[chain * 68 + s]; const unsigned char* rec = ws + WS_RECG + (size_t)(chain * 68 + s) * REC_G_BYTES;
#pragma unroll
        for (int i = 0; i < 4; ++i) st[i] = *(const u32x4*)(rec + (size_t)(tid + 512 * i) * 16); };
    auto l_store = [&](int bsel, int s) { LAS unsigned char* sb = lds + bsel * SBUF;
#pragma unroll
        for (int i = 0; i < 4; ++i) { const int ch = tid + 512 * i; u32x2 lo, h2; lo.x = st[i].x; lo.y = st[i].y; h2.x = st[i].z; h2.y = st[i].w;
            if (ch < 512) { const int r = ch >> 3, c8 = ch & 7; LAS u32x2* d = (LAS u32x2*)(sb + SB_W + r * (WP * 2) + 16 * c8); d[0] = lo; d[1] = h2; }
            else if (ch < 1536) { const int q = ch - 512, r = q >> 4, c4 = q & 15; *(LAS u32x4*)(sb + SB_U + r * (UP * 4) + 16 * c4) = st[i]; }
            else { const int q = ch - 1536, r = q >> 3, c8 = q & 7; LAS u32x2* d = (LAS u32x2*)(sb + SB_K + r * (WP * 2) + 16 * c8); d[0] = lo; d[1] = h2; } }
        if (tid == 0) *(LAS float*)(sb + SB_D) = dreg; (void)s; };
    f32x16 S0, S1;
#pragma unroll
    for (int r = 0; r < 16; ++r) { S0[r] = 0.f; S1[r] = 0.f; }
    __syncthreads();
    g_load(0); l_store(0, 0);
    __syncthreads();
    for (int s = 0; s < 68; ++s) {
        const int bsel = s & 1;
        if (s + 1 < 68) g_load(s + 1);
        if (w < 2) {
            const int ct = w; LAS unsigned char* sb = lds + bsel * SBUF;
            unsigned char* rec = ws + WS_RECG + (size_t)(chain * 68 + s) * REC_G_BYTES;
            bf16x8 sf[2][2];
#pragma unroll
            for (int ks = 0; ks < 2; ++ks) {
                sf[0][ks] = mk_frag4(cvtpk(S0[8 * ks], S0[8 * ks + 1]), cvtpk(S0[8 * ks + 2], S0[8 * ks + 3]), cvtpk(S0[8 * ks + 4], S0[8 * ks + 5]), cvtpk(S0[8 * ks + 6], S0[8 * ks + 7]));
                sf[1][ks] = mk_frag4(cvtpk(S1[8 * ks], S1[8 * ks + 1]), cvtpk(S1[8 * ks + 2], S1[8 * ks + 3]), cvtpk(S1[8 * ks + 4], S1[8 * ks + 5]), cvtpk(S1[8 * ks + 6], S1[8 * ks + 7]));
            }
#pragma unroll
            for (int T = 0; T < 2; ++T)
#pragma unroll
                for (int ks = 0; ks < 2; ++ks) *(bf16x8*)(rec + REC_G_SP + (size_t)((((ct * 2 + T) * 2 + ks) * 64 + lane) * 16)) = sf[T][ks];
            f32x16 vn[2];
#pragma unroll
            for (int Ti = 0; Ti < 2; ++Ti) {
                f32x16 acc;
#pragma unroll
                for (int r = 0; r < 16; ++r) acc[r] = 0.f;
#pragma unroll
                for (int T = 0; T < 2; ++T)
#pragma unroll
                    for (int ks = 0; ks < 2; ++ks) { const LAS unsigned char* ap = sb + SB_W + (32 * Ti + c) * (WP * 2) + (32 * T + 16 * ks + 4 * hi) * 2;
                        acc = mfma32(mk_frag(*(const LAS u32x2*)ap, *(const LAS u32x2*)(ap + 16)), sf[T][ks], acc); }
#pragma unroll
                for (int g = 0; g < 4; ++g) { const f32x4 u = *(const LAS f32x4*)(sb + SB_U + (32 * ct + c) * (UP * 4) + (32 * Ti + 8 * g + 4 * hi) * 4);
                    vn[Ti][4 * g] = u.x - acc[4 * g]; vn[Ti][4 * g + 1] = u.y - acc[4 * g + 1]; vn[Ti][4 * g + 2] = u.z - acc[4 * g + 2]; vn[Ti][4 * g + 3] = u.w - acc[4 * g + 3]; }
            }
            bf16x8 vf[2][2];
#pragma unroll
            for (int Ti = 0; Ti < 2; ++Ti)
#pragma unroll
                for (int ks = 0; ks < 2; ++ks) {
                    vf[Ti][ks] = mk_frag4(cvtpk(vn[Ti][8 * ks], vn[Ti][8 * ks + 1]), cvtpk(vn[Ti][8 * ks + 2], vn[Ti][8 * ks + 3]), cvtpk(vn[Ti][8 * ks + 4], vn[Ti][8 * ks + 5]), cvtpk(vn[Ti][8 * ks + 6], vn[Ti][8 * ks + 7]));
                    *(bf16x8*)(rec + REC_G_VN + (size_t)((((ct * 2 + Ti) * 2 + ks) * 64 + lane) * 16)) = vf[Ti][ks]; }
            const float dec = *(const LAS float*)(sb + SB_D);
#pragma unroll
            for (int r = 0; r < 16; ++r) { S0[r] *= dec; S1[r] *= dec; }
#pragma unroll
            for (int Ti = 0; Ti < 2; ++Ti)
#pragma unroll
                for (int ks = 0; ks < 2; ++ks) {
                    const LAS unsigned char* a0 = sb + SB_K + c * (WP * 2) + (32 * Ti + 16 * ks + 4 * hi) * 2; const LAS unsigned char* a1 = a0 + 32 * (WP * 2);
                    S0 = mfma32(mk_frag(*(const LAS u32x2*)a0, *(const LAS u32x2*)(a0 + 16)), vf[Ti][ks], S0);
                    S1 = mfma32(mk_frag(*(const LAS u32x2*)a1, *(const LAS u32x2*)(a1 + 16)), vf[Ti][ks], S1); }
        }
        if (s + 1 < 68) l_store(bsel ^ 1, s + 1);
        __syncthreads();
    }
}
__device__ __forceinline__ void ret_scan_items(KArg p, const Ctx& C, int l, int item0, int nitems_total, int stride) {
    unsigned char* ws = p->ws;
    for (int it = item0; it < nitems_total; it += stride) {
        const int dbh = it >> 11, q = it & 2047; const int jp = q & 3, ln = (q >> 2) & 63, ks = (q >> 8) & 1, T = (q >> 9) & 1, ct = q >> 10;
        const int d = dbh >> 4, h = dbh & 3;
        const int j0 = 2 * jp, dk0 = 32 * T + 16 * ks + 8 * (j0 >> 2) + 4 * (ln >> 5) + (j0 & 3), dv = 32 * ct + (ln & 31);
        const float g64 = __expf(-__expf(p->in[I_RLOGD][(l * 2 + d) * 4 + h]) * 64.f);
        float s0 = 0.f, s1 = 0.f;
        for (int s = 0; s < 68; ++s) {
            unsigned char* rec = ws + WS_RECR + (size_t)(dbh * 68 + s) * REC_R_BYTES;
            *(unsigned*)(rec + REC_R_SP + (size_t)q * 4) = cvtpk(s0, s1);
            const float* kv = (const float*)(rec + REC_R_KV);
            s0 = s0 * g64 + kv[dk0 * 64 + dv]; s1 = s1 * g64 + kv[(dk0 + 1) * 64 + dv];
        }
    }
}

__device__ __forceinline__ void rec_out_unit(KArg p, const Ctx& C, int l, int b, int h, int cg) {
    unsigned char* ws = p->ws; const int tid = C.tid, lane = C.lane, w = C.wave, c = lane & 31, hi = lane >> 5;
    const int mixer = w >> 2, rt = (w >> 1) & 1, ct = w & 1;
    LAS float* ob = (LAS float*)C.lds;
    f32x16 acc;
#pragma unroll
    for (int r = 0; r < 16; ++r) acc[r] = 0.f;
#pragma unroll
    for (int d = 0; d < 2; ++d) {
        const int su = su_index(d, b, h, cg);
        const unsigned char* rec = mixer ? ws + WS_RECR + (size_t)su * REC_R_BYTES : ws + WS_RECG + (size_t)su * REC_G_BYTES;
        const unsigned char* qg = rec + (mixer ? REC_R_QG : REC_G_QG); const unsigned char* at = rec + (mixer ? REC_R_ATT : REC_G_ATT);
        const unsigned char* sp = rec + (mixer ? REC_R_SP : REC_G_SP); const unsigned char* vn = rec + (mixer ? REC_R_VF : REC_G_VN);
#pragma unroll
        for (int T = 0; T < 2; ++T)
#pragma unroll
            for (int ks = 0; ks < 2; ++ks) {
                const size_t ao = (size_t)((32 * rt + c) * 64 + 32 * T + 16 * ks + 4 * hi) * 2, bo = (size_t)((((ct * 2 + T) * 2 + ks) * 64 + lane) * 16);
                acc = mfma32(mk_frag(*(const u32x2*)(qg + ao), *(const u32x2*)(qg + ao + 16)), *(const bf16x8*)(sp + bo), acc);
                acc = mfma32(mk_frag(*(const u32x2*)(at + ao), *(const u32x2*)(at + ao + 16)), *(const bf16x8*)(vn + bo), acc);
            }
    }
    __syncthreads();
#pragma unroll
    for (int r = 0; r < 16; ++r) ob[(mixer * 64 + 32 * rt + crow(r, hi)) * XP + 32 * ct + c] = acc[r];
    __syncthreads();
    {
        const int rowi = tid >> 2, q4 = tid & 3, mx = rowi >> 6, tau = rowi & 63;
        const int row = (cg < 4 ? 256 * b + 64 * cg : MC + 4096 * b + 64 * (cg - 4)) + tau;
        const LAS float* o = ob + rowi * XP + 16 * q4; float v[16]; float s = 0.f, ss = 0.f;
#pragma unroll
        for (int j = 0; j < 16; ++j) { v[j] = o[j]; s += v[j]; ss += v[j] * v[j]; }
        s += __shfl_xor(s, 1); s += __shfl_xor(s, 2); ss += __shfl_xor(ss, 1); ss += __shfl_xor(ss, 2);
        const bf16_t* P = (const bf16_t*)(ws + WS_P) + (size_t)row * DINP + (mx ? PC_DGATE : PC_BGATE) + 64 * h + 16 * q4;
        const float* gn = mx ? p->in[I_RNORM] + (size_t)l * 256 + 64 * h + 16 * q4 : p->in[I_GNORM] + (size_t)l * 64 + 16 * q4;
        float mu = 0.f, rs;
        if (mx) { mu = s * (1.f / 64.f); const float var = ss * (1.f / 64.f) - mu * mu; rs = rsqrtf(fmaxf(var, 0.f) + EPS); } else rs = rsqrtf(ss * (1.f / 64.f) + EPS);
        unsigned ov[8];
#pragma unroll
        for (int j = 0; j < 16; j += 2) { const float y0 = (v[j] - mu) * rs * gn[j] * silu_f(bf2f(P[j])), y1 = (v[j + 1] - mu) * rs * gn[j + 1] * silu_f(bf2f(P[j + 1])); ov[j >> 1] = cvtpk(y0, y1); }
        bf16_t* dst = (bf16_t*)(ws + WS_MIX) + (size_t)row * D + (mx ? 768 : 256) + 64 * h + 16 * q4;
        u32x4 o0, o1; o0.x = ov[0]; o0.y = ov[1]; o0.z = ov[2]; o0.w = ov[3]; o1.x = ov[4]; o1.y = ov[5]; o1.z = ov[6]; o1.w = ov[7];
        *(u32x4*)dst = o0; *(u32x4*)(dst + 8) = o1;
    }
}

#ifndef ONLY_PHASE
#define ONLY_PHASE -1
#endif
#ifndef SUB3
#define SUB3 31
#endif
#ifndef DUP_K
#define DUP_K -1
#endif
#define NREP(k) ((DUP_K == (k)) ? 2 : 1)
#ifndef DUP2
#define DUP2 0
#endif
#define PH_ON(k) (ONLY_PHASE < 0 || ONLY_PHASE == (k))
constexpr int PH_PER_LAYER = 10, PH_FINAL = 1 + PH_PER_LAYER * DEPTH, N_PHASES = PH_FINAL + 1;
__global__ void __launch_bounds__(NTHR, 2) mega_fwd(Params p_arg) {
    extern __shared__ __attribute__((aligned(16))) unsigned char lds_raw[];
    Ctx C0; C0.lds = (LAS unsigned char*)lds_raw; C0.tid = threadIdx.x; C0.lane = C0.tid & 63; C0.wave = __builtin_amdgcn_readfirstlane(C0.tid >> 6); C0.bid = blockIdx.x; C0.G = gridDim.x;
    const Ctx& C = C0;
    int lo, hi; unsigned* ctl0; { KArg p = kp_get(); lo = p->ph_lo; hi = p->ph_hi; ctl0 = (unsigned*)(p->ws + WS_CTL); }
    const bool fused = (hi - lo) > 1;
    if (C.tid < 64) ((LAS unsigned*)(C.lds + LDS_MISC))[C.tid] = 0u;
    __syncthreads();
    XcdBarrier bar; bar.bar = ctl0 + CW_BAR; bar.x = 0; bar.st = (volatile LAS unsigned*)(C.lds + LDS_MISC);
    if (fused) bar = xcd_barrier_post(ctl0 + CW_BAR, (volatile LAS unsigned*)(C.lds + LDS_MISC));
#define IN(k) (lo <= (k) && (k) < hi)
#define RELAUNDER do { int t_ = C0.tid, b_ = C0.bid, g_ = C0.G; unsigned l_ = (unsigned)(size_t)C0.lds; asm volatile("" : "+v"(t_), "+s"(b_), "+s"(g_), "+s"(l_)); C.tid = t_; C.lane = t_ & 63; C.wave = __builtin_amdgcn_readfirstlane(t_ >> 6); C.bid = b_; C.G = g_; C.lds = (LAS unsigned char*)(size_t)l_; p = kp_get(); ws = p->ws; } while (0)
#define PHASE_VARS Ctx C; { int t_ = C0.tid, b_ = C0.bid, g_ = C0.G; unsigned l_ = (unsigned)(size_t)C0.lds; asm volatile("" : "+v"(t_), "+s"(b_), "+s"(g_), "+s"(l_)); C.tid = t_; C.lane = t_ & 63; C.wave = __builtin_amdgcn_readfirstlane(t_ >> 6); C.bid = b_; C.G = g_; C.lds = (LAS unsigned char*)(size_t)l_; } KArg p = kp_get(); unsigned char* ws = p->ws; unsigned* ctl = (unsigned*)(ws + WS_CTL); const float* MOD = (const float*)(ws + WS_MOD); bf16_t* U = (bf16_t*)(ws + WS_U); (void)ctl; (void)MOD; (void)U;
#define SEAM(k) do { if (IN(k) && IN((k) + 1)) xcd_barrier(bar); } while (0)

    if (PH_ON(10) && IN(0)) { PHASE_VARS prologue_phase(p, C); }
    SEAM(0);

    for (int l = 0; l < DEPTH; ++l) {
        const int base = 1 + PH_PER_LAYER * l;
        const bool moe = (l & 1) != 0, last = (l == DEPTH - 1);
        const int row_min = last ? MC : 0, pm0 = last ? 4 : 0, Meff = last ? MX : MT;

        if (PH_ON(0) && IN(base + 0)) { PHASE_VARS
            norm_phase<0>(p, C, l, l == 2, l - 1, false, 0, (l == 1 || l == 3) ? 7 : 0);
        }
        SEAM(base + 0);
        if (PH_ON(1) && IN(base + 1)) { PHASE_VARS
            { pg8::Gemm g{U, (const bf16_t*)(ws + WS_WIN) + (size_t)l * DINP * D, MT, DINP, D, D, D}; pg8::OrderPM S; S.init(MT, DINP, C.G, C.bid); S.pm0 = 0;
              pg8::EpiStore E{(bf16_t*)(ws + WS_P), DINP, 1 << 20};
              pg8::gemm_phase<pg8::EpiStore, pg8::OrderPM, true, true>(C.lds, g, S, E); }
            { pg8::Gemm g{(const bf16_t*)(ws + WS_WINV) + (size_t)l * 256 * D, U, 256, MT, D, D, D}; pg8::OrderPM S; S.init(256, MT, C.G, (C.bid + 208) & 255); S.pm0 = 0;
              pg8::EpiStore E{(bf16_t*)(ws + WS_VTS), MT, 1 << 20};
              pg8::gemm_phase<pg8::EpiStore, pg8::OrderPM, true, true>(C.lds, g, S, E); }
        }
        SEAM(base + 1);
        if (PH_ON(2) && IN(base + 2)) for (int rep = 0; rep < NREP(2); ++rep) { PHASE_VARS
            for (int r2 = 0; r2 < ((DUP2 & 1) ? 2 : 1); ++r2) prep_phase(p, C, l);
            for (int u = C.bid; u < 2 * 1088; u += C.G) { const int mixer = u / 1088, v = u % 1088, b = v / 272, h = (v / 68) & 3, cg = v % 68;
                if (mixer == 0) { for (int r2 = 0; r2 < ((DUP2 & 2) ? 2 : 1); ++r2) gdn_chunk_unit(p, C, l, b, h, cg); } else { for (int r2 = 0; r2 < ((DUP2 & 4) ? 2 : 1); ++r2) ret_chunk_unit(p, C, l, b, h, cg); } }
        }
        SEAM(base + 2);
        if (PH_ON(3) && IN(base + 3)) for (int rep = 0; rep < NREP(3); ++rep) { PHASE_VARS
            if (SUB3 & 1) { if (C.bid < 32) gdn_scan_chain(p, C, C.bid); }
            RELAUNDER;
            if (C.bid >= 32) {
                const int G2 = C.G - 32, c2 = C.bid - 32;
                if (SUB3 & 2) { pg8::Gemm g{(const bf16_t*)(ws + WS_AUP), (const bf16_t*)(ws + WS_WUP) + (size_t)l * 1024 * 512, MT, 1024, 512, 512, 512}; pg8::OrderPM S; S.init(MT, 1024, G2, c2); S.pm0 = 0;
                  pg8::EpiUp E{(bf16_t*)(ws + WS_QRAW), (bf16_t*)(ws + WS_KFULL)};
                  pg8::gemm_phase<pg8::EpiUp, pg8::OrderPM, true, true>(C.lds, g, S, E); }
                RELAUNDER;
                if (SUB3 & 4) { pg8::Gemm g{(const bf16_t*)(ws + WS_WUPV) + (size_t)l * 256 * 512, (const bf16_t*)(ws + WS_AUP), 256, MT, 512, 512, 512}; pg8::OrderPM S; S.init(256, MT, G2, (c2 + 176) % G2); S.pm0 = 0;
                  pg8::EpiStore E{(bf16_t*)(ws + WS_VTM), MT, 1 << 20};
                  pg8::gemm_phase<pg8::EpiStore, pg8::OrderPM, true, true>(C.lds, g, S, E); }
                RELAUNDER;
                if (SUB3 & 8) ret_scan_items(p, C, l, c2 * NTHR + C.tid, 65536, G2 * NTHR);
                RELAUNDER;
                if (SUB3 & 16) { for (int u = 256 + c2; u < 512; u += G2) attn_dispatch(p, C, l, u);
                if (!last) for (int u = 528 + c2; u < 544; u += G2) attn_dispatch(p, C, l, u); }
                RELAUNDER;
                if (!last) { __syncthreads(); convert_layer_weights(p, C, l + 1, c2 * NWAVES + C.wave, G2 * NWAVES); }
            }
        }
        SEAM(base + 3);
        if (PH_ON(4) && IN(base + 4)) for (int rep = 0; rep < NREP(4); ++rep) { PHASE_VARS
            for (int u = C.bid; u < 256; u += C.G) attn_dispatch(p, C, l, u);
            if (!last) for (int u = 512 + C.bid; u < 528; u += C.G) attn_dispatch(p, C, l, u);
            for (int u = C.bid; u < 1088; u += C.G) { const int b = u / 272, h = (u / 68) & 3, cg = u % 68; if (last && cg < 4) continue; rec_out_unit(p, C, l, b, h, cg); }
        }
        SEAM(base + 4);
        if (PH_ON(5) && IN(base + 5)) { PHASE_VARS
            { pg8::Gemm g{(const bf16_t*)(ws + WS_MIX), (const bf16_t*)(ws + WS_WOUT) + (size_t)l * D * D, MX, D, D, D, D}; pg8::OrderPM S; S.init(MX, D, C.G, C.bid); S.pm0 = 4;
              pg8::EpiRes E{(float*)(ws + WS_H), MOD + (size_t)l * 5 * 6144 + 2 * 1024};
              pg8::gemm_phase<pg8::EpiRes, pg8::OrderPM, true, true>(C.lds, g, S, E); }
            if (!last) { RELAUNDER;
              pg8::Gemm g{(const bf16_t*)(ws + WS_MIX), (const bf16_t*)(ws + WS_WOUT) + (size_t)l * D * D, MC, D, 256, D, D}; pg8::SplitKOrder S{C.G, C.bid, 4, 256};
              pg8::EpiSlab E{(float*)(ws + WS_SLAB), (const float*)(ws + WS_MOD) + (size_t)l * 5 * 6144 + 2 * 1024, 256};
              pg8::gemm_phase<pg8::EpiSlab, pg8::SplitKOrder, true, true>(C.lds, g, S, E); }
        }
        SEAM(base + 5);
        if (PH_ON(6) && IN(base + 6)) { PHASE_VARS norm_phase<1>(p, C, l, false, 0, moe, row_min, last ? 0 : 4); }
        SEAM(base + 6);
        if (PH_ON(7) && IN(base + 7)) { PHASE_VARS if (moe) moe_gather_phase(p, C, row_min); }
        if (moe) SEAM(base + 7);
        if (PH_ON(8) && IN(base + 8)) { PHASE_VARS
            pg8::EpiSwiGLU E{(bf16_t*)(ws + WS_HD)};
            if (!moe) { pg8::Gemm g{U, (const bf16_t*)(ws + WS_WFF + (size_t)(l >> 1) * FFW_BYTES), MT, 7168, D, D, D}; pg8::OrderPM S; S.init(MT, 7168, C.G, C.bid); S.pm0 = 0;
                pg8::gemm_phase<pg8::EpiSwiGLU, pg8::OrderPM, true, true>(C.lds, g, S, E); }
            else { const int nt = (int)__hip_atomic_load(ctl + CW_TILEE + 160, __ATOMIC_RELAXED, __HIP_MEMORY_SCOPE_AGENT);
                pg8::Gemm g{(const bf16_t*)(ws + WS_ASORT), (const bf16_t*)(ws + WS_WMOE), MOE_ROWS, 8 * 7168, D, D, D}; pg8::MoeOrder S{28, C.G, C.bid, __builtin_amdgcn_readfirstlane(nt), ctl + CW_TILEE};
                pg8::gemm_phase<pg8::EpiSwiGLU, pg8::MoeOrder, true, true>(C.lds, g, S, E); }
        }
        SEAM(base + 8);
        if (PH_ON(9) && IN(base + 9)) { PHASE_VARS
            if (!moe) {
                const bf16_t* Wd = (const bf16_t*)(ws + WS_WFF + (size_t)(l >> 1) * FFW_BYTES) + (size_t)7168 * 1024;
                { pg8::Gemm g{(const bf16_t*)(ws + WS_HD), Wd, MX, D, DFF, DFF, DFF}; pg8::OrderPM S; S.init(MX, D, C.G, C.bid); S.pm0 = 4;
                  pg8::EpiRes E{(float*)(ws + WS_H), MOD + (size_t)l * 5 * 6144 + 5 * 1024};
                  pg8::gemm_phase<pg8::EpiRes, pg8::OrderPM, true, true>(C.lds, g, S, E); }
                RELAUNDER;
                { pg8::Gemm g{(const bf16_t*)(ws + WS_HD), (const bf16_t*)(ws + WS_WFF + (size_t)(l >> 1) * FFW_BYTES) + (size_t)7168 * 1024, MC, D, 512, DFF, DFF}; pg8::SplitKOrder S{C.G, C.bid, 7, 512};
                  pg8::EpiSlab E{(float*)(ws + WS_SLAB), (const float*)(ws + WS_MOD) + (size_t)l * 5 * 6144 + 5 * 1024, 512};
                  pg8::gemm_phase<pg8::EpiSlab, pg8::SplitKOrder, true, true>(C.lds, g, S, E); } }
            else { const int nt = (int)__hip_atomic_load(ctl + CW_TILEE + 160, __ATOMIC_RELAXED, __HIP_MEMORY_SCOPE_AGENT);
                pg8::Gemm g{(const bf16_t*)(ws + WS_HD), (const bf16_t*)(ws + WS_WMOE) + (size_t)8 * 7168 * 1024, MOE_ROWS, 8 * 1024, DFF, DFF, DFF}; pg8::MoeOrder S{4, C.G, C.bid, __builtin_amdgcn_readfirstlane(nt), ctl + CW_TILEE};
                pg8::EpiStore E{(bf16_t*)(ws + WS_YD), D, 4};
                pg8::gemm_phase<pg8::EpiStore, pg8::MoeOrder, true, true>(C.lds, g, S, E); }
        }
        SEAM(base + 9);
    }
    if (PH_ON(11) && IN(PH_FINAL)) { PHASE_VARS norm_phase<2>(p, C, DEPTH, true, DEPTH - 1, false, MC, 0); }
#undef IN
#undef SEAM
}

extern "C" void kernel_launch(void* const* d_in, const int* in_sizes, int n_in, void* d_out, int out_size, void* d_ws, size_t ws_size, hipStream_t stream) {
    static int grid = 0;
    if (grid == 0) {
        if (n_in != N_IN || out_size != MX * D || ws_size < WS_TOTAL) { fprintf(stderr, "kernel_launch: unexpected shapes (n_in %d out %d ws %zu, need %zu)\n", n_in, out_size, ws_size, (size_t)WS_TOTAL); grid = -1; return; }
        int dev = 0, cus = 0, per_cu = 0;
        if (hipGetDevice(&dev) != hipSuccess || hipDeviceGetAttribute(&cus, hipDeviceAttributeMultiprocessorCount, dev) != hipSuccess) { grid = -1; return; }
        if (hipFuncSetAttribute((const void*)mega_fwd, hipFuncAttributeMaxDynamicSharedMemorySize, LDS_BYTES) != hipSuccess) { fprintf(stderr, "kernel_launch: hipFuncSetAttribute failed\n"); grid = -1; return; }
        if (hipOccupancyMaxActiveBlocksPerMultiprocessor(&per_cu, (const void*)mega_fwd, NTHR, LDS_BYTES) != hipSuccess || per_cu < 1) { fprintf(stderr, "kernel_launch: occupancy query says %d\n", per_cu); }
        (void)hipGetLastError();
        grid = (cus == 256) ? 256 : -1;
        if (grid < 0) { fprintf(stderr, "kernel_launch: built for a 256-CU device, found %d\n", cus); return; }
    }
    if (grid < 0) return;
    if (hipMemsetAsync((char*)d_ws + WS_CTL, 0, CTL_BYTES, stream) != hipSuccess) return;
    Params p; memset(&p, 0, sizeof(p));
    for (int i = 0; i < N_IN; ++i) p.in[i] = (const float*)d_in[i];
    p.out = (float*)d_out; p.ws = (unsigned char*)d_ws;
#if MK_ONE_LAUNCH
    p.ph_lo = 0; p.ph_hi = N_PHASES;
    hipLaunchKernelGGL(mega_fwd, dim3(grid), dim3(NTHR), LDS_BYTES, stream, p);
#else
    for (int ph = 0; ph < N_PHASES; ++ph) {
        if (ph >= 1 && ph < PH_FINAL) { const int l = (ph - 1) / PH_PER_LAYER, k = (ph - 1) % PH_PER_LAYER; if (k == 7 && !(l & 1)) continue; }
        p.ph_lo = ph; p.ph_hi = ph + 1;
        hipLaunchKernelGGL(mega_fwd, dim3(grid), dim3(NTHR), LDS_BYTES, stream, p);
    }
#endif
}
```

```cpp
#include <hip/hip_runtime.h>
#include <cstdio>
#include <cstdint>
#include <cstring>

#ifndef MK_ONE_LAUNCH
#define MK_ONE_LAUNCH 1
#endif

#define LAS __attribute__((address_space(3)))
#define GAS __attribute__((address_space(1)))
typedef unsigned short bf16_t;
typedef short bf16x8 __attribute__((ext_vector_type(8)));
typedef float f32x4 __attribute__((ext_vector_type(4)));
typedef float f32x2 __attribute__((ext_vector_type(2)));
typedef float f32x16 __attribute__((ext_vector_type(16)));
typedef unsigned u32x4 __attribute__((ext_vector_type(4)));
typedef unsigned u32x2 __attribute__((ext_vector_type(2)));

constexpr int D = 1024, NB = 4, SEQ = 4096, CTX = 256, DEPTH = 4;
constexpr int MC = NB * CTX, MX = NB * SEQ, MT = MC + MX;
constexpr int DIN = 2992, DINP = 3072, DFF = 3584, NE = 8;
constexpr int NSU = 2 * NB * 4 * 68;
constexpr int PC_AQ = 0, PC_AK = 256, PC_AV = 384, PC_BQKV = 512, PC_BGATE = 1280, PC_BAB = 1536, PC_CQ = 1552, PC_CKV = 1808, PC_CKR = 1936,
              PC_DQ = 1968, PC_DK = 2224, PC_DV = 2480, PC_DGATE = 2736;
constexpr float EPS = 1e-6f, LOG2E = 1.4426950408889634f;
constexpr int MOE_ROWS = 36864, MOE_TILES = MOE_ROWS / 256;

constexpr size_t MiB = 1u << 20;
constexpr size_t WS_CTL = 0, CTL_BYTES = 1 * MiB;
constexpr int CW_BAR = 4096;
constexpr int CW_CNT = 16384;
constexpr int CW_TILEE = 20480;
constexpr size_t WS_TAB = 1 * MiB;
constexpr size_t WS_MOD = WS_TAB + 65536;
constexpr size_t WS_ROUTE = 2 * MiB;
constexpr size_t WS_DEC = 3 * MiB;
constexpr size_t WS_WIN = 4 * MiB;
constexpr size_t WS_WINV = WS_WIN + 24 * MiB;
constexpr size_t WS_WOUT = WS_WINV + 2 * MiB;
constexpr size_t WS_WUP = WS_WOUT + 8 * MiB;
constexpr size_t WS_WUPV = WS_WUP + 4 * MiB;
constexpr size_t WS_WFF = WS_WUPV + 1 * MiB;
constexpr size_t FFW_BYTES = (size_t)(7168 * 1024 + 1024 * 3584) * 2;
constexpr size_t WS_WMOE = WS_WFF + 42 * MiB;
constexpr size_t WS_H = WS_WMOE + 168 * MiB;
constexpr size_t WS_U = WS_H + 68 * MiB;
constexpr size_t WS_OV = WS_U + 34 * MiB;
constexpr size_t WS_P = WS_OV;
constexpr size_t WS_VTS = WS_P + 102 * MiB;
constexpr size_t WS_AUP = WS_VTS + 9 * MiB;
constexpr size_t WS_QRAW = WS_AUP + 17 * MiB;
constexpr size_t WS_KFULL = WS_QRAW + 13 * MiB;
constexpr size_t WS_VTM = WS_KFULL + 13 * MiB;
constexpr size_t WS_QS = WS_VTM + 9 * MiB;
constexpr size_t WS_KS = WS_QS + 9 * MiB;
constexpr size_t WS_MIX = WS_KS + 5 * MiB;
constexpr size_t WS_REC = WS_MIX + 34 * MiB;
constexpr size_t REC_G_W = 0, REC_G_UT = 8192, REC_G_KDT = 24576, REC_G_QG = 32768, REC_G_ATT = 40960, REC_G_SP = 49152, REC_G_VN = 57344, REC_G_BYTES = 65536;
constexpr size_t REC_R_KV = 0, REC_R_QG = 16384, REC_R_ATT = 24576, REC_R_VF = 32768, REC_R_SP = 40960, REC_R_BYTES = 49152;
constexpr size_t WS_RECG = WS_REC, WS_RECR = WS_REC + (size_t)NSU * REC_G_BYTES;
constexpr size_t WS_OV_END_MIX = WS_RECR + (size_t)NSU * REC_R_BYTES;
constexpr size_t WS_YD = WS_OV + 112 * MiB;
constexpr size_t WS_ASORT = WS_YD + 72 * MiB;
constexpr size_t WS_HD = WS_ASORT + 72 * MiB;
constexpr size_t WS_OV_END_FFN = WS_HD + 252 * MiB;
constexpr size_t WS_END = (WS_OV_END_MIX > WS_OV_END_FFN ? WS_OV_END_MIX : WS_OV_END_FFN);
static_assert(WS_P + (size_t)MT * DINP * 2 <= WS_VTS && WS_VTS + (size_t)256 * MT * 2 <= WS_AUP && WS_AUP + (size_t)MT * 512 * 2 <= WS_QRAW && WS_QRAW + (size_t)MT * 384 * 2 <= WS_KFULL &&
              WS_KFULL + (size_t)MT * 384 * 2 <= WS_VTM && WS_VTM + (size_t)256 * MT * 2 <= WS_QS && WS_QS + (size_t)MT * 256 * 2 <= WS_KS && WS_KS + (size_t)MT * 128 * 2 <= WS_MIX &&
              WS_MIX + (size_t)MT * D * 2 <= WS_REC && WS_YD >= WS_VTS + 9 * MiB && WS_MOD + 491520 <= WS_ROUTE && WS_ROUTE + 417792 <= WS_DEC && WS_DEC + NSU * 4 <= WS_WIN, "ws map");
constexpr size_t WS_MSLAB = WS_P;
constexpr int MOE_SPLIT_TILE = 128, MOE_SPLIT_ROW = MOE_SPLIT_TILE * 256;
constexpr size_t WS_SLAB = ((WS_END + MiB - 1) / MiB) * MiB;
constexpr size_t WS_TOTAL = WS_SLAB + 28 * MiB;
static_assert(WS_TOTAL <= 900 * MiB, "ws budget");

constexpr int LDS_BYTES = 147456;
constexpr int LDS_MISC = 147456 - 256;
constexpr int NWAVES = 8, NTHR = 512;

#ifndef PROBE_ID
#define PROBE_ID 0
#endif
#ifndef PROBE_BLOCK
#define PROBE_BLOCK 100
#endif
#ifndef PROBE_MULT
#define PROBE_MULT 4
#endif
#if PROBE_ID
#define PROBE_ACC ((volatile LAS unsigned long long*)(lds_probe_base + 147456 - 256 + 64))
#define TIC(id) do { if ((id) == PROBE_ID && blockIdx.x == PROBE_BLOCK && threadIdx.x == 0) PROBE_ACC[1] = __builtin_amdgcn_s_memrealtime(); } while (0)
#define TOC(id) do { if ((id) == PROBE_ID && blockIdx.x == PROBE_BLOCK && threadIdx.x == 0) PROBE_ACC[0] += __builtin_amdgcn_s_memrealtime() - PROBE_ACC[1]; } while (0)
#else
#define TIC(id) do { } while (0)
#define TOC(id) do { } while (0)
#endif
#define lds_probe_base ((LAS unsigned char*)0)

__device__ __forceinline__ unsigned cvtpk(float lo, float hi) { unsigned r; asm volatile("v_cvt_pk_bf16_f32 %0, %1, %2" : "=v"(r) : "v"(lo), "v"(hi)); return r; }
__device__ __forceinline__ float bf_lo(unsigned u) { return __uint_as_float(u << 16); }
__device__ __forceinline__ float bf_hi(unsigned u) { return __uint_as_float(u & 0xffff0000u); }
__device__ __forceinline__ float bf2f(bf16_t h) { return __uint_as_float((unsigned)h << 16); }
__device__ __forceinline__ bf16_t f2bf(float f) { return (bf16_t)(cvtpk(f, 0.f) & 0xffffu); }
template <int CTRL> __device__ __forceinline__ float dppf(float x) { return __builtin_bit_cast(float, __builtin_amdgcn_update_dpp(0, __builtin_bit_cast(int, x), CTRL, 0xF, 0xF, true)); }
__device__ __forceinline__ float quad_sum(float v) { v += dppf<0xB1>(v); v += dppf<0x4E>(v); return v; }
__device__ __forceinline__ float wave_sum(float v) {
    v = quad_sum(v); v += dppf<0x141>(v); v += dppf<0x140>(v);
    const int b = __builtin_bit_cast(int, v);
    return (__builtin_bit_cast(float, __builtin_amdgcn_readlane(b, 0)) + __builtin_bit_cast(float, __builtin_amdgcn_readlane(b, 16)))
         + (__builtin_bit_cast(float, __builtin_amdgcn_readlane(b, 32)) + __builtin_bit_cast(float, __builtin_amdgcn_readlane(b, 48)));
}
__device__ __forceinline__ float half_swap(float x, float& other) {
    float a = x, b = x;
    asm volatile("v_nop\n\tv_nop\n\tv_permlane32_swap_b32 %0, %1" : "+v"(a), "+v"(b));
    other = b; return a;
}
__device__ __forceinline__ float xor32_sum(float x) { float o; const float s = half_swap(x, o); return s + o; }
__device__ __forceinline__ float xor32_max(float x) { float o; const float s = half_swap(x, o); return fmaxf(s, o); }
__device__ __forceinline__ float silu_f(float x) { return x * __builtin_amdgcn_rcpf(1.f + __expf(-x)); }
__device__ __forceinline__ float sigmoid_f(float x) { return __builtin_amdgcn_rcpf(1.f + __expf(-x)); }
__device__ __forceinline__ float softplus_f(float x) { return x > 20.f ? x : log1pf(__expf(x)); }
__device__ __forceinline__ int crow(int r, int hi) { return (r & 3) + 8 * (r >> 2) + 4 * hi; }
__device__ __forceinline__ f32x16 mfma32(bf16x8 a, bf16x8 b, f32x16 c) { return __builtin_amdgcn_mfma_f32_32x32x16_bf16(a, b, c, 0, 0, 0); }
__device__ __forceinline__ bf16x8 mk_frag(u32x2 lo, u32x2 hi) { u32x4 v; v.x = lo.x; v.y = lo.y; v.z = hi.x; v.w = hi.y; return __builtin_bit_cast(bf16x8, v); }
__device__ __forceinline__ bf16x8 mk_frag4(unsigned a, unsigned b, unsigned c, unsigned d) { u32x4 v; v.x = a; v.y = b; v.z = c; v.w = d; return __builtin_bit_cast(bf16x8, v); }
__device__ __forceinline__ int mod_row(int row) { return row < MC ? 4 : ((row - MC) >> 12); }

#define XB_TMO      128
#define XB_XCNT(j)  (256  + 64 * (j))
#define XB_XSUB(j)  (1280 + 64 * (j))
#define XB_XGEN(j)  (2304 + 64 * (j))
#define XB_TOP      3328
#define XB_TOPGEN   3392
#define XCD_BAR_WORDS 3456
#define XB_SPIN_CAP (1u << 18)
__device__ __forceinline__ unsigned xb_ld(unsigned* p)              { return __hip_atomic_load(p, __ATOMIC_RELAXED, __HIP_MEMORY_SCOPE_AGENT); }
__device__ __forceinline__ unsigned xb_add(unsigned* p, unsigned v) { return __hip_atomic_fetch_add(p, v, __ATOMIC_RELAXED, __HIP_MEMORY_SCOPE_AGENT); }
__device__ __forceinline__ unsigned xb_xcc_id() { return (unsigned)__builtin_amdgcn_s_getreg((3 << 11) | 20) & 0xFu; }
#define XB_SPIN(cond, bar) do { unsigned _sp = 0; while (cond) { __builtin_amdgcn_s_sleep(1); \
    if ((++_sp & 255u) == 0u) { if (xb_ld(&(bar)[XB_TMO])) break; if (_sp > XB_SPIN_CAP) { atomicAdd(&(bar)[XB_TMO], 1u); break; } } } } while (0)
struct XcdBarrier { unsigned* bar; unsigned x; volatile LAS unsigned* st; };
__device__ __forceinline__ XcdBarrier xcd_barrier_post(unsigned* bar, volatile LAS unsigned* st) {
    XcdBarrier b; b.bar = bar; b.x = xb_xcc_id(); b.st = st;
    if (threadIdx.x == 0) (void)xb_add(&bar[XB_XCNT(b.x)], 1u);
    return b;
}
__device__ __forceinline__ void xcd_barrier_complete(unsigned* bar, unsigned x, unsigned& nloc, unsigned& nx) {
    const unsigned G = gridDim.x * gridDim.y * gridDim.z;
    unsigned sum, cnt, mine, sp = 0u;
    for (;;) {
        sum = 0u; cnt = 0u; mine = 0u;
#pragma unroll
        for (unsigned j = 0; j < 16; ++j) { const unsigned c = xb_ld(&bar[XB_XCNT(j)]); sum += c; cnt += (c > 0u) ? 1u : 0u; mine = (j == x) ? c : mine; }
        if (sum == G) break;
        __builtin_amdgcn_s_sleep(1);
        if ((++sp & 255u) == 0u) { if (xb_ld(&bar[XB_TMO])) break; if (sp > XB_SPIN_CAP) { atomicAdd(&bar[XB_TMO], 1u); break; } }
    }
    nloc = mine > 0u ? mine : 1u; nx = cnt > 0u ? cnt : 1u;
}
__device__ __forceinline__ void xcd_barrier(const XcdBarrier& b) {
    asm volatile("s_waitcnt vmcnt(0)" ::: "memory");
    __syncthreads();
    if (threadIdx.x == 0) {
        unsigned* bar = b.bar;
        __builtin_amdgcn_s_waitcnt(0);
        unsigned nloc = b.st[0], nx = b.st[1];
        if (nloc == 0u) { xcd_barrier_complete(bar, b.x, nloc, nx); b.st[0] = nloc; b.st[1] = nx; }
        const unsigned old = xb_add(&bar[XB_XSUB(b.x)], 1u);
        const unsigned gen = old / nloc;
        if (old + 1u == (gen + 1u) * nloc) {
            __builtin_amdgcn_fence(__ATOMIC_RELEASE, "agent");
            asm volatile("s_waitcnt vmcnt(0)" ::: "memory");
            const unsigned og = xb_add(&bar[XB_TOP], 1u);
            const unsigned tg = og / nx;
            if (og + 1u == (tg + 1u) * nx) xb_add(&bar[XB_TOPGEN], 1u);
            else XB_SPIN(xb_ld(&bar[XB_TOPGEN]) == tg, bar);
            __builtin_amdgcn_fence(__ATOMIC_ACQUIRE, "agent");
            xb_add(&bar[XB_XGEN(b.x)], 1u);
            asm volatile("s_waitcnt vmcnt(0)" ::: "memory");
        } else {
            XB_SPIN(xb_ld(&bar[XB_XGEN(b.x)]) == gen, bar);
            __builtin_amdgcn_fence(__ATOMIC_ACQUIRE, "agent");
            asm volatile("s_waitcnt vmcnt(0)" ::: "memory");
        }
    }
    __syncthreads();
}
namespace pg8 {
#define PG8_LAS __attribute__((address_space(3)))
typedef unsigned short bf16_t;
typedef short bf16x8 __attribute__((ext_vector_type(8)));
typedef float f32x4 __attribute__((ext_vector_type(4)));
typedef unsigned u32x4 __attribute__((ext_vector_type(4)));
constexpr int BM = 256, BK = 64, HALF = 128, HTB = HALF * BK * 2  , STAGE_BYTES = 8 * HTB, NXCD = 8, WGM = 8;

__host__ __device__ __forceinline__ int lds_byte(int r, int c) { const int st = (r >> 4) * 2 + (c >> 5), rr = r & 15, cc = c & 31, ob = rr * 64 + cc * 2; return st * 1024 + (ob ^ (((ob >> 9) & 1) << 5)); }
__host__ __device__ __forceinline__ void stage_rc(int b, int& R, int& C) { const int st = b / 1024, sb = b % 1024, swz = sb ^ (((sb >> 9) & 1) << 5); R = (st >> 1) * 16 + swz / 64; C = (st & 1) * 32 + (swz % 64) / 2; }
__host__ __device__ __forceinline__ int perm32(int rho) { const int n = rho >> 4, i = rho & 15; return 8 * (i >> 2) + 4 * n + (i & 3); }

struct Unit { int pm, pn, ko; };
struct Gemm { const bf16_t* A; const bf16_t* Bt; int M, N, K, lda, ldb; };

struct StaticOrder {
    int nM, nN, nwg, G, c;
    __host__ __device__ void init(int M, int N, int G_, int c_) { nM = M / BM; nN = N / BM; nwg = nM * nN; G = G_; c = c_; }
    __host__ __device__ bool next(int i, Unit& u) const {
        const long L = (long)i * G + c; if (L >= nwg) return false;
        int wgid = (int)L; { const int q = nwg / NXCD, r = nwg % NXCD, xcd = wgid % NXCD, off = wgid / NXCD; wgid = (xcd < r ? xcd * (q + 1) : r * (q + 1) + (xcd - r) * q) + off; }
        const int nig = WGM * nN, gid = wgid / nig, fm = gid * WGM, gsz = (nM - fm) < WGM ? (nM - fm) : WGM;
        u.pm = fm + ((wgid % nig) % gsz); u.pn = (wgid % nig) / gsz; u.ko = 0; return true;
    }
    __device__ __forceinline__ void a_ready(const Unit&) const {}
    __device__ __forceinline__ void done(const Unit&) const {}
};
__device__ __forceinline__ unsigned cvt_pk_bf16(float lo, float hi) { unsigned r; asm volatile("v_cvt_pk_bf16_f32 %0, %1, %2" : "=v"(r) : "v"(lo), "v"(hi)); return r; }
template <class Epi, class Sched, bool ALIGN_EPI = false, bool SP2 = false>
__device__ __forceinline__ void gemm_phase(PG8_LAS unsigned char* lds, const Gemm g, const Sched& S, const Epi& E) {
    int tid_l = threadIdx.x; asm volatile("" : "+v"(tid_l));
    const int tid = tid_l, wid = __builtin_amdgcn_readfirstlane(tid >> 6), lane = tid & 63, wr = wid >> 2, wc = wid & 3, fr = lane & 15, fq = lane >> 4;
    const int K = g.K, nt = K / BK;
    unsigned voffA[2], voffB[2];
#pragma unroll
    for (int i = 0; i < 2; ++i) { int R, C; stage_rc(tid * 16 + i * 8192, R, C); const int Rb = Epi::PERM ? ((R & ~31) + perm32(R & 31)) : R;
        voffA[i] = (unsigned)(R * g.lda + C) * 2u; voffB[i] = (unsigned)(Rb * g.ldb + C) * 2u; }
    const size_t kstep = (size_t)(BK * 2);
    const size_t hstepA = (size_t)HALF * g.lda * 2, hstepB = (size_t)HALF * g.ldb * 2;
    const size_t tstepA = 2 * hstepA, tstepB = 2 * hstepB;
    const unsigned ldsw = (unsigned)wid * 1024u;
    const int aoff = lds_byte(wr * 64 + fr, fq * 8), boff = lds_byte(wc * 32 + fr, fq * 8);
#define PG8_SA(b, h) (((b) * 2 + (h)) * HTB)
#define PG8_SB(b, h) ((4 + (b) * 2 + (h)) * HTB)
#define PG8_STAGE(bufoff, gbase, voff) do { _Pragma("unroll") for (int _i = 0; _i < 2; ++_i) \
        __builtin_amdgcn_global_load_lds((const unsigned*)((const char*)(gbase) + (voff)[_i]), (PG8_LAS unsigned*)(lds + (bufoff) + ldsw + _i * 8192), 16, 0, 0); } while (0)
#define PG8_LDA(dst, b, h) do { _Pragma("unroll") for (int m = 0; m < 4; ++m) _Pragma("unroll") for (int k = 0; k < 2; ++k) dst[m][k] = *(const PG8_LAS bf16x8*)(lds + PG8_SA(b, h) + aoff + m * 2048 + k * 1024); } while (0)
#define PG8_LDB(dst, b, h) do { _Pragma("unroll") for (int n = 0; n < 2; ++n) _Pragma("unroll") for (int k = 0; k < 2; ++k) dst[n][k] = *(const PG8_LAS bf16x8*)(lds + PG8_SB(b, h) + boff + n * 2048 + k * 1024); } while (0)
#define PG8_MMA(ai, bj, At, Bt) do { __builtin_amdgcn_s_setprio(1); _Pragma("unroll") for (int m = 0; m < 4; ++m) _Pragma("unroll") for (int n = 0; n < 2; ++n) _Pragma("unroll") for (int k = 0; k < 2; ++k) \
        acc[ai][bj][m][n] = __builtin_amdgcn_mfma_f32_16x16x32_bf16(Bt[n][k], At[m][k], acc[ai][bj][m][n], 0, 0, 0); __builtin_amdgcn_s_setprio(0); } while (0)
#define PG8_WAIT_V(n) asm volatile("s_waitcnt vmcnt(" #n ")" ::: "memory")
#define PG8_WAIT_L(n) asm volatile("s_waitcnt lgkmcnt(" #n ")" ::: "memory")
#define PG8_BAR __builtin_amdgcn_s_barrier()
#define PG8_SCHED __builtin_amdgcn_sched_barrier(0)
    Unit cur, nxt; int ui = 0;
    if (!S.next(0, cur)) return;
    f32x4 acc[2][2][4][2];
#pragma unroll
    for (int a = 0; a < 2; ++a)
#pragma unroll
        for (int b = 0; b < 2; ++b)
#pragma unroll
            for (int m = 0; m < 4; ++m)
#pragma unroll
                for (int n = 0; n < 2; ++n) acc[a][b][m][n] = (f32x4){0.f, 0.f, 0.f, 0.f};
    bf16x8 At[4][2], B0[2][2], B1[2][2];
    const char* cA = (const char*)g.A + (size_t)cur.pm * tstepA + (size_t)cur.ko * 2; const char* cB = (const char*)g.Bt + (size_t)cur.pn * tstepB + (size_t)cur.ko * 2;
    S.a_ready(cur);
    if constexpr (SP2) {
        PG8_STAGE(PG8_SB(0, 0), cB, voffB); PG8_STAGE(PG8_SB(0, 1), cB + hstepB, voffB); PG8_STAGE(PG8_SA(0, 0), cA, voffA); PG8_STAGE(PG8_SA(0, 1), cA + hstepA, voffA);
        if (wr == 1) PG8_BAR;
        PG8_WAIT_V(2); PG8_BAR;
        PG8_STAGE(PG8_SB(1, 0), cB + kstep, voffB); PG8_STAGE(PG8_SA(1, 0), cA + kstep, voffA); PG8_STAGE(PG8_SB(1, 1), cB + hstepB + kstep, voffB);
        PG8_WAIT_V(6); PG8_BAR;
    } else {
        PG8_STAGE(PG8_SB(0, 0), cB, voffB); PG8_STAGE(PG8_SA(0, 0), cA, voffA); PG8_STAGE(PG8_SB(0, 1), cB + hstepB, voffB); PG8_STAGE(PG8_SA(0, 1), cA + hstepA, voffA);
        if (wr == 1) PG8_BAR;
        PG8_WAIT_V(4); PG8_BAR;
        PG8_STAGE(PG8_SB(1, 0), cB + kstep, voffB); PG8_STAGE(PG8_SA(1, 0), cA + kstep, voffA); PG8_STAGE(PG8_SB(1, 1), cB + hstepB + kstep, voffB);
        PG8_WAIT_V(6); PG8_BAR;
    }
    for (;;) {
        const bool has_next = S.next(ui + 1, nxt);
        const char* nA = has_next ? (const char*)g.A + (size_t)nxt.pm * tstepA + (size_t)nxt.ko * 2 : cA; const char* nB = has_next ? (const char*)g.Bt + (size_t)nxt.pn * tstepB + (size_t)nxt.ko * 2 : cB;
        for (int t = 0; t < nt; t += 2) {
            const bool last = (t == nt - 2);
            const char* a1 = cA + (size_t)(t + 1) * kstep;
            const char* a2 = last ? nA : cA + (size_t)(t + 2) * kstep; const char* b2 = last ? nB : cB + (size_t)(t + 2) * kstep;
            const char* a3 = a2 + kstep; const char* b3 = b2 + kstep;
            if (last && has_next) S.a_ready(nxt);
            if constexpr (SP2) {
            PG8_LDB(B0, 0, 0); PG8_LDB(B1, 0, 1); PG8_SCHED; PG8_LDA(At, 0, 0); PG8_STAGE(PG8_SA(1, 1), a1 + hstepA, voffA);
            PG8_WAIT_V(8); PG8_WAIT_L(0); PG8_BAR; PG8_MMA(0, 0, At, B0); PG8_MMA(0, 1, At, B1); PG8_BAR; PG8_SCHED;
            PG8_LDA(At, 0, 1); PG8_STAGE(PG8_SB(0, 0), b2, voffB); PG8_STAGE(PG8_SB(0, 1), b2 + hstepB, voffB); PG8_STAGE(PG8_SA(0, 0), a2, voffA);
            PG8_WAIT_V(8); PG8_WAIT_L(0); PG8_BAR; PG8_MMA(1, 0, At, B0); PG8_MMA(1, 1, At, B1); PG8_BAR; PG8_SCHED;
            PG8_LDB(B0, 1, 0); PG8_LDB(B1, 1, 1); PG8_SCHED; PG8_LDA(At, 1, 0); PG8_STAGE(PG8_SA(0, 1), a2 + hstepA, voffA);
            PG8_WAIT_V(8); PG8_WAIT_L(0); PG8_BAR; PG8_MMA(0, 0, At, B0); PG8_MMA(0, 1, At, B1); PG8_BAR; PG8_SCHED;
            PG8_LDA(At, 1, 1); PG8_STAGE(PG8_SB(1, 0), b3, voffB); PG8_STAGE(PG8_SB(1, 1), b3 + hstepB, voffB); PG8_STAGE(PG8_SA(1, 0), a3, voffA);
            PG8_WAIT_V(8); PG8_WAIT_L(0); PG8_BAR; PG8_MMA(1, 0, At, B0); PG8_MMA(1, 1, At, B1); PG8_BAR; PG8_SCHED;
            } else {
            PG8_LDB(B0, 0, 0); PG8_SCHED; PG8_LDA(At, 0, 0); PG8_STAGE(PG8_SA(1, 1), a1 + hstepA, voffA);
            PG8_WAIT_L(8); PG8_BAR; PG8_WAIT_L(0); PG8_MMA(0, 0, At, B0); PG8_BAR; PG8_SCHED;
            PG8_LDB(B1, 0, 1); PG8_STAGE(PG8_SB(0, 0), b2, voffB);
            PG8_BAR; PG8_WAIT_L(0); PG8_MMA(0, 1, At, B1); PG8_BAR;
            PG8_LDA(At, 0, 1); PG8_STAGE(PG8_SA(0, 0), a2, voffA);
            PG8_BAR; PG8_WAIT_L(0); PG8_MMA(1, 0, At, B0); PG8_BAR; PG8_SCHED;
            PG8_STAGE(PG8_SB(0, 1), b2 + hstepB, voffB);
            PG8_WAIT_V(6); PG8_BAR; PG8_MMA(1, 1, At, B1); PG8_BAR;
            PG8_LDB(B0, 1, 0); PG8_SCHED; PG8_LDA(At, 1, 0); PG8_STAGE(PG8_SA(0, 1), a2 + hstepA, voffA);
            PG8_WAIT_L(8); PG8_BAR; PG8_WAIT_L(0); PG8_MMA(0, 0, At, B0); PG8_BAR; PG8_SCHED;
            PG8_LDB(B1, 1, 1); PG8_STAGE(PG8_SB(1, 0), b3, voffB);
            PG8_BAR; PG8_WAIT_L(0); PG8_MMA(0, 1, At, B1); PG8_BAR;
            PG8_LDA(At, 1, 1); PG8_STAGE(PG8_SA(1, 0), a3, voffA);
            PG8_BAR; PG8_WAIT_L(0); PG8_MMA(1, 0, At, B0); PG8_BAR; PG8_SCHED;
            PG8_STAGE(PG8_SB(1, 1), b3 + hstepB, voffB);
            PG8_WAIT_V(6); PG8_BAR; PG8_MMA(1, 1, At, B1); PG8_BAR;
            }
        }
        if constexpr (ALIGN_EPI) { if (wr == 0) PG8_BAR; }
        if constexpr (!Epi::AFTER_DRAIN) { E(acc, cur, wr, wc, fr, fq); S.done(cur); }
        if (!has_next) break;
#pragma unroll
        for (int a = 0; a < 2; ++a)
#pragma unroll
            for (int b = 0; b < 2; ++b)
#pragma unroll
                for (int m = 0; m < 4; ++m)
#pragma unroll
                    for (int n = 0; n < 2; ++n) acc[a][b][m][n] = (f32x4){0.f, 0.f, 0.f, 0.f};
        cur = nxt; cA = nA; cB = nB; ++ui;
        if constexpr (ALIGN_EPI) { if (wr == 1) PG8_BAR; }
    }
    PG8_WAIT_V(0);
    if constexpr (!ALIGN_EPI) { if (wr == 0) PG8_BAR; }
    PG8_BAR;
    if constexpr (Epi::AFTER_DRAIN) { E.fused(acc, cur, wr, wc, fr, fq, lds, wid, lane); S.done(cur); }
#undef PG8_SA
#undef PG8_SB
#undef PG8_STAGE
#undef PG8_LDA
#undef PG8_LDB
#undef PG8_MMA
#undef PG8_WAIT_V
#undef PG8_WAIT_L
#undef PG8_BAR
#undef PG8_SCHED
}
}

namespace pg8 {
struct OrderPM : StaticOrder {
    int pm0;
    __device__ __forceinline__ bool next(int i, Unit& u) const { if (!StaticOrder::next(i, u)) return false; u.pm += pm0; return true; }
};
struct MoeOrder {
    int nN, G, c, ntiles; const unsigned* tile_e;
    __device__ __forceinline__ bool next(int i, Unit& u) const {
        const long L = (long)i * G + c; if (L >= (long)ntiles * nN) return false;
        const int pm = (int)(L / nN), pl = (int)(L % nN);
        const int e = (int)__hip_atomic_load(tile_e + pm, __ATOMIC_RELAXED, __HIP_MEMORY_SCOPE_AGENT);
        u.pm = pm; u.pn = __builtin_amdgcn_readfirstlane(e) * nN + pl; u.ko = 0; return true;
    }
    __device__ __forceinline__ void a_ready(const Unit&) const {}
    __device__ __forceinline__ void done(const Unit&) const {}
};

struct MoeSplitOrder {
    int G, c, ntiles; const unsigned* tile_e;
    __device__ __forceinline__ bool next(int i, Unit& u) const {
        const int L = i * G + c; if (L >= (ntiles - MOE_SPLIT_TILE) * 28) return false;
        const int sl = L % 7, t = L / 7, pm = MOE_SPLIT_TILE + (t >> 2), pl = t & 3;
        const int e = (int)__hip_atomic_load(tile_e + pm, __ATOMIC_RELAXED, __HIP_MEMORY_SCOPE_AGENT);
        u.pm = pm; u.pn = __builtin_amdgcn_readfirstlane(e) * 4 + pl; u.ko = sl * 512; return true;
    }
    __device__ __forceinline__ void a_ready(const Unit&) const {}
    __device__ __forceinline__ void done(const Unit&) const {}
};
struct EpiMoeSlab {
    static constexpr bool PERM = true, AFTER_DRAIN = false;
    bf16_t* slab;
    __device__ __forceinline__ void operator()(const f32x4 (&acc)[2][2][4][2], const Unit& u, int wr, int wc, int fr, int fq) const {
        const int row0 = (u.pm - MOE_SPLIT_TILE) * BM + wr * 64 + fr, col0 = (u.pn & 3) * BM + wc * 32 + 8 * fq;
        bf16_t* sb = slab + (size_t)(u.ko / 512) * 4096 * D;
#pragma unroll
        for (int ai = 0; ai < 2; ++ai)
#pragma unroll
            for (int m = 0; m < 4; ++m) { bf16_t* rowp = sb + (size_t)(row0 + ai * HALF + m * 16) * D + col0;
#pragma unroll
                for (int bj = 0; bj < 2; ++bj) { const f32x4 v0 = acc[ai][bj][m][0], v1 = acc[ai][bj][m][1];
                    u32x4 w; w.x = cvt_pk_bf16(v0[0], v0[1]); w.y = cvt_pk_bf16(v0[2], v0[3]); w.z = cvt_pk_bf16(v1[0], v1[1]); w.w = cvt_pk_bf16(v1[2], v1[3]);
                    *(u32x4*)(rowp + bj * HALF) = w; } }
    }
};
struct SplitKOrder {
    int G, c, ns, kslice;
    __device__ __forceinline__ bool next(int i, Unit& u) const { const int L = i * G + c; if (L >= 16 * ns) return false; const int sl = L % ns, t = L / ns; u.pm = t & 3; u.pn = t >> 2; u.ko = sl * kslice; return true; }
    __device__ __forceinline__ void a_ready(const Unit&) const {}
    __device__ __forceinline__ void done(const Unit&) const {}
};
struct EpiStore {
    static constexpr bool PERM = true, AFTER_DRAIN = false;
    bf16_t* O; int ldc; int pn_mod;
    __device__ __forceinline__ void operator()(const f32x4 (&acc)[2][2][4][2], const Unit& u, int wr, int wc, int fr, int fq) const {
        const int row0 = u.pm * BM + wr * 64 + fr, col0 = (u.pn % pn_mod) * BM + wc * 32 + 8 * fq;
#pragma unroll
        for (int ai = 0; ai < 2; ++ai)
#pragma unroll
            for (int m = 0; m < 4; ++m) { bf16_t* rowp = O + (size_t)(row0 + ai * HALF + m * 16) * ldc + col0;
#pragma unroll
                for (int bj = 0; bj < 2; ++bj) { const f32x4 v0 = acc[ai][bj][m][0], v1 = acc[ai][bj][m][1];
                    u32x4 w; w.x = cvt_pk_bf16(v0[0], v0[1]); w.y = cvt_pk_bf16(v0[2], v0[3]); w.z = cvt_pk_bf16(v1[0], v1[1]); w.w = cvt_pk_bf16(v1[2], v1[3]);
                    *(u32x4*)(rowp + bj * HALF) = w; } }
    }
};
struct EpiUp {
    static constexpr bool PERM = true, AFTER_DRAIN = false;
    bf16_t* Q; bf16_t* K;
    __device__ __forceinline__ void operator()(const f32x4 (&acc)[2][2][4][2], const Unit& u, int wr, int wc, int fr, int fq) const {
        const int row0 = u.pm * BM + wr * 64 + fr;
#pragma unroll
        for (int bj = 0; bj < 2; ++bj) {
            const int col = u.pn * BM + bj * HALF + wc * 32 + 8 * fq;
            bf16_t* base;
            if (col < 384) base = Q + col; else if (col < 640) { const int c2 = col - 384; base = K + (c2 >> 6) * 96 + (c2 & 63); } else continue;
#pragma unroll
            for (int ai = 0; ai < 2; ++ai)
#pragma unroll
                for (int m = 0; m < 4; ++m) { const f32x4 v0 = acc[ai][bj][m][0], v1 = acc[ai][bj][m][1];
                    u32x4 w; w.x = cvt_pk_bf16(v0[0], v0[1]); w.y = cvt_pk_bf16(v0[2], v0[3]); w.z = cvt_pk_bf16(v1[0], v1[1]); w.w = cvt_pk_bf16(v1[2], v1[3]);
                    *(u32x4*)(base + (size_t)(row0 + ai * HALF + m * 16) * 384) = w; }
        }
    }
};
template <bool ATOMIC> struct EpiResT {
    static constexpr bool PERM = false, AFTER_DRAIN = false;
    float* H; const float* gate;
    __device__ __forceinline__ void operator()(const f32x4 (&acc)[2][2][4][2], const Unit& u, int wr, int wc, int fr, int fq) const {
        const int row0 = u.pm * BM + wr * 64 + fr, col0 = u.pn * BM + wc * 32 + 4 * fq;
        const int mb = (u.pm < 4) ? 4 : ((u.pm - 4) >> 4);
        const float* gp = gate + (size_t)mb * 6144 + col0;
        f32x4 gv[2][2];
#pragma unroll
        for (int bj = 0; bj < 2; ++bj)
#pragma unroll
            for (int n = 0; n < 2; ++n) gv[bj][n] = *(const f32x4*)(gp + bj * HALF + n * 16);
#pragma unroll
        for (int ai = 0; ai < 2; ++ai)
#pragma unroll
            for (int m = 0; m < 4; ++m) { float* rowp = H + (size_t)(row0 + ai * HALF + m * 16) * D + col0;
#pragma unroll
                for (int bj = 0; bj < 2; ++bj)
#pragma unroll
                    for (int n = 0; n < 2; ++n) { float* pp = rowp + bj * HALF + n * 16; const f32x4 v = gv[bj][n] * acc[ai][bj][m][n];
                        f32x4* p = (f32x4*)pp; *p = *p + v; } }
    }
};
typedef EpiResT<false> EpiRes;
struct EpiSlab {
    static constexpr bool PERM = false, AFTER_DRAIN = false;
    float* slab; const float* gate; int kslice;
    __device__ __forceinline__ void operator()(const f32x4 (&acc)[2][2][4][2], const Unit& u, int wr, int wc, int fr, int fq) const {
        const int row0 = u.pm * BM + wr * 64 + fr, col0 = u.pn * BM + wc * 32 + 4 * fq;
        const float* gp = gate + (size_t)4 * 6144 + col0; float* sb = slab + (size_t)(u.ko / kslice) * MC * D;
        f32x4 gv[2][2];
#pragma unroll
        for (int bj = 0; bj < 2; ++bj)
#pragma unroll
            for (int n = 0; n < 2; ++n) gv[bj][n] = *(const f32x4*)(gp + bj * HALF + n * 16);
#pragma unroll
        for (int ai = 0; ai < 2; ++ai)
#pragma unroll
            for (int m = 0; m < 4; ++m) { float* rowp = sb + (size_t)(row0 + ai * HALF + m * 16) * D + col0;
#pragma unroll
                for (int bj = 0; bj < 2; ++bj)
#pragma unroll
                    for (int n = 0; n < 2; ++n) *(f32x4*)(rowp + bj * HALF + n * 16) = gv[bj][n] * acc[ai][bj][m][n]; }
    }
};
struct EpiSwiGLU {
    static constexpr bool PERM = true, AFTER_DRAIN = false;
    bf16_t* Hd;
    __device__ __forceinline__ void operator()(const f32x4 (&acc)[2][2][4][2], const Unit& u, int wr, int wc, int fr, int fq) const {
        const int row0 = u.pm * BM + wr * 64 + fr, col0 = (u.pn % 28) * HALF + wc * 32 + 8 * fq;
#pragma unroll
        for (int ai = 0; ai < 2; ++ai)
#pragma unroll
            for (int m = 0; m < 4; ++m) {
                float o[8];
#pragma unroll
                for (int n = 0; n < 2; ++n)
#pragma unroll
                    for (int q = 0; q < 4; ++q) { const float g = acc[ai][0][m][n][q], up = acc[ai][1][m][n][q]; o[n * 4 + q] = g * __builtin_amdgcn_rcpf(1.f + __expf(-g)) * up; }
                u32x4 w; w.x = cvt_pk_bf16(o[0], o[1]); w.y = cvt_pk_bf16(o[2], o[3]); w.z = cvt_pk_bf16(o[4], o[5]); w.w = cvt_pk_bf16(o[6], o[7]);
                *(u32x4*)(Hd + (size_t)(row0 + ai * HALF + m * 16) * DFF + col0) = w; }
    }
};
}

enum { I_X = 0, I_C, I_CTX, I_CCTX, I_WMOD, I_BMOD, I_NORM1, I_NORM2, I_WIN, I_WOUT, I_SINK, I_GCONV, I_GALOG, I_GDTB, I_GNORM, I_QNORM, I_KVNORM, I_WQUP, I_WKVUP,
       I_RLOGD, I_RNORM, I_FGATE, I_FUP, I_FDOWN, I_ROUTER, I_MGATE, I_MUP, I_MDOWN, I_FNORM, N_IN };
struct Params { const float* in[N_IN]; float* out; unsigned char* ws; int ph_lo, ph_hi; };
typedef const __attribute__((address_space(4))) Params* KArg;
__device__ __forceinline__ KArg kp_get() { KArg k = (KArg)__builtin_amdgcn_kernarg_segment_ptr(); asm volatile("" : "+s"(k)); return k; }

struct Ctx {
    LAS unsigned char* lds; int tid, lane, wave, bid, G;
};

__device__ __forceinline__ void tr_item(const float* src, int ldsrc, int nvalid, int k0, int c0, bf16_t* dst, int ldd, int drow0, LAS float* scr, int lane) {
    const int cl = 4 * (lane & 15), rr = lane >> 4, cc = c0 + cl; const bool ok = cc < nvalid;
    f32x4 v[16];
#pragma unroll
    for (int i = 0; i < 16; ++i) v[i] = ok ? *(const f32x4*)(src + (size_t)(k0 + 4 * i + rr) * ldsrc + cc) : (f32x4){0.f, 0.f, 0.f, 0.f};
#pragma unroll
    for (int i = 0; i < 16; ++i) { LAS float* d = scr + (4 * i + rr) * 65 + cl; d[0] = v[i].x; d[1] = v[i].y; d[2] = v[i].z; d[3] = v[i].w; }
    asm volatile("s_waitcnt lgkmcnt(0)" ::: "memory");
    const int c = lane & 7;
#pragma unroll
    for (int j = 0; j < 8; ++j) { const int n = (lane >> 3) + 8 * j; const LAS float* s = scr + (8 * c) * 65 + n;
        u32x4 o; o.x = cvtpk(s[0 * 65], s[1 * 65]); o.y = cvtpk(s[2 * 65], s[3 * 65]); o.z = cvtpk(s[4 * 65], s[5 * 65]); o.w = cvtpk(s[6 * 65], s[7 * 65]);
        *(u32x4*)(dst + (size_t)(drow0 + n) * ldd + k0 + 8 * c) = o; }
    asm volatile("s_waitcnt lgkmcnt(0)" ::: "memory");
}
__device__ __forceinline__ void ffn_tr_item(const float* g, const float* u, const float* d, bf16_t* gu, bf16_t* dn, int it, LAS float* scr, int lane) {
    if (it < 1792) { const bool up = it >= 896; const int r = up ? it - 896 : it; const int kb = r / 56, cb = r % 56, c0 = 64 * cb;
        tr_item(up ? u : g, DFF, DFF, 64 * kb, c0, gu, 1024, 256 * (c0 >> 7) + (up ? 128 : 0) + (c0 & 127), scr, lane); }
    else { const int r = it - 1792; const int kb = r / 16, cb = r % 16; tr_item(d, 1024, 1024, 64 * kb, 64 * cb, dn, DFF, 64 * cb, scr, lane); }
}

__device__ __forceinline__ void convert_layer_weights(KArg p, const Ctx& C, int ln, int gw, int NGW) {
    unsigned char* ws = p->ws; LAS float* scr = (LAS float*)(C.lds + C.wave * 16640);
    constexpr int I_IN = 16 * 48, I_OUT = 16 * 16, I_FF = 2688;
    const bool moe = (ln & 1) != 0; const int i = ln >> 1;
    const int nit = I_IN + I_OUT + (moe ? 8 * I_FF : I_FF);
    for (int it = gw; it < nit; it += NGW) {
        int r = it;
        if (r < I_IN) { const int kb = r / 48, cb = r % 48;
            tr_item(p->in[I_WIN] + (size_t)ln * D * DIN, DIN, DIN, 64 * kb, 64 * cb, (bf16_t*)(ws + WS_WIN) + (size_t)ln * DINP * D, D, 64 * cb, scr, C.lane); continue; }
        r -= I_IN;
        if (r < I_OUT) { const int kb = r / 16, cb = r % 16;
            tr_item(p->in[I_WOUT] + (size_t)ln * D * D, D, D, 64 * kb, 64 * cb, (bf16_t*)(ws + WS_WOUT) + (size_t)ln * D * D, D, 64 * cb, scr, C.lane); continue; }
        r -= I_OUT;
        if (!moe) { bf16_t* gu = (bf16_t*)(ws + WS_WFF + (size_t)i * FFW_BYTES);
            ffn_tr_item(p->in[I_FGATE] + (size_t)i * D * DFF, p->in[I_FUP] + (size_t)i * D * DFF, p->in[I_FDOWN] + (size_t)i * DFF * D, gu, gu + (size_t)7168 * 1024, r, scr, C.lane); }
        else { const int e = r / I_FF; r %= I_FF; const size_t eo = (size_t)i * NE + e;
            bf16_t* gu = (bf16_t*)(ws + WS_WMOE) + (size_t)e * 7168 * 1024; bf16_t* dn = (bf16_t*)(ws + WS_WMOE) + (size_t)8 * 7168 * 1024 + (size_t)e * 1024 * DFF;
            ffn_tr_item(p->in[I_MGATE] + eo * D * DFF, p->in[I_MUP] + eo * D * DFF, p->in[I_MDOWN] + eo * DFF * D, gu, dn, r, scr, C.lane); }
    }
}

__device__ __forceinline__ void prologue_phase(KArg p, const Ctx& C) {
    unsigned char* ws = p->ws;
    const int gw = C.bid * NWAVES + C.wave, NGW = C.G * NWAVES, gt = C.bid * NTHR + C.tid, NGT = C.G * NTHR;
    convert_layer_weights(p, C, 0, gw, NGW);
    {
        constexpr int PER_L = 256 * 128 + 1024 * 64 + 256 * 64;
        for (int it = gt; it < 4 * PER_L; it += NGT) {
            const int l = it / PER_L; int r = it % PER_L;
            const float* win = p->in[I_WIN] + (size_t)l * D * DIN; const float* qup = p->in[I_WQUP] + (size_t)l * 256 * 384; const float* kvup = p->in[I_WKVUP] + (size_t)l * 128 * 512;
            float v[8]; bf16_t* dst;
            if (r < 256 * 128) { const int n = r % 256, kg = r / 256;
#pragma unroll
                for (int j = 0; j < 8; ++j) v[j] = (n < 128) ? win[(size_t)(8 * kg + j) * DIN + PC_AV + n] : 0.f;
                dst = (bf16_t*)(ws + WS_WINV) + ((size_t)l * 256 + n) * 1024 + 8 * kg; }
            else if ((r -= 256 * 128) < 1024 * 64) { const int n = r % 1024, kg = r / 1024;
#pragma unroll
                for (int j = 0; j < 8; ++j) { const int k = 8 * kg + j; float x = 0.f;
                    if (n < 384) { if (k < 256) x = qup[(size_t)k * 384 + n]; }
                    else if (n < 640) { const int c2 = n - 384; if (k >= 256 && k < 384) x = kvup[(size_t)(k - 256) * 512 + 128 * (c2 >> 6) + (c2 & 63)]; }
                    v[j] = x; }
                dst = (bf16_t*)(ws + WS_WUP) + ((size_t)l * 1024 + n) * 512 + 8 * kg; }
            else { r -= 1024 * 64; const int n = r % 256, kg = r / 256;
#pragma unroll
                for (int j = 0; j < 8; ++j) { const int k = 8 * kg + j; v[j] = (k >= 256 && k < 384) ? kvup[(size_t)(k - 256) * 512 + 128 * (n >> 6) + 64 + (n & 63)] : 0.f; }
                dst = (bf16_t*)(ws + WS_WUPV) + ((size_t)l * 256 + n) * 512 + 8 * kg; }
            u32x4 o; o.x = cvtpk(v[0], v[1]); o.y = cvtpk(v[2], v[3]); o.z = cvtpk(v[4], v[5]); o.w = cvtpk(v[6], v[7]);
            *(u32x4*)dst = o;
        }
    }
    {
        float* tab = (float*)(ws + WS_TAB);
        for (int it = gt; it < 64 * 16 + 64 * 8; it += NGT) {
            if (it < 1024) { const int pos = it >> 4, j = it & 15; const float inv = (float)pow(10000.0, -(double)j / 16.0); const float ang = (float)pos * inv;
                tab[it] = (float)cos((double)ang); tab[1024 + it] = (float)sin((double)ang); }
            else { const int r = it - 1024; const int pos = r >> 3, j = r & 7; const float inv = (float)pow(10000.0, -(double)j / 8.0); const float ang = (float)pos * inv;
                tab[2048 + r] = (float)cos((double)ang); tab[2560 + r] = (float)sin((double)ang); }
        }
    }
    {
        f32x4* H4 = (f32x4*)(ws + WS_H); const f32x4* x4 = (const f32x4*)p->in[I_X]; const f32x4* c4 = (const f32x4*)p->in[I_CTX];
        for (int it = gt; it < MT * 256; it += NGT) H4[it] = (it < MC * 256) ? c4[it] : x4[it - MC * 256];
    }
    __syncthreads();
    if (C.bid < 192) {
        LAS float* sl = (LAS float*)C.lds;
        LAS float* red = (LAS float*)(C.lds + 20480);
        for (int i = C.tid; i < 5 * 1024; i += NTHR) { const int r = i >> 10, k = i & 1023; const float cv = (r < 4) ? p->in[I_C][r * 1024 + k] : p->in[I_CCTX][k]; sl[i] = silu_f(cv); }
        __syncthreads();
        for (int it = C.bid; it < 192; it += C.G) {
            const int l = it / 48, cb = it % 48, cl = C.tid & 127, kq = C.tid >> 7, col = cb * 128 + cl;
            const float* w = p->in[I_WMOD] + (size_t)l * D * 6144 + col;
            float a0 = 0.f, a1 = 0.f, a2 = 0.f, a3 = 0.f, a4 = 0.f;
#pragma unroll 32
            for (int k = 256 * kq; k < 256 * kq + 256; ++k) { const float wv = w[(size_t)k * 6144]; a0 += sl[k] * wv; a1 += sl[1024 + k] * wv; a2 += sl[2048 + k] * wv; a3 += sl[3072 + k] * wv; a4 += sl[4096 + k] * wv; }
            red[(kq * 5 + 0) * 128 + cl] = a0; red[(kq * 5 + 1) * 128 + cl] = a1; red[(kq * 5 + 2) * 128 + cl] = a2; red[(kq * 5 + 3) * 128 + cl] = a3; red[(kq * 5 + 4) * 128 + cl] = a4;
            __syncthreads();
            for (int i = C.tid; i < 5 * 128; i += NTHR) { const int r = i >> 7, c2 = i & 127; const int cc = cb * 128 + c2;
                const float s = red[(0 * 5 + r) * 128 + c2] + red[(1 * 5 + r) * 128 + c2] + red[(2 * 5 + r) * 128 + c2] + red[(3 * 5 + r) * 128 + c2] + p->in[I_BMOD][l * 6144 + cc];
                ((float*)(ws + WS_MOD))[((size_t)l * 5 + r) * 6144 + cc] = s; }
            __syncthreads();
        }
    }
}
template <int MODE>
__device__ __forceinline__ void norm_phase(KArg p, const Ctx& C, int l, bool comb, int lprev, bool moe, int row_min, int nslab) {
    unsigned char* ws = p->ws;
    float* H = (float*)(ws + WS_H); bf16_t* U = (bf16_t*)(ws + WS_U); const float* MOD = (const float*)(ws + WS_MOD);
    int* RE = (int*)(ws + WS_ROUTE); float* RW = (float*)(ws + WS_ROUTE + (size_t)MT * 8); const int* RP = (const int*)(ws + WS_ROUTE + (size_t)MT * 16);
    const bf16_t* YD = (const bf16_t*)(ws + WS_YD);
    LAS unsigned* lcnt = (LAS unsigned*)C.lds;
    if (MODE == 1 && moe) { if (C.tid < 8) lcnt[C.tid] = 0u; __syncthreads(); }
    f32x4 nv[4];
    { const int row0 = C.bid + 256 * C.wave;
#pragma unroll
      for (int j = 0; j < 4; ++j) nv[j] = *(const f32x4*)(H + (size_t)row0 * D + 4 * C.lane + 256 * j); }
    for (int ri = C.wave; ri < MT / 256; ri += NWAVES) {
        const int row = C.bid + 256 * ri;
        f32x4 v[4];
#pragma unroll
        for (int j = 0; j < 4; ++j) v[j] = nv[j];
        if (ri + NWAVES < MT / 256) {
#pragma unroll
            for (int j = 0; j < 4; ++j) nv[j] = *(const f32x4*)(H + (size_t)(row + 256 * NWAVES) * D + 4 * C.lane + 256 * j); }
        if (row < row_min) continue;
        const int mb = mod_row(row);
        if (comb) {
            const int p0 = RP[row * 2], p1 = RP[row * 2 + 1]; const float w0 = RW[row * 2], w1 = RW[row * 2 + 1];
            const float* g2 = MOD + ((size_t)lprev * 5 + mb) * 6144 + 5 * 1024;
            const bf16_t* MS = (const bf16_t*)(ws + WS_MSLAB);
            f32x4 ya[4], yb[4];
#pragma unroll
            for (int k = 0; k < 2; ++k) { const int ps = k ? p1 : p0; f32x4 (&yy)[4] = k ? yb : ya;
                if (ps < MOE_SPLIT_ROW) {
#pragma unroll
                    for (int j = 0; j < 4; ++j) { const u32x2 t = *(const u32x2*)(YD + (size_t)ps * D + 4 * C.lane + 256 * j); yy[j] = (f32x4){bf_lo(t.x), bf_hi(t.x), bf_lo(t.y), bf_hi(t.y)}; }
                } else {
#pragma unroll
                    for (int j = 0; j < 4; ++j) { u32x2 t[7];
#pragma unroll
                        for (int s = 0; s < 7; ++s) t[s] = *(const u32x2*)(MS + ((size_t)s * 4096 + (ps - MOE_SPLIT_ROW)) * D + 4 * C.lane + 256 * j);
                        f32x4 a = (f32x4){0.f, 0.f, 0.f, 0.f};
#pragma unroll
                        for (int s = 0; s < 7; ++s) a += (f32x4){bf_lo(t[s].x), bf_hi(t[s].x), bf_lo(t[s].y), bf_hi(t[s].y)};
                        yy[j] = a; }
                } }
#pragma unroll
            for (int j = 0; j < 4; ++j) { const int e = 4 * C.lane + 256 * j; const f32x4 g = *(const f32x4*)(g2 + e);
                v[j] += g * (ya[j] * w0 + yb[j] * w1);
                if (MODE != 2) *(f32x4*)(H + (size_t)row * D + e) = v[j]; }
        }
        if (nslab > 0 && row < MC) {
            const float* sl = (const float*)(ws + WS_SLAB) + (size_t)row * D + 4 * C.lane;
#pragma unroll
            for (int j = 0; j < 4; ++j) { f32x4 t[7];
#pragma unroll
                for (int s = 0; s < 7; ++s) t[s] = *(const f32x4*)(sl + (size_t)(s < nslab ? s : 0) * MC * D + 256 * j);
#pragma unroll
                for (int s = 0; s < 7; ++s) if (s < nslab) v[j] += t[s];
                *(f32x4*)(H + (size_t)row * D + 4 * C.lane + 256 * j) = v[j]; }
        }
        float ss = 0.f;
#pragma unroll
        for (int j = 0; j < 4; ++j) ss += (v[j].x * v[j].x + v[j].y * v[j].y) + (v[j].z * v[j].z + v[j].w * v[j].w);
        const float rstd = rsqrtf(wave_sum(ss) * (1.f / D) + EPS);
        if (MODE == 2) {
            const float* gam = p->in[I_FNORM];
#pragma unroll
            for (int j = 0; j < 4; ++j) { const int e = 4 * C.lane + 256 * j; const f32x4 g = *(const f32x4*)(gam + e); *(f32x4*)(p->out + (size_t)(row - MC) * D + e) = v[j] * rstd * g; }
        } else {
            const float* gam = p->in[MODE == 0 ? I_NORM1 : I_NORM2] + (size_t)l * D;
            const float* sh = MOD + ((size_t)l * 5 + mb) * 6144 + (MODE == 0 ? 0 : 3) * 1024; const float* sc = sh + 1024;
            f32x4 y[4];
#pragma unroll
            for (int j = 0; j < 4; ++j) { const int e = 4 * C.lane + 256 * j; const f32x4 g = *(const f32x4*)(gam + e), s1 = *(const f32x4*)(sc + e), s0 = *(const f32x4*)(sh + e);
                y[j] = v[j] * rstd * g * (1.f + s1) + s0;
                u32x2 o; o.x = cvtpk(y[j].x, y[j].y); o.y = cvtpk(y[j].z, y[j].w); *(u32x2*)(U + (size_t)row * D + e) = o; }
            if (MODE == 1 && moe) {
                const float* wr = p->in[I_ROUTER] + (size_t)(l >> 1) * D * NE;
                float lg[8];
#pragma unroll
                for (int e = 0; e < 8; ++e) lg[e] = 0.f;
#pragma unroll
                for (int j = 0; j < 4; ++j)
#pragma unroll
                    for (int q = 0; q < 4; ++q) { const int e = 4 * C.lane + 256 * j + q; const f32x4 wa = *(const f32x4*)(wr + (size_t)e * 8), wb = *(const f32x4*)(wr + (size_t)e * 8 + 4); const float yv = y[j][q];
                        lg[0] += yv * wa.x; lg[1] += yv * wa.y; lg[2] += yv * wa.z; lg[3] += yv * wa.w; lg[4] += yv * wb.x; lg[5] += yv * wb.y; lg[6] += yv * wb.z; lg[7] += yv * wb.w; }
#pragma unroll
                for (int e = 0; e < 8; ++e) lg[e] = wave_sum(lg[e]);
                int e0 = 0; float v0 = lg[0];
#pragma unroll
                for (int e = 1; e < 8; ++e) if (lg[e] > v0) { v0 = lg[e]; e0 = e; }
                int e1 = -1; float v1 = -3.0e38f;
#pragma unroll
                for (int e = 0; e < 8; ++e) if (e != e0 && lg[e] > v1) { v1 = lg[e]; e1 = e; }
                const float t = __expf(v1 - v0), w0 = 1.f / (1.f + t), w1 = t * w0;
                if (C.lane == 0) { RE[row * 2] = e0; RE[row * 2 + 1] = e1; RW[row * 2] = w0; RW[row * 2 + 1] = w1; atomicAdd((unsigned*)&lcnt[e0], 1u); atomicAdd((unsigned*)&lcnt[e1], 1u); }
            }
        }
    }
    if (MODE == 1 && moe) { __syncthreads(); if (C.tid < 8) __hip_atomic_store((unsigned*)(ws + WS_CTL) + CW_CNT + C.bid * 8 + C.tid, lcnt[C.tid], __ATOMIC_RELAXED, __HIP_MEMORY_SCOPE_AGENT); }
}

__device__ __forceinline__ void moe_gather_phase(KArg p, const Ctx& C, int row_min) {
    unsigned char* ws = p->ws;
    unsigned* ctl = (unsigned*)(ws + WS_CTL);
    const int* RE = (const int*)(ws + WS_ROUTE); int* RP = (int*)(ws + WS_ROUTE + (size_t)MT * 16);
    const bf16_t* U = (const bf16_t*)(ws + WS_U); bf16_t* AS = (bf16_t*)(ws + WS_ASORT);
    LAS unsigned* cn = (LAS unsigned*)C.lds;
    LAS int* myoff = (LAS int*)(C.lds + 8192);
    LAS int* base = (LAS int*)(C.lds + 8192 + 64);
    LAS int* pos = (LAS int*)(C.lds + 8192 + 128);
    for (int i = C.tid; i < 2048; i += NTHR) cn[i] = __hip_atomic_load(ctl + CW_CNT + i, __ATOMIC_RELAXED, __HIP_MEMORY_SCOPE_AGENT);
    __syncthreads();
    if (C.tid < 8) { int tot = 0, mine = 0; for (int b = 0; b < 256; ++b) { const int c = (int)cn[b * 8 + C.tid]; if (b < C.bid) mine += c; tot += c; } myoff[C.tid] = mine; base[C.tid] = (tot + 255) & ~255; }
    __syncthreads();
    if (C.tid == 0) {
        int b0 = 0; for (int e = 0; e < 8; ++e) { const int t = base[e]; base[e] = b0; myoff[e] += b0; b0 += t; } base[8] = b0;
        for (int ri = 0; ri < MT / 256; ++ri) { const int row = C.bid + 256 * ri; if (row < row_min) { pos[ri * 2] = -1; pos[ri * 2 + 1] = -1; continue; }
            for (int k = 0; k < 2; ++k) { const int e = RE[row * 2 + k]; const int ps = myoff[e]++; pos[ri * 2 + k] = ps; RP[row * 2 + k] = ps; } }
    }
    __syncthreads();
    if (C.bid == 0) {
        const int ntiles = base[8] >> 8;
        if (C.tid < MOE_TILES) { int e = 0; for (int q = 1; q < 8; ++q) if (C.tid * 256 >= base[q]) e = q; __hip_atomic_store(ctl + CW_TILEE + C.tid, (unsigned)e, __ATOMIC_RELAXED, __HIP_MEMORY_SCOPE_AGENT); }
        if (C.tid == 0) __hip_atomic_store(ctl + CW_TILEE + 160, (unsigned)ntiles, __ATOMIC_RELAXED, __HIP_MEMORY_SCOPE_AGENT);
    }
    for (int it = C.tid; it < (MT / 256) * 2 * 128; it += NTHR) { const int slot = it >> 7, ch = it & 127; const int ps = pos[slot]; if (ps < 0) continue;
        *(u32x4*)(AS + (size_t)ps * D + 8 * ch) = *(const u32x4*)(U + (size_t)(C.bid + 256 * (slot >> 1)) * D + 8 * ch); }
}

__device__ __forceinline__ void prep_row(KArg p, int lane, int l, int row) {
    unsigned char* ws = p->ws;
    const bf16_t* P = (const bf16_t*)(ws + WS_P); bf16_t* QS = (bf16_t*)(ws + WS_QS); bf16_t* KS = (bf16_t*)(ws + WS_KS); bf16_t* AUP = (bf16_t*)(ws + WS_AUP); bf16_t* KF = (bf16_t*)(ws + WS_KFULL);
    const float* tab = (const float*)(ws + WS_TAB);
    const float* qg = p->in[I_QNORM] + (size_t)l * 256; const float* kvg = p->in[I_KVNORM] + (size_t)l * 128;
        const bf16_t* pr = P + (size_t)row * DINP;
        const bool lat = row >= MC; const int t = (row - MC) & 4095, prow = t >> 6, pcol = t & 63;
        {
            const int hd = lane >> 4, j = lane & 15;
            float c_r = 1.f, s_r = 0.f, c_c = 1.f, s_c = 0.f;
            if (lat) { c_r = tab[prow * 16 + j]; s_r = tab[1024 + prow * 16 + j]; c_c = tab[pcol * 16 + j]; s_c = tab[1024 + pcol * 16 + j]; }
            { const bf16_t* q = pr + PC_AQ + hd * 64; const float x1 = bf2f(q[j]), x2 = bf2f(q[16 + j]), x3 = bf2f(q[32 + j]), x4 = bf2f(q[48 + j]); const float qs = 0.125f * LOG2E;
              bf16_t* o = QS + (size_t)row * 256 + hd * 64;
              o[j] = f2bf((x1 * c_r - x2 * s_r) * qs); o[16 + j] = f2bf((x2 * c_r + x1 * s_r) * qs); o[32 + j] = f2bf((x3 * c_c - x4 * s_c) * qs); o[48 + j] = f2bf((x4 * c_c + x3 * s_c) * qs); }
            if (lane < 32) { const bf16_t* k = pr + PC_AK + hd * 64; const float x1 = bf2f(k[j]), x2 = bf2f(k[16 + j]), x3 = bf2f(k[32 + j]), x4 = bf2f(k[48 + j]);
              bf16_t* o = KS + (size_t)row * 128 + hd * 64;
              o[j] = f2bf(x1 * c_r - x2 * s_r); o[16 + j] = f2bf(x2 * c_r + x1 * s_r); o[32 + j] = f2bf(x3 * c_c - x4 * s_c); o[48 + j] = f2bf(x4 * c_c + x3 * s_c); }
        }
        {
            const u32x2 a = *(const u32x2*)(pr + PC_CQ + 4 * lane); const float q0 = bf_lo(a.x), q1 = bf_hi(a.x), q2 = bf_lo(a.y), q3 = bf_hi(a.y);
            const float rq = rsqrtf(wave_sum(q0 * q0 + q1 * q1 + q2 * q2 + q3 * q3) * (1.f / 256.f) + EPS);
            const f32x4 g = *(const f32x4*)(qg + 4 * lane);
            u32x2 o; o.x = cvtpk(q0 * rq * g.x, q1 * rq * g.y); o.y = cvtpk(q2 * rq * g.z, q3 * rq * g.w); *(u32x2*)(AUP + (size_t)row * 512 + 4 * lane) = o;
            const unsigned b = *(const unsigned*)(pr + PC_CKV + 2 * lane); const float k0 = bf_lo(b), k1 = bf_hi(b);
            const float rk = rsqrtf(wave_sum(k0 * k0 + k1 * k1) * (1.f / 128.f) + EPS);
            const f32x2 g2 = *(const f32x2*)(kvg + 2 * lane);
            *(unsigned*)(AUP + (size_t)row * 512 + 256 + 2 * lane) = cvtpk(k0 * rk * g2.x, k1 * rk * g2.y);
            *(unsigned*)(AUP + (size_t)row * 512 + 384 + 2 * lane) = 0u;
        }
        if (lane < 16) {
            const int part = lane >> 3, j = lane & 7; const float xa = bf2f(pr[PC_CKR + 16 * part + j]), xb = bf2f(pr[PC_CKR + 16 * part + 8 + j]);
            float cs = 1.f, sn = 0.f; if (lat) { const int ps = part ? pcol : prow; cs = tab[2048 + ps * 8 + j]; sn = tab[2560 + ps * 8 + j]; }
            const bf16_t oa = f2bf(xa * cs - xb * sn), ob = f2bf(xb * cs + xa * sn);
#pragma unroll
            for (int h = 0; h < 4; ++h) { bf16_t* o = KF + (size_t)row * 384 + h * 96 + 64 + 16 * part; o[j] = oa; o[8 + j] = ob; }
        }
    }

__device__ __forceinline__ void rope8(const u32x4 a, const u32x4 b, const float* cs, const float* sn, float sc, u32x4& oa, u32x4& ob) {
    const f32x4 c0 = *(const f32x4*)cs, c1 = *(const f32x4*)(cs + 4), s0 = *(const f32x4*)sn, s1 = *(const f32x4*)(sn + 4);
    const float av[8] = {bf_lo(a.x), bf_hi(a.x), bf_lo(a.y), bf_hi(a.y), bf_lo(a.z), bf_hi(a.z), bf_lo(a.w), bf_hi(a.w)};
    const float bv[8] = {bf_lo(b.x), bf_hi(b.x), bf_lo(b.y), bf_hi(b.y), bf_lo(b.z), bf_hi(b.z), bf_lo(b.w), bf_hi(b.w)};
    const float cc[8] = {c0.x, c0.y, c0.z, c0.w, c1.x, c1.y, c1.z, c1.w}, ss[8] = {s0.x, s0.y, s0.z, s0.w, s1.x, s1.y, s1.z, s1.w};
    float ra[8], rb[8];
#pragma unroll
    for (int i = 0; i < 8; ++i) { ra[i] = (av[i] * cc[i] - bv[i] * ss[i]) * sc; rb[i] = (bv[i] * cc[i] + av[i] * ss[i]) * sc; }
    oa.x = cvtpk(ra[0], ra[1]); oa.y = cvtpk(ra[2], ra[3]); oa.z = cvtpk(ra[4], ra[5]); oa.w = cvtpk(ra[6], ra[7]);
    ob.x = cvtpk(rb[0], rb[1]); ob.y = cvtpk(rb[2], rb[3]); ob.z = cvtpk(rb[4], rb[5]); ob.w = cvtpk(rb[6], rb[7]);
}
__device__ __forceinline__ void prep_rows4(KArg p, int lane, int l, int row_base) {
    unsigned char* ws = p->ws;
    const bf16_t* P = (const bf16_t*)(ws + WS_P); bf16_t* QS = (bf16_t*)(ws + WS_QS); bf16_t* KS = (bf16_t*)(ws + WS_KS); bf16_t* AUP = (bf16_t*)(ws + WS_AUP); bf16_t* KF = (bf16_t*)(ws + WS_KFULL);
    const float* tab = (const float*)(ws + WS_TAB);
    const float* qg = p->in[I_QNORM] + (size_t)l * 256; const float* kvg = p->in[I_KVNORM] + (size_t)l * 128;
    const int row = row_base + (lane >> 4), ln = lane & 15;
    const bf16_t* pr = P + (size_t)row * DINP;
    const bool lat = row >= MC; const int t = (row - MC) & 4095, prow = t >> 6, pcol = t & 63;
    const int hd = ln >> 2, part = (ln >> 1) & 1, jq = ln & 1, ps = lat ? (part ? pcol : prow) : 0;
    const float* cs16 = tab + ps * 16 + 8 * jq; const float* sn16 = tab + 1024 + ps * 16 + 8 * jq;
    { const u32x4 qa = *(const u32x4*)(pr + PC_AQ + hd * 64 + 32 * part + 8 * jq), qb = *(const u32x4*)(pr + PC_AQ + hd * 64 + 32 * part + 16 + 8 * jq);
      u32x4 oa, ob; rope8(qa, qb, cs16, sn16, 0.125f * LOG2E, oa, ob);
      bf16_t* o = QS + (size_t)row * 256 + hd * 64 + 32 * part + 8 * jq; *(u32x4*)o = oa; *(u32x4*)(o + 16) = ob; }
    asm volatile("" ::: "memory");
    if (ln < 8) { const u32x4 ka = *(const u32x4*)(pr + PC_AK + hd * 64 + 32 * part + 8 * jq), kb = *(const u32x4*)(pr + PC_AK + hd * 64 + 32 * part + 16 + 8 * jq);
      u32x4 oa, ob; rope8(ka, kb, cs16, sn16, 1.f, oa, ob);
      bf16_t* o = KS + (size_t)row * 128 + hd * 64 + 32 * part + 8 * jq; *(u32x4*)o = oa; *(u32x4*)(o + 16) = ob; }
    asm volatile("" ::: "memory");
    {
        const u32x4 cq0 = *(const u32x4*)(pr + PC_CQ + 16 * ln), cq1 = *(const u32x4*)(pr + PC_CQ + 16 * ln + 8);
        float qv[16] = {bf_lo(cq0.x), bf_hi(cq0.x), bf_lo(cq0.y), bf_hi(cq0.y), bf_lo(cq0.z), bf_hi(cq0.z), bf_lo(cq0.w), bf_hi(cq0.w),
                        bf_lo(cq1.x), bf_hi(cq1.x), bf_lo(cq1.y), bf_hi(cq1.y), bf_lo(cq1.z), bf_hi(cq1.z), bf_lo(cq1.w), bf_hi(cq1.w)};
        float sq = 0.f;
#pragma unroll
        for (int i = 0; i < 16; ++i) sq += qv[i] * qv[i];
        sq = quad_sum(sq); sq += dppf<0x141>(sq); sq += dppf<0x140>(sq);
        const float rq = rsqrtf(sq * (1.f / 256.f) + EPS);
        unsigned ow[8];
#pragma unroll
        for (int i4 = 0; i4 < 4; ++i4) { const f32x4 g = *(const f32x4*)(qg + 16 * ln + 4 * i4);
            ow[2 * i4] = cvtpk(qv[4 * i4] * rq * g.x, qv[4 * i4 + 1] * rq * g.y); ow[2 * i4 + 1] = cvtpk(qv[4 * i4 + 2] * rq * g.z, qv[4 * i4 + 3] * rq * g.w); }
        u32x4 o0, o1; o0.x = ow[0]; o0.y = ow[1]; o0.z = ow[2]; o0.w = ow[3]; o1.x = ow[4]; o1.y = ow[5]; o1.z = ow[6]; o1.w = ow[7];
        *(u32x4*)(AUP + (size_t)row * 512 + 16 * ln) = o0; *(u32x4*)(AUP + (size_t)row * 512 + 16 * ln + 8) = o1;
    }
    asm volatile("" ::: "memory");
    {
        const u32x4 ckv = *(const u32x4*)(pr + PC_CKV + 8 * ln);
        float kv[8] = {bf_lo(ckv.x), bf_hi(ckv.x), bf_lo(ckv.y), bf_hi(ckv.y), bf_lo(ckv.z), bf_hi(ckv.z), bf_lo(ckv.w), bf_hi(ckv.w)};
        float sk = 0.f;
#pragma unroll
        for (int i = 0; i < 8; ++i) sk += kv[i] * kv[i];
        sk = quad_sum(sk); sk += dppf<0x141>(sk); sk += dppf<0x140>(sk);
        const float rk = rsqrtf(sk * (1.f / 128.f) + EPS);
        const f32x4 g0 = *(const f32x4*)(kvg + 8 * ln), g1 = *(const f32x4*)(kvg + 8 * ln + 4);
        u32x4 o2; o2.x = cvtpk(kv[0] * rk * g0.x, kv[1] * rk * g0.y); o2.y = cvtpk(kv[2] * rk * g0.z, kv[3] * rk * g0.w); o2.z = cvtpk(kv[4] * rk * g1.x, kv[5] * rk * g1.y); o2.w = cvtpk(kv[6] * rk * g1.z, kv[7] * rk * g1.w);
        *(u32x4*)(AUP + (size_t)row * 512 + 256 + 8 * ln) = o2;
        u32x4 z; z.x = z.y = z.z = z.w = 0u; *(u32x4*)(AUP + (size_t)row * 512 + 384 + 8 * ln) = z;
    }
    asm volatile("" ::: "memory");
    if (ln < 2) { const u32x4 ra = *(const u32x4*)(pr + PC_CKR + 16 * ln), rb = *(const u32x4*)(pr + PC_CKR + 16 * ln + 8);
      const int ps2 = lat ? (ln ? pcol : prow) : 0; u32x4 oa, ob; rope8(ra, rb, tab + 2048 + ps2 * 8, tab + 2560 + ps2 * 8, 1.f, oa, ob);
#pragma unroll
        for (int h = 0; h < 4; ++h) { bf16_t* o = KF + (size_t)row * 384 + h * 96 + 64 + 16 * ln; *(u32x4*)o = oa; *(u32x4*)(o + 8) = ob; } }
}

__device__ __forceinline__ void prep_phase(KArg p, const Ctx& C, int l) {
    const int gw = C.bid * NWAVES + C.wave, NGW = C.G * NWAVES;
    for (int it = gw; it < MT / 4; it += NGW) prep_rows4(p, C.lane, l, 4 * it);
}

struct AttnArgs {
    const bf16_t* Q; int q_pitch, q_col0, q_row0;
    const bf16_t* K; int k_pitch, k_col0;
    const bf16_t* Vt; int vt_row0;
    int seg_tok0, seg_nt0, seg_tok1, seg_nt1;
    int qpos0, kpos0;
    float m_init, l_init, qscale;
    bf16_t* O; int o_col0;
    const float* tab32; int qt0;
};
template <int DQK, bool MASK, bool ROPEQ>
__device__ __forceinline__ void attn_unit(const Ctx& C, const AttnArgs& a) {
    constexpr int KP = DQK + 8, NCH = DQK / 8, KT_BYTES = 64 * KP * 2, VP = 68, VT_BYTES = 64 * VP * 2, BUF = KT_BYTES + VT_BYTES, NKS = DQK / 16;
    LAS unsigned char* lds = C.lds;
    const int lane = C.lane, c = lane & 31, hi = lane >> 5, w = C.wave, tid = C.tid;
    const int qi = 32 * w + c;
    bf16x8 qf[NKS];
    {
        const bf16_t* qp = a.Q + (size_t)(a.q_row0 + qi) * a.q_pitch + a.q_col0;
#pragma unroll
        for (int ks = 0; ks < NKS; ++ks) {
            const u32x4 raw = *(const u32x4*)(qp + 16 * ks + 8 * hi);
            float f[8] = {bf_lo(raw.x), bf_hi(raw.x), bf_lo(raw.y), bf_hi(raw.y), bf_lo(raw.z), bf_hi(raw.z), bf_lo(raw.w), bf_hi(raw.w)};
            if (ROPEQ && ks >= 4) {
                const u32x4 ro = *(const u32x4*)(qp + 16 * ks + 8 * (1 - hi));
                const float g[8] = {bf_lo(ro.x), bf_hi(ro.x), bf_lo(ro.y), bf_hi(ro.y), bf_lo(ro.z), bf_hi(ro.z), bf_lo(ro.w), bf_hi(ro.w)};
                const int t = a.qt0 + qi, ps = (ks == 4) ? (t >> 6) : (t & 63);
#pragma unroll
                for (int j = 0; j < 8; ++j) { const float cs = a.tab32[ps * 8 + j], sn = a.tab32[512 + ps * 8 + j]; f[j] = hi ? (f[j] * cs + g[j] * sn) : (f[j] * cs - g[j] * sn); }
            }
            qf[ks] = mk_frag4(cvtpk(f[0] * a.qscale, f[1] * a.qscale), cvtpk(f[2] * a.qscale, f[3] * a.qscale), cvtpk(f[4] * a.qscale, f[5] * a.qscale), cvtpk(f[6] * a.qscale, f[7] * a.qscale));
        }
    }
    f32x16 o0, o1;
#pragma unroll
    for (int r = 0; r < 16; ++r) { o0[r] = 0.f; o1[r] = 0.f; }
    float m = a.m_init, l = a.l_init;
    const int NT = a.seg_nt0 + a.seg_nt1;
    u32x4 kst[2][2]; u32x4 vst[2];
    auto tile_tok = [&](int t) { return t < a.seg_nt0 ? a.seg_tok0 + 64 * t : a.seg_tok1 + 64 * (t - a.seg_nt0); };
    auto g_load = [&](int t, u32x4 (&ks_)[2], u32x4& vs_) {
        const int tk = tile_tok(t);
#pragma unroll
        for (int i = 0; i < 2; ++i) { const int ch = tid + 512 * i; if (ch < 64 * NCH) { const int r = ch / NCH, c8 = ch % NCH; ks_[i] = *(const u32x4*)(a.K + (size_t)(tk + r) * a.k_pitch + a.k_col0 + 8 * c8); } }
        { const int r = tid >> 3, c8 = tid & 7; vs_ = *(const u32x4*)(a.Vt + (size_t)(a.vt_row0 + r) * MT + tk + 8 * c8); }
    };
    auto l_store = [&](int b, const u32x4 (&ks_)[2], const u32x4& vs_) {
        LAS unsigned char* kb = lds + b * BUF; LAS unsigned char* vb = kb + KT_BYTES;
#pragma unroll
        for (int i = 0; i < 2; ++i) { const int ch = tid + 512 * i; if (ch < 64 * NCH) { const int r = ch / NCH, c8 = ch % NCH; *(LAS u32x4*)(kb + r * (KP * 2) + 16 * c8) = ks_[i]; } }
        { const int r = tid >> 3, c8 = tid & 7; LAS u32x2* d = (LAS u32x2*)(vb + r * (VP * 2) + 16 * c8); u32x2 lo, hi2; lo.x = vs_.x; lo.y = vs_.y; hi2.x = vs_.z; hi2.y = vs_.w; d[0] = lo; d[1] = hi2; }
    };
    __syncthreads();
    g_load(0, kst[0], vst[0]); if (NT > 1) g_load(1, kst[1], vst[1]);
    l_store(0, kst[0], vst[0]);
    __syncthreads();
    auto tile = [&](int t) {

        const int b = t & 1;
        LAS unsigned char* kb = lds + b * BUF; LAS unsigned char* vb = kb + KT_BYTES;
        f32x16 s0, s1;
        const float negm = -m;
#pragma unroll
        for (int r = 0; r < 16; ++r) { s0[r] = negm; s1[r] = negm; }
        bf16x8 kf0[NKS], kf1[NKS];
#pragma unroll
        for (int ks = 0; ks < NKS; ++ks) { kf0[ks] = *(const LAS bf16x8*)(kb + c * (KP * 2) + 32 * ks + 16 * hi); kf1[ks] = *(const LAS bf16x8*)(kb + (32 + c) * (KP * 2) + 32 * ks + 16 * hi); }
        asm volatile("s_waitcnt lgkmcnt(0)" ::: "memory"); __builtin_amdgcn_sched_barrier(0);
        bf16x8 vf0[2][2], vf1[2][2];
#pragma unroll
        for (int kt = 0; kt < 2; ++kt)
#pragma unroll
            for (int s2 = 0; s2 < 2; ++s2) {
                const int ko = (32 * kt + 16 * s2 + 4 * hi) * 2;
                const LAS unsigned char* v0p = vb + c * (VP * 2) + ko; const LAS unsigned char* v1p = vb + (32 + c) * (VP * 2) + ko;
                vf0[kt][s2] = mk_frag(*(const LAS u32x2*)v0p, *(const LAS u32x2*)(v0p + 16));
                vf1[kt][s2] = mk_frag(*(const LAS u32x2*)v1p, *(const LAS u32x2*)(v1p + 16));
            }
#pragma unroll
        for (int ks = 0; ks < NKS; ++ks) { s0 = mfma32(kf0[ks], qf[ks], s0); s1 = mfma32(kf1[ks], qf[ks], s1); }
        if (MASK && t >= a.seg_nt0) {
            const int qpos = a.qpos0 + qi, kbase = a.kpos0 + 64 * (t - a.seg_nt0);
#pragma unroll
            for (int r = 0; r < 16; ++r) { const int k0p = kbase + crow(r, hi), d0 = qpos - k0p, d1 = d0 - 32;
                if (d0 > 128 || d0 < -128) s0[r] = -1e30f; if (d1 > 128 || d1 < -128) s1[r] = -1e30f; }
        }
        float mx = s0[0];
#pragma unroll
        for (int r = 1; r < 16; ++r) mx = fmaxf(mx, s0[r]);
#pragma unroll
        for (int r = 0; r < 16; ++r) mx = fmaxf(mx, s1[r]);
        mx = xor32_max(mx);
        if (t == 0 || __builtin_amdgcn_ballot_w64(mx > 6.f) != 0ull) {
            const float delta = (t == 0) ? fmaxf(mx, -64.f) : fmaxf(mx, 0.f), alpha = __builtin_amdgcn_exp2f(-delta);
            m += delta; l *= alpha;
#pragma unroll
            for (int r = 0; r < 16; ++r) { o0[r] *= alpha; o1[r] *= alpha; s0[r] -= delta; s1[r] -= delta; }
        }
        float ls = 0.f;
#pragma unroll
        for (int r = 0; r < 16; ++r) { s0[r] = __builtin_amdgcn_exp2f(s0[r]); s1[r] = __builtin_amdgcn_exp2f(s1[r]); ls += s0[r] + s1[r]; }
        ls = xor32_sum(ls);
        l += ls;
        bf16x8 pf[2][2];
#pragma unroll
        for (int s2 = 0; s2 < 2; ++s2) {
            pf[0][s2] = mk_frag4(cvtpk(s0[8 * s2 + 0], s0[8 * s2 + 1]), cvtpk(s0[8 * s2 + 2], s0[8 * s2 + 3]), cvtpk(s0[8 * s2 + 4], s0[8 * s2 + 5]), cvtpk(s0[8 * s2 + 6], s0[8 * s2 + 7]));
            pf[1][s2] = mk_frag4(cvtpk(s1[8 * s2 + 0], s1[8 * s2 + 1]), cvtpk(s1[8 * s2 + 2], s1[8 * s2 + 3]), cvtpk(s1[8 * s2 + 4], s1[8 * s2 + 5]), cvtpk(s1[8 * s2 + 6], s1[8 * s2 + 7]));
        }
#pragma unroll
        for (int kt = 0; kt < 2; ++kt)
#pragma unroll
            for (int s2 = 0; s2 < 2; ++s2) { o0 = mfma32(vf0[kt][s2], pf[kt][s2], o0); o1 = mfma32(vf1[kt][s2], pf[kt][s2], o1); }
    };
    for (int t = 0; t < NT; t += 2) {
        if (t + 2 < NT) g_load(t + 2, kst[0], vst[0]);
        TIC(30); tile(t); TOC(30);
        TIC(31); l_store(1, kst[1], vst[1]); TOC(31);
        __syncthreads();
        if (t + 3 < NT) g_load(t + 3, kst[1], vst[1]);
        TIC(30); tile(t + 1); TOC(30);
        TIC(31); if (t + 2 < NT) l_store(0, kst[0], vst[0]); TOC(31);
        __syncthreads();
    }
    const float inv = __builtin_amdgcn_rcpf(l);
    bf16_t* op = a.O + (size_t)(a.q_row0 + qi) * D + a.o_col0;
#pragma unroll
    for (int g = 0; g < 4; ++g) {
        u32x2 w0, w1;
        w0.x = cvtpk(o0[4 * g] * inv, o0[4 * g + 1] * inv); w0.y = cvtpk(o0[4 * g + 2] * inv, o0[4 * g + 3] * inv);
        w1.x = cvtpk(o1[4 * g] * inv, o1[4 * g + 1] * inv); w1.y = cvtpk(o1[4 * g + 2] * inv, o1[4 * g + 3] * inv);
        *(u32x2*)(op + 8 * g + 4 * hi) = w0; *(u32x2*)(op + 32 + 8 * g + 4 * hi) = w1;
    }
}

__device__ __forceinline__ void attn_dispatch(KArg p, const Ctx& C, int l, int u) {
    unsigned char* ws = p->ws;
    AttnArgs a;
    a.tab32 = (const float*)(ws + WS_TAB) + 2048; a.O = (bf16_t*)(ws + WS_MIX);
    if (u < 256 || (u >= 512 && u < 528)) {
        const bool ctxq = u >= 512; const int v = ctxq ? u - 512 : u;
        const int b = ctxq ? (v >> 2) : (v >> 6), h = ctxq ? (v & 3) : ((v >> 4) & 3), qb = ctxq ? 0 : (v & 15);
        a.Q = (const bf16_t*)(ws + WS_QRAW); a.q_pitch = 384; a.q_col0 = 96 * h; a.q_row0 = ctxq ? 256 * b : MC + 4096 * b + 256 * qb;
        a.K = (const bf16_t*)(ws + WS_KFULL); a.k_pitch = 384; a.k_col0 = 96 * h; a.Vt = (const bf16_t*)(ws + WS_VTM); a.vt_row0 = 64 * h;
        a.seg_tok0 = 256 * b; a.seg_nt0 = 4; a.seg_tok1 = MC + 4096 * b; a.seg_nt1 = ctxq ? 0 : 64; a.qpos0 = 0; a.kpos0 = 0;
        a.m_init = 0.f; a.l_init = 0.f; a.qscale = 0.10206207261596575f * LOG2E; a.o_col0 = 512 + 64 * h; a.qt0 = 256 * qb;
        if (ctxq) attn_unit<96, false, false>(C, a); else attn_unit<96, false, true>(C, a);
    } else {
        const bool ctxq = u >= 528; const int v = ctxq ? u - 528 : u - 256;
        const int b = ctxq ? (v >> 2) : (v >> 6), hq = ctxq ? (v & 3) : ((v >> 4) & 3), qb = ctxq ? 0 : (v & 15), g = hq >> 1;
        a.Q = (const bf16_t*)(ws + WS_QS); a.q_pitch = 256; a.q_col0 = 64 * hq; a.q_row0 = ctxq ? 256 * b : MC + 4096 * b + 256 * qb;
        a.K = (const bf16_t*)(ws + WS_KS); a.k_pitch = 128; a.k_col0 = 64 * g; a.Vt = (const bf16_t*)(ws + WS_VTS); a.vt_row0 = 64 * g;
        const int q0 = 256 * qb, ks = q0 - 128 < 0 ? 0 : q0 - 128, ke = q0 + 384 > SEQ ? SEQ : q0 + 384;
        a.seg_tok0 = 256 * b; a.seg_nt0 = 4; a.seg_tok1 = MC + 4096 * b + ks; a.seg_nt1 = ctxq ? 0 : (ke - ks) >> 6; a.qpos0 = q0; a.kpos0 = ks;
        a.m_init = p->in[I_SINK][l * 4 + hq] * LOG2E; a.l_init = 1.f; a.qscale = 1.f; a.o_col0 = 64 * hq; a.qt0 = 0;
        if (ctxq) attn_unit<64, false, false>(C, a); else attn_unit<64, true, false>(C, a);
    }
}

template <class FA, class FB>
__device__ __forceinline__ f32x16 lds_mma64(int lane, FA fa, FB fb) {
    const int c = lane & 31, hi = lane >> 5;
    f32x16 acc;
#pragma unroll
    for (int r = 0; r < 16; ++r) acc[r] = 0.f;
#pragma unroll
    for (int s = 0; s < 4; ++s) {
        float av[8], bv[8];
#pragma unroll
        for (int j = 0; j < 8; ++j) { const int k = 16 * s + 8 * hi + j; av[j] = fa(c, k); bv[j] = fb(k, c); }
        acc = mfma32(mk_frag4(cvtpk(av[0], av[1]), cvtpk(av[2], av[3]), cvtpk(av[4], av[5]), cvtpk(av[6], av[7])),
                     mk_frag4(cvtpk(bv[0], bv[1]), cvtpk(bv[2], bv[3]), cvtpk(bv[4], bv[5]), cvtpk(bv[6], bv[7])), acc);
    }
    return acc;
}
__device__ __forceinline__ void frag_store(unsigned char* base, int r, int c8, u32x4 o) {
#pragma unroll
    for (int g = 0; g < 2; ++g) { const int g4 = 2 * c8 + g, T = g4 >> 3, rem = g4 & 7, ks = rem >> 2, jh = (rem >> 1) & 1, hi = rem & 1;
        u32x2 w; w.x = g ? o.z : o.x; w.y = g ? o.w : o.y;
        *(u32x2*)(base + (size_t)(((((r >> 5) * 2 + T) * 2 + ks) * 64 + (r & 31) + 32 * hi) * 16 + 8 * jh)) = w; }
}
__device__ __forceinline__ void lds_barrier() { asm volatile("s_waitcnt lgkmcnt(0)" ::: "memory"); __builtin_amdgcn_s_barrier(); asm volatile("" ::: "memory"); }
__device__ __forceinline__ int su_index(int d, int b, int h, int cg) {
    const int s = cg < 4 ? (d ? 3 - cg : cg) : 4 + (d ? 63 - (cg - 4) : (cg - 4));
    return ((d * 4 + b) * 4 + h) * 68 + s;
}
#ifndef PREP_IN_GDN
#define PREP_IN_GDN 0
#endif
#ifndef GSECT
#define GSECT 0
#endif
constexpr int XP = 65;

template <int I>
__device__ __forceinline__ void solve_rows(float (&x)[64], f32x4 (&Lc)[8], f32x4 (&Ln)[8], const LAS float* Ld) {
    if constexpr (I < 64) {
        f32x4 Lt[8];
#pragma unroll
        for (int q = 8; q < 16; ++q) if (4 * q < I) Lt[q - 8] = *(const LAS f32x4*)(Ld + I * 68 + 4 * q);
        if constexpr (I + 1 < 64) {
#pragma unroll
            for (int q = 0; q < 8; ++q) if (4 * q < I + 1) Ln[q] = *(const LAS f32x4*)(Ld + (I + 1) * 68 + 4 * q);
        }
        float s0 = 0.f, s1 = 0.f, s2 = 0.f, s3 = 0.f;
#pragma unroll
        for (int q = 0; q < 16; ++q) if (4 * q < I) { const f32x4 lv = q < 8 ? Lc[q & 7] : Lt[q & 7];
            s0 += lv.x * x[4 * q]; if (4 * q + 1 < I) s1 += lv.y * x[4 * q + 1]; if (4 * q + 2 < I) s2 += lv.z * x[4 * q + 2]; if (4 * q + 3 < I) s3 += lv.w * x[4 * q + 3]; }
        x[I] -= (s0 + s1) + (s2 + s3);
        solve_rows<I + 1>(x, Ln, Lc, Ld);
    }
}
__device__ __forceinline__ void gdn_chunk_unit(KArg p, const Ctx& C, int l, int b, int h, int cg, int ug) {
    unsigned char* ws = p->ws; const bf16_t* P = (const bf16_t*)(ws + WS_P);
    int tid_l = C.tid; asm volatile("" : "+v"(tid_l));
    const int tid = tid_l, lane = tid & 63, w = __builtin_amdgcn_readfirstlane(tid >> 6);
    LAS float* xq = (LAS float*)C.lds; LAS float* xk = xq + 64 * XP; LAS float* xv = xk + 64 * XP;
    LAS float* KK = xv + 64 * XP; LAS float* QK = KK + 64 * XP;
    LAS float* Lm = QK + 64 * XP;
    LAS float* gcs = Lm + 2 * 64 * 68; LAS float* bts = gcs + 128; LAS float* egs = bts + 128; LAS float* cw = egs + 128;
    LAS float* raw = KK;
    LAS float* Wst = KK;
    const int seq0 = cg < 4 ? 256 * b : MC + 4096 * b, seqlen = cg < 4 ? 256 : 4096, t0 = cg < 4 ? 64 * cg : 64 * (cg - 4);
    bf16_t ab_a = 0, ab_b = 0;
    if (w < 2) { const int tau = w ? 63 - lane : lane; const bf16_t* pr = P + (size_t)(seq0 + t0 + tau) * DINP + PC_BAB + w * 8 + h; ab_a = pr[0]; ab_b = pr[4]; }
    lds_barrier();
    TIC(1);
    for (int rr1 = 0; rr1 < ((GSECT == 1) ? 2 : 1); ++rr1) {
    if (rr1) lds_barrier();
    TIC(41);
    {
        u32x4 rv[4]; float cwv[2];
#pragma unroll
        for (int k = 0; k < 4; ++k) { const int it = tid + NTHR * k; const int r = it / 24, ch = it % 24, t = t0 - 2 + r; const int part = ch >> 3, c8 = ch & 7;
            rv[k].x = rv[k].y = rv[k].z = rv[k].w = 0u;
            if (it < 68 * 24 && t >= 0 && t < seqlen) rv[k] = *(const u32x4*)(P + (size_t)(seq0 + t) * DINP + PC_BQKV + 256 * part + 64 * h + 8 * c8); }
#pragma unroll
        for (int k = 0; k < 2; ++k) { const int it = tid + NTHR * k; const int j = it / 192, cc = it % 192; cwv[k] = (it < 5 * 192) ? p->in[I_GCONV][((size_t)l * 5 + j) * 768 + 256 * (cc >> 6) + 64 * h + (cc & 63)] : 0.f; }
#pragma unroll
        for (int k = 0; k < 4; ++k) { const int it = tid + NTHR * k; if (it < 68 * 24) { const int r = it / 24, ch = it % 24; const int part = ch >> 3, c8 = ch & 7; const u32x4 v = rv[k];
            LAS float* d = raw + r * 192 + 64 * part + 8 * c8;
            d[0] = bf_lo(v.x); d[1] = bf_hi(v.x); d[2] = bf_lo(v.y); d[3] = bf_hi(v.y); d[4] = bf_lo(v.z); d[5] = bf_hi(v.z); d[6] = bf_lo(v.w); d[7] = bf_hi(v.w); } }
#pragma unroll
        for (int k = 0; k < 2; ++k) { const int it = tid + NTHR * k; if (it < 5 * 192) cw[it] = cwv[k]; }
    }
    lds_barrier();
    TOC(41); TIC(42);
    if (tid < 384) {
        const int cc = tid % 192, th = tid / 192; LAS float* dst = (cc < 64) ? xq : (cc < 128 ? xk : xv);
        float wj[5], rw[36];
#pragma unroll
        for (int j = 0; j < 5; ++j) wj[j] = cw[j * 192 + cc];
#pragma unroll
        for (int r = 0; r < 36; ++r) rw[r] = raw[(32 * th + r) * 192 + cc];
#pragma unroll
        for (int t = 0; t < 32; ++t) { float y = rw[t] * wj[0];
#pragma unroll
            for (int j = 1; j < 5; ++j) y += rw[t + j] * wj[j];
            dst[(32 * th + t) * XP + (cc & 63)] = silu_f(y); }
    }
    lds_barrier();
    TOC(42); TIC(43);
    {
        const int mat = tid >> 8, r = (tid >> 2) & 63, q4 = tid & 3; LAS float* m = (mat ? xk : xq) + r * XP + 16 * q4; float v[16]; float ss = 0.f;
#pragma unroll
        for (int k = 0; k < 16; ++k) { v[k] = m[k]; ss += v[k] * v[k]; }
        ss = quad_sum(ss);
        const float sc = rsqrtf(ss + EPS) * (mat ? 1.f : 0.125f);
#pragma unroll
        for (int k = 0; k < 16; ++k) m[k] = v[k] * sc;
    }
    lds_barrier();
    TOC(43); TIC(44);
    {
        const int mat = w >> 2, rt = (w >> 1) & 1, ct = w & 1; LAS float* Am = mat ? xq : xk;
        const f32x16 acc = lds_mma64(lane, [&](int r, int k) { return Am[(32 * rt + r) * XP + k]; }, [&](int k, int c2) { return xk[(32 * ct + c2) * XP + k]; });
        LAS float* Om = mat ? QK : KK;
#pragma unroll
        for (int r = 0; r < 16; ++r) Om[(32 * rt + crow(r, lane >> 5)) * XP + 32 * ct + (lane & 31)] = acc[r];
    }
    }
    TOC(1); TIC(2);
    for (int rr2 = 0; rr2 < ((GSECT == 2) ? 2 : 1); ++rr2) {
    if (rr2) lds_barrier();
    TOC(44);
    TIC(48);
    if (w < 2) {
        const int d = w;
        const float a = bf2f(ab_a), bt = bf2f(ab_b);
        float g = -__expf(p->in[I_GALOG][(l * 2 + d) * 4 + h]) * softplus_f(a + p->in[I_GDTB][(l * 2 + d) * 4 + h]);
#pragma unroll
        for (int o = 1; o < 64; o <<= 1) { const float n = __shfl_up(g, o); if (lane >= o) g += n; }
        gcs[d * 64 + lane] = g; bts[d * 64 + lane] = sigmoid_f(bt); egs[d * 64 + lane] = __expf(g);
        if (lane == 63) ((float*)(ws + WS_DEC))[su_index(d, b, h, cg)] = __expf(g);
    }
    lds_barrier();
    TOC(48); TIC(49);
    {
        const int j = tid & 63, wq = tid >> 6;
#pragma unroll
        for (int d = 0; d < 2; ++d) { const int tj = d ? 63 - j : j; const float gj = gcs[d * 64 + j];
            float kkv[8], bi[8], gi[8];
#pragma unroll
            for (int k = 0; k < 8; ++k) { const int i = wq + 8 * k, ti = d ? 63 - i : i; kkv[k] = KK[ti * XP + tj]; bi[k] = bts[d * 64 + i]; gi[k] = gcs[d * 64 + i]; }
#pragma unroll
            for (int k = 0; k < 8; ++k) { const int i = wq + 8 * k; Lm[(d * 64 + i) * 68 + j] = (j < i) ? bi[k] * kkv[k] * __expf(gi[k] - gj) : 0.f; } }
    }
    TOC(49); TIC(50);
#pragma unroll
    for (int d = 0; d < 2; ++d) {
        unsigned char* rec = ws + WS_RECG + (size_t)su_index(d, b, h, cg) * REC_G_BYTES; const LAS float* gc = gcs + d * 64;
        const int r = tid >> 3, c8 = tid & 7, it_ = d ? 63 - r : r;
        { float v[8];
#pragma unroll
          for (int j = 0; j < 8; ++j) { const int i = 8 * c8 + j, ti = d ? 63 - i : i; v[j] = xk[ti * XP + r] * __expf(gc[63] - gc[i]); }
          u32x4 o; o.x = cvtpk(v[0], v[1]); o.y = cvtpk(v[2], v[3]); o.z = cvtpk(v[4], v[5]); o.w = cvtpk(v[6], v[7]); *(u32x4*)(rec + REC_G_KDT + (r * 64 + 8 * c8) * 2) = o; }
        { const float e = egs[d * 64 + it_]; float v[8];
#pragma unroll
          for (int j = 0; j < 8; ++j) v[j] = xq[r * XP + 8 * c8 + j] * e;
          u32x4 o; o.x = cvtpk(v[0], v[1]); o.y = cvtpk(v[2], v[3]); o.z = cvtpk(v[4], v[5]); o.w = cvtpk(v[6], v[7]); frag_store(rec + REC_G_QG, r, c8, o); }
        { float v[8];
#pragma unroll
          for (int j = 0; j < 8; ++j) { const int i = 8 * c8 + j, ti = d ? 63 - i : i; v[j] = (it_ >= i) ? QK[r * XP + ti] * __expf(gc[it_] - gc[i]) : 0.f; }
          u32x4 o; o.x = cvtpk(v[0], v[1]); o.y = cvtpk(v[2], v[3]); o.z = cvtpk(v[4], v[5]); o.w = cvtpk(v[6], v[7]); frag_store(rec + REC_G_ATT, r, c8, o); }
    }
    }
    TOC(50);
    lds_barrier();
    TOC(2); TIC(3);
    for (int rr3 = 0; rr3 < ((GSECT == 3) ? 2 : 1); ++rr3) {
    if (PREP_IN_GDN && tid >= 256) {
        prep_rows4(p, lane, l, 16 * ug + 4 * (w - 4));
    }
    if (tid < 256) {
        const int d = tid >> 7, col = tid & 127; const LAS float* Ld = Lm + d * 64 * 68; const LAS float* bt = bts + d * 64; const LAS float* eg = egs + d * 64;
        TIC(45);
        float x[64];
        {
            const LAS float* src = (col < 64) ? xv + col : xk + (col - 64);
#pragma unroll
            for (int i = 0; i < 64; ++i) { const int ti = d ? 63 - i : i; x[i] = src[ti * XP]; }
#pragma unroll
            for (int i4 = 0; i4 < 16; ++i4) { f32x4 bq = *(const LAS f32x4*)(bt + 4 * i4);
                if (col >= 64) bq *= *(const LAS f32x4*)(eg + 4 * i4);
                x[4 * i4] *= bq.x; x[4 * i4 + 1] *= bq.y; x[4 * i4 + 2] *= bq.z; x[4 * i4 + 3] *= bq.w; }
        }
        TOC(45); TIC(46);
        f32x4 La[8], Lb[8];
        La[0] = *(const LAS f32x4*)(Ld + 1 * 68);
        solve_rows<1>(x, La, Lb, Ld);
        TOC(46); TIC(47);
        unsigned char* rec = ws + WS_RECG + (size_t)su_index(d, b, h, cg) * REC_G_BYTES;
        if (col < 64) {
#pragma unroll
            for (int i4 = 0; i4 < 16; ++i4) { f32x4 o; o.x = x[4 * i4]; o.y = x[4 * i4 + 1]; o.z = x[4 * i4 + 2]; o.w = x[4 * i4 + 3]; *(f32x4*)(rec + REC_G_UT + (col * 64 + 4 * i4) * 4) = o; }
        } else {
#pragma unroll
            for (int i = 0; i < 64; ++i) Wst[(d * 64 + i) * XP + col - 64] = x[i];
        }
    }
    }
    lds_barrier();
#pragma unroll
    for (int d = 0; d < 2; ++d) { const int r = tid >> 3, c8 = tid & 7;
        unsigned char* rec = ws + WS_RECG + (size_t)su_index(d, b, h, cg) * REC_G_BYTES;
        u32x4 o; const LAS float* s = Wst + (d * 64 + r) * XP + 8 * c8; o.x = cvtpk(s[0], s[1]); o.y = cvtpk(s[2], s[3]); o.z = cvtpk(s[4], s[5]); o.w = cvtpk(s[6], s[7]);
        *(u32x4*)(rec + REC_G_W + (r * 64 + 8 * c8) * 2) = o; }
    TOC(3);
}

__device__ __forceinline__ void ret_chunk_unit(KArg p, const Ctx& C, int l, int b, int h, int cg) {
    unsigned char* ws = p->ws; const bf16_t* P = (const bf16_t*)(ws + WS_P); const float* tab = (const float*)(ws + WS_TAB);
    int tid_l = C.tid; asm volatile("" : "+v"(tid_l));
    const int tid = tid_l, lane = tid & 63, w = __builtin_amdgcn_readfirstlane(tid >> 6);
    LAS float* xq = (LAS float*)C.lds; LAS float* xk = xq + 64 * XP; LAS float* xv = xk + 64 * XP; LAS float* QK = xv + 64 * XP;
    const bool lat = cg >= 4;
    const int seq0 = lat ? MC + 4096 * b : 256 * b, t0 = lat ? 64 * (cg - 4) : 64 * cg;
    lds_barrier();
    TIC(51);
    {
        const int mat = tid >> 8, r = (tid >> 2) & 63, part = (tid >> 1) & 1, jq = tid & 1; const int t = t0 + r;
        const bf16_t* pr = P + (size_t)(seq0 + t) * DINP + (mat ? PC_DK : PC_DQ) + 64 * h + 32 * part + 8 * jq;
        const u32x4 va = *(const u32x4*)pr, vb = *(const u32x4*)(pr + 16);
        const int ps = lat ? (part ? (t & 63) : (t >> 6)) : 0;
        const f32x4 c0 = *(const f32x4*)(tab + ps * 16 + 8 * jq), c1 = *(const f32x4*)(tab + ps * 16 + 8 * jq + 4), s0 = *(const f32x4*)(tab + 1024 + ps * 16 + 8 * jq), s1 = *(const f32x4*)(tab + 1024 + ps * 16 + 8 * jq + 4);
        const float av[8] = {bf_lo(va.x), bf_hi(va.x), bf_lo(va.y), bf_hi(va.y), bf_lo(va.z), bf_hi(va.z), bf_lo(va.w), bf_hi(va.w)};
        const float bv[8] = {bf_lo(vb.x), bf_hi(vb.x), bf_lo(vb.y), bf_hi(vb.y), bf_lo(vb.z), bf_hi(vb.z), bf_lo(vb.w), bf_hi(vb.w)};
        const float cc[8] = {c0.x, c0.y, c0.z, c0.w, c1.x, c1.y, c1.z, c1.w}, ss[8] = {s0.x, s0.y, s0.z, s0.w, s1.x, s1.y, s1.z, s1.w};
        const float sc = mat ? 0.125f : 1.f; LAS float* m = (mat ? xk : xq) + r * XP + 32 * part + 8 * jq;
#pragma unroll
        for (int i = 0; i < 8; ++i) { m[i] = (av[i] * cc[i] - bv[i] * ss[i]) * sc; m[16 + i] = (bv[i] * cc[i] + av[i] * ss[i]) * sc; }
    }
    { const int r = tid >> 3, c8 = tid & 7; const u32x4 v = *(const u32x4*)(P + (size_t)(seq0 + t0 + r) * DINP + PC_DV + 64 * h + 8 * c8); LAS float* d = xv + r * XP + 8 * c8;
      d[0] = bf_lo(v.x); d[1] = bf_hi(v.x); d[2] = bf_lo(v.y); d[3] = bf_hi(v.y); d[4] = bf_lo(v.z); d[5] = bf_hi(v.z); d[6] = bf_lo(v.w); d[7] = bf_hi(v.w); }
    lds_barrier();
    TOC(51); TIC(52);
    if (w < 4) { const int rt = w >> 1, ct = w & 1;
        const f32x16 acc = lds_mma64(lane, [&](int r, int k) { return xq[(32 * rt + r) * XP + k]; }, [&](int k, int c2) { return xk[(32 * ct + c2) * XP + k]; });
#pragma unroll
        for (int r = 0; r < 16; ++r) QK[(32 * rt + crow(r, lane >> 5)) * XP + 32 * ct + (lane & 31)] = acc[r]; }
    lds_barrier();
    TOC(52); TIC(53);
    {
        const int d = w >> 2, T = (w >> 1) & 1, ct = w & 1; const float lg = -__expf(p->in[I_RLOGD][(l * 2 + d) * 4 + h]);
        const f32x16 acc = lds_mma64(lane, [&](int r, int k) { const int ti = d ? 63 - k : k; return xk[ti * XP + 32 * T + r] * __expf(lg * (float)(63 - k)); },
                                           [&](int k, int c2) { const int ti = d ? 63 - k : k; return xv[ti * XP + 32 * ct + c2]; });
        float* kv = (float*)(ws + WS_RECR + (size_t)su_index(d, b, h, cg) * REC_R_BYTES + REC_R_KV);
#pragma unroll
        for (int r = 0; r < 16; ++r) kv[(32 * T + crow(r, lane >> 5)) * 64 + 32 * ct + (lane & 31)] = acc[r];
    }
    TOC(53); TIC(54);
    for (int d = 0; d < 2; ++d) {
        unsigned char* rec = ws + WS_RECR + (size_t)su_index(d, b, h, cg) * REC_R_BYTES; const float lg = -__expf(p->in[I_RLOGD][(l * 2 + d) * 4 + h]);
        const int r = tid >> 3, c8 = tid & 7, it_ = d ? 63 - r : r;
        { const float e = __expf(lg * (float)(it_ + 1)); float v[8];
#pragma unroll
          for (int j = 0; j < 8; ++j) v[j] = xq[r * XP + 8 * c8 + j] * e;
          u32x4 o; o.x = cvtpk(v[0], v[1]); o.y = cvtpk(v[2], v[3]); o.z = cvtpk(v[4], v[5]); o.w = cvtpk(v[6], v[7]); frag_store(rec + REC_R_QG, r, c8, o); }
        { float v[8];
#pragma unroll
          for (int j = 0; j < 8; ++j) { const int i = 8 * c8 + j, ti = d ? 63 - i : i; v[j] = (it_ >= i) ? QK[r * XP + ti] * __expf(lg * (float)(it_ - i)) : 0.f; }
          u32x4 o; o.x = cvtpk(v[0], v[1]); o.y = cvtpk(v[2], v[3]); o.z = cvtpk(v[4], v[5]); o.w = cvtpk(v[6], v[7]); frag_store(rec + REC_R_ATT, r, c8, o); }
        { const int ln = tid & 63, s = (tid >> 6) & 1, T = (tid >> 7) & 1, ct = tid >> 8; float v[8];
#pragma unroll
          for (int j = 0; j < 8; ++j) { const int i = 32 * T + 16 * s + 8 * (j >> 2) + 4 * (ln >> 5) + (j & 3), ti = d ? 63 - i : i; v[j] = xv[ti * XP + 32 * ct + (ln & 31)]; }
          u32x4 o; o.x = cvtpk(v[0], v[1]); o.y = cvtpk(v[2], v[3]); o.z = cvtpk(v[4], v[5]); o.w = cvtpk(v[6], v[7]); *(u32x4*)(rec + REC_R_VF + (size_t)tid * 16) = o; }
    }
    TOC(54);
}

__device__ __forceinline__ void gdn_scan_chain(KArg p, const Ctx& C, int chain) {
    unsigned char* ws = p->ws; const int lane = C.lane, w = C.wave, c = lane & 31, hi = lane >> 5;
    constexpr int WP = 68, UP = 68, SB_W = 0, SB_K = 64 * WP * 2, SB_U = 2 * 64 * WP * 2, SB_D = SB_U + 64 * UP * 4, SBUF = SB_D + 16, NSLOT = 4, FL = NSLOT * SBUF;
    LAS unsigned char* lds = C.lds;
    volatile LAS unsigned* full = (volatile LAS unsigned*)(lds + FL); volatile LAS unsigned* done = full + NSLOT;
    __syncthreads();
    if (C.tid < 2 * NSLOT) full[C.tid] = 0u;
    __syncthreads();
    if (w >= 2) {
        const float* DEC = (const float*)(ws + WS_DEC);
        for (int s = w - 2; s < 68; s += 6) {
            const int slot = s & (NSLOT - 1); LAS unsigned char* sb = lds + slot * SBUF;
            const unsigned char* rec = ws + WS_RECG + (size_t)(chain * 68 + s) * REC_G_BYTES;
            u32x4 R[32];
#pragma unroll
            for (int i = 0; i < 32; ++i) R[i] = *(const u32x4*)(rec + (size_t)(lane + 64 * i) * 16);
            const float dr = DEC[chain * 68 + s];
            { const unsigned need = 2u * (unsigned)(s >> 2); unsigned sp = 0; while (done[slot] < need && ++sp < (1u << 22)) __builtin_amdgcn_s_sleep(1); }
            asm volatile("" ::: "memory");
#pragma unroll
            for (int i = 0; i < 32; ++i) { const int ch = lane + 64 * i; u32x2 lo, h2; lo.x = R[i].x; lo.y = R[i].y; h2.x = R[i].z; h2.y = R[i].w;
                if (i < 8) { const int r = ch >> 3, c8 = ch & 7; LAS u32x2* d = (LAS u32x2*)(sb + SB_W + r * (WP * 2) + 16 * c8); d[0] = lo; d[1] = h2; }
                else if (i < 24) { const int q = ch - 512, r = q >> 4, c4 = q & 15; *(LAS u32x4*)(sb + SB_U + r * (UP * 4) + 16 * c4) = R[i]; }
                else { const int q = ch - 1536, r = q >> 3, c8 = q & 7; LAS u32x2* d = (LAS u32x2*)(sb + SB_K + r * (WP * 2) + 16 * c8); d[0] = lo; d[1] = h2; } }
            if (lane == 0) *(LAS float*)(sb + SB_D) = dr;
            asm volatile("s_waitcnt lgkmcnt(0)" ::: "memory");
            if (lane == 0) full[slot] = (unsigned)(s + 1);
        }
    } else {
        const int ct = w;
        f32x16 S0, S1;
#pragma unroll
        for (int r = 0; r < 16; ++r) { S0[r] = 0.f; S1[r] = 0.f; }
        for (int s = 0; s < 68; ++s) {
            const int slot = s & (NSLOT - 1); LAS unsigned char* sb = lds + slot * SBUF;
            unsigned char* rec = ws + WS_RECG + (size_t)(chain * 68 + s) * REC_G_BYTES;
            TIC(24);
            { unsigned sp = 0; while (full[slot] != (unsigned)(s + 1) && ++sp < (1u << 22)) __builtin_amdgcn_s_sleep(1); }
            TOC(24);
            asm volatile("" ::: "memory");
            bf16x8 wf[2][2][2], kf[2][2][2]; f32x4 uf[2][4];
#pragma unroll
            for (int Ti = 0; Ti < 2; ++Ti)
#pragma unroll
                for (int T = 0; T < 2; ++T)
#pragma unroll
                    for (int ks = 0; ks < 2; ++ks) { const LAS unsigned char* ap = sb + SB_W + (32 * Ti + c) * (WP * 2) + (32 * T + 16 * ks + 4 * hi) * 2;
                        wf[Ti][T][ks] = mk_frag(*(const LAS u32x2*)ap, *(const LAS u32x2*)(ap + 16)); }
#pragma unroll
            for (int Ti = 0; Ti < 2; ++Ti)
#pragma unroll
                for (int g = 0; g < 4; ++g) uf[Ti][g] = *(const LAS f32x4*)(sb + SB_U + (32 * ct + c) * (UP * 4) + (32 * Ti + 8 * g + 4 * hi) * 4);
#pragma unroll
            for (int T = 0; T < 2; ++T)
#pragma unroll
                for (int Ti = 0; Ti < 2; ++Ti)
#pragma unroll
                    for (int ks = 0; ks < 2; ++ks) { const LAS unsigned char* a0 = sb + SB_K + (32 * T + c) * (WP * 2) + (32 * Ti + 16 * ks + 4 * hi) * 2;
                        kf[T][Ti][ks] = mk_frag(*(const LAS u32x2*)a0, *(const LAS u32x2*)(a0 + 16)); }
            const float dec = *(const LAS float*)(sb + SB_D);
            asm volatile("s_waitcnt lgkmcnt(0)" ::: "memory"); __builtin_amdgcn_sched_barrier(0);
            if (lane == 0) __hip_atomic_fetch_add((LAS unsigned*)(lds + FL) + NSLOT + slot, 1u, __ATOMIC_RELAXED, __HIP_MEMORY_SCOPE_WORKGROUP);
            bf16x8 sf[2][2];
#pragma unroll
            for (int ks = 0; ks < 2; ++ks) {
                sf[0][ks] = mk_frag4(cvtpk(S0[8 * ks], S0[8 * ks + 1]), cvtpk(S0[8 * ks + 2], S0[8 * ks + 3]), cvtpk(S0[8 * ks + 4], S0[8 * ks + 5]), cvtpk(S0[8 * ks + 6], S0[8 * ks + 7]));
                sf[1][ks] = mk_frag4(cvtpk(S1[8 * ks], S1[8 * ks + 1]), cvtpk(S1[8 * ks + 2], S1[8 * ks + 3]), cvtpk(S1[8 * ks + 4], S1[8 * ks + 5]), cvtpk(S1[8 * ks + 6], S1[8 * ks + 7]));
            }
            f32x16 vn[2];
#pragma unroll
            for (int Ti = 0; Ti < 2; ++Ti) {
                f32x16 acc;
#pragma unroll
                for (int r = 0; r < 16; ++r) acc[r] = 0.f;
#pragma unroll
                for (int T = 0; T < 2; ++T)
#pragma unroll
                    for (int ks = 0; ks < 2; ++ks) acc = mfma32(wf[Ti][T][ks], sf[T][ks], acc);
#pragma unroll
                for (int g = 0; g < 4; ++g) { const f32x4 u = uf[Ti][g];
                    vn[Ti][4 * g] = u.x - acc[4 * g]; vn[Ti][4 * g + 1] = u.y - acc[4 * g + 1]; vn[Ti][4 * g + 2] = u.z - acc[4 * g + 2]; vn[Ti][4 * g + 3] = u.w - acc[4 * g + 3]; }
            }
            bf16x8 vf[2][2];
#pragma unroll
            for (int Ti = 0; Ti < 2; ++Ti)
#pragma unroll
                for (int ks = 0; ks < 2; ++ks)
                    vf[Ti][ks] = mk_frag4(cvtpk(vn[Ti][8 * ks], vn[Ti][8 * ks + 1]), cvtpk(vn[Ti][8 * ks + 2], vn[Ti][8 * ks + 3]), cvtpk(vn[Ti][8 * ks + 4], vn[Ti][8 * ks + 5]), cvtpk(vn[Ti][8 * ks + 6], vn[Ti][8 * ks + 7]));
#pragma unroll
            for (int r = 0; r < 16; ++r) { S0[r] *= dec; S1[r] *= dec; }
#pragma unroll
            for (int Ti = 0; Ti < 2; ++Ti)
#pragma unroll
                for (int ks = 0; ks < 2; ++ks) { S0 = mfma32(kf[0][Ti][ks], vf[Ti][ks], S0); S1 = mfma32(kf[1][Ti][ks], vf[Ti][ks], S1); }
#pragma unroll
            for (int T = 0; T < 2; ++T)
#pragma unroll
                for (int ks = 0; ks < 2; ++ks) { *(bf16x8*)(rec + REC_G_SP + (size_t)((((ct * 2 + T) * 2 + ks) * 64 + lane) * 16)) = sf[T][ks];
                    *(bf16x8*)(rec + REC_G_VN + (size_t)((((ct * 2 + T) * 2 + ks) * 64 + lane) * 16)) = vf[T][ks]; }
        }
    }
    __syncthreads();
}
__device__ __forceinline__ void ret_scan_items(KArg p, const Ctx& C, int l, int item0, int nitems_total, int stride) {
    unsigned char* ws = p->ws;
    for (int it = item0; it < nitems_total; it += stride) {
        const int dbh = it >> 11, q = it & 2047; const int jp = q & 3, ln = (q >> 2) & 63, ks = (q >> 8) & 1, T = (q >> 9) & 1, ct = q >> 10;
        const int d = dbh >> 4, h = dbh & 3;
        const int j0 = 2 * jp, dk0 = 32 * T + 16 * ks + 8 * (j0 >> 2) + 4 * (ln >> 5) + (j0 & 3), dv = 32 * ct + (ln & 31);
        const float g64 = __expf(-__expf(p->in[I_RLOGD][(l * 2 + d) * 4 + h]) * 64.f);
        float s0 = 0.f, s1 = 0.f;
        unsigned char* rec0 = ws + WS_RECR + (size_t)(dbh * 68) * REC_R_BYTES;
        for (int s = 0; s < 68; s += 4) {
            float a[4], bq[4];
#pragma unroll
            for (int k = 0; k < 4; ++k) { const float* kv = (const float*)(rec0 + (size_t)(s + k) * REC_R_BYTES + REC_R_KV); a[k] = kv[dk0 * 64 + dv]; bq[k] = kv[(dk0 + 1) * 64 + dv]; }
#pragma unroll
            for (int k = 0; k < 4; ++k) { *(unsigned*)(rec0 + (size_t)(s + k) * REC_R_BYTES + REC_R_SP + (size_t)q * 4) = cvtpk(s0, s1); s0 = s0 * g64 + a[k]; s1 = s1 * g64 + bq[k]; }
        }
    }
}

__device__ __forceinline__ void rec_out_item(KArg p, int lane, int l, int mixer, int b, int h, int cg, int rt) {
    unsigned char* ws = p->ws; const int c = lane & 31, hi = lane >> 5;
    f32x16 acc[2];
#pragma unroll
    for (int r = 0; r < 16; ++r) { acc[0][r] = 0.f; acc[1][r] = 0.f; }
    const int row = (cg < 4 ? 256 * b + 64 * cg : MC + 4096 * b + 64 * (cg - 4)) + 32 * rt + c;
    const bf16_t* P = (const bf16_t*)(ws + WS_P) + (size_t)row * DINP + (mixer ? PC_DGATE : PC_BGATE) + 64 * h;
    u32x2 gt[2][4];
#pragma unroll
    for (int ct = 0; ct < 2; ++ct)
#pragma unroll
        for (int g = 0; g < 4; ++g) gt[ct][g] = *(const u32x2*)(P + 32 * ct + 8 * g + 4 * hi);
#pragma unroll
    for (int d = 0; d < 2; ++d) {
        const int su = su_index(d, b, h, cg);
        const unsigned char* rec = mixer ? ws + WS_RECR + (size_t)su * REC_R_BYTES : ws + WS_RECG + (size_t)su * REC_G_BYTES;
        const unsigned char* qg = rec + (mixer ? REC_R_QG : REC_G_QG); const unsigned char* at = rec + (mixer ? REC_R_ATT : REC_G_ATT);
        const unsigned char* sp = rec + (mixer ? REC_R_SP : REC_G_SP); const unsigned char* vn = rec + (mixer ? REC_R_VF : REC_G_VN);
        bf16x8 bq[4], ba[4], as_[2][4], av[2][4];
#pragma unroll
        for (int f = 0; f < 4; ++f) { const int T = f >> 1, ks = f & 1;
            const size_t ao = (size_t)((((rt * 2 + T) * 2 + ks) * 64 + lane) * 16);
            bq[f] = *(const bf16x8*)(qg + ao); ba[f] = *(const bf16x8*)(at + ao);
#pragma unroll
            for (int ct = 0; ct < 2; ++ct) { const size_t bo = (size_t)((((ct * 2 + T) * 2 + ks) * 64 + lane) * 16); as_[ct][f] = *(const bf16x8*)(sp + bo); av[ct][f] = *(const bf16x8*)(vn + bo); } }
        asm volatile("s_waitcnt vmcnt(0)" ::: "memory"); __builtin_amdgcn_sched_barrier(0);
#pragma unroll
        for (int f = 0; f < 4; ++f)
#pragma unroll
            for (int ct = 0; ct < 2; ++ct) { acc[ct] = mfma32(as_[ct][f], bq[f], acc[ct]); acc[ct] = mfma32(av[ct][f], ba[f], acc[ct]); }
    }
    float s = 0.f, ss = 0.f;
#pragma unroll
    for (int r = 0; r < 16; ++r) { s += acc[0][r] + acc[1][r]; ss += acc[0][r] * acc[0][r] + acc[1][r] * acc[1][r]; }
    s = xor32_sum(s); ss = xor32_sum(ss);
    float mu = 0.f, rs;
    if (mixer) { mu = s * (1.f / 64.f); const float var = ss * (1.f / 64.f) - mu * mu; rs = rsqrtf(fmaxf(var, 0.f) + EPS); } else rs = rsqrtf(ss * (1.f / 64.f) + EPS);
    const float* gn = mixer ? p->in[I_RNORM] + (size_t)l * 256 + 64 * h : p->in[I_GNORM] + (size_t)l * 64;
    bf16_t* dst = (bf16_t*)(ws + WS_MIX) + (size_t)row * D + (mixer ? 768 : 256) + 64 * h;
#pragma unroll
    for (int ct = 0; ct < 2; ++ct)
#pragma unroll
        for (int g = 0; g < 4; ++g) { const int dv0 = 32 * ct + 8 * g + 4 * hi;
            const u32x2 gtv = gt[ct][g]; const f32x4 gv = *(const f32x4*)(gn + dv0);
            const float y0 = (acc[ct][4 * g] - mu) * rs * gv.x * silu_f(bf_lo(gtv.x)), y1 = (acc[ct][4 * g + 1] - mu) * rs * gv.y * silu_f(bf_hi(gtv.x));
            const float y2 = (acc[ct][4 * g + 2] - mu) * rs * gv.z * silu_f(bf_lo(gtv.y)), y3 = (acc[ct][4 * g + 3] - mu) * rs * gv.w * silu_f(bf_hi(gtv.y));
            u32x2 o; o.x = cvtpk(y0, y1); o.y = cvtpk(y2, y3); *(u32x2*)(dst + dv0) = o; }
}

#ifndef ONLY_PHASE
#define ONLY_PHASE -1
#endif
#ifndef SUB3
#define SUB3 31
#endif
#ifndef DUP_K
#define DUP_K -1
#endif
#define NREP(k) ((DUP_K == (k)) ? 2 : 1)
#ifndef RET_DEAL_OLD
#define RET_DEAL_OLD 0
#endif
#ifndef DUP2
#define DUP2 0
#endif
#define PH_ON(k) (ONLY_PHASE < 0 || ONLY_PHASE == (k))
constexpr int PH_PER_LAYER = 10, PH_FINAL = 1 + PH_PER_LAYER * DEPTH, N_PHASES = PH_FINAL + 1;
__global__ void __launch_bounds__(NTHR, 2) mega_fwd(Params p_arg) {
    extern __shared__ __attribute__((aligned(16))) unsigned char lds_raw[];
    Ctx C0; C0.lds = (LAS unsigned char*)lds_raw; C0.tid = threadIdx.x; C0.lane = C0.tid & 63; C0.wave = __builtin_amdgcn_readfirstlane(C0.tid >> 6); C0.bid = blockIdx.x; C0.G = gridDim.x;
    const Ctx& C = C0;
    int lo, hi; unsigned* ctl0; { KArg p = kp_get(); lo = p->ph_lo; hi = p->ph_hi; ctl0 = (unsigned*)(p->ws + WS_CTL); }
    const bool fused = (hi - lo) > 1;
    if (C.tid < 64) ((LAS unsigned*)(C.lds + LDS_MISC))[C.tid] = 0u;
    __syncthreads();
    XcdBarrier bar; bar.bar = ctl0 + CW_BAR; bar.x = 0; bar.st = (volatile LAS unsigned*)(C.lds + LDS_MISC);
    if (fused) bar = xcd_barrier_post(ctl0 + CW_BAR, (volatile LAS unsigned*)(C.lds + LDS_MISC));
#define IN(k) (lo <= (k) && (k) < hi)
#define RELAUNDER do { int t_ = C0.tid, b_ = C0.bid, g_ = C0.G; unsigned l_ = (unsigned)(size_t)C0.lds; asm volatile("" : "+v"(t_), "+s"(b_), "+s"(g_), "+s"(l_)); C.tid = t_; C.lane = t_ & 63; C.wave = __builtin_amdgcn_readfirstlane(t_ >> 6); C.bid = b_; C.G = g_; C.lds = (LAS unsigned char*)(size_t)l_; p = kp_get(); ws = p->ws; } while (0)
#define PHASE_VARS Ctx C; { int t_ = C0.tid, b_ = C0.bid, g_ = C0.G; unsigned l_ = (unsigned)(size_t)C0.lds; asm volatile("" : "+v"(t_), "+s"(b_), "+s"(g_), "+s"(l_)); C.tid = t_; C.lane = t_ & 63; C.wave = __builtin_amdgcn_readfirstlane(t_ >> 6); C.bid = b_; C.G = g_; C.lds = (LAS unsigned char*)(size_t)l_; } KArg p = kp_get(); unsigned char* ws = p->ws; unsigned* ctl = (unsigned*)(ws + WS_CTL); const float* MOD = (const float*)(ws + WS_MOD); bf16_t* U = (bf16_t*)(ws + WS_U); (void)ctl; (void)MOD; (void)U;
#define SEAM(k) do { if (IN(k) && IN((k) + 1)) xcd_barrier(bar); } while (0)

    TIC(300); TIC(301);
    if (PH_ON(10) && IN(0)) { PHASE_VARS prologue_phase(p, C); }
    TOC(300);
    SEAM(0);
    TOC(301);

    for (int l = 0; l < DEPTH; ++l) {
        const int base = 1 + PH_PER_LAYER * l;
        const bool moe = (l & 1) != 0, last = (l == DEPTH - 1);
        const int row_min = last ? MC : 0, pm0 = last ? 4 : 0, Meff = last ? MX : MT;

        TIC(100); TIC(200);
        if (PH_ON(0) && IN(base + 0)) { PHASE_VARS
            norm_phase<0>(p, C, l, l == 2, l - 1, false, 0, (l == 1 || l == 3) ? 7 : 0);
        }
        TOC(100);
        SEAM(base + 0);
        TOC(200);
        TIC(101); TIC(201);
        if (PH_ON(1) && IN(base + 1)) { PHASE_VARS
            { pg8::Gemm g{U, (const bf16_t*)(ws + WS_WIN) + (size_t)l * DINP * D, MT, DINP, D, D, D}; pg8::OrderPM S; S.init(MT, DINP, C.G, C.bid); S.pm0 = 0;
              pg8::EpiStore E{(bf16_t*)(ws + WS_P), DINP, 1 << 20};
              pg8::gemm_phase<pg8::EpiStore, pg8::OrderPM, true, true>(C.lds, g, S, E); }
            { pg8::Gemm g{(const bf16_t*)(ws + WS_WINV) + (size_t)l * 256 * D, U, 256, MT, D, D, D}; pg8::OrderPM S; S.init(256, MT, C.G, (C.bid + 208) & 255); S.pm0 = 0;
              pg8::EpiStore E{(bf16_t*)(ws + WS_VTS), MT, 1 << 20};
              pg8::gemm_phase<pg8::EpiStore, pg8::OrderPM, true, true>(C.lds, g, S, E); }
        }
        TOC(101);
        SEAM(base + 1);
        TOC(201);
        TIC(102); TIC(202);
        if (PH_ON(2) && IN(base + 2)) for (int rep = 0; rep < NREP(2); ++rep) { PHASE_VARS
            if (!PREP_IN_GDN) prep_phase(p, C, l);
            for (int v = C.bid; v < 1088; v += C.G) { const int b = v / 272, h = (v / 68) & 3, cg = v % 68; gdn_chunk_unit(p, C, l, b, h, cg, v); }
            RELAUNDER;
            TIC(5);
#if RET_DEAL_OLD
            for (int v = C.bid; v < 1088; v += C.G) { const int b = v / 272, h = (v / 68) & 3, cg = v % 68; ret_chunk_unit(p, C, l, b, h, cg); }
#else
            if (C.bid >= 64) { for (int k = 0; k < 5; ++k) { const int v = (C.bid - 64) + 192 * k; const int b = v / 272, h = (v / 68) & 3, cg = v % 68; ret_chunk_unit(p, C, l, b, h, cg); } }
            else { for (int k = 0; k < 2; ++k) { const int v = 960 + C.bid + 64 * k; const int b = v / 272, h = (v / 68) & 3, cg = v % 68; ret_chunk_unit(p, C, l, b, h, cg); } }
#endif
            TOC(5);
        }
        TOC(102);
        SEAM(base + 2);
        TOC(202);
        TIC(103); TIC(203);
        if (PH_ON(3) && IN(base + 3)) for (int rep = 0; rep < NREP(3); ++rep) { PHASE_VARS
            if (SUB3 & 1) { if (C.bid < 32) { TIC(7); gdn_scan_chain(p, C, C.bid); TOC(7); } }
            RELAUNDER;
            if (C.bid >= 32) {
                const int G2 = C.G - 32, c2 = C.bid - 32;
                TIC(8);
                if (SUB3 & 2) { pg8::Gemm g{(const bf16_t*)(ws + WS_AUP), (const bf16_t*)(ws + WS_WUP) + (size_t)l * 1024 * 512, MT, 1024, 512, 512, 512}; pg8::OrderPM S; S.init(MT, 1024, G2, c2); S.pm0 = 0;
                  pg8::EpiUp E{(bf16_t*)(ws + WS_QRAW), (bf16_t*)(ws + WS_KFULL)};
                  pg8::gemm_phase<pg8::EpiUp, pg8::OrderPM, true, true>(C.lds, g, S, E); }
                RELAUNDER;
                if (SUB3 & 4) { pg8::Gemm g{(const bf16_t*)(ws + WS_WUPV) + (size_t)l * 256 * 512, (const bf16_t*)(ws + WS_AUP), 256, MT, 512, 512, 512}; pg8::OrderPM S; S.init(256, MT, G2, (c2 + 176) % G2); S.pm0 = 0;
                  pg8::EpiStore E{(bf16_t*)(ws + WS_VTM), MT, 1 << 20};
                  pg8::gemm_phase<pg8::EpiStore, pg8::OrderPM, true, true>(C.lds, g, S, E); }
                RELAUNDER;
                TOC(8); TIC(9);
                if (SUB3 & 8) ret_scan_items(p, C, l, c2 * NTHR + C.tid, 65536, G2 * NTHR);
                RELAUNDER;
                TOC(9); TIC(10);
                if (SUB3 & 16) { for (int u = 256 + c2; u < 512; u += G2) attn_dispatch(p, C, l, u);
                if (!last) for (int u = 528 + c2; u < 544; u += G2) attn_dispatch(p, C, l, u); }
                RELAUNDER;
                TOC(10); TIC(11);
                RELAUNDER;
                if (!last) { __syncthreads();
                    constexpr int NWK = 116 + 2 * 108;
                    if (c2 < 116) convert_layer_weights(p, C, l + 1, c2 * NWAVES + C.wave, NWK * NWAVES);
                    else { convert_layer_weights(p, C, l + 1, (116 + 2 * (c2 - 116)) * NWAVES + C.wave, NWK * NWAVES); convert_layer_weights(p, C, l + 1, (117 + 2 * (c2 - 116)) * NWAVES + C.wave, NWK * NWAVES); } }
                TOC(11);
            }
        }
        TOC(103);
        SEAM(base + 3);
        TOC(203);
        TIC(104); TIC(204);
        if (PH_ON(4) && IN(base + 4)) for (int rep = 0; rep < NREP(4); ++rep) { PHASE_VARS
            TIC(12);
            for (int u = C.bid; u < 256; u += C.G) attn_dispatch(p, C, l, u);
            if (!last) for (int u = 512 + C.bid; u < 528; u += C.G) attn_dispatch(p, C, l, u);
            TOC(12); TIC(13);
            for (int it = C.bid * NWAVES + C.wave; it < 4 * 1088; it += C.G * NWAVES) { const int u = it >> 2, mixer = (it >> 1) & 1, rt = it & 1; const int b = u / 272, h = (u / 68) & 3, cg = u % 68; if (last && cg < 4) continue; rec_out_item(p, C.lane, l, mixer, b, h, cg, rt); }
            TOC(13);
        }
        TOC(104);
        SEAM(base + 4);
        TOC(204);
        TIC(105); TIC(205);
        if (PH_ON(5) && IN(base + 5)) { PHASE_VARS
            { pg8::Gemm g{(const bf16_t*)(ws + WS_MIX), (const bf16_t*)(ws + WS_WOUT) + (size_t)l * D * D, MX, D, D, D, D}; pg8::OrderPM S; S.init(MX, D, C.G, C.bid); S.pm0 = 4;
              pg8::EpiRes E{(float*)(ws + WS_H), MOD + (size_t)l * 5 * 6144 + 2 * 1024};
              pg8::gemm_phase<pg8::EpiRes, pg8::OrderPM, true, true>(C.lds, g, S, E); }
            if (!last) { RELAUNDER;
              pg8::Gemm g{(const bf16_t*)(ws + WS_MIX), (const bf16_t*)(ws + WS_WOUT) + (size_t)l * D * D, MC, D, 256, D, D}; pg8::SplitKOrder S{C.G, C.bid, 4, 256};
              pg8::EpiSlab E{(float*)(ws + WS_SLAB), (const float*)(ws + WS_MOD) + (size_t)l * 5 * 6144 + 2 * 1024, 256};
              pg8::gemm_phase<pg8::EpiSlab, pg8::SplitKOrder, true, true>(C.lds, g, S, E); }
        }
        TOC(105);
        SEAM(base + 5);
        TOC(205);
        TIC(106); TIC(206);
        if (PH_ON(6) && IN(base + 6)) { PHASE_VARS norm_phase<1>(p, C, l, false, 0, moe, row_min, last ? 0 : 4); }
        TOC(106);
        SEAM(base + 6);
        TOC(206);
        TIC(107); TIC(207);
        if (PH_ON(7) && IN(base + 7)) { PHASE_VARS if (moe) moe_gather_phase(p, C, row_min); }
        TOC(107);
        if (moe) SEAM(base + 7);
        TOC(207);
        TIC(108); TIC(208);
        if (PH_ON(8) && IN(base + 8)) { PHASE_VARS
            pg8::EpiSwiGLU E{(bf16_t*)(ws + WS_HD)};
            if (!moe) { pg8::Gemm g{U, (const bf16_t*)(ws + WS_WFF + (size_t)(l >> 1) * FFW_BYTES), MT, 7168, D, D, D}; pg8::OrderPM S; S.init(MT, 7168, C.G, C.bid); S.pm0 = 0;
                pg8::gemm_phase<pg8::EpiSwiGLU, pg8::OrderPM, true, true>(C.lds, g, S, E); }
            else { const int nt = (int)__hip_atomic_load(ctl + CW_TILEE + 160, __ATOMIC_RELAXED, __HIP_MEMORY_SCOPE_AGENT);
                pg8::Gemm g{(const bf16_t*)(ws + WS_ASORT), (const bf16_t*)(ws + WS_WMOE), MOE_ROWS, 8 * 7168, D, D, D}; pg8::MoeOrder S{28, C.G, C.bid, __builtin_amdgcn_readfirstlane(nt), ctl + CW_TILEE};
                pg8::gemm_phase<pg8::EpiSwiGLU, pg8::MoeOrder, true, true>(C.lds, g, S, E); }
        }
        TOC(108);
        SEAM(base + 8);
        TOC(208);
        TIC(109); TIC(209);
        if (PH_ON(9) && IN(base + 9)) { PHASE_VARS
            if (!moe) {
                const bf16_t* Wd = (const bf16_t*)(ws + WS_WFF + (size_t)(l >> 1) * FFW_BYTES) + (size_t)7168 * 1024;
                { pg8::Gemm g{(const bf16_t*)(ws + WS_HD), Wd, MX, D, DFF, DFF, DFF}; pg8::OrderPM S; S.init(MX, D, C.G, C.bid); S.pm0 = 4;
                  pg8::EpiRes E{(float*)(ws + WS_H), MOD + (size_t)l * 5 * 6144 + 5 * 1024};
                  pg8::gemm_phase<pg8::EpiRes, pg8::OrderPM, true, true>(C.lds, g, S, E); }
                RELAUNDER;
                { pg8::Gemm g{(const bf16_t*)(ws + WS_HD), (const bf16_t*)(ws + WS_WFF + (size_t)(l >> 1) * FFW_BYTES) + (size_t)7168 * 1024, MC, D, 512, DFF, DFF}; pg8::SplitKOrder S{C.G, C.bid, 7, 512};
                  pg8::EpiSlab E{(float*)(ws + WS_SLAB), (const float*)(ws + WS_MOD) + (size_t)l * 5 * 6144 + 5 * 1024, 512};
                  pg8::gemm_phase<pg8::EpiSlab, pg8::SplitKOrder, true, true>(C.lds, g, S, E); } }
            else { const int nt = __builtin_amdgcn_readfirstlane((int)__hip_atomic_load(ctl + CW_TILEE + 160, __ATOMIC_RELAXED, __HIP_MEMORY_SCOPE_AGENT));
                { pg8::Gemm g{(const bf16_t*)(ws + WS_HD), (const bf16_t*)(ws + WS_WMOE) + (size_t)8 * 7168 * 1024, MOE_ROWS, 8 * 1024, DFF, DFF, DFF}; pg8::MoeOrder S{4, C.G, C.bid, nt < MOE_SPLIT_TILE ? nt : MOE_SPLIT_TILE, ctl + CW_TILEE};
                  pg8::EpiStore E{(bf16_t*)(ws + WS_YD), D, 4};
                  pg8::gemm_phase<pg8::EpiStore, pg8::MoeOrder, true, true>(C.lds, g, S, E); }
                RELAUNDER;
                if (nt > MOE_SPLIT_TILE) { pg8::Gemm g{(const bf16_t*)(ws + WS_HD), (const bf16_t*)(ws + WS_WMOE) + (size_t)8 * 7168 * 1024, MOE_ROWS, 8 * 1024, 512, DFF, DFF}; pg8::MoeSplitOrder S{C.G, C.bid, nt, (unsigned*)(ws + WS_CTL) + CW_TILEE};
                  pg8::EpiMoeSlab E{(bf16_t*)(ws + WS_MSLAB)};
                  pg8::gemm_phase<pg8::EpiMoeSlab, pg8::MoeSplitOrder, true, true>(C.lds, g, S, E); } }
        }
        TOC(109);
        SEAM(base + 9);
        TOC(209);
    }
    if (PH_ON(11) && IN(PH_FINAL)) { PHASE_VARS norm_phase<2>(p, C, DEPTH, true, DEPTH - 1, false, MC, 0); }
#if PROBE_ID
    if (blockIdx.x == PROBE_BLOCK && threadIdx.x == 0) { const unsigned long long w = PROBE_ACC[0] * PROBE_MULT, t0 = __builtin_amdgcn_s_memrealtime(); while (__builtin_amdgcn_s_memrealtime() - t0 < w) __builtin_amdgcn_s_sleep(8); }
#endif
#undef IN
#undef SEAM
}

extern "C" void kernel_launch(void* const* d_in, const int* in_sizes, int n_in, void* d_out, int out_size, void* d_ws, size_t ws_size, hipStream_t stream) {
    static int grid = 0;
    if (grid == 0) {
        if (n_in != N_IN || out_size != MX * D || ws_size < WS_TOTAL) { fprintf(stderr, "kernel_launch: unexpected shapes (n_in %d out %d ws %zu, need %zu)\n", n_in, out_size, ws_size, (size_t)WS_TOTAL); grid = -1; return; }
        int dev = 0, cus = 0, per_cu = 0;
        if (hipGetDevice(&dev) != hipSuccess || hipDeviceGetAttribute(&cus, hipDeviceAttributeMultiprocessorCount, dev) != hipSuccess) { grid = -1; return; }
        if (hipFuncSetAttribute((const void*)mega_fwd, hipFuncAttributeMaxDynamicSharedMemorySize, LDS_BYTES) != hipSuccess) { fprintf(stderr, "kernel_launch: hipFuncSetAttribute failed\n"); grid = -1; return; }
        if (hipOccupancyMaxActiveBlocksPerMultiprocessor(&per_cu, (const void*)mega_fwd, NTHR, LDS_BYTES) != hipSuccess || per_cu < 1) { fprintf(stderr, "kernel_launch: occupancy query says %d\n", per_cu); }
        (void)hipGetLastError();
        grid = (cus == 256) ? 256 : -1;
        if (grid < 0) { fprintf(stderr, "kernel_launch: built for a 256-CU device, found %d\n", cus); return; }
    }
    if (grid < 0) return;
    if (hipMemsetAsync((char*)d_ws + WS_CTL, 0, CTL_BYTES, stream) != hipSuccess) return;
    Params p; memset(&p, 0, sizeof(p));
    for (int i = 0; i < N_IN; ++i) p.in[i] = (const float*)d_in[i];
    p.out = (float*)d_out; p.ws = (unsigned char*)d_ws;
#if MK_ONE_LAUNCH
    p.ph_lo = 0; p.ph_hi = N_PHASES;
    hipLaunchKernelGGL(mega_fwd, dim3(grid), dim3(NTHR), LDS_BYTES, stream, p);
#else
    for (int ph = 0; ph < N_PHASES; ++ph) {
        if (ph >= 1 && ph < PH_FINAL) { const int l = (ph - 1) / PH_PER_LAYER, k = (ph - 1) % PH_PER_LAYER; if (k == 7 && !(l & 1)) continue; }
        p.ph_lo = ph; p.ph_hi = ph + 1;
        hipLaunchKernelGGL(mega_fwd, dim3(grid), dim3(NTHR), LDS_BYTES, stream, p);
    }
#endif
}
```

```cpp
#include <hip/hip_runtime.h>
#include <cstdio>
#include <cstdint>
#include <cstring>

#ifndef MK_ONE_LAUNCH
#define MK_ONE_LAUNCH 1
#endif

#define LAS __attribute__((address_space(3)))
#define GAS __attribute__((address_space(1)))
typedef unsigned short bf16_t;
typedef short bf16x8 __attribute__((ext_vector_type(8)));
typedef float f32x4 __attribute__((ext_vector_type(4)));
typedef float f32x2 __attribute__((ext_vector_type(2)));
typedef float f32x16 __attribute__((ext_vector_type(16)));
typedef unsigned u32x4 __attribute__((ext_vector_type(4)));
typedef unsigned u32x2 __attribute__((ext_vector_type(2)));

constexpr int D = 1024, NB = 4, SEQ = 4096, CTX = 256, DEPTH = 4;
constexpr int MC = NB * CTX, MX = NB * SEQ, MT = MC + MX;
constexpr int DIN = 2992, DINP = 3072, DFF = 3584, NE = 8;
constexpr int NSU = 2 * NB * 4 * 68;
constexpr int PC_AQ = 0, PC_AK = 256, PC_AV = 384, PC_BQKV = 512, PC_BGATE = 1280, PC_BAB = 1536, PC_CQ = 1552, PC_CKV = 1808, PC_CKR = 1936,
              PC_DQ = 1968, PC_DK = 2224, PC_DV = 2480, PC_DGATE = 2736;
constexpr float EPS = 1e-6f, LOG2E = 1.4426950408889634f;
constexpr int MOE_ROWS = 36864, MOE_TILES = MOE_ROWS / 256;

constexpr size_t MiB = 1u << 20;
constexpr size_t WS_CTL = 0, CTL_BYTES = 1 * MiB;
constexpr int CW_BAR = 4096;
constexpr int CW_CNT = 16384;
constexpr int CW_TILEE = 20480;
constexpr size_t WS_TAB = 1 * MiB;
constexpr size_t WS_MOD = WS_TAB + 65536;
constexpr size_t WS_ROUTE = 2 * MiB;
constexpr size_t WS_DEC = 3 * MiB;
constexpr size_t WS_WIN = 4 * MiB;
constexpr size_t WS_WINV = WS_WIN + 24 * MiB;
constexpr size_t WS_WOUT = WS_WINV + 2 * MiB;
constexpr size_t WS_WUP = WS_WOUT + 8 * MiB;
constexpr size_t WS_WUPV = WS_WUP + 4 * MiB;
constexpr size_t WS_WFF = WS_WUPV + 1 * MiB;
constexpr size_t FFW_BYTES = (size_t)(7168 * 1024 + 1024 * 3584) * 2;
constexpr size_t WS_WMOE = WS_WFF + 42 * MiB;
constexpr size_t WS_H = WS_WMOE + 168 * MiB;
constexpr size_t WS_U = WS_H + 68 * MiB;
constexpr size_t WS_OV = WS_U + 34 * MiB;
constexpr size_t WS_P = WS_OV;
constexpr size_t WS_VTS = WS_P + 102 * MiB;
constexpr size_t WS_AUP = WS_VTS + 9 * MiB;
constexpr size_t WS_QRAW = WS_AUP + 17 * MiB;
constexpr size_t WS_KFULL = WS_QRAW + 13 * MiB;
constexpr size_t WS_VTM = WS_KFULL + 13 * MiB;
constexpr size_t WS_QS = WS_VTM + 9 * MiB;
constexpr size_t WS_KS = WS_QS + 9 * MiB;
constexpr size_t WS_MIX = WS_KS + 5 * MiB;
constexpr size_t WS_REC = WS_MIX + 34 * MiB;
constexpr size_t REC_G_W = 0, REC_G_UT = 8192, REC_G_KDT = 24576, REC_G_QG = 32768, REC_G_ATT = 40960, REC_G_SP = 49152, REC_G_VN = 57344, REC_G_BYTES = 65536;
constexpr size_t REC_R_KV = 0, REC_R_QG = 16384, REC_R_ATT = 24576, REC_R_VF = 32768, REC_R_SP = 40960, REC_R_BYTES = 49152;
constexpr size_t WS_RECG = WS_REC, WS_RECR = WS_REC + (size_t)NSU * REC_G_BYTES;
constexpr size_t WS_OV_END_MIX = WS_RECR + (size_t)NSU * REC_R_BYTES;
constexpr size_t WS_YD = WS_OV + 112 * MiB;
constexpr size_t WS_ASORT = WS_YD + 72 * MiB;
constexpr size_t WS_HD = WS_ASORT + 72 * MiB;
constexpr size_t WS_OV_END_FFN = WS_HD + 252 * MiB;
constexpr size_t WS_END = (WS_OV_END_MIX > WS_OV_END_FFN ? WS_OV_END_MIX : WS_OV_END_FFN);
static_assert(WS_P + (size_t)MT * DINP * 2 <= WS_VTS && WS_VTS + (size_t)256 * MT * 2 <= WS_AUP && WS_AUP + (size_t)MT * 512 * 2 <= WS_QRAW && WS_QRAW + (size_t)MT * 384 * 2 <= WS_KFULL &&
              WS_KFULL + (size_t)MT * 384 * 2 <= WS_VTM && WS_VTM + (size_t)256 * MT * 2 <= WS_QS && WS_QS + (size_t)MT * 256 * 2 <= WS_KS && WS_KS + (size_t)MT * 128 * 2 <= WS_MIX &&
              WS_MIX + (size_t)MT * D * 2 <= WS_REC && WS_YD >= WS_VTS + 9 * MiB && WS_MOD + 491520 <= WS_ROUTE && WS_ROUTE + 417792 <= WS_DEC && WS_DEC + NSU * 4 <= WS_WIN, "ws map");
constexpr size_t WS_MSLAB = WS_P;
constexpr int MOE_SPLIT_TILE = 128, MOE_SPLIT_ROW = MOE_SPLIT_TILE * 256;
constexpr size_t WS_SLAB = ((WS_END + MiB - 1) / MiB) * MiB;
constexpr size_t WS_TOTAL = WS_SLAB + 28 * MiB;
static_assert(WS_TOTAL <= 900 * MiB, "ws budget");

constexpr int LDS_BYTES = 147456;
constexpr int LDS_MISC = 147456 - 256;
constexpr int NWAVES = 8, NTHR = 512;

#ifndef PROBE_ID
#define PROBE_ID 0
#endif
#ifndef PROBE_BLOCK
#define PROBE_BLOCK 100
#endif
#ifndef PROBE_MULT
#define PROBE_MULT 4
#endif
#if PROBE_ID
#define PROBE_ACC ((volatile LAS unsigned long long*)(lds_probe_base + 147456 - 256 + 64))
#define TIC(id) do { if ((id) == PROBE_ID && blockIdx.x == PROBE_BLOCK && threadIdx.x == 0) PROBE_ACC[1] = __builtin_amdgcn_s_memrealtime(); } while (0)
#define TOC(id) do { if ((id) == PROBE_ID && blockIdx.x == PROBE_BLOCK && threadIdx.x == 0) PROBE_ACC[0] += __builtin_amdgcn_s_memrealtime() - PROBE_ACC[1]; } while (0)
#else
#define TIC(id) do { } while (0)
#define TOC(id) do { } while (0)
#endif
#define lds_probe_base ((LAS unsigned char*)0)

__device__ __forceinline__ unsigned cvtpk(float lo, float hi) { unsigned r; asm volatile("v_cvt_pk_bf16_f32 %0, %1, %2" : "=v"(r) : "v"(lo), "v"(hi)); return r; }
__device__ __forceinline__ float bf_lo(unsigned u) { return __uint_as_float(u << 16); }
__device__ __forceinline__ float bf_hi(unsigned u) { return __uint_as_float(u & 0xffff0000u); }
__device__ __forceinline__ float bf2f(bf16_t h) { return __uint_as_float((unsigned)h << 16); }
__device__ __forceinline__ bf16_t f2bf(float f) { return (bf16_t)(cvtpk(f, 0.f) & 0xffffu); }
template <int CTRL> __device__ __forceinline__ float dppf(float x) { return __builtin_bit_cast(float, __builtin_amdgcn_update_dpp(0, __builtin_bit_cast(int, x), CTRL, 0xF, 0xF, true)); }
__device__ __forceinline__ float quad_sum(float v) { v += dppf<0xB1>(v); v += dppf<0x4E>(v); return v; }
__device__ __forceinline__ float wave_sum(float v) {
    v = quad_sum(v); v += dppf<0x141>(v); v += dppf<0x140>(v);
    const int b = __builtin_bit_cast(int, v);
    return (__builtin_bit_cast(float, __builtin_amdgcn_readlane(b, 0)) + __builtin_bit_cast(float, __builtin_amdgcn_readlane(b, 16)))
         + (__builtin_bit_cast(float, __builtin_amdgcn_readlane(b, 32)) + __builtin_bit_cast(float, __builtin_amdgcn_readlane(b, 48)));
}
__device__ __forceinline__ float half_swap(float x, float& other) {
    float a = x, b = x;
    asm volatile("v_nop\n\tv_nop\n\tv_permlane32_swap_b32 %0, %1" : "+v"(a), "+v"(b));
    other = b; return a;
}
__device__ __forceinline__ float xor32_sum(float x) { float o; const float s = half_swap(x, o); return s + o; }
__device__ __forceinline__ float xor32_max(float x) { float o; const float s = half_swap(x, o); return fmaxf(s, o); }
__device__ __forceinline__ float silu_f(float x) { return x * __builtin_amdgcn_rcpf(1.f + __expf(-x)); }
__device__ __forceinline__ float sigmoid_f(float x) { return __builtin_amdgcn_rcpf(1.f + __expf(-x)); }
__device__ __forceinline__ float softplus_f(float x) { return x > 20.f ? x : log1pf(__expf(x)); }
__device__ __forceinline__ int crow(int r, int hi) { return (r & 3) + 8 * (r >> 2) + 4 * hi; }
__device__ __forceinline__ f32x16 mfma32(bf16x8 a, bf16x8 b, f32x16 c) { return __builtin_amdgcn_mfma_f32_32x32x16_bf16(a, b, c, 0, 0, 0); }
__device__ __forceinline__ bf16x8 mk_frag(u32x2 lo, u32x2 hi) { u32x4 v; v.x = lo.x; v.y = lo.y; v.z = hi.x; v.w = hi.y; return __builtin_bit_cast(bf16x8, v); }
__device__ __forceinline__ bf16x8 mk_frag4(unsigned a, unsigned b, unsigned c, unsigned d) { u32x4 v; v.x = a; v.y = b; v.z = c; v.w = d; return __builtin_bit_cast(bf16x8, v); }
__device__ __forceinline__ int mod_row(int row) { return row < MC ? 4 : ((row - MC) >> 12); }

#define XB_TMO      128
#define XB_XCNT(j)  (256  + 64 * (j))
#define XB_XSUB(j)  (1280 + 64 * (j))
#define XB_XGEN(j)  (2304 + 64 * (j))
#define XB_TOP      3328
#define XB_TOPGEN   3392
#define XCD_BAR_WORDS 3456
#define XB_SPIN_CAP (1u << 18)
__device__ __forceinline__ unsigned xb_ld(unsigned* p)              { return __hip_atomic_load(p, __ATOMIC_RELAXED, __HIP_MEMORY_SCOPE_AGENT); }
__device__ __forceinline__ unsigned xb_add(unsigned* p, unsigned v) { return __hip_atomic_fetch_add(p, v, __ATOMIC_RELAXED, __HIP_MEMORY_SCOPE_AGENT); }
__device__ __forceinline__ unsigned xb_xcc_id() { return (unsigned)__builtin_amdgcn_s_getreg((3 << 11) | 20) & 0xFu; }
#define XB_SPIN(cond, bar) do { unsigned _sp = 0; while (cond) { __builtin_amdgcn_s_sleep(1); \
    if ((++_sp & 255u) == 0u) { if (xb_ld(&(bar)[XB_TMO])) break; if (_sp > XB_SPIN_CAP) { atomicAdd(&(bar)[XB_TMO], 1u); break; } } } } while (0)
struct XcdBarrier { unsigned* bar; unsigned x; volatile LAS unsigned* st; };
__device__ __forceinline__ XcdBarrier xcd_barrier_post(unsigned* bar, volatile LAS unsigned* st) {
    XcdBarrier b; b.bar = bar; b.x = xb_xcc_id(); b.st = st;
    if (threadIdx.x == 0) (void)xb_add(&bar[XB_XCNT(b.x)], 1u);
    return b;
}
__device__ __forceinline__ void xcd_barrier_complete(unsigned* bar, unsigned x, unsigned& nloc, unsigned& nx) {
    const unsigned G = gridDim.x * gridDim.y * gridDim.z;
    unsigned sum, cnt, mine, sp = 0u;
    for (;;) {
        sum = 0u; cnt = 0u; mine = 0u;
#pragma unroll
        for (unsigned j = 0; j < 16; ++j) { const unsigned c = xb_ld(&bar[XB_XCNT(j)]); sum += c; cnt += (c > 0u) ? 1u : 0u; mine = (j == x) ? c : mine; }
        if (sum == G) break;
        __builtin_amdgcn_s_sleep(1);
        if ((++sp & 255u) == 0u) { if (xb_ld(&bar[XB_TMO])) break; if (sp > XB_SPIN_CAP) { atomicAdd(&bar[XB_TMO], 1u); break; } }
    }
    nloc = mine > 0u ? mine : 1u; nx = cnt > 0u ? cnt : 1u;
}
__device__ __forceinline__ void xcd_barrier(const XcdBarrier& b) {
    asm volatile("s_waitcnt vmcnt(0)" ::: "memory");
    __syncthreads();
    if (threadIdx.x == 0) {
        unsigned* bar = b.bar;
        __builtin_amdgcn_s_waitcnt(0);
        unsigned nloc = b.st[0], nx = b.st[1];
        if (nloc == 0u) { xcd_barrier_complete(bar, b.x, nloc, nx); b.st[0] = nloc; b.st[1] = nx; }
        const unsigned old = xb_add(&bar[XB_XSUB(b.x)], 1u);
        const unsigned gen = old / nloc;
        if (old + 1u == (gen + 1u) * nloc) {
            __builtin_amdgcn_fence(__ATOMIC_RELEASE, "agent");
            asm volatile("s_waitcnt vmcnt(0)" ::: "memory");
            const unsigned og = xb_add(&bar[XB_TOP], 1u);
            const unsigned tg = og / nx;
            if (og + 1u == (tg + 1u) * nx) xb_add(&bar[XB_TOPGEN], 1u);
            else XB_SPIN(xb_ld(&bar[XB_TOPGEN]) == tg, bar);
            __builtin_amdgcn_fence(__ATOMIC_ACQUIRE, "agent");
            xb_add(&bar[XB_XGEN(b.x)], 1u);
            asm volatile("s_waitcnt vmcnt(0)" ::: "memory");
        } else {
            XB_SPIN(xb_ld(&bar[XB_XGEN(b.x)]) == gen, bar);
            __builtin_amdgcn_fence(__ATOMIC_ACQUIRE, "agent");
            asm volatile("s_waitcnt vmcnt(0)" ::: "memory");
        }
    }
    __syncthreads();
}
namespace pg8 {
#define PG8_LAS __attribute__((address_space(3)))
typedef unsigned short bf16_t;
typedef short bf16x8 __attribute__((ext_vector_type(8)));
typedef float f32x4 __attribute__((ext_vector_type(4)));
typedef unsigned u32x4 __attribute__((ext_vector_type(4)));
constexpr int BM = 256, BK = 64, HALF = 128, HTB = HALF * BK * 2  , STAGE_BYTES = 8 * HTB, NXCD = 8, WGM = 8;

__host__ __device__ __forceinline__ int lds_byte(int r, int c) { const int st = (r >> 4) * 2 + (c >> 5), rr = r & 15, cc = c & 31, ob = rr * 64 + cc * 2; return st * 1024 + (ob ^ (((ob >> 9) & 1) << 5)); }
__host__ __device__ __forceinline__ void stage_rc(int b, int& R, int& C) { const int st = b / 1024, sb = b % 1024, swz = sb ^ (((sb >> 9) & 1) << 5); R = (st >> 1) * 16 + swz / 64; C = (st & 1) * 32 + (swz % 64) / 2; }
__host__ __device__ __forceinline__ int perm32(int rho) { const int n = rho >> 4, i = rho & 15; return 8 * (i >> 2) + 4 * n + (i & 3); }

struct Unit { int pm, pn, ko; };
struct Gemm { const bf16_t* A; const bf16_t* Bt; int M, N, K, lda, ldb; };

struct StaticOrder {
    int nM, nN, nwg, G, c;
    __host__ __device__ void init(int M, int N, int G_, int c_) { nM = M / BM; nN = N / BM; nwg = nM * nN; G = G_; c = c_; }
    __host__ __device__ bool next(int i, Unit& u) const {
        const long L = (long)i * G + c; if (L >= nwg) return false;
        int wgid = (int)L; { const int q = nwg / NXCD, r = nwg % NXCD, xcd = wgid % NXCD, off = wgid / NXCD; wgid = (xcd < r ? xcd * (q + 1) : r * (q + 1) + (xcd - r) * q) + off; }
        const int nig = WGM * nN, gid = wgid / nig, fm = gid * WGM, gsz = (nM - fm) < WGM ? (nM - fm) : WGM;
        u.pm = fm + ((wgid % nig) % gsz); u.pn = (wgid % nig) / gsz; u.ko = 0; return true;
    }
    __device__ __forceinline__ void a_ready(const Unit&) const {}
    __device__ __forceinline__ void done(const Unit&) const {}
};
__device__ __forceinline__ unsigned cvt_pk_bf16(float lo, float hi) { unsigned r; asm volatile("v_cvt_pk_bf16_f32 %0, %1, %2" : "=v"(r) : "v"(lo), "v"(hi)); return r; }
template <class Epi, class Sched, bool ALIGN_EPI = false, bool SP2 = false>
__device__ __forceinline__ void gemm_phase(PG8_LAS unsigned char* lds, const Gemm g, const Sched& S, const Epi& E) {
    int tid_l = threadIdx.x; asm volatile("" : "+v"(tid_l));
    const int tid = tid_l, wid = __builtin_amdgcn_readfirstlane(tid >> 6), lane = tid & 63, wr = wid >> 2, wc = wid & 3, fr = lane & 15, fq = lane >> 4;
    const int K = g.K, nt = K / BK;
    unsigned voffA[2], voffB[2];
#pragma unroll
    for (int i = 0; i < 2; ++i) { int R, C; stage_rc(tid * 16 + i * 8192, R, C); const int Rb = Epi::PERM ? ((R & ~31) + perm32(R & 31)) : R;
        voffA[i] = (unsigned)(R * g.lda + C) * 2u; voffB[i] = (unsigned)(Rb * g.ldb + C) * 2u; }
    const size_t kstep = (size_t)(BK * 2);
    const size_t hstepA = (size_t)HALF * g.lda * 2, hstepB = (size_t)HALF * g.ldb * 2;
    const size_t tstepA = 2 * hstepA, tstepB = 2 * hstepB;
    const unsigned ldsw = (unsigned)wid * 1024u;
    const int aoff = lds_byte(wr * 64 + fr, fq * 8), boff = lds_byte(wc * 32 + fr, fq * 8);
#define PG8_SA(b, h) (((b) * 2 + (h)) * HTB)
#define PG8_SB(b, h) ((4 + (b) * 2 + (h)) * HTB)
#define PG8_STAGE(bufoff, gbase, voff) do { _Pragma("unroll") for (int _i = 0; _i < 2; ++_i) \
        __builtin_amdgcn_global_load_lds((const unsigned*)((const char*)(gbase) + (voff)[_i]), (PG8_LAS unsigned*)(lds + (bufoff) + ldsw + _i * 8192), 16, 0, 0); } while (0)
#define PG8_LDA(dst, b, h) do { _Pragma("unroll") for (int m = 0; m < 4; ++m) _Pragma("unroll") for (int k = 0; k < 2; ++k) dst[m][k] = *(const PG8_LAS bf16x8*)(lds + PG8_SA(b, h) + aoff + m * 2048 + k * 1024); } while (0)
#define PG8_LDB(dst, b, h) do { _Pragma("unroll") for (int n = 0; n < 2; ++n) _Pragma("unroll") for (int k = 0; k < 2; ++k) dst[n][k] = *(const PG8_LAS bf16x8*)(lds + PG8_SB(b, h) + boff + n * 2048 + k * 1024); } while (0)
#define PG8_MMA(ai, bj, At, Bt) do { __builtin_amdgcn_s_setprio(1); _Pragma("unroll") for (int m = 0; m < 4; ++m) _Pragma("unroll") for (int n = 0; n < 2; ++n) _Pragma("unroll") for (int k = 0; k < 2; ++k) \
        acc[ai][bj][m][n] = __builtin_amdgcn_mfma_f32_16x16x32_bf16(Bt[n][k], At[m][k], acc[ai][bj][m][n], 0, 0, 0); __builtin_amdgcn_s_setprio(0); } while (0)
#define PG8_WAIT_V(n) asm volatile("s_waitcnt vmcnt(" #n ")" ::: "memory")
#define PG8_WAIT_L(n) asm volatile("s_waitcnt lgkmcnt(" #n ")" ::: "memory")
#define PG8_BAR __builtin_amdgcn_s_barrier()
#define PG8_SCHED __builtin_amdgcn_sched_barrier(0)
    Unit cur, nxt; int ui = 0;
    if (!S.next(0, cur)) return;
    f32x4 acc[2][2][4][2];
#pragma unroll
    for (int a = 0; a < 2; ++a)
#pragma unroll
        for (int b = 0; b < 2; ++b)
#pragma unroll
            for (int m = 0; m < 4; ++m)
#pragma unroll
                for (int n = 0; n < 2; ++n) acc[a][b][m][n] = (f32x4){0.f, 0.f, 0.f, 0.f};
    bf16x8 At[4][2], B0[2][2], B1[2][2];
    const char* cA = (const char*)g.A + (size_t)cur.pm * tstepA + (size_t)cur.ko * 2; const char* cB = (const char*)g.Bt + (size_t)cur.pn * tstepB + (size_t)cur.ko * 2;
    S.a_ready(cur);
    if constexpr (SP2) {
        PG8_STAGE(PG8_SB(0, 0), cB, voffB); PG8_STAGE(PG8_SB(0, 1), cB + hstepB, voffB); PG8_STAGE(PG8_SA(0, 0), cA, voffA); PG8_STAGE(PG8_SA(0, 1), cA + hstepA, voffA);
        if (wr == 1) PG8_BAR;
        PG8_WAIT_V(2); PG8_BAR;
        PG8_STAGE(PG8_SB(1, 0), cB + kstep, voffB); PG8_STAGE(PG8_SA(1, 0), cA + kstep, voffA); PG8_STAGE(PG8_SB(1, 1), cB + hstepB + kstep, voffB);
        PG8_WAIT_V(6); PG8_BAR;
    } else {
        PG8_STAGE(PG8_SB(0, 0), cB, voffB); PG8_STAGE(PG8_SA(0, 0), cA, voffA); PG8_STAGE(PG8_SB(0, 1), cB + hstepB, voffB); PG8_STAGE(PG8_SA(0, 1), cA + hstepA, voffA);
        if (wr == 1) PG8_BAR;
        PG8_WAIT_V(4); PG8_BAR;
        PG8_STAGE(PG8_SB(1, 0), cB + kstep, voffB); PG8_STAGE(PG8_SA(1, 0), cA + kstep, voffA); PG8_STAGE(PG8_SB(1, 1), cB + hstepB + kstep, voffB);
        PG8_WAIT_V(6); PG8_BAR;
    }
    for (;;) {
        const bool has_next = S.next(ui + 1, nxt);
        const char* nA = has_next ? (const char*)g.A + (size_t)nxt.pm * tstepA + (size_t)nxt.ko * 2 : cA; const char* nB = has_next ? (const char*)g.Bt + (size_t)nxt.pn * tstepB + (size_t)nxt.ko * 2 : cB;
        for (int t = 0; t < nt; t += 2) {
            const bool last = (t == nt - 2);
            const char* a1 = cA + (size_t)(t + 1) * kstep;
            const char* a2 = last ? nA : cA + (size_t)(t + 2) * kstep; const char* b2 = last ? nB : cB + (size_t)(t + 2) * kstep;
            const char* a3 = a2 + kstep; const char* b3 = b2 + kstep;
            if (last && has_next) S.a_ready(nxt);
            if constexpr (SP2) {
            PG8_LDB(B0, 0, 0); PG8_LDB(B1, 0, 1); PG8_SCHED; PG8_LDA(At, 0, 0); PG8_STAGE(PG8_SA(1, 1), a1 + hstepA, voffA);
            PG8_WAIT_V(8); PG8_WAIT_L(0); PG8_BAR; PG8_MMA(0, 0, At, B0); PG8_MMA(0, 1, At, B1); PG8_BAR; PG8_SCHED;
            PG8_LDA(At, 0, 1); PG8_STAGE(PG8_SB(0, 0), b2, voffB); PG8_STAGE(PG8_SB(0, 1), b2 + hstepB, voffB); PG8_STAGE(PG8_SA(0, 0), a2, voffA);
            PG8_WAIT_V(8); PG8_WAIT_L(0); PG8_BAR; PG8_MMA(1, 0, At, B0); PG8_MMA(1, 1, At, B1); PG8_BAR; PG8_SCHED;
            PG8_LDB(B0, 1, 0); PG8_LDB(B1, 1, 1); PG8_SCHED; PG8_LDA(At, 1, 0); PG8_STAGE(PG8_SA(0, 1), a2 + hstepA, voffA);
            PG8_WAIT_V(8); PG8_WAIT_L(0); PG8_BAR; PG8_MMA(0, 0, At, B0); PG8_MMA(0, 1, At, B1); PG8_BAR; PG8_SCHED;
            PG8_LDA(At, 1, 1); PG8_STAGE(PG8_SB(1, 0), b3, voffB); PG8_STAGE(PG8_SB(1, 1), b3 + hstepB, voffB); PG8_STAGE(PG8_SA(1, 0), a3, voffA);
            PG8_WAIT_V(8); PG8_WAIT_L(0); PG8_BAR; PG8_MMA(1, 0, At, B0); PG8_MMA(1, 1, At, B1); PG8_BAR; PG8_SCHED;
            } else {
            PG8_LDB(B0, 0, 0); PG8_SCHED; PG8_LDA(At, 0, 0); PG8_STAGE(PG8_SA(1, 1), a1 + hstepA, voffA);
            PG8_WAIT_L(8); PG8_BAR; PG8_WAIT_L(0); PG8_MMA(0, 0, At, B0); PG8_BAR; PG8_SCHED;
            PG8_LDB(B1, 0, 1); PG8_STAGE(PG8_SB(0, 0), b2, voffB);
            PG8_BAR; PG8_WAIT_L(0); PG8_MMA(0, 1, At, B1); PG8_BAR;
            PG8_LDA(At, 0, 1); PG8_STAGE(PG8_SA(0, 0), a2, voffA);
            PG8_BAR; PG8_WAIT_L(0); PG8_MMA(1, 0, At, B0); PG8_BAR; PG8_SCHED;
            PG8_STAGE(PG8_SB(0, 1), b2 + hstepB, voffB);
            PG8_WAIT_V(6); PG8_BAR; PG8_MMA(1, 1, At, B1); PG8_BAR;
            PG8_LDB(B0, 1, 0); PG8_SCHED; PG8_LDA(At, 1, 0); PG8_STAGE(PG8_SA(0, 1), a2 + hstepA, voffA);
            PG8_WAIT_L(8); PG8_BAR; PG8_WAIT_L(0); PG8_MMA(0, 0, At, B0); PG8_BAR; PG8_SCHED;
            PG8_LDB(B1, 1, 1); PG8_STAGE(PG8_SB(1, 0), b3, voffB);
            PG8_BAR; PG8_WAIT_L(0); PG8_MMA(0, 1, At, B1); PG8_BAR;
            PG8_LDA(At, 1, 1); PG8_STAGE(PG8_SA(1, 0), a3, voffA);
            PG8_BAR; PG8_WAIT_L(0); PG8_MMA(1, 0, At, B0); PG8_BAR; PG8_SCHED;
            PG8_STAGE(PG8_SB(1, 1), b3 + hstepB, voffB);
            PG8_WAIT_V(6); PG8_BAR; PG8_MMA(1, 1, At, B1); PG8_BAR;
            }
        }
        if constexpr (ALIGN_EPI) { if (wr == 0) PG8_BAR; }
        if constexpr (!Epi::AFTER_DRAIN) { E(acc, cur, wr, wc, fr, fq); S.done(cur); }
        if (!has_next) break;
#pragma unroll
        for (int a = 0; a < 2; ++a)
#pragma unroll
            for (int b = 0; b < 2; ++b)
#pragma unroll
                for (int m = 0; m < 4; ++m)
#pragma unroll
                    for (int n = 0; n < 2; ++n) acc[a][b][m][n] = (f32x4){0.f, 0.f, 0.f, 0.f};
        cur = nxt; cA = nA; cB = nB; ++ui;
        if constexpr (ALIGN_EPI) { if (wr == 1) PG8_BAR; }
    }
    PG8_WAIT_V(0);
    if constexpr (!ALIGN_EPI) { if (wr == 0) PG8_BAR; }
    PG8_BAR;
    if constexpr (Epi::AFTER_DRAIN) { E.fused(acc, cur, wr, wc, fr, fq, lds, wid, lane); S.done(cur); }
#undef PG8_SA
#undef PG8_SB
#undef PG8_STAGE
#undef PG8_LDA
#undef PG8_LDB
#undef PG8_MMA
#undef PG8_WAIT_V
#undef PG8_WAIT_L
#undef PG8_BAR
#undef PG8_SCHED
}
}

namespace pg8 {
struct OrderPM : StaticOrder {
    int pm0;
    __device__ __forceinline__ bool next(int i, Unit& u) const { if (!StaticOrder::next(i, u)) return false; u.pm += pm0; return true; }
};
struct MoeOrder {
    int nN, G, c, ntiles; const unsigned* tile_e;
    __device__ __forceinline__ bool next(int i, Unit& u) const {
        const long L = (long)i * G + c; if (L >= (long)ntiles * nN) return false;
        const int pm = (int)(L / nN), pl = (int)(L % nN);
        const int e = (int)__hip_atomic_load(tile_e + pm, __ATOMIC_RELAXED, __HIP_MEMORY_SCOPE_AGENT);
        u.pm = pm; u.pn = __builtin_amdgcn_readfirstlane(e) * nN + pl; u.ko = 0; return true;
    }
    __device__ __forceinline__ void a_ready(const Unit&) const {}
    __device__ __forceinline__ void done(const Unit&) const {}
};

struct MoeSplitOrder {
    int G, c, ntiles; const unsigned* tile_e;
    __device__ __forceinline__ bool next(int i, Unit& u) const {
        const int L = i * G + c; if (L >= (ntiles - MOE_SPLIT_TILE) * 28) return false;
        const int sl = L % 7, t = L / 7, pm = MOE_SPLIT_TILE + (t >> 2), pl = t & 3;
        const int e = (int)__hip_atomic_load(tile_e + pm, __ATOMIC_RELAXED, __HIP_MEMORY_SCOPE_AGENT);
        u.pm = pm; u.pn = __builtin_amdgcn_readfirstlane(e) * 4 + pl; u.ko = sl * 512; return true;
    }
    __device__ __forceinline__ void a_ready(const Unit&) const {}
    __device__ __forceinline__ void done(const Unit&) const {}
};
struct EpiMoeSlab {
    static constexpr bool PERM = true, AFTER_DRAIN = false;
    bf16_t* slab;
    __device__ __forceinline__ void operator()(const f32x4 (&acc)[2][2][4][2], const Unit& u, int wr, int wc, int fr, int fq) const {
        const int row0 = (u.pm - MOE_SPLIT_TILE) * BM + wr * 64 + fr, col0 = (u.pn & 3) * BM + wc * 32 + 8 * fq;
        bf16_t* sb = slab + (size_t)(u.ko / 512) * 4096 * D;
#pragma unroll
        for (int ai = 0; ai < 2; ++ai)
#pragma unroll
            for (int m = 0; m < 4; ++m) { bf16_t* rowp = sb + (size_t)(row0 + ai * HALF + m * 16) * D + col0;
#pragma unroll
                for (int bj = 0; bj < 2; ++bj) { const f32x4 v0 = acc[ai][bj][m][0], v1 = acc[ai][bj][m][1];
                    u32x4 w; w.x = cvt_pk_bf16(v0[0], v0[1]); w.y = cvt_pk_bf16(v0[2], v0[3]); w.z = cvt_pk_bf16(v1[0], v1[1]); w.w = cvt_pk_bf16(v1[2], v1[3]);
                    *(u32x4*)(rowp + bj * HALF) = w; } }
    }
};
struct SplitKOrder {
    int G, c, ns, kslice;
    __device__ __forceinline__ bool next(int i, Unit& u) const { const int L = i * G + c; if (L >= 16 * ns) return false; const int sl = L % ns, t = L / ns; u.pm = t & 3; u.pn = t >> 2; u.ko = sl * kslice; return true; }
    __device__ __forceinline__ void a_ready(const Unit&) const {}
    __device__ __forceinline__ void done(const Unit&) const {}
};
struct EpiStore {
    static constexpr bool PERM = true, AFTER_DRAIN = false;
    bf16_t* O; int ldc; int pn_mod;
    __device__ __forceinline__ void operator()(const f32x4 (&acc)[2][2][4][2], const Unit& u, int wr, int wc, int fr, int fq) const {
        const int row0 = u.pm * BM + wr * 64 + fr, col0 = (u.pn % pn_mod) * BM + wc * 32 + 8 * fq;
#pragma unroll
        for (int ai = 0; ai < 2; ++ai)
#pragma unroll
            for (int m = 0; m < 4; ++m) { bf16_t* rowp = O + (size_t)(row0 + ai * HALF + m * 16) * ldc + col0;
#pragma unroll
                for (int bj = 0; bj < 2; ++bj) { const f32x4 v0 = acc[ai][bj][m][0], v1 = acc[ai][bj][m][1];
                    u32x4 w; w.x = cvt_pk_bf16(v0[0], v0[1]); w.y = cvt_pk_bf16(v0[2], v0[3]); w.z = cvt_pk_bf16(v1[0], v1[1]); w.w = cvt_pk_bf16(v1[2], v1[3]);
                    *(u32x4*)(rowp + bj * HALF) = w; } }
    }
};
struct EpiUp {
    static constexpr bool PERM = true, AFTER_DRAIN = false;
    bf16_t* Q; bf16_t* K;
    __device__ __forceinline__ void operator()(const f32x4 (&acc)[2][2][4][2], const Unit& u, int wr, int wc, int fr, int fq) const {
        const int row0 = u.pm * BM + wr * 64 + fr;
#pragma unroll
        for (int bj = 0; bj < 2; ++bj) {
            const int col = u.pn * BM + bj * HALF + wc * 32 + 8 * fq;
            bf16_t* base;
            if (col < 384) base = Q + col; else if (col < 640) { const int c2 = col - 384; base = K + (c2 >> 6) * 96 + (c2 & 63); } else continue;
#pragma unroll
            for (int ai = 0; ai < 2; ++ai)
#pragma unroll
                for (int m = 0; m < 4; ++m) { const f32x4 v0 = acc[ai][bj][m][0], v1 = acc[ai][bj][m][1];
                    u32x4 w; w.x = cvt_pk_bf16(v0[0], v0[1]); w.y = cvt_pk_bf16(v0[2], v0[3]); w.z = cvt_pk_bf16(v1[0], v1[1]); w.w = cvt_pk_bf16(v1[2], v1[3]);
                    *(u32x4*)(base + (size_t)(row0 + ai * HALF + m * 16) * 384) = w; }
        }
    }
};
template <bool ATOMIC> struct EpiResT {
    static constexpr bool PERM = false, AFTER_DRAIN = false;
    float* H; const float* gate; const float* Hin;
    __device__ __forceinline__ void operator()(const f32x4 (&acc)[2][2][4][2], const Unit& u, int wr, int wc, int fr, int fq) const {
        const int row0 = u.pm * BM + wr * 64 + fr, col0 = u.pn * BM + wc * 32 + 4 * fq;
        const int mb = (u.pm < 4) ? 4 : ((u.pm - 4) >> 4);
        const float* gp = gate + (size_t)mb * 6144 + col0;
        f32x4 gv[2][2];
#pragma unroll
        for (int bj = 0; bj < 2; ++bj)
#pragma unroll
            for (int n = 0; n < 2; ++n) gv[bj][n] = *(const f32x4*)(gp + bj * HALF + n * 16);
#pragma unroll
        for (int ai = 0; ai < 2; ++ai)
#pragma unroll
            for (int m = 0; m < 4; ++m) { const size_t ro = (size_t)(row0 + ai * HALF + m * 16) * D + col0;
#pragma unroll
                for (int bj = 0; bj < 2; ++bj)
#pragma unroll
                    for (int n = 0; n < 2; ++n) { const size_t o = ro + bj * HALF + n * 16; *(f32x4*)(H + o) = *(const f32x4*)(Hin + o) + gv[bj][n] * acc[ai][bj][m][n]; } }
    }
};
typedef EpiResT<false> EpiRes;
struct EpiSlab {
    static constexpr bool PERM = false, AFTER_DRAIN = false;
    float* slab; const float* gate; int kslice;
    __device__ __forceinline__ void operator()(const f32x4 (&acc)[2][2][4][2], const Unit& u, int wr, int wc, int fr, int fq) const {
        const int row0 = u.pm * BM + wr * 64 + fr, col0 = u.pn * BM + wc * 32 + 4 * fq;
        const float* gp = gate + (size_t)4 * 6144 + col0; float* sb = slab + (size_t)(u.ko / kslice) * MC * D;
        f32x4 gv[2][2];
#pragma unroll
        for (int bj = 0; bj < 2; ++bj)
#pragma unroll
            for (int n = 0; n < 2; ++n) gv[bj][n] = *(const f32x4*)(gp + bj * HALF + n * 16);
#pragma unroll
        for (int ai = 0; ai < 2; ++ai)
#pragma unroll
            for (int m = 0; m < 4; ++m) { float* rowp = sb + (size_t)(row0 + ai * HALF + m * 16) * D + col0;
#pragma unroll
                for (int bj = 0; bj < 2; ++bj)
#pragma unroll
                    for (int n = 0; n < 2; ++n) *(f32x4*)(rowp + bj * HALF + n * 16) = gv[bj][n] * acc[ai][bj][m][n]; }
    }
};
struct EpiSwiGLU {
    static constexpr bool PERM = true, AFTER_DRAIN = false;
    bf16_t* Hd;
    __device__ __forceinline__ void operator()(const f32x4 (&acc)[2][2][4][2], const Unit& u, int wr, int wc, int fr, int fq) const {
        const int row0 = u.pm * BM + wr * 64 + fr, col0 = (u.pn % 28) * HALF + wc * 32 + 8 * fq;
#pragma unroll
        for (int ai = 0; ai < 2; ++ai)
#pragma unroll
            for (int m = 0; m < 4; ++m) {
                float o[8];
#pragma unroll
                for (int n = 0; n < 2; ++n)
#pragma unroll
                    for (int q = 0; q < 4; ++q) { const float g = acc[ai][0][m][n][q], up = acc[ai][1][m][n][q]; o[n * 4 + q] = g * __builtin_amdgcn_rcpf(1.f + __expf(-g)) * up; }
                u32x4 w; w.x = cvt_pk_bf16(o[0], o[1]); w.y = cvt_pk_bf16(o[2], o[3]); w.z = cvt_pk_bf16(o[4], o[5]); w.w = cvt_pk_bf16(o[6], o[7]);
                *(u32x4*)(Hd + (size_t)(row0 + ai * HALF + m * 16) * DFF + col0) = w; }
    }
};
}

enum { I_X = 0, I_C, I_CTX, I_CCTX, I_WMOD, I_BMOD, I_NORM1, I_NORM2, I_WIN, I_WOUT, I_SINK, I_GCONV, I_GALOG, I_GDTB, I_GNORM, I_QNORM, I_KVNORM, I_WQUP, I_WKVUP,
       I_RLOGD, I_RNORM, I_FGATE, I_FUP, I_FDOWN, I_ROUTER, I_MGATE, I_MUP, I_MDOWN, I_FNORM, N_IN };
struct Params { const float* in[N_IN]; float* out; unsigned char* ws; int ph_lo, ph_hi; };
typedef const __attribute__((address_space(4))) Params* KArg;
__device__ __forceinline__ KArg kp_get() { KArg k = (KArg)__builtin_amdgcn_kernarg_segment_ptr(); asm volatile("" : "+s"(k)); return k; }

struct Ctx {
    LAS unsigned char* lds; int tid, lane, wave, bid, G;
};

__device__ __forceinline__ void tr_item(const float* src, int ldsrc, int nvalid, int k0, int c0, bf16_t* dst, int ldd, int drow0, LAS float* scr, int lane) {
    const int cl = 4 * (lane & 15), rr = lane >> 4, cc = c0 + cl; const bool ok = cc < nvalid;
    f32x4 v[16];
#pragma unroll
    for (int i = 0; i < 16; ++i) v[i] = ok ? *(const f32x4*)(src + (size_t)(k0 + 4 * i + rr) * ldsrc + cc) : (f32x4){0.f, 0.f, 0.f, 0.f};
#pragma unroll
    for (int i = 0; i < 16; ++i) { LAS float* d = scr + (4 * i + rr) * 65 + cl; d[0] = v[i].x; d[1] = v[i].y; d[2] = v[i].z; d[3] = v[i].w; }
    asm volatile("s_waitcnt lgkmcnt(0)" ::: "memory");
    const int c = lane & 7;
#pragma unroll
    for (int j = 0; j < 8; ++j) { const int n = (lane >> 3) + 8 * j; const LAS float* s = scr + (8 * c) * 65 + n;
        u32x4 o; o.x = cvtpk(s[0 * 65], s[1 * 65]); o.y = cvtpk(s[2 * 65], s[3 * 65]); o.z = cvtpk(s[4 * 65], s[5 * 65]); o.w = cvtpk(s[6 * 65], s[7 * 65]);
        *(u32x4*)(dst + (size_t)(drow0 + n) * ldd + k0 + 8 * c) = o; }
    asm volatile("s_waitcnt lgkmcnt(0)" ::: "memory");
}
__device__ __forceinline__ void ffn_tr_item(const float* g, const float* u, const float* d, bf16_t* gu, bf16_t* dn, int it, LAS float* scr, int lane) {
    if (it < 1792) { const bool up = it >= 896; const int r = up ? it - 896 : it; const int kb = r / 56, cb = r % 56, c0 = 64 * cb;
        tr_item(up ? u : g, DFF, DFF, 64 * kb, c0, gu, 1024, 256 * (c0 >> 7) + (up ? 128 : 0) + (c0 & 127), scr, lane); }
    else { const int r = it - 1792; const int kb = r / 16, cb = r % 16; tr_item(d, 1024, 1024, 64 * kb, 64 * cb, dn, DFF, 64 * cb, scr, lane); }
}

__device__ __forceinline__ void convert_layer_weights(KArg p, const Ctx& C, int ln, int gw, int NGW) {
    unsigned char* ws = p->ws; LAS float* scr = (LAS float*)(C.lds + C.wave * 16640);
    constexpr int I_IN = 16 * 48, I_OUT = 16 * 16, I_FF = 2688;
    const bool moe = (ln & 1) != 0; const int i = ln >> 1;
    const int nit = I_IN + I_OUT + (moe ? 8 * I_FF : I_FF);
    for (int it = gw; it < nit; it += NGW) {
        int r = it;
        if (r < I_IN) { const int kb = r / 48, cb = r % 48;
            tr_item(p->in[I_WIN] + (size_t)ln * D * DIN, DIN, DIN, 64 * kb, 64 * cb, (bf16_t*)(ws + WS_WIN) + (size_t)ln * DINP * D, D, 64 * cb, scr, C.lane); continue; }
        r -= I_IN;
        if (r < I_OUT) { const int kb = r / 16, cb = r % 16;
            tr_item(p->in[I_WOUT] + (size_t)ln * D * D, D, D, 64 * kb, 64 * cb, (bf16_t*)(ws + WS_WOUT) + (size_t)ln * D * D, D, 64 * cb, scr, C.lane); continue; }
        r -= I_OUT;
        if (!moe) { bf16_t* gu = (bf16_t*)(ws + WS_WFF + (size_t)i * FFW_BYTES);
            ffn_tr_item(p->in[I_FGATE] + (size_t)i * D * DFF, p->in[I_FUP] + (size_t)i * D * DFF, p->in[I_FDOWN] + (size_t)i * DFF * D, gu, gu + (size_t)7168 * 1024, r, scr, C.lane); }
        else { const int e = r / I_FF; r %= I_FF; const size_t eo = (size_t)i * NE + e;
            bf16_t* gu = (bf16_t*)(ws + WS_WMOE) + (size_t)e * 7168 * 1024; bf16_t* dn = (bf16_t*)(ws + WS_WMOE) + (size_t)8 * 7168 * 1024 + (size_t)e * 1024 * DFF;
            ffn_tr_item(p->in[I_MGATE] + eo * D * DFF, p->in[I_MUP] + eo * D * DFF, p->in[I_MDOWN] + eo * DFF * D, gu, dn, r, scr, C.lane); }
    }
}

__device__ __forceinline__ void prologue_phase(KArg p, const Ctx& C) {
    unsigned char* ws = p->ws;
    const int gw = C.bid * NWAVES + C.wave, NGW = C.G * NWAVES, gt = C.bid * NTHR + C.tid, NGT = C.G * NTHR;
    convert_layer_weights(p, C, 0, gw, NGW);
    {
        constexpr int PER_L = 256 * 128 + 1024 * 64 + 256 * 64;
        for (int it = gt; it < 4 * PER_L; it += NGT) {
            const int l = it / PER_L; int r = it % PER_L;
            const float* win = p->in[I_WIN] + (size_t)l * D * DIN; const float* qup = p->in[I_WQUP] + (size_t)l * 256 * 384; const float* kvup = p->in[I_WKVUP] + (size_t)l * 128 * 512;
            float v[8]; bf16_t* dst;
            if (r < 256 * 128) { const int n = r % 256, kg = r / 256;
#pragma unroll
                for (int j = 0; j < 8; ++j) v[j] = (n < 128) ? win[(size_t)(8 * kg + j) * DIN + PC_AV + n] : 0.f;
                dst = (bf16_t*)(ws + WS_WINV) + ((size_t)l * 256 + n) * 1024 + 8 * kg; }
            else if ((r -= 256 * 128) < 1024 * 64) { const int n = r % 1024, kg = r / 1024;
#pragma unroll
                for (int j = 0; j < 8; ++j) { const int k = 8 * kg + j; float x = 0.f;
                    if (n < 384) { if (k < 256) x = qup[(size_t)k * 384 + n]; }
                    else if (n < 640) { const int c2 = n - 384; if (k >= 256 && k < 384) x = kvup[(size_t)(k - 256) * 512 + 128 * (c2 >> 6) + (c2 & 63)]; }
                    v[j] = x; }
                dst = (bf16_t*)(ws + WS_WUP) + ((size_t)l * 1024 + n) * 512 + 8 * kg; }
            else { r -= 1024 * 64; const int n = r % 256, kg = r / 256;
#pragma unroll
                for (int j = 0; j < 8; ++j) { const int k = 8 * kg + j; v[j] = (k >= 256 && k < 384) ? kvup[(size_t)(k - 256) * 512 + 128 * (n >> 6) + 64 + (n & 63)] : 0.f; }
                dst = (bf16_t*)(ws + WS_WUPV) + ((size_t)l * 256 + n) * 512 + 8 * kg; }
            u32x4 o; o.x = cvtpk(v[0], v[1]); o.y = cvtpk(v[2], v[3]); o.z = cvtpk(v[4], v[5]); o.w = cvtpk(v[6], v[7]);
            *(u32x4*)dst = o;
        }
    }
    {
        float* tab = (float*)(ws + WS_TAB);
        for (int it = gt; it < 64 * 16 + 64 * 8; it += NGT) {
            if (it < 1024) { const int pos = it >> 4, j = it & 15; const float inv = (float)pow(10000.0, -(double)j / 16.0); const float ang = (float)pos * inv;
                tab[it] = (float)cos((double)ang); tab[1024 + it] = (float)sin((double)ang); }
            else { const int r = it - 1024; const int pos = r >> 3, j = r & 7; const float inv = (float)pow(10000.0, -(double)j / 8.0); const float ang = (float)pos * inv;
                tab[2048 + r] = (float)cos((double)ang); tab[2560 + r] = (float)sin((double)ang); }
        }
    }
    {
        f32x4* H4 = (f32x4*)(ws + WS_H); const f32x4* x4 = (const f32x4*)p->in[I_X]; const f32x4* c4 = (const f32x4*)p->in[I_CTX];
        for (int it = gt; it < MC * 256; it += NGT) H4[it] = c4[it];
        (void)x4;
    }
    __syncthreads();
    if (C.bid < 192) {
        LAS float* sl = (LAS float*)C.lds;
        LAS float* red = (LAS float*)(C.lds + 20480);
        for (int i = C.tid; i < 5 * 1024; i += NTHR) { const int r = i >> 10, k = i & 1023; const float cv = (r < 4) ? p->in[I_C][r * 1024 + k] : p->in[I_CCTX][k]; sl[i] = silu_f(cv); }
        __syncthreads();
        for (int it = C.bid; it < 192; it += C.G) {
            const int l = it / 48, cb = it % 48, cl = C.tid & 127, kq = C.tid >> 7, col = cb * 128 + cl;
            const float* w = p->in[I_WMOD] + (size_t)l * D * 6144 + col;
            float a0 = 0.f, a1 = 0.f, a2 = 0.f, a3 = 0.f, a4 = 0.f;
#pragma unroll 32
            for (int k = 256 * kq; k < 256 * kq + 256; ++k) { const float wv = w[(size_t)k * 6144]; a0 += sl[k] * wv; a1 += sl[1024 + k] * wv; a2 += sl[2048 + k] * wv; a3 += sl[3072 + k] * wv; a4 += sl[4096 + k] * wv; }
            red[(kq * 5 + 0) * 128 + cl] = a0; red[(kq * 5 + 1) * 128 + cl] = a1; red[(kq * 5 + 2) * 128 + cl] = a2; red[(kq * 5 + 3) * 128 + cl] = a3; red[(kq * 5 + 4) * 128 + cl] = a4;
            __syncthreads();
            for (int i = C.tid; i < 5 * 128; i += NTHR) { const int r = i >> 7, c2 = i & 127; const int cc = cb * 128 + c2;
                const float s = red[(0 * 5 + r) * 128 + c2] + red[(1 * 5 + r) * 128 + c2] + red[(2 * 5 + r) * 128 + c2] + red[(3 * 5 + r) * 128 + c2] + p->in[I_BMOD][l * 6144 + cc];
                ((float*)(ws + WS_MOD))[((size_t)l * 5 + r) * 6144 + cc] = s; }
            __syncthreads();
        }
    }
}
template <int MODE>
__device__ __forceinline__ void norm_phase(KArg p, const Ctx& C, int l, bool comb, int lprev, bool moe, int row_min, int nslab) {
    unsigned char* ws = p->ws;
    float* H = (float*)(ws + WS_H); bf16_t* U = (bf16_t*)(ws + WS_U); const float* MOD = (const float*)(ws + WS_MOD);
    const float* Hlat = (MODE == 0 && l == 0) ? p->in[I_X] - (size_t)MC * D : H;
    int* RE = (int*)(ws + WS_ROUTE); float* RW = (float*)(ws + WS_ROUTE + (size_t)MT * 8); const int* RP = (const int*)(ws + WS_ROUTE + (size_t)MT * 16);
    const bf16_t* YD = (const bf16_t*)(ws + WS_YD);
    LAS unsigned* lcnt = (LAS unsigned*)C.lds;
    if (MODE == 1 && moe) { if (C.tid < 8) lcnt[C.tid] = 0u; __syncthreads(); }
    f32x4 nv[4];
    { const int row0 = C.bid + 256 * C.wave;
#pragma unroll
      for (int j = 0; j < 4; ++j) nv[j] = *(const f32x4*)((row0 < MC ? (const float*)H : Hlat) + (size_t)row0 * D + 4 * C.lane + 256 * j); }
    for (int ri = C.wave; ri < MT / 256; ri += NWAVES) {
        const int row = C.bid + 256 * ri;
        f32x4 v[4];
#pragma unroll
        for (int j = 0; j < 4; ++j) v[j] = nv[j];
        if (ri + NWAVES < MT / 256) {
#pragma unroll
            for (int j = 0; j < 4; ++j) nv[j] = *(const f32x4*)(Hlat + (size_t)(row + 256 * NWAVES) * D + 4 * C.lane + 256 * j); }
        if (row < row_min) continue;
        const int mb = mod_row(row);
        if (comb) {
            const int p0 = RP[row * 2], p1 = RP[row * 2 + 1]; const float w0 = RW[row * 2], w1 = RW[row * 2 + 1];
            const float* g2 = MOD + ((size_t)lprev * 5 + mb) * 6144 + 5 * 1024;
            const bf16_t* MS = (const bf16_t*)(ws + WS_MSLAB);
            f32x4 ya[4], yb[4];
#pragma unroll
            for (int k = 0; k < 2; ++k) { const int ps = k ? p1 : p0; f32x4 (&yy)[4] = k ? yb : ya;
                if (ps < MOE_SPLIT_ROW) {
#pragma unroll
                    for (int j = 0; j < 4; ++j) { const u32x2 t = *(const u32x2*)(YD + (size_t)ps * D + 4 * C.lane + 256 * j); yy[j] = (f32x4){bf_lo(t.x), bf_hi(t.x), bf_lo(t.y), bf_hi(t.y)}; }
                } else {
#pragma unroll
                    for (int j = 0; j < 4; ++j) { u32x2 t[7];
#pragma unroll
                        for (int s = 0; s < 7; ++s) t[s] = *(const u32x2*)(MS + ((size_t)s * 4096 + (ps - MOE_SPLIT_ROW)) * D + 4 * C.lane + 256 * j);
                        f32x4 a = (f32x4){0.f, 0.f, 0.f, 0.f};
#pragma unroll
                        for (int s = 0; s < 7; ++s) a += (f32x4){bf_lo(t[s].x), bf_hi(t[s].x), bf_lo(t[s].y), bf_hi(t[s].y)};
                        yy[j] = a; }
                } }
#pragma unroll
            for (int j = 0; j < 4; ++j) { const int e = 4 * C.lane + 256 * j; const f32x4 g = *(const f32x4*)(g2 + e);
                v[j] += g * (ya[j] * w0 + yb[j] * w1);
                if (MODE != 2) *(f32x4*)(H + (size_t)row * D + e) = v[j]; }
        }
        if (nslab > 0 && row < MC) {
            const float* sl = (const float*)(ws + WS_SLAB) + (size_t)row * D + 4 * C.lane;
#pragma unroll
            for (int j = 0; j < 4; ++j) { f32x4 t[7];
#pragma unroll
                for (int s = 0; s < 7; ++s) t[s] = *(const f32x4*)(sl + (size_t)(s < nslab ? s : 0) * MC * D + 256 * j);
#pragma unroll
                for (int s = 0; s < 7; ++s) if (s < nslab) v[j] += t[s];
                *(f32x4*)(H + (size_t)row * D + 4 * C.lane + 256 * j) = v[j]; }
        }
        float ss = 0.f;
#pragma unroll
        for (int j = 0; j < 4; ++j) ss += (v[j].x * v[j].x + v[j].y * v[j].y) + (v[j].z * v[j].z + v[j].w * v[j].w);
        const float rstd = rsqrtf(wave_sum(ss) * (1.f / D) + EPS);
        if (MODE == 2) {
            const float* gam = p->in[I_FNORM];
#pragma unroll
            for (int j = 0; j < 4; ++j) { const int e = 4 * C.lane + 256 * j; const f32x4 g = *(const f32x4*)(gam + e); *(f32x4*)(p->out + (size_t)(row - MC) * D + e) = v[j] * rstd * g; }
        } else {
            const float* gam = p->in[MODE == 0 ? I_NORM1 : I_NORM2] + (size_t)l * D;
            const float* sh = MOD + ((size_t)l * 5 + mb) * 6144 + (MODE == 0 ? 0 : 3) * 1024; const float* sc = sh + 1024;
            f32x4 y[4];
#pragma unroll
            for (int j = 0; j < 4; ++j) { const int e = 4 * C.lane + 256 * j; const f32x4 g = *(const f32x4*)(gam + e), s1 = *(const f32x4*)(sc + e), s0 = *(const f32x4*)(sh + e);
                y[j] = v[j] * rstd * g * (1.f + s1) + s0;
                u32x2 o; o.x = cvtpk(y[j].x, y[j].y); o.y = cvtpk(y[j].z, y[j].w); *(u32x2*)(U + (size_t)row * D + e) = o; }
            if (MODE == 1 && moe) {
                const float* wr = p->in[I_ROUTER] + (size_t)(l >> 1) * D * NE;
                float lg[8];
#pragma unroll
                for (int e = 0; e < 8; ++e) lg[e] = 0.f;
#pragma unroll
                for (int j = 0; j < 4; ++j)
#pragma unroll
                    for (int q = 0; q < 4; ++q) { const int e = 4 * C.lane + 256 * j + q; const f32x4 wa = *(const f32x4*)(wr + (size_t)e * 8), wb = *(const f32x4*)(wr + (size_t)e * 8 + 4); const float yv = y[j][q];
                        lg[0] += yv * wa.x; lg[1] += yv * wa.y; lg[2] += yv * wa.z; lg[3] += yv * wa.w; lg[4] += yv * wb.x; lg[5] += yv * wb.y; lg[6] += yv * wb.z; lg[7] += yv * wb.w; }
#pragma unroll
                for (int e = 0; e < 8; ++e) lg[e] = wave_sum(lg[e]);
                int e0 = 0; float v0 = lg[0];
#pragma unroll
                for (int e = 1; e < 8; ++e) if (lg[e] > v0) { v0 = lg[e]; e0 = e; }
                int e1 = -1; float v1 = -3.0e38f;
#pragma unroll
                for (int e = 0; e < 8; ++e) if (e != e0 && lg[e] > v1) { v1 = lg[e]; e1 = e; }
                const float t = __expf(v1 - v0), w0 = 1.f / (1.f + t), w1 = t * w0;
                if (C.lane == 0) { RE[row * 2] = e0; RE[row * 2 + 1] = e1; RW[row * 2] = w0; RW[row * 2 + 1] = w1; atomicAdd((unsigned*)&lcnt[e0], 1u); atomicAdd((unsigned*)&lcnt[e1], 1u); }
            }
        }
    }
    if (MODE == 1 && moe) { __syncthreads(); if (C.tid < 8) __hip_atomic_store((unsigned*)(ws + WS_CTL) + CW_CNT + C.bid * 8 + C.tid, lcnt[C.tid], __ATOMIC_RELAXED, __HIP_MEMORY_SCOPE_AGENT); }
}

__device__ __forceinline__ void moe_gather_phase(KArg p, const Ctx& C, int row_min) {
    unsigned char* ws = p->ws;
    unsigned* ctl = (unsigned*)(ws + WS_CTL);
    const int* RE = (const int*)(ws + WS_ROUTE); int* RP = (int*)(ws + WS_ROUTE + (size_t)MT * 16);
    const bf16_t* U = (const bf16_t*)(ws + WS_U); bf16_t* AS = (bf16_t*)(ws + WS_ASORT);
    LAS unsigned* cn = (LAS unsigned*)C.lds;
    LAS int* myoff = (LAS int*)(C.lds + 8192);
    LAS int* base = (LAS int*)(C.lds + 8192 + 64);
    LAS int* pos = (LAS int*)(C.lds + 8192 + 128);
    for (int i = C.tid; i < 2048; i += NTHR) cn[i] = __hip_atomic_load(ctl + CW_CNT + i, __ATOMIC_RELAXED, __HIP_MEMORY_SCOPE_AGENT);
    __syncthreads();
    if (C.tid < 8) { int tot = 0, mine = 0; for (int b = 0; b < 256; ++b) { const int c = (int)cn[b * 8 + C.tid]; if (b < C.bid) mine += c; tot += c; } myoff[C.tid] = mine; base[C.tid] = (tot + 255) & ~255; }
    __syncthreads();
    if (C.tid == 0) {
        int b0 = 0; for (int e = 0; e < 8; ++e) { const int t = base[e]; base[e] = b0; myoff[e] += b0; b0 += t; } base[8] = b0;
        for (int ri = 0; ri < MT / 256; ++ri) { const int row = C.bid + 256 * ri; if (row < row_min) { pos[ri * 2] = -1; pos[ri * 2 + 1] = -1; continue; }
            for (int k = 0; k < 2; ++k) { const int e = RE[row * 2 + k]; const int ps = myoff[e]++; pos[ri * 2 + k] = ps; RP[row * 2 + k] = ps; } }
    }
    __syncthreads();
    if (C.bid == 0) {
        const int ntiles = base[8] >> 8;
        if (C.tid < MOE_TILES) { int e = 0; for (int q = 1; q < 8; ++q) if (C.tid * 256 >= base[q]) e = q; __hip_atomic_store(ctl + CW_TILEE + C.tid, (unsigned)e, __ATOMIC_RELAXED, __HIP_MEMORY_SCOPE_AGENT); }
        if (C.tid == 0) __hip_atomic_store(ctl + CW_TILEE + 160, (unsigned)ntiles, __ATOMIC_RELAXED, __HIP_MEMORY_SCOPE_AGENT);
    }
    for (int it = C.tid; it < (MT / 256) * 2 * 128; it += NTHR) { const int slot = it >> 7, ch = it & 127; const int ps = pos[slot]; if (ps < 0) continue;
        *(u32x4*)(AS + (size_t)ps * D + 8 * ch) = *(const u32x4*)(U + (size_t)(C.bid + 256 * (slot >> 1)) * D + 8 * ch); }
}

__device__ __forceinline__ void prep_row(KArg p, int lane, int l, int row) {
    unsigned char* ws = p->ws;
    const bf16_t* P = (const bf16_t*)(ws + WS_P); bf16_t* QS = (bf16_t*)(ws + WS_QS); bf16_t* KS = (bf16_t*)(ws + WS_KS); bf16_t* AUP = (bf16_t*)(ws + WS_AUP); bf16_t* KF = (bf16_t*)(ws + WS_KFULL);
    const float* tab = (const float*)(ws + WS_TAB);
    const float* qg = p->in[I_QNORM] + (size_t)l * 256; const float* kvg = p->in[I_KVNORM] + (size_t)l * 128;
        const bf16_t* pr = P + (size_t)row * DINP;
        const bool lat = row >= MC; const int t = (row - MC) & 4095, prow = t >> 6, pcol = t & 63;
        {
            const int hd = lane >> 4, j = lane & 15;
            float c_r = 1.f, s_r = 0.f, c_c = 1.f, s_c = 0.f;
            if (lat) { c_r = tab[prow * 16 + j]; s_r = tab[1024 + prow * 16 + j]; c_c = tab[pcol * 16 + j]; s_c = tab[1024 + pcol * 16 + j]; }
            { const bf16_t* q = pr + PC_AQ + hd * 64; const float x1 = bf2f(q[j]), x2 = bf2f(q[16 + j]), x3 = bf2f(q[32 + j]), x4 = bf2f(q[48 + j]); const float qs = 0.125f * LOG2E;
              bf16_t* o = QS + (size_t)row * 256 + hd * 64;
              o[j] = f2bf((x1 * c_r - x2 * s_r) * qs); o[16 + j] = f2bf((x2 * c_r + x1 * s_r) * qs); o[32 + j] = f2bf((x3 * c_c - x4 * s_c) * qs); o[48 + j] = f2bf((x4 * c_c + x3 * s_c) * qs); }
            if (lane < 32) { const bf16_t* k = pr + PC_AK + hd * 64; const float x1 = bf2f(k[j]), x2 = bf2f(k[16 + j]), x3 = bf2f(k[32 + j]), x4 = bf2f(k[48 + j]);
              bf16_t* o = KS + (size_t)row * 128 + hd * 64;
              o[j] = f2bf(x1 * c_r - x2 * s_r); o[16 + j] = f2bf(x2 * c_r + x1 * s_r); o[32 + j] = f2bf(x3 * c_c - x4 * s_c); o[48 + j] = f2bf(x4 * c_c + x3 * s_c); }
        }
        {
            const u32x2 a = *(const u32x2*)(pr + PC_CQ + 4 * lane); const float q0 = bf_lo(a.x), q1 = bf_hi(a.x), q2 = bf_lo(a.y), q3 = bf_hi(a.y);
            const float rq = rsqrtf(wave_sum(q0 * q0 + q1 * q1 + q2 * q2 + q3 * q3) * (1.f / 256.f) + EPS);
            const f32x4 g = *(const f32x4*)(qg + 4 * lane);
            u32x2 o; o.x = cvtpk(q0 * rq * g.x, q1 * rq * g.y); o.y = cvtpk(q2 * rq * g.z, q3 * rq * g.w); *(u32x2*)(AUP + (size_t)row * 512 + 4 * lane) = o;
            const unsigned b = *(const unsigned*)(pr + PC_CKV + 2 * lane); const float k0 = bf_lo(b), k1 = bf_hi(b);
            const float rk = rsqrtf(wave_sum(k0 * k0 + k1 * k1) * (1.f / 128.f) + EPS);
            const f32x2 g2 = *(const f32x2*)(kvg + 2 * lane);
            *(unsigned*)(AUP + (size_t)row * 512 + 256 + 2 * lane) = cvtpk(k0 * rk * g2.x, k1 * rk * g2.y);
            *(unsigned*)(AUP + (size_t)row * 512 + 384 + 2 * lane) = 0u;
        }
        if (lane < 16) {
            const int part = lane >> 3, j = lane & 7; const float xa = bf2f(pr[PC_CKR + 16 * part + j]), xb = bf2f(pr[PC_CKR + 16 * part + 8 + j]);
            float cs = 1.f, sn = 0.f; if (lat) { const int ps = part ? pcol : prow; cs = tab[2048 + ps * 8 + j]; sn = tab[2560 + ps * 8 + j]; }
            const bf16_t oa = f2bf(xa * cs - xb * sn), ob = f2bf(xb * cs + xa * sn);
#pragma unroll
            for (int h = 0; h < 4; ++h) { bf16_t* o = KF + (size_t)row * 384 + h * 96 + 64 + 16 * part; o[j] = oa; o[8 + j] = ob; }
        }
    }

__device__ __forceinline__ void rope8(const u32x4 a, const u32x4 b, const float* cs, const float* sn, float sc, u32x4& oa, u32x4& ob) {
    const f32x4 c0 = *(const f32x4*)cs, c1 = *(const f32x4*)(cs + 4), s0 = *(const f32x4*)sn, s1 = *(const f32x4*)(sn + 4);
    const float av[8] = {bf_lo(a.x), bf_hi(a.x), bf_lo(a.y), bf_hi(a.y), bf_lo(a.z), bf_hi(a.z), bf_lo(a.w), bf_hi(a.w)};
    const float bv[8] = {bf_lo(b.x), bf_hi(b.x), bf_lo(b.y), bf_hi(b.y), bf_lo(b.z), bf_hi(b.z), bf_lo(b.w), bf_hi(b.w)};
    const float cc[8] = {c0.x, c0.y, c0.z, c0.w, c1.x, c1.y, c1.z, c1.w}, ss[8] = {s0.x, s0.y, s0.z, s0.w, s1.x, s1.y, s1.z, s1.w};
    float ra[8], rb[8];
#pragma unroll
    for (int i = 0; i < 8; ++i) { ra[i] = (av[i] * cc[i] - bv[i] * ss[i]) * sc; rb[i] = (bv[i] * cc[i] + av[i] * ss[i]) * sc; }
    oa.x = cvtpk(ra[0], ra[1]); oa.y = cvtpk(ra[2], ra[3]); oa.z = cvtpk(ra[4], ra[5]); oa.w = cvtpk(ra[6], ra[7]);
    ob.x = cvtpk(rb[0], rb[1]); ob.y = cvtpk(rb[2], rb[3]); ob.z = cvtpk(rb[4], rb[5]); ob.w = cvtpk(rb[6], rb[7]);
}
__device__ __forceinline__ void prep_rows4(KArg p, int lane, int l, int row_base) {
    unsigned char* ws = p->ws;
    const bf16_t* P = (const bf16_t*)(ws + WS_P); bf16_t* QS = (bf16_t*)(ws + WS_QS); bf16_t* KS = (bf16_t*)(ws + WS_KS); bf16_t* AUP = (bf16_t*)(ws + WS_AUP); bf16_t* KF = (bf16_t*)(ws + WS_KFULL);
    const float* tab = (const float*)(ws + WS_TAB);
    const float* qg = p->in[I_QNORM] + (size_t)l * 256; const float* kvg = p->in[I_KVNORM] + (size_t)l * 128;
    const int row = row_base + (lane >> 4), ln = lane & 15;
    const bf16_t* pr = P + (size_t)row * DINP;
    const bool lat = row >= MC; const int t = (row - MC) & 4095, prow = t >> 6, pcol = t & 63;
    const int hd = ln >> 2, part = (ln >> 1) & 1, jq = ln & 1, ps = lat ? (part ? pcol : prow) : 0;
    const float* cs16 = tab + ps * 16 + 8 * jq; const float* sn16 = tab + 1024 + ps * 16 + 8 * jq;
    { const u32x4 qa = *(const u32x4*)(pr + PC_AQ + hd * 64 + 32 * part + 8 * jq), qb = *(const u32x4*)(pr + PC_AQ + hd * 64 + 32 * part + 16 + 8 * jq);
      u32x4 oa, ob; rope8(qa, qb, cs16, sn16, 0.125f * LOG2E, oa, ob);
      bf16_t* o = QS + (size_t)row * 256 + hd * 64 + 32 * part + 8 * jq; *(u32x4*)o = oa; *(u32x4*)(o + 16) = ob; }
    asm volatile("" ::: "memory");
    if (ln < 8) { const u32x4 ka = *(const u32x4*)(pr + PC_AK + hd * 64 + 32 * part + 8 * jq), kb = *(const u32x4*)(pr + PC_AK + hd * 64 + 32 * part + 16 + 8 * jq);
      u32x4 oa, ob; rope8(ka, kb, cs16, sn16, 1.f, oa, ob);
      bf16_t* o = KS + (size_t)row * 128 + hd * 64 + 32 * part + 8 * jq; *(u32x4*)o = oa; *(u32x4*)(o + 16) = ob; }
    asm volatile("" ::: "memory");
    {
        const u32x4 cq0 = *(const u32x4*)(pr + PC_CQ + 16 * ln), cq1 = *(const u32x4*)(pr + PC_CQ + 16 * ln + 8);
        float qv[16] = {bf_lo(cq0.x), bf_hi(cq0.x), bf_lo(cq0.y), bf_hi(cq0.y), bf_lo(cq0.z), bf_hi(cq0.z), bf_lo(cq0.w), bf_hi(cq0.w),
                        bf_lo(cq1.x), bf_hi(cq1.x), bf_lo(cq1.y), bf_hi(cq1.y), bf_lo(cq1.z), bf_hi(cq1.z), bf_lo(cq1.w), bf_hi(cq1.w)};
        float sq = 0.f;
#pragma unroll
        for (int i = 0; i < 16; ++i) sq += qv[i] * qv[i];
        sq = quad_sum(sq); sq += dppf<0x141>(sq); sq += dppf<0x140>(sq);
        const float rq = rsqrtf(sq * (1.f / 256.f) + EPS);
        unsigned ow[8];
#pragma unroll
        for (int i4 = 0; i4 < 4; ++i4) { const f32x4 g = *(const f32x4*)(qg + 16 * ln + 4 * i4);
            ow[2 * i4] = cvtpk(qv[4 * i4] * rq * g.x, qv[4 * i4 + 1] * rq * g.y); ow[2 * i4 + 1] = cvtpk(qv[4 * i4 + 2] * rq * g.z, qv[4 * i4 + 3] * rq * g.w); }
        u32x4 o0, o1; o0.x = ow[0]; o0.y = ow[1]; o0.z = ow[2]; o0.w = ow[3]; o1.x = ow[4]; o1.y = ow[5]; o1.z = ow[6]; o1.w = ow[7];
        *(u32x4*)(AUP + (size_t)row * 512 + 16 * ln) = o0; *(u32x4*)(AUP + (size_t)row * 512 + 16 * ln + 8) = o1;
    }
    asm volatile("" ::: "memory");
    {
        const u32x4 ckv = *(const u32x4*)(pr + PC_CKV + 8 * ln);
        float kv[8] = {bf_lo(ckv.x), bf_hi(ckv.x), bf_lo(ckv.y), bf_hi(ckv.y), bf_lo(ckv.z), bf_hi(ckv.z), bf_lo(ckv.w), bf_hi(ckv.w)};
        float sk = 0.f;
#pragma unroll
        for (int i = 0; i < 8; ++i) sk += kv[i] * kv[i];
        sk = quad_sum(sk); sk += dppf<0x141>(sk); sk += dppf<0x140>(sk);
        const float rk = rsqrtf(sk * (1.f / 128.f) + EPS);
        const f32x4 g0 = *(const f32x4*)(kvg + 8 * ln), g1 = *(const f32x4*)(kvg + 8 * ln + 4);
        u32x4 o2; o2.x = cvtpk(kv[0] * rk * g0.x, kv[1] * rk * g0.y); o2.y = cvtpk(kv[2] * rk * g0.z, kv[3] * rk * g0.w); o2.z = cvtpk(kv[4] * rk * g1.x, kv[5] * rk * g1.y); o2.w = cvtpk(kv[6] * rk * g1.z, kv[7] * rk * g1.w);
        *(u32x4*)(AUP + (size_t)row * 512 + 256 + 8 * ln) = o2;
        u32x4 z; z.x = z.y = z.z = z.w = 0u; *(u32x4*)(AUP + (size_t)row * 512 + 384 + 8 * ln) = z;
    }
    asm volatile("" ::: "memory");
    if (ln < 2) { const u32x4 ra = *(const u32x4*)(pr + PC_CKR + 16 * ln), rb = *(const u32x4*)(pr + PC_CKR + 16 * ln + 8);
      const int ps2 = lat ? (ln ? pcol : prow) : 0; u32x4 oa, ob; rope8(ra, rb, tab + 2048 + ps2 * 8, tab + 2560 + ps2 * 8, 1.f, oa, ob);
#pragma unroll
        for (int h = 0; h < 4; ++h) { bf16_t* o = KF + (size_t)row * 384 + h * 96 + 64 + 16 * ln; *(u32x4*)o = oa; *(u32x4*)(o + 8) = ob; } }
}

__device__ __forceinline__ void prep_phase(KArg p, const Ctx& C, int l) {
    const int gw = C.bid * NWAVES + C.wave, NGW = C.G * NWAVES;
    for (int it = gw; it < MT / 4; it += NGW) prep_rows4(p, C.lane, l, 4 * it);
}

struct AttnArgs {
    const bf16_t* Q; int q_pitch, q_col0, q_row0;
    const bf16_t* K; int k_pitch, k_col0;
    const bf16_t* Vt; int vt_row0;
    int seg_tok0, seg_nt0, seg_tok1, seg_nt1;
    int qpos0, kpos0;
    float m_init, l_init, qscale;
    bf16_t* O; int o_col0;
    const float* tab32; int qt0;
};
template <int DQK, bool MASK, bool ROPEQ>
__device__ __forceinline__ void attn_unit(const Ctx& C, const AttnArgs& a) {
    constexpr int KP = DQK + 8, NCH = DQK / 8, KT_BYTES = 64 * KP * 2, VP = 68, VT_BYTES = 64 * VP * 2, BUF = KT_BYTES + VT_BYTES, NKS = DQK / 16;
    LAS unsigned char* lds = C.lds;
    const int lane = C.lane, c = lane & 31, hi = lane >> 5, w = C.wave, tid = C.tid;
    const int qi = 32 * w + c;
    bf16x8 qf[NKS];
    {
        const bf16_t* qp = a.Q + (size_t)(a.q_row0 + qi) * a.q_pitch + a.q_col0;
#pragma unroll
        for (int ks = 0; ks < NKS; ++ks) {
            const u32x4 raw = *(const u32x4*)(qp + 16 * ks + 8 * hi);
            float f[8] = {bf_lo(raw.x), bf_hi(raw.x), bf_lo(raw.y), bf_hi(raw.y), bf_lo(raw.z), bf_hi(raw.z), bf_lo(raw.w), bf_hi(raw.w)};
            if (ROPEQ && ks >= 4) {
                const u32x4 ro = *(const u32x4*)(qp + 16 * ks + 8 * (1 - hi));
                const float g[8] = {bf_lo(ro.x), bf_hi(ro.x), bf_lo(ro.y), bf_hi(ro.y), bf_lo(ro.z), bf_hi(ro.z), bf_lo(ro.w), bf_hi(ro.w)};
                const int t = a.qt0 + qi, ps = (ks == 4) ? (t >> 6) : (t & 63);
#pragma unroll
                for (int j = 0; j < 8; ++j) { const float cs = a.tab32[ps * 8 + j], sn = a.tab32[512 + ps * 8 + j]; f[j] = hi ? (f[j] * cs + g[j] * sn) : (f[j] * cs - g[j] * sn); }
            }
            qf[ks] = mk_frag4(cvtpk(f[0] * a.qscale, f[1] * a.qscale), cvtpk(f[2] * a.qscale, f[3] * a.qscale), cvtpk(f[4] * a.qscale, f[5] * a.qscale), cvtpk(f[6] * a.qscale, f[7] * a.qscale));
        }
    }
    f32x16 o0, o1;
#pragma unroll
    for (int r = 0; r < 16; ++r) { o0[r] = 0.f; o1[r] = 0.f; }
    float m = a.m_init, l = a.l_init;
    const int NT = a.seg_nt0 + a.seg_nt1;
    u32x4 kst[2][2]; u32x4 vst[2];
    auto tile_tok = [&](int t) { return t < a.seg_nt0 ? a.seg_tok0 + 64 * t : a.seg_tok1 + 64 * (t - a.seg_nt0); };
    auto g_load = [&](int t, u32x4 (&ks_)[2], u32x4& vs_) {
        const int tk = tile_tok(t);
#pragma unroll
        for (int i = 0; i < 2; ++i) { const int ch = tid + 512 * i; if (ch < 64 * NCH) { const int r = ch / NCH, c8 = ch % NCH; ks_[i] = *(const u32x4*)(a.K + (size_t)(tk + r) * a.k_pitch + a.k_col0 + 8 * c8); } }
        { const int r = tid >> 3, c8 = tid & 7; vs_ = *(const u32x4*)(a.Vt + (size_t)(a.vt_row0 + r) * MT + tk + 8 * c8); }
    };
    auto l_store = [&](int b, const u32x4 (&ks_)[2], const u32x4& vs_) {
        LAS unsigned char* kb = lds + b * BUF; LAS unsigned char* vb = kb + KT_BYTES;
#pragma unroll
        for (int i = 0; i < 2; ++i) { const int ch = tid + 512 * i; if (ch < 64 * NCH) { const int r = ch / NCH, c8 = ch % NCH; *(LAS u32x4*)(kb + r * (KP * 2) + 16 * c8) = ks_[i]; } }
        { const int r = tid >> 3, c8 = tid & 7; LAS u32x2* d = (LAS u32x2*)(vb + r * (VP * 2) + 16 * c8); u32x2 lo, hi2; lo.x = vs_.x; lo.y = vs_.y; hi2.x = vs_.z; hi2.y = vs_.w; d[0] = lo; d[1] = hi2; }
    };
    __syncthreads();
    g_load(0, kst[0], vst[0]); if (NT > 1) g_load(1, kst[1], vst[1]);
    l_store(0, kst[0], vst[0]);
    __syncthreads();
    auto tile = [&](int t) {

        const int b = t & 1;
        LAS unsigned char* kb = lds + b * BUF; LAS unsigned char* vb = kb + KT_BYTES;
        f32x16 s0, s1;
        const float negm = -m;
#pragma unroll
        for (int r = 0; r < 16; ++r) { s0[r] = negm; s1[r] = negm; }
        bf16x8 kf0[NKS], kf1[NKS];
#pragma unroll
        for (int ks = 0; ks < NKS; ++ks) { kf0[ks] = *(const LAS bf16x8*)(kb + c * (KP * 2) + 32 * ks + 16 * hi); kf1[ks] = *(const LAS bf16x8*)(kb + (32 + c) * (KP * 2) + 32 * ks + 16 * hi); }
        asm volatile("s_waitcnt lgkmcnt(0)" ::: "memory"); __builtin_amdgcn_sched_barrier(0);
        bf16x8 vf0[2][2], vf1[2][2];
#pragma unroll
        for (int kt = 0; kt < 2; ++kt)
#pragma unroll
            for (int s2 = 0; s2 < 2; ++s2) {
                const int ko = (32 * kt + 16 * s2 + 4 * hi) * 2;
                const LAS unsigned char* v0p = vb + c * (VP * 2) + ko; const LAS unsigned char* v1p = vb + (32 + c) * (VP * 2) + ko;
                vf0[kt][s2] = mk_frag(*(const LAS u32x2*)v0p, *(const LAS u32x2*)(v0p + 16));
                vf1[kt][s2] = mk_frag(*(const LAS u32x2*)v1p, *(const LAS u32x2*)(v1p + 16));
            }
#pragma unroll
        for (int ks = 0; ks < NKS; ++ks) { s0 = mfma32(kf0[ks], qf[ks], s0); s1 = mfma32(kf1[ks], qf[ks], s1); }
        if (MASK && t >= a.seg_nt0) {
            const int qpos = a.qpos0 + qi, kbase = a.kpos0 + 64 * (t - a.seg_nt0);
#pragma unroll
            for (int r = 0; r < 16; ++r) { const int k0p = kbase + crow(r, hi), d0 = qpos - k0p, d1 = d0 - 32;
                if (d0 > 128 || d0 < -128) s0[r] = -1e30f; if (d1 > 128 || d1 < -128) s1[r] = -1e30f; }
        }
        float mx = s0[0];
#pragma unroll
        for (int r = 1; r < 16; ++r) mx = fmaxf(mx, s0[r]);
#pragma unroll
        for (int r = 0; r < 16; ++r) mx = fmaxf(mx, s1[r]);
        mx = xor32_max(mx);
        if (t == 0 || __builtin_amdgcn_ballot_w64(mx > 6.f) != 0ull) {
            const float delta = (t == 0) ? fmaxf(mx, -64.f) : fmaxf(mx, 0.f), alpha = __builtin_amdgcn_exp2f(-delta);
            m += delta; l *= alpha;
#pragma unroll
            for (int r = 0; r < 16; ++r) { o0[r] *= alpha; o1[r] *= alpha; s0[r] -= delta; s1[r] -= delta; }
        }
        float ls = 0.f;
#pragma unroll
        for (int r = 0; r < 16; ++r) { s0[r] = __builtin_amdgcn_exp2f(s0[r]); s1[r] = __builtin_amdgcn_exp2f(s1[r]); ls += s0[r] + s1[r]; }
        ls = xor32_sum(ls);
        l += ls;
        bf16x8 pf[2][2];
#pragma unroll
        for (int s2 = 0; s2 < 2; ++s2) {
            pf[0][s2] = mk_frag4(cvtpk(s0[8 * s2 + 0], s0[8 * s2 + 1]), cvtpk(s0[8 * s2 + 2], s0[8 * s2 + 3]), cvtpk(s0[8 * s2 + 4], s0[8 * s2 + 5]), cvtpk(s0[8 * s2 + 6], s0[8 * s2 + 7]));
            pf[1][s2] = mk_frag4(cvtpk(s1[8 * s2 + 0], s1[8 * s2 + 1]), cvtpk(s1[8 * s2 + 2], s1[8 * s2 + 3]), cvtpk(s1[8 * s2 + 4], s1[8 * s2 + 5]), cvtpk(s1[8 * s2 + 6], s1[8 * s2 + 7]));
        }
#pragma unroll
        for (int kt = 0; kt < 2; ++kt)
#pragma unroll
            for (int s2 = 0; s2 < 2; ++s2) { o0 = mfma32(vf0[kt][s2], pf[kt][s2], o0); o1 = mfma32(vf1[kt][s2], pf[kt][s2], o1); }
    };
    for (int t = 0; t < NT; t += 2) {
        if (t + 2 < NT) g_load(t + 2, kst[0], vst[0]);
        TIC(30); tile(t); TOC(30);
        TIC(31); l_store(1, kst[1], vst[1]); TOC(31);
        __syncthreads();
        if (t + 3 < NT) g_load(t + 3, kst[1], vst[1]);
        TIC(30); tile(t + 1); TOC(30);
        TIC(31); if (t + 2 < NT) l_store(0, kst[0], vst[0]); TOC(31);
        __syncthreads();
    }
    const float inv = __builtin_amdgcn_rcpf(l);
    bf16_t* op = a.O + (size_t)(a.q_row0 + qi) * D + a.o_col0;
#pragma unroll
    for (int g = 0; g < 4; ++g) {
        u32x2 w0, w1;
        w0.x = cvtpk(o0[4 * g] * inv, o0[4 * g + 1] * inv); w0.y = cvtpk(o0[4 * g + 2] * inv, o0[4 * g + 3] * inv);
        w1.x = cvtpk(o1[4 * g] * inv, o1[4 * g + 1] * inv); w1.y = cvtpk(o1[4 * g + 2] * inv, o1[4 * g + 3] * inv);
        *(u32x2*)(op + 8 * g + 4 * hi) = w0; *(u32x2*)(op + 32 + 8 * g + 4 * hi) = w1;
    }
}

__device__ __forceinline__ void attn_dispatch(KArg p, const Ctx& C, int l, int u) {
    unsigned char* ws = p->ws;
    AttnArgs a;
    a.tab32 = (const float*)(ws + WS_TAB) + 2048; a.O = (bf16_t*)(ws + WS_MIX);
    if (u < 256 || (u >= 512 && u < 528)) {
        const bool ctxq = u >= 512; const int v = ctxq ? u - 512 : u;
        const int b = ctxq ? (v >> 2) : (v >> 6), h = ctxq ? (v & 3) : ((v >> 4) & 3), qb = ctxq ? 0 : (v & 15);
        a.Q = (const bf16_t*)(ws + WS_QRAW); a.q_pitch = 384; a.q_col0 = 96 * h; a.q_row0 = ctxq ? 256 * b : MC + 4096 * b + 256 * qb;
        a.K = (const bf16_t*)(ws + WS_KFULL); a.k_pitch = 384; a.k_col0 = 96 * h; a.Vt = (const bf16_t*)(ws + WS_VTM); a.vt_row0 = 64 * h;
        a.seg_tok0 = 256 * b; a.seg_nt0 = 4; a.seg_tok1 = MC + 4096 * b; a.seg_nt1 = ctxq ? 0 : 64; a.qpos0 = 0; a.kpos0 = 0;
        a.m_init = 0.f; a.l_init = 0.f; a.qscale = 0.10206207261596575f * LOG2E; a.o_col0 = 512 + 64 * h; a.qt0 = 256 * qb;
        if (ctxq) attn_unit<96, false, false>(C, a); else attn_unit<96, false, true>(C, a);
    } else {
        const bool ctxq = u >= 528; const int v = ctxq ? u - 528 : u - 256;
        const int b = ctxq ? (v >> 2) : (v >> 6), hq = ctxq ? (v & 3) : ((v >> 4) & 3), qb = ctxq ? 0 : (v & 15), g = hq >> 1;
        a.Q = (const bf16_t*)(ws + WS_QS); a.q_pitch = 256; a.q_col0 = 64 * hq; a.q_row0 = ctxq ? 256 * b : MC + 4096 * b + 256 * qb;
        a.K = (const bf16_t*)(ws + WS_KS); a.k_pitch = 128; a.k_col0 = 64 * g; a.Vt = (const bf16_t*)(ws + WS_VTS); a.vt_row0 = 64 * g;
        const int q0 = 256 * qb, ks = q0 - 128 < 0 ? 0 : q0 - 128, ke = q0 + 384 > SEQ ? SEQ : q0 + 384;
        a.seg_tok0 = 256 * b; a.seg_nt0 = 4; a.seg_tok1 = MC + 4096 * b + ks; a.seg_nt1 = ctxq ? 0 : (ke - ks) >> 6; a.qpos0 = q0; a.kpos0 = ks;
        a.m_init = p->in[I_SINK][l * 4 + hq] * LOG2E; a.l_init = 1.f; a.qscale = 1.f; a.o_col0 = 64 * hq; a.qt0 = 0;
        if (ctxq) attn_unit<64, false, false>(C, a); else attn_unit<64, true, false>(C, a);
    }
}

template <class FA, class FB>
__device__ __forceinline__ f32x16 lds_mma64(int lane, FA fa, FB fb) {
    const int c = lane & 31, hi = lane >> 5;
    f32x16 acc;
#pragma unroll
    for (int r = 0; r < 16; ++r) acc[r] = 0.f;
#pragma unroll
    for (int s = 0; s < 4; ++s) {
        float av[8], bv[8];
#pragma unroll
        for (int j = 0; j < 8; ++j) { const int k = 16 * s + 8 * hi + j; av[j] = fa(c, k); bv[j] = fb(k, c); }
        acc = mfma32(mk_frag4(cvtpk(av[0], av[1]), cvtpk(av[2], av[3]), cvtpk(av[4], av[5]), cvtpk(av[6], av[7])),
                     mk_frag4(cvtpk(bv[0], bv[1]), cvtpk(bv[2], bv[3]), cvtpk(bv[4], bv[5]), cvtpk(bv[6], bv[7])), acc);
    }
    return acc;
}
__device__ __forceinline__ void frag_store(unsigned char* base, int r, int c8, u32x4 o) {
#pragma unroll
    for (int g = 0; g < 2; ++g) { const int g4 = 2 * c8 + g, T = g4 >> 3, rem = g4 & 7, ks = rem >> 2, jh = (rem >> 1) & 1, hi = rem & 1;
        u32x2 w; w.x = g ? o.z : o.x; w.y = g ? o.w : o.y;
        *(u32x2*)(base + (size_t)(((((r >> 5) * 2 + T) * 2 + ks) * 64 + (r & 31) + 32 * hi) * 16 + 8 * jh)) = w; }
}
__device__ __forceinline__ void lds_barrier() { asm volatile("s_waitcnt lgkmcnt(0)" ::: "memory"); __builtin_amdgcn_s_barrier(); asm volatile("" ::: "memory"); }
__device__ __forceinline__ int su_index(int d, int b, int h, int cg) {
    const int s = cg < 4 ? (d ? 3 - cg : cg) : 4 + (d ? 63 - (cg - 4) : (cg - 4));
    return ((d * 4 + b) * 4 + h) * 68 + s;
}
#ifndef PREP_IN_GDN
#define PREP_IN_GDN 0
#endif
#ifndef GSECT
#define GSECT 0
#endif
constexpr int XP = 65;

template <int I>
__device__ __forceinline__ void solve_rows(float (&x)[64], f32x4 (&Lc)[8], f32x4 (&Ln)[8], const LAS float* Ld) {
    if constexpr (I < 64) {
        f32x4 Lt[8];
#pragma unroll
        for (int q = 8; q < 16; ++q) if (4 * q < I) Lt[q - 8] = *(const LAS f32x4*)(Ld + I * 68 + 4 * q);
        if constexpr (I + 1 < 64) {
#pragma unroll
            for (int q = 0; q < 8; ++q) if (4 * q < I + 1) Ln[q] = *(const LAS f32x4*)(Ld + (I + 1) * 68 + 4 * q);
        }
        float s0 = 0.f, s1 = 0.f, s2 = 0.f, s3 = 0.f;
#pragma unroll
        for (int q = 0; q < 16; ++q) if (4 * q < I) { const f32x4 lv = q < 8 ? Lc[q & 7] : Lt[q & 7];
            s0 += lv.x * x[4 * q]; if (4 * q + 1 < I) s1 += lv.y * x[4 * q + 1]; if (4 * q + 2 < I) s2 += lv.z * x[4 * q + 2]; if (4 * q + 3 < I) s3 += lv.w * x[4 * q + 3]; }
        x[I] -= (s0 + s1) + (s2 + s3);
        solve_rows<I + 1>(x, Ln, Lc, Ld);
    }
}
__device__ __forceinline__ void gdn_chunk_unit(KArg p, const Ctx& C, int l, int b, int h, int cg, int ug) {
    unsigned char* ws = p->ws; const bf16_t* P = (const bf16_t*)(ws + WS_P);
    int tid_l = C.tid; asm volatile("" : "+v"(tid_l));
    const int tid = tid_l, lane = tid & 63, w = __builtin_amdgcn_readfirstlane(tid >> 6);
    LAS float* xq = (LAS float*)C.lds; LAS float* xk = xq + 64 * XP; LAS float* xv = xk + 64 * XP;
    LAS float* KK = xv + 64 * XP; LAS float* QK = KK + 64 * XP;
    LAS float* Lm = QK + 64 * XP;
    LAS float* gcs = Lm + 2 * 64 * 68; LAS float* bts = gcs + 128; LAS float* egs = bts + 128; LAS float* cw = egs + 128;
    LAS float* raw = KK;
    LAS float* Wst = KK;
    const int seq0 = cg < 4 ? 256 * b : MC + 4096 * b, seqlen = cg < 4 ? 256 : 4096, t0 = cg < 4 ? 64 * cg : 64 * (cg - 4);
    bf16_t ab_a = 0, ab_b = 0;
    if (w < 2) { const int tau = w ? 63 - lane : lane; const bf16_t* pr = P + (size_t)(seq0 + t0 + tau) * DINP + PC_BAB + w * 8 + h; ab_a = pr[0]; ab_b = pr[4]; }
    lds_barrier();
    TIC(1);
    for (int rr1 = 0; rr1 < ((GSECT == 1) ? 2 : 1); ++rr1) {
    if (rr1) lds_barrier();
    TIC(41);
    {
        u32x4 rv[4]; float cwv[2];
#pragma unroll
        for (int k = 0; k < 4; ++k) { const int it = tid + NTHR * k; const int r = it / 24, ch = it % 24, t = t0 - 2 + r; const int part = ch >> 3, c8 = ch & 7;
            rv[k].x = rv[k].y = rv[k].z = rv[k].w = 0u;
            if (it < 68 * 24 && t >= 0 && t < seqlen) rv[k] = *(const u32x4*)(P + (size_t)(seq0 + t) * DINP + PC_BQKV + 256 * part + 64 * h + 8 * c8); }
#pragma unroll
        for (int k = 0; k < 2; ++k) { const int it = tid + NTHR * k; const int j = it / 192, cc = it % 192; cwv[k] = (it < 5 * 192) ? p->in[I_GCONV][((size_t)l * 5 + j) * 768 + 256 * (cc >> 6) + 64 * h + (cc & 63)] : 0.f; }
#pragma unroll
        for (int k = 0; k < 4; ++k) { const int it = tid + NTHR * k; if (it < 68 * 24) { const int r = it / 24, ch = it % 24; const int part = ch >> 3, c8 = ch & 7; const u32x4 v = rv[k];
            LAS float* d = raw + r * 192 + 64 * part + 8 * c8;
            d[0] = bf_lo(v.x); d[1] = bf_hi(v.x); d[2] = bf_lo(v.y); d[3] = bf_hi(v.y); d[4] = bf_lo(v.z); d[5] = bf_hi(v.z); d[6] = bf_lo(v.w); d[7] = bf_hi(v.w); } }
#pragma unroll
        for (int k = 0; k < 2; ++k) { const int it = tid + NTHR * k; if (it < 5 * 192) cw[it] = cwv[k]; }
    }
    lds_barrier();
    TOC(41); TIC(42);
    if (tid < 384) {
        const int cc = tid % 192, th = tid / 192; LAS float* dst = (cc < 64) ? xq : (cc < 128 ? xk : xv);
        float wj[5], rw[36];
#pragma unroll
        for (int j = 0; j < 5; ++j) wj[j] = cw[j * 192 + cc];
#pragma unroll
        for (int r = 0; r < 36; ++r) rw[r] = raw[(32 * th + r) * 192 + cc];
#pragma unroll
        for (int t = 0; t < 32; ++t) { float y = rw[t] * wj[0];
#pragma unroll
            for (int j = 1; j < 5; ++j) y += rw[t + j] * wj[j];
            dst[(32 * th + t) * XP + (cc & 63)] = silu_f(y); }
    }
    lds_barrier();
    TOC(42); TIC(43);
    {
        const int mat = tid >> 8, r = (tid >> 2) & 63, q4 = tid & 3; LAS float* m = (mat ? xk : xq) + r * XP + 16 * q4; float v[16]; float ss = 0.f;
#pragma unroll
        for (int k = 0; k < 16; ++k) { v[k] = m[k]; ss += v[k] * v[k]; }
        ss = quad_sum(ss);
        const float sc = rsqrtf(ss + EPS) * (mat ? 1.f : 0.125f);
#pragma unroll
        for (int k = 0; k < 16; ++k) m[k] = v[k] * sc;
    }
    lds_barrier();
    TOC(43); TIC(44);
    {
        const int mat = w >> 2, rt = (w >> 1) & 1, ct = w & 1; LAS float* Am = mat ? xq : xk;
        const f32x16 acc = lds_mma64(lane, [&](int r, int k) { return Am[(32 * rt + r) * XP + k]; }, [&](int k, int c2) { return xk[(32 * ct + c2) * XP + k]; });
        LAS float* Om = mat ? QK : KK;
#pragma unroll
        for (int r = 0; r < 16; ++r) Om[(32 * rt + crow(r, lane >> 5)) * XP + 32 * ct + (lane & 31)] = acc[r];
    }
    }
    TOC(1); TIC(2);
    for (int rr2 = 0; rr2 < ((GSECT == 2) ? 2 : 1); ++rr2) {
    if (rr2) lds_barrier();
    TOC(44);
    TIC(48);
    if (w < 2) {
        const int d = w;
        const float a = bf2f(ab_a), bt = bf2f(ab_b);
        float g = -__expf(p->in[I_GALOG][(l * 2 + d) * 4 + h]) * softplus_f(a + p->in[I_GDTB][(l * 2 + d) * 4 + h]);
#pragma unroll
        for (int o = 1; o < 64; o <<= 1) { const float n = __shfl_up(g, o); if (lane >= o) g += n; }
        gcs[d * 64 + lane] = g; bts[d * 64 + lane] = sigmoid_f(bt); egs[d * 64 + lane] = __expf(g);
        if (lane == 63) ((float*)(ws + WS_DEC))[su_index(d, b, h, cg)] = __expf(g);
    }
    lds_barrier();
    TOC(48); TIC(49);
    {
        const int j = tid & 63, wq = tid >> 6;
#pragma unroll
        for (int d = 0; d < 2; ++d) { const int tj = d ? 63 - j : j; const float gj = gcs[d * 64 + j];
            float kkv[8], bi[8], gi[8];
#pragma unroll
            for (int k = 0; k < 8; ++k) { const int i = wq + 8 * k, ti = d ? 63 - i : i; kkv[k] = KK[ti * XP + tj]; bi[k] = bts[d * 64 + i]; gi[k] = gcs[d * 64 + i]; }
#pragma unroll
            for (int k = 0; k < 8; ++k) { const int i = wq + 8 * k; Lm[(d * 64 + i) * 68 + j] = (j < i) ? bi[k] * kkv[k] * __expf(gi[k] - gj) : 0.f; } }
    }
    TOC(49); TIC(50);
#pragma unroll
    for (int d = 0; d < 2; ++d) {
        unsigned char* rec = ws + WS_RECG + (size_t)su_index(d, b, h, cg) * REC_G_BYTES; const LAS float* gc = gcs + d * 64;
        const int r = tid >> 3, c8 = tid & 7, it_ = d ? 63 - r : r;
        { float v[8];
#pragma unroll
          for (int j = 0; j < 8; ++j) { const int i = 8 * c8 + j, ti = d ? 63 - i : i; v[j] = xk[ti * XP + r] * __expf(gc[63] - gc[i]); }
          u32x4 o; o.x = cvtpk(v[0], v[1]); o.y = cvtpk(v[2], v[3]); o.z = cvtpk(v[4], v[5]); o.w = cvtpk(v[6], v[7]); *(u32x4*)(rec + REC_G_KDT + (r * 64 + 8 * c8) * 2) = o; }
        { const float e = egs[d * 64 + it_]; float v[8];
#pragma unroll
          for (int j = 0; j < 8; ++j) v[j] = xq[r * XP + 8 * c8 + j] * e;
          u32x4 o; o.x = cvtpk(v[0], v[1]); o.y = cvtpk(v[2], v[3]); o.z = cvtpk(v[4], v[5]); o.w = cvtpk(v[6], v[7]); frag_store(rec + REC_G_QG, r, c8, o); }
        { float v[8];
#pragma unroll
          for (int j = 0; j < 8; ++j) { const int i = 8 * c8 + j, ti = d ? 63 - i : i; v[j] = (it_ >= i) ? QK[r * XP + ti] * __expf(gc[it_] - gc[i]) : 0.f; }
          u32x4 o; o.x = cvtpk(v[0], v[1]); o.y = cvtpk(v[2], v[3]); o.z = cvtpk(v[4], v[5]); o.w = cvtpk(v[6], v[7]); frag_store(rec + REC_G_ATT, r, c8, o); }
    }
    }
    TOC(50);
    lds_barrier();
    TOC(2); TIC(3);
    for (int rr3 = 0; rr3 < ((GSECT == 3) ? 2 : 1); ++rr3) {
    if (PREP_IN_GDN && tid >= 256) {
        prep_rows4(p, lane, l, 16 * ug + 4 * (w - 4));
    }
    if (tid < 256) {
        const int d = tid >> 7, col = tid & 127; const LAS float* Ld = Lm + d * 64 * 68; const LAS float* bt = bts + d * 64; const LAS float* eg = egs + d * 64;
        TIC(45);
        float x[64];
        {
            const LAS float* src = (col < 64) ? xv + col : xk + (col - 64);
#pragma unroll
            for (int i = 0; i < 64; ++i) { const int ti = d ? 63 - i : i; x[i] = src[ti * XP]; }
#pragma unroll
            for (int i4 = 0; i4 < 16; ++i4) { f32x4 bq = *(const LAS f32x4*)(bt + 4 * i4);
                if (col >= 64) bq *= *(const LAS f32x4*)(eg + 4 * i4);
                x[4 * i4] *= bq.x; x[4 * i4 + 1] *= bq.y; x[4 * i4 + 2] *= bq.z; x[4 * i4 + 3] *= bq.w; }
        }
        TOC(45); TIC(46);
        f32x4 La[8], Lb[8];
        La[0] = *(const LAS f32x4*)(Ld + 1 * 68);
        solve_rows<1>(x, La, Lb, Ld);
        TOC(46); TIC(47);
        unsigned char* rec = ws + WS_RECG + (size_t)su_index(d, b, h, cg) * REC_G_BYTES;
        if (col < 64) {
#pragma unroll
            for (int i4 = 0; i4 < 16; ++i4) { f32x4 o; o.x = x[4 * i4]; o.y = x[4 * i4 + 1]; o.z = x[4 * i4 + 2]; o.w = x[4 * i4 + 3]; *(f32x4*)(rec + REC_G_UT + (col * 64 + 4 * i4) * 4) = o; }
        } else {
#pragma unroll
            for (int i = 0; i < 64; ++i) Wst[(d * 64 + i) * XP + col - 64] = x[i];
        }
    }
    }
    lds_barrier();
#pragma unroll
    for (int d = 0; d < 2; ++d) { const int r = tid >> 3, c8 = tid & 7;
        unsigned char* rec = ws + WS_RECG + (size_t)su_index(d, b, h, cg) * REC_G_BYTES;
        u32x4 o; const LAS float* s = Wst + (d * 64 + r) * XP + 8 * c8; o.x = cvtpk(s[0], s[1]); o.y = cvtpk(s[2], s[3]); o.z = cvtpk(s[4], s[5]); o.w = cvtpk(s[6], s[7]);
        *(u32x4*)(rec + REC_G_W + (r * 64 + 8 * c8) * 2) = o; }
    TOC(3);
}

__device__ __forceinline__ void ret_chunk_unit(KArg p, const Ctx& C, int l, int b, int h, int cg) {
    unsigned char* ws = p->ws; const bf16_t* P = (const bf16_t*)(ws + WS_P); const float* tab = (const float*)(ws + WS_TAB);
    int tid_l = C.tid; asm volatile("" : "+v"(tid_l));
    const int tid = tid_l, lane = tid & 63, w = __builtin_amdgcn_readfirstlane(tid >> 6);
    LAS float* xq = (LAS float*)C.lds; LAS float* xk = xq + 64 * XP; LAS float* xv = xk + 64 * XP; LAS float* QK = xv + 64 * XP;
    const bool lat = cg >= 4;
    const int seq0 = lat ? MC + 4096 * b : 256 * b, t0 = lat ? 64 * (cg - 4) : 64 * cg;
    lds_barrier();
    TIC(51);
    {
        const int mat = tid >> 8, r = (tid >> 2) & 63, part = (tid >> 1) & 1, jq = tid & 1; const int t = t0 + r;
        const bf16_t* pr = P + (size_t)(seq0 + t) * DINP + (mat ? PC_DK : PC_DQ) + 64 * h + 32 * part + 8 * jq;
        const u32x4 va = *(const u32x4*)pr, vb = *(const u32x4*)(pr + 16);
        const int ps = lat ? (part ? (t & 63) : (t >> 6)) : 0;
        const f32x4 c0 = *(const f32x4*)(tab + ps * 16 + 8 * jq), c1 = *(const f32x4*)(tab + ps * 16 + 8 * jq + 4), s0 = *(const f32x4*)(tab + 1024 + ps * 16 + 8 * jq), s1 = *(const f32x4*)(tab + 1024 + ps * 16 + 8 * jq + 4);
        const float av[8] = {bf_lo(va.x), bf_hi(va.x), bf_lo(va.y), bf_hi(va.y), bf_lo(va.z), bf_hi(va.z), bf_lo(va.w), bf_hi(va.w)};
        const float bv[8] = {bf_lo(vb.x), bf_hi(vb.x), bf_lo(vb.y), bf_hi(vb.y), bf_lo(vb.z), bf_hi(vb.z), bf_lo(vb.w), bf_hi(vb.w)};
        const float cc[8] = {c0.x, c0.y, c0.z, c0.w, c1.x, c1.y, c1.z, c1.w}, ss[8] = {s0.x, s0.y, s0.z, s0.w, s1.x, s1.y, s1.z, s1.w};
        const float sc = mat ? 0.125f : 1.f; LAS float* m = (mat ? xk : xq) + r * XP + 32 * part + 8 * jq;
#pragma unroll
        for (int i = 0; i < 8; ++i) { m[i] = (av[i] * cc[i] - bv[i] * ss[i]) * sc; m[16 + i] = (bv[i] * cc[i] + av[i] * ss[i]) * sc; }
    }
    { const int r = tid >> 3, c8 = tid & 7; const u32x4 v = *(const u32x4*)(P + (size_t)(seq0 + t0 + r) * DINP + PC_DV + 64 * h + 8 * c8); LAS float* d = xv + r * XP + 8 * c8;
      d[0] = bf_lo(v.x); d[1] = bf_hi(v.x); d[2] = bf_lo(v.y); d[3] = bf_hi(v.y); d[4] = bf_lo(v.z); d[5] = bf_hi(v.z); d[6] = bf_lo(v.w); d[7] = bf_hi(v.w); }
    lds_barrier();
    TOC(51); TIC(52);
    if (w < 4) { const int rt = w >> 1, ct = w & 1;
        const f32x16 acc = lds_mma64(lane, [&](int r, int k) { return xq[(32 * rt + r) * XP + k]; }, [&](int k, int c2) { return xk[(32 * ct + c2) * XP + k]; });
#pragma unroll
        for (int r = 0; r < 16; ++r) QK[(32 * rt + crow(r, lane >> 5)) * XP + 32 * ct + (lane & 31)] = acc[r]; }
    lds_barrier();
    TOC(52); TIC(53);
    {
        const int d = w >> 2, T = (w >> 1) & 1, ct = w & 1; const float lg = -__expf(p->in[I_RLOGD][(l * 2 + d) * 4 + h]);
        const f32x16 acc = lds_mma64(lane, [&](int r, int k) { const int ti = d ? 63 - k : k; return xk[ti * XP + 32 * T + r] * __expf(lg * (float)(63 - k)); },
                                           [&](int k, int c2) { const int ti = d ? 63 - k : k; return xv[ti * XP + 32 * ct + c2]; });
        float* kv = (float*)(ws + WS_RECR + (size_t)su_index(d, b, h, cg) * REC_R_BYTES + REC_R_KV);
#pragma unroll
        for (int r = 0; r < 16; ++r) kv[(32 * T + crow(r, lane >> 5)) * 64 + 32 * ct + (lane & 31)] = acc[r];
    }
    TOC(53); TIC(54);
    for (int d = 0; d < 2; ++d) {
        unsigned char* rec = ws + WS_RECR + (size_t)su_index(d, b, h, cg) * REC_R_BYTES; const float lg = -__expf(p->in[I_RLOGD][(l * 2 + d) * 4 + h]);
        const int r = tid >> 3, c8 = tid & 7, it_ = d ? 63 - r : r;
        { const float e = __expf(lg * (float)(it_ + 1)); float v[8];
#pragma unroll
          for (int j = 0; j < 8; ++j) v[j] = xq[r * XP + 8 * c8 + j] * e;
          u32x4 o; o.x = cvtpk(v[0], v[1]); o.y = cvtpk(v[2], v[3]); o.z = cvtpk(v[4], v[5]); o.w = cvtpk(v[6], v[7]); frag_store(rec + REC_R_QG, r, c8, o); }
        { float v[8];
#pragma unroll
          for (int j = 0; j < 8; ++j) { const int i = 8 * c8 + j, ti = d ? 63 - i : i; v[j] = (it_ >= i) ? QK[r * XP + ti] * __expf(lg * (float)(it_ - i)) : 0.f; }
          u32x4 o; o.x = cvtpk(v[0], v[1]); o.y = cvtpk(v[2], v[3]); o.z = cvtpk(v[4], v[5]); o.w = cvtpk(v[6], v[7]); frag_store(rec + REC_R_ATT, r, c8, o); }
        { const int ln = tid & 63, s = (tid >> 6) & 1, T = (tid >> 7) & 1, ct = tid >> 8; float v[8];
#pragma unroll
          for (int j = 0; j < 8; ++j) { const int i = 32 * T + 16 * s + 8 * (j >> 2) + 4 * (ln >> 5) + (j & 3), ti = d ? 63 - i : i; v[j] = xv[ti * XP + 32 * ct + (ln & 31)]; }
          u32x4 o; o.x = cvtpk(v[0], v[1]); o.y = cvtpk(v[2], v[3]); o.z = cvtpk(v[4], v[5]); o.w = cvtpk(v[6], v[7]); *(u32x4*)(rec + REC_R_VF + (size_t)tid * 16) = o; }
    }
    TOC(54);
}

__device__ __forceinline__ void gdn_scan_chain(KArg p, const Ctx& C, int chain) {
    unsigned char* ws = p->ws; const int lane = C.lane, w = C.wave, c = lane & 31, hi = lane >> 5;
    constexpr int WP = 68, UP = 68, SB_W = 0, SB_K = 64 * WP * 2, SB_U = 2 * 64 * WP * 2, SB_D = SB_U + 64 * UP * 4, SBUF = SB_D + 16, NSLOT = 4, FL = NSLOT * SBUF;
    LAS unsigned char* lds = C.lds;
    volatile LAS unsigned* full = (volatile LAS unsigned*)(lds + FL); volatile LAS unsigned* done = full + NSLOT;
    __syncthreads();
    if (C.tid < 2 * NSLOT) full[C.tid] = 0u;
    __syncthreads();
    if (w >= 2) {
        const float* DEC = (const float*)(ws + WS_DEC);
        for (int s = w - 2; s < 68; s += 6) {
            const int slot = s & (NSLOT - 1); LAS unsigned char* sb = lds + slot * SBUF;
            const unsigned char* rec = ws + WS_RECG + (size_t)(chain * 68 + s) * REC_G_BYTES;
            u32x4 R[32];
#pragma unroll
            for (int i = 0; i < 32; ++i) R[i] = *(const u32x4*)(rec + (size_t)(lane + 64 * i) * 16);
            const float dr = DEC[chain * 68 + s];
            { const unsigned need = 2u * (unsigned)(s >> 2); unsigned sp = 0; while (done[slot] < need && ++sp < (1u << 22)) __builtin_amdgcn_s_sleep(1); }
            asm volatile("" ::: "memory");
#pragma unroll
            for (int i = 0; i < 32; ++i) { const int ch = lane + 64 * i; u32x2 lo, h2; lo.x = R[i].x; lo.y = R[i].y; h2.x = R[i].z; h2.y = R[i].w;
                if (i < 8) { const int r = ch >> 3, c8 = ch & 7; LAS u32x2* d = (LAS u32x2*)(sb + SB_W + r * (WP * 2) + 16 * c8); d[0] = lo; d[1] = h2; }
                else if (i < 24) { const int q = ch - 512, r = q >> 4, c4 = q & 15; *(LAS u32x4*)(sb + SB_U + r * (UP * 4) + 16 * c4) = R[i]; }
                else { const int q = ch - 1536, r = q >> 3, c8 = q & 7; LAS u32x2* d = (LAS u32x2*)(sb + SB_K + r * (WP * 2) + 16 * c8); d[0] = lo; d[1] = h2; } }
            if (lane == 0) *(LAS float*)(sb + SB_D) = dr;
            asm volatile("s_waitcnt lgkmcnt(0)" ::: "memory");
            if (lane == 0) full[slot] = (unsigned)(s + 1);
        }
    } else {
        const int ct = w;
        f32x16 S0, S1;
#pragma unroll
        for (int r = 0; r < 16; ++r) { S0[r] = 0.f; S1[r] = 0.f; }
        for (int s = 0; s < 68; ++s) {
            const int slot = s & (NSLOT - 1); LAS unsigned char* sb = lds + slot * SBUF;
            unsigned char* rec = ws + WS_RECG + (size_t)(chain * 68 + s) * REC_G_BYTES;
            TIC(24);
            { unsigned sp = 0; while (full[slot] != (unsigned)(s + 1) && ++sp < (1u << 22)) __builtin_amdgcn_s_sleep(1); }
            TOC(24);
            asm volatile("" ::: "memory");
            bf16x8 wf[2][2][2], kf[2][2][2]; f32x4 uf[2][4];
#pragma unroll
            for (int Ti = 0; Ti < 2; ++Ti)
#pragma unroll
                for (int T = 0; T < 2; ++T)
#pragma unroll
                    for (int ks = 0; ks < 2; ++ks) { const LAS unsigned char* ap = sb + SB_W + (32 * Ti + c) * (WP * 2) + (32 * T + 16 * ks + 4 * hi) * 2;
                        wf[Ti][T][ks] = mk_frag(*(const LAS u32x2*)ap, *(const LAS u32x2*)(ap + 16)); }
#pragma unroll
            for (int Ti = 0; Ti < 2; ++Ti)
#pragma unroll
                for (int g = 0; g < 4; ++g) uf[Ti][g] = *(const LAS f32x4*)(sb + SB_U + (32 * ct + c) * (UP * 4) + (32 * Ti + 8 * g + 4 * hi) * 4);
#pragma unroll
            for (int T = 0; T < 2; ++T)
#pragma unroll
                for (int Ti = 0; Ti < 2; ++Ti)
#pragma unroll
                    for (int ks = 0; ks < 2; ++ks) { const LAS unsigned char* a0 = sb + SB_K + (32 * T + c) * (WP * 2) + (32 * Ti + 16 * ks + 4 * hi) * 2;
                        kf[T][Ti][ks] = mk_frag(*(const LAS u32x2*)a0, *(const LAS u32x2*)(a0 + 16)); }
            const float dec = *(const LAS float*)(sb + SB_D);
            asm volatile("s_waitcnt lgkmcnt(0)" ::: "memory"); __builtin_amdgcn_sched_barrier(0);
            if (lane == 0) __hip_atomic_fetch_add((LAS unsigned*)(lds + FL) + NSLOT + slot, 1u, __ATOMIC_RELAXED, __HIP_MEMORY_SCOPE_WORKGROUP);
            bf16x8 sf[2][2];
#pragma unroll
            for (int ks = 0; ks < 2; ++ks) {
                sf[0][ks] = mk_frag4(cvtpk(S0[8 * ks], S0[8 * ks + 1]), cvtpk(S0[8 * ks + 2], S0[8 * ks + 3]), cvtpk(S0[8 * ks + 4], S0[8 * ks + 5]), cvtpk(S0[8 * ks + 6], S0[8 * ks + 7]));
                sf[1][ks] = mk_frag4(cvtpk(S1[8 * ks], S1[8 * ks + 1]), cvtpk(S1[8 * ks + 2], S1[8 * ks + 3]), cvtpk(S1[8 * ks + 4], S1[8 * ks + 5]), cvtpk(S1[8 * ks + 6], S1[8 * ks + 7]));
            }
            f32x16 vn[2];
#pragma unroll
            for (int Ti = 0; Ti < 2; ++Ti) {
                f32x16 acc;
#pragma unroll
                for (int r = 0; r < 16; ++r) acc[r] = 0.f;
#pragma unroll
                for (int T = 0; T < 2; ++T)
#pragma unroll
                    for (int ks = 0; ks < 2; ++ks) acc = mfma32(wf[Ti][T][ks], sf[T][ks], acc);
#pragma unroll
                for (int g = 0; g < 4; ++g) { const f32x4 u = uf[Ti][g];
                    vn[Ti][4 * g] = u.x - acc[4 * g]; vn[Ti][4 * g + 1] = u.y - acc[4 * g + 1]; vn[Ti][4 * g + 2] = u.z - acc[4 * g + 2]; vn[Ti][4 * g + 3] = u.w - acc[4 * g + 3]; }
            }
            bf16x8 vf[2][2];
#pragma unroll
            for (int Ti = 0; Ti < 2; ++Ti)
#pragma unroll
                for (int ks = 0; ks < 2; ++ks)
                    vf[Ti][ks] = mk_frag4(cvtpk(vn[Ti][8 * ks], vn[Ti][8 * ks + 1]), cvtpk(vn[Ti][8 * ks + 2], vn[Ti][8 * ks + 3]), cvtpk(vn[Ti][8 * ks + 4], vn[Ti][8 * ks + 5]), cvtpk(vn[Ti][8 * ks + 6], vn[Ti][8 * ks + 7]));
#pragma unroll
            for (int r = 0; r < 16; ++r) { S0[r] *= dec; S1[r] *= dec; }
#pragma unroll
            for (int Ti = 0; Ti < 2; ++Ti)
#pragma unroll
                for (int ks = 0; ks < 2; ++ks) { S0 = mfma32(kf[0][Ti][ks], vf[Ti][ks], S0); S1 = mfma32(kf[1][Ti][ks], vf[Ti][ks], S1); }
#pragma unroll
            for (int T = 0; T < 2; ++T)
#pragma unroll
                for (int ks = 0; ks < 2; ++ks) { *(bf16x8*)(rec + REC_G_SP + (size_t)((((ct * 2 + T) * 2 + ks) * 64 + lane) * 16)) = sf[T][ks];
                    *(bf16x8*)(rec + REC_G_VN + (size_t)((((ct * 2 + T) * 2 + ks) * 64 + lane) * 16)) = vf[T][ks]; }
        }
    }
    __syncthreads();
}
__device__ __forceinline__ void ret_scan_items(KArg p, const Ctx& C, int l, int item0, int nitems_total, int stride) {
    unsigned char* ws = p->ws;
    for (int it = item0; it < nitems_total; it += stride) {
        const int dbh = it >> 11, q = it & 2047; const int jp = q & 3, ln = (q >> 2) & 63, ks = (q >> 8) & 1, T = (q >> 9) & 1, ct = q >> 10;
        const int d = dbh >> 4, h = dbh & 3;
        const int j0 = 2 * jp, dk0 = 32 * T + 16 * ks + 8 * (j0 >> 2) + 4 * (ln >> 5) + (j0 & 3), dv = 32 * ct + (ln & 31);
        const float g64 = __expf(-__expf(p->in[I_RLOGD][(l * 2 + d) * 4 + h]) * 64.f);
        float s0 = 0.f, s1 = 0.f;
        unsigned char* rec0 = ws + WS_RECR + (size_t)(dbh * 68) * REC_R_BYTES;
        for (int s = 0; s < 68; s += 4) {
            float a[4], bq[4];
#pragma unroll
            for (int k = 0; k < 4; ++k) { const float* kv = (const float*)(rec0 + (size_t)(s + k) * REC_R_BYTES + REC_R_KV); a[k] = kv[dk0 * 64 + dv]; bq[k] = kv[(dk0 + 1) * 64 + dv]; }
#pragma unroll
            for (int k = 0; k < 4; ++k) { *(unsigned*)(rec0 + (size_t)(s + k) * REC_R_BYTES + REC_R_SP + (size_t)q * 4) = cvtpk(s0, s1); s0 = s0 * g64 + a[k]; s1 = s1 * g64 + bq[k]; }
        }
    }
}

__device__ __forceinline__ void rec_out_item(KArg p, int lane, int l, int mixer, int b, int h, int cg, int rt) {
    unsigned char* ws = p->ws; const int c = lane & 31, hi = lane >> 5;
    f32x16 acc[2];
#pragma unroll
    for (int r = 0; r < 16; ++r) { acc[0][r] = 0.f; acc[1][r] = 0.f; }
    const int row = (cg < 4 ? 256 * b + 64 * cg : MC + 4096 * b + 64 * (cg - 4)) + 32 * rt + c;
    const bf16_t* P = (const bf16_t*)(ws + WS_P) + (size_t)row * DINP + (mixer ? PC_DGATE : PC_BGATE) + 64 * h;
    u32x2 gt[2][4];
#pragma unroll
    for (int ct = 0; ct < 2; ++ct)
#pragma unroll
        for (int g = 0; g < 4; ++g) gt[ct][g] = *(const u32x2*)(P + 32 * ct + 8 * g + 4 * hi);
#pragma unroll
    for (int d = 0; d < 2; ++d) {
        const int su = su_index(d, b, h, cg);
        const unsigned char* rec = mixer ? ws + WS_RECR + (size_t)su * REC_R_BYTES : ws + WS_RECG + (size_t)su * REC_G_BYTES;
        const unsigned char* qg = rec + (mixer ? REC_R_QG : REC_G_QG); const unsigned char* at = rec + (mixer ? REC_R_ATT : REC_G_ATT);
        const unsigned char* sp = rec + (mixer ? REC_R_SP : REC_G_SP); const unsigned char* vn = rec + (mixer ? REC_R_VF : REC_G_VN);
        bf16x8 bq[4], ba[4], as_[2][4], av[2][4];
#pragma unroll
        for (int f = 0; f < 4; ++f) { const int T = f >> 1, ks = f & 1;
            const size_t ao = (size_t)((((rt * 2 + T) * 2 + ks) * 64 + lane) * 16);
            bq[f] = *(const bf16x8*)(qg + ao); ba[f] = *(const bf16x8*)(at + ao);
#pragma unroll
            for (int ct = 0; ct < 2; ++ct) { const size_t bo = (size_t)((((ct * 2 + T) * 2 + ks) * 64 + lane) * 16); as_[ct][f] = *(const bf16x8*)(sp + bo); av[ct][f] = *(const bf16x8*)(vn + bo); } }
        asm volatile("s_waitcnt vmcnt(0)" ::: "memory"); __builtin_amdgcn_sched_barrier(0);
#pragma unroll
        for (int f = 0; f < 4; ++f)
#pragma unroll
            for (int ct = 0; ct < 2; ++ct) { acc[ct] = mfma32(as_[ct][f], bq[f], acc[ct]); acc[ct] = mfma32(av[ct][f], ba[f], acc[ct]); }
    }
    float s = 0.f, ss = 0.f;
#pragma unroll
    for (int r = 0; r < 16; ++r) { s += acc[0][r] + acc[1][r]; ss += acc[0][r] * acc[0][r] + acc[1][r] * acc[1][r]; }
    s = xor32_sum(s); ss = xor32_sum(ss);
    float mu = 0.f, rs;
    if (mixer) { mu = s * (1.f / 64.f); const float var = ss * (1.f / 64.f) - mu * mu; rs = rsqrtf(fmaxf(var, 0.f) + EPS); } else rs = rsqrtf(ss * (1.f / 64.f) + EPS);
    const float* gn = mixer ? p->in[I_RNORM] + (size_t)l * 256 + 64 * h : p->in[I_GNORM] + (size_t)l * 64;
    bf16_t* dst = (bf16_t*)(ws + WS_MIX) + (size_t)row * D + (mixer ? 768 : 256) + 64 * h;
#pragma unroll
    for (int ct = 0; ct < 2; ++ct)
#pragma unroll
        for (int g = 0; g < 4; ++g) { const int dv0 = 32 * ct + 8 * g + 4 * hi;
            const u32x2 gtv = gt[ct][g]; const f32x4 gv = *(const f32x4*)(gn + dv0);
            const float y0 = (acc[ct][4 * g] - mu) * rs * gv.x * silu_f(bf_lo(gtv.x)), y1 = (acc[ct][4 * g + 1] - mu) * rs * gv.y * silu_f(bf_hi(gtv.x));
            const float y2 = (acc[ct][4 * g + 2] - mu) * rs * gv.z * silu_f(bf_lo(gtv.y)), y3 = (acc[ct][4 * g + 3] - mu) * rs * gv.w * silu_f(bf_hi(gtv.y));
            u32x2 o; o.x = cvtpk(y0, y1); o.y = cvtpk(y2, y3); *(u32x2*)(dst + dv0) = o; }
}

#ifndef ONLY_PHASE
#define ONLY_PHASE -1
#endif
#ifndef SUB3
#define SUB3 31
#endif
#ifndef DUP_K
#define DUP_K -1
#endif
#define NREP(k) ((DUP_K == (k)) ? 2 : 1)
#ifndef RET_DEAL_OLD
#define RET_DEAL_OLD 0
#endif
#ifndef DUP2
#define DUP2 0
#endif
#define PH_ON(k) (ONLY_PHASE < 0 || ONLY_PHASE == (k))
constexpr int PH_PER_LAYER = 10, PH_FINAL = 1 + PH_PER_LAYER * DEPTH, N_PHASES = PH_FINAL + 1;
__global__ void __launch_bounds__(NTHR, 2) mega_fwd(Params p_arg) {
    extern __shared__ __attribute__((aligned(16))) unsigned char lds_raw[];
    Ctx C0; C0.lds = (LAS unsigned char*)lds_raw; C0.tid = threadIdx.x; C0.lane = C0.tid & 63; C0.wave = __builtin_amdgcn_readfirstlane(C0.tid >> 6); C0.bid = blockIdx.x; C0.G = gridDim.x;
    const Ctx& C = C0;
    int lo, hi; unsigned* ctl0; { KArg p = kp_get(); lo = p->ph_lo; hi = p->ph_hi; ctl0 = (unsigned*)(p->ws + WS_CTL); }
    const bool fused = (hi - lo) > 1;
    if (C.tid < 64) ((LAS unsigned*)(C.lds + LDS_MISC))[C.tid] = 0u;
    __syncthreads();
    XcdBarrier bar; bar.bar = ctl0 + CW_BAR; bar.x = 0; bar.st = (volatile LAS unsigned*)(C.lds + LDS_MISC);
    if (fused) bar = xcd_barrier_post(ctl0 + CW_BAR, (volatile LAS unsigned*)(C.lds + LDS_MISC));
#define IN(k) (lo <= (k) && (k) < hi)
#define RELAUNDER do { int t_ = C0.tid, b_ = C0.bid, g_ = C0.G; unsigned l_ = (unsigned)(size_t)C0.lds; asm volatile("" : "+v"(t_), "+s"(b_), "+s"(g_), "+s"(l_)); C.tid = t_; C.lane = t_ & 63; C.wave = __builtin_amdgcn_readfirstlane(t_ >> 6); C.bid = b_; C.G = g_; C.lds = (LAS unsigned char*)(size_t)l_; p = kp_get(); ws = p->ws; } while (0)
#define PHASE_VARS Ctx C; { int t_ = C0.tid, b_ = C0.bid, g_ = C0.G; unsigned l_ = (unsigned)(size_t)C0.lds; asm volatile("" : "+v"(t_), "+s"(b_), "+s"(g_), "+s"(l_)); C.tid = t_; C.lane = t_ & 63; C.wave = __builtin_amdgcn_readfirstlane(t_ >> 6); C.bid = b_; C.G = g_; C.lds = (LAS unsigned char*)(size_t)l_; } KArg p = kp_get(); unsigned char* ws = p->ws; unsigned* ctl = (unsigned*)(ws + WS_CTL); const float* MOD = (const float*)(ws + WS_MOD); bf16_t* U = (bf16_t*)(ws + WS_U); (void)ctl; (void)MOD; (void)U;
#define SEAM(k) do { if (IN(k) && IN((k) + 1)) xcd_barrier(bar); } while (0)

    TIC(300); TIC(301);
    if (PH_ON(10) && IN(0)) { PHASE_VARS prologue_phase(p, C); }
    TOC(300);
    SEAM(0);
    TOC(301);

    for (int l = 0; l < DEPTH; ++l) {
        const int base = 1 + PH_PER_LAYER * l;
        const bool moe = (l & 1) != 0, last = (l == DEPTH - 1);
        const int row_min = last ? MC : 0, pm0 = last ? 4 : 0, Meff = last ? MX : MT;

        TIC(100); TIC(200);
        if (PH_ON(0) && IN(base + 0)) { PHASE_VARS
            norm_phase<0>(p, C, l, l == 2, l - 1, false, 0, (l == 1 || l == 3) ? 7 : 0);
        }
        TOC(100);
        SEAM(base + 0);
        TOC(200);
        TIC(101); TIC(201);
        if (PH_ON(1) && IN(base + 1)) { PHASE_VARS
            { pg8::Gemm g{U, (const bf16_t*)(ws + WS_WIN) + (size_t)l * DINP * D, MT, DINP, D, D, D}; pg8::OrderPM S; S.init(MT, DINP, C.G, C.bid); S.pm0 = 0;
              pg8::EpiStore E{(bf16_t*)(ws + WS_P), DINP, 1 << 20};
              pg8::gemm_phase<pg8::EpiStore, pg8::OrderPM, true, true>(C.lds, g, S, E); }
            { pg8::Gemm g{(const bf16_t*)(ws + WS_WINV) + (size_t)l * 256 * D, U, 256, MT, D, D, D}; pg8::OrderPM S; S.init(256, MT, C.G, (C.bid + 208) & 255); S.pm0 = 0;
              pg8::EpiStore E{(bf16_t*)(ws + WS_VTS), MT, 1 << 20};
              pg8::gemm_phase<pg8::EpiStore, pg8::OrderPM, true, true>(C.lds, g, S, E); }
        }
        TOC(101);
        SEAM(base + 1);
        TOC(201);
        TIC(102); TIC(202);
        if (PH_ON(2) && IN(base + 2)) for (int rep = 0; rep < NREP(2); ++rep) { PHASE_VARS
            if (!PREP_IN_GDN) prep_phase(p, C, l);
            for (int v = C.bid; v < 1088; v += C.G) { const int b = v / 272, h = (v / 68) & 3, cg = v % 68; gdn_chunk_unit(p, C, l, b, h, cg, v); }
            RELAUNDER;
            TIC(5);
#if RET_DEAL_OLD
            for (int v = C.bid; v < 1088; v += C.G) { const int b = v / 272, h = (v / 68) & 3, cg = v % 68; ret_chunk_unit(p, C, l, b, h, cg); }
#else
            if (C.bid >= 64) { for (int k = 0; k < 5; ++k) { const int v = (C.bid - 64) + 192 * k; const int b = v / 272, h = (v / 68) & 3, cg = v % 68; ret_chunk_unit(p, C, l, b, h, cg); } }
            else { for (int k = 0; k < 2; ++k) { const int v = 960 + C.bid + 64 * k; const int b = v / 272, h = (v / 68) & 3, cg = v % 68; ret_chunk_unit(p, C, l, b, h, cg); } }
#endif
            TOC(5);
        }
        TOC(102);
        SEAM(base + 2);
        TOC(202);
        TIC(103); TIC(203);
        if (PH_ON(3) && IN(base + 3)) for (int rep = 0; rep < NREP(3); ++rep) { PHASE_VARS
            if (SUB3 & 1) { if (C.bid < 32) { TIC(7); gdn_scan_chain(p, C, C.bid); TOC(7); } }
            RELAUNDER;
            if (C.bid >= 32) {
                const int G2 = C.G - 32, c2 = C.bid - 32;
                TIC(8);
                if (SUB3 & 2) { pg8::Gemm g{(const bf16_t*)(ws + WS_AUP), (const bf16_t*)(ws + WS_WUP) + (size_t)l * 1024 * 512, MT, 1024, 512, 512, 512}; pg8::OrderPM S; S.init(MT, 1024, G2, c2); S.pm0 = 0;
                  pg8::EpiUp E{(bf16_t*)(ws + WS_QRAW), (bf16_t*)(ws + WS_KFULL)};
                  pg8::gemm_phase<pg8::EpiUp, pg8::OrderPM, true, true>(C.lds, g, S, E); }
                RELAUNDER;
                if (SUB3 & 4) { pg8::Gemm g{(const bf16_t*)(ws + WS_WUPV) + (size_t)l * 256 * 512, (const bf16_t*)(ws + WS_AUP), 256, MT, 512, 512, 512}; pg8::OrderPM S; S.init(256, MT, G2, (c2 + 176) % G2); S.pm0 = 0;
                  pg8::EpiStore E{(bf16_t*)(ws + WS_VTM), MT, 1 << 20};
                  pg8::gemm_phase<pg8::EpiStore, pg8::OrderPM, true, true>(C.lds, g, S, E); }
                RELAUNDER;
                TOC(8); TIC(9);
                if (SUB3 & 8) ret_scan_items(p, C, l, c2 * NTHR + C.tid, 65536, G2 * NTHR);
                RELAUNDER;
                TOC(9); TIC(10);
                if (SUB3 & 16) { for (int u = 256 + c2; u < 512; u += G2) attn_dispatch(p, C, l, u);
                if (!last) for (int u = 528 + c2; u < 544; u += G2) attn_dispatch(p, C, l, u); }
                RELAUNDER;
                TOC(10); TIC(11);
                RELAUNDER;
                if (!last) { __syncthreads();
                    constexpr int NWK = 116 + 2 * 108;
                    if (c2 < 116) convert_layer_weights(p, C, l + 1, c2 * NWAVES + C.wave, NWK * NWAVES);
                    else { convert_layer_weights(p, C, l + 1, (116 + 2 * (c2 - 116)) * NWAVES + C.wave, NWK * NWAVES); convert_layer_weights(p, C, l + 1, (117 + 2 * (c2 - 116)) * NWAVES + C.wave, NWK * NWAVES); } }
                TOC(11);
            }
        }
        TOC(103);
        SEAM(base + 3);
        TOC(203);
        TIC(104); TIC(204);
        if (PH_ON(4) && IN(base + 4)) for (int rep = 0; rep < NREP(4); ++rep) { PHASE_VARS
            TIC(12);
            for (int u = C.bid; u < 256; u += C.G) attn_dispatch(p, C, l, u);
            if (!last) for (int u = 512 + C.bid; u < 528; u += C.G) attn_dispatch(p, C, l, u);
            TOC(12); TIC(13);
            for (int it = C.bid * NWAVES + C.wave; it < 4 * 1088; it += C.G * NWAVES) { const int u = it >> 2, mixer = (it >> 1) & 1, rt = it & 1; const int b = u / 272, h = (u / 68) & 3, cg = u % 68; if (last && cg < 4) continue; rec_out_item(p, C.lane, l, mixer, b, h, cg, rt); }
            TOC(13);
        }
        TOC(104);
        SEAM(base + 4);
        TOC(204);
        TIC(105); TIC(205);
        if (PH_ON(5) && IN(base + 5)) { PHASE_VARS
            { pg8::Gemm g{(const bf16_t*)(ws + WS_MIX), (const bf16_t*)(ws + WS_WOUT) + (size_t)l * D * D, MX, D, D, D, D}; pg8::OrderPM S; S.init(MX, D, C.G, C.bid); S.pm0 = 4;
              pg8::EpiRes E{(float*)(ws + WS_H), MOD + (size_t)l * 5 * 6144 + 2 * 1024, l == 0 ? p->in[I_X] - (size_t)MC * D : (const float*)(ws + WS_H)};
              pg8::gemm_phase<pg8::EpiRes, pg8::OrderPM, true, true>(C.lds, g, S, E); }
            if (!last) { RELAUNDER;
              pg8::Gemm g{(const bf16_t*)(ws + WS_MIX), (const bf16_t*)(ws + WS_WOUT) + (size_t)l * D * D, MC, D, 256, D, D}; pg8::SplitKOrder S{C.G, C.bid, 4, 256};
              pg8::EpiSlab E{(float*)(ws + WS_SLAB), (const float*)(ws + WS_MOD) + (size_t)l * 5 * 6144 + 2 * 1024, 256};
              pg8::gemm_phase<pg8::EpiSlab, pg8::SplitKOrder, true, true>(C.lds, g, S, E); }
        }
        TOC(105);
        SEAM(base + 5);
        TOC(205);
        TIC(106); TIC(206);
        if (PH_ON(6) && IN(base + 6)) { PHASE_VARS norm_phase<1>(p, C, l, false, 0, moe, row_min, last ? 0 : 4); }
        TOC(106);
        SEAM(base + 6);
        TOC(206);
        TIC(107); TIC(207);
        if (PH_ON(7) && IN(base + 7)) { PHASE_VARS if (moe) moe_gather_phase(p, C, row_min); }
        TOC(107);
        if (moe) SEAM(base + 7);
        TOC(207);
        TIC(108); TIC(208);
        if (PH_ON(8) && IN(base + 8)) { PHASE_VARS
            pg8::EpiSwiGLU E{(bf16_t*)(ws + WS_HD)};
            if (!moe) { pg8::Gemm g{U, (const bf16_t*)(ws + WS_WFF + (size_t)(l >> 1) * FFW_BYTES), MT, 7168, D, D, D}; pg8::OrderPM S; S.init(MT, 7168, C.G, C.bid); S.pm0 = 0;
                pg8::gemm_phase<pg8::EpiSwiGLU, pg8::OrderPM, true, true>(C.lds, g, S, E); }
            else { const int nt = (int)__hip_atomic_load(ctl + CW_TILEE + 160, __ATOMIC_RELAXED, __HIP_MEMORY_SCOPE_AGENT);
                pg8::Gemm g{(const bf16_t*)(ws + WS_ASORT), (const bf16_t*)(ws + WS_WMOE), MOE_ROWS, 8 * 7168, D, D, D}; pg8::MoeOrder S{28, C.G, C.bid, __builtin_amdgcn_readfirstlane(nt), ctl + CW_TILEE};
                pg8::gemm_phase<pg8::EpiSwiGLU, pg8::MoeOrder, true, true>(C.lds, g, S, E); }
        }
        TOC(108);
        SEAM(base + 8);
        TOC(208);
        TIC(109); TIC(209);
        if (PH_ON(9) && IN(base + 9)) { PHASE_VARS
            if (!moe) {
                const bf16_t* Wd = (const bf16_t*)(ws + WS_WFF + (size_t)(l >> 1) * FFW_BYTES) + (size_t)7168 * 1024;
                { pg8::Gemm g{(const bf16_t*)(ws + WS_HD), Wd, MX, D, DFF, DFF, DFF}; pg8::OrderPM S; S.init(MX, D, C.G, C.bid); S.pm0 = 4;
                  pg8::EpiRes E{(float*)(ws + WS_H), MOD + (size_t)l * 5 * 6144 + 5 * 1024, (const float*)(ws + WS_H)};
                  pg8::gemm_phase<pg8::EpiRes, pg8::OrderPM, true, true>(C.lds, g, S, E); }
                RELAUNDER;
                { pg8::Gemm g{(const bf16_t*)(ws + WS_HD), (const bf16_t*)(ws + WS_WFF + (size_t)(l >> 1) * FFW_BYTES) + (size_t)7168 * 1024, MC, D, 512, DFF, DFF}; pg8::SplitKOrder S{C.G, C.bid, 7, 512};
                  pg8::EpiSlab E{(float*)(ws + WS_SLAB), (const float*)(ws + WS_MOD) + (size_t)l * 5 * 6144 + 5 * 1024, 512};
                  pg8::gemm_phase<pg8::EpiSlab, pg8::SplitKOrder, true, true>(C.lds, g, S, E); } }
            else { const int nt = __builtin_amdgcn_readfirstlane((int)__hip_atomic_load(ctl + CW_TILEE + 160, __ATOMIC_RELAXED, __HIP_MEMORY_SCOPE_AGENT));
                { pg8::Gemm g{(const bf16_t*)(ws + WS_HD), (const bf16_t*)(ws + WS_WMOE) + (size_t)8 * 7168 * 1024, MOE_ROWS, 8 * 1024, DFF, DFF, DFF}; pg8::MoeOrder S{4, C.G, C.bid, nt < MOE_SPLIT_TILE ? nt : MOE_SPLIT_TILE, ctl + CW_TILEE};
                  pg8::EpiStore E{(bf16_t*)(ws + WS_YD), D, 4};
                  pg8::gemm_phase<pg8::EpiStore, pg8::MoeOrder, true, true>(C.lds, g, S, E); }
                RELAUNDER;
                if (nt > MOE_SPLIT_TILE) { pg8::Gemm g{(const bf16_t*)(ws + WS_HD), (const bf16_t*)(ws + WS_WMOE) + (size_t)8 * 7168 * 1024, MOE_ROWS, 8 * 1024, 512, DFF, DFF}; pg8::MoeSplitOrder S{C.G, C.bid, nt, (unsigned*)(ws + WS_CTL) + CW_TILEE};
                  pg8::EpiMoeSlab E{(bf16_t*)(ws + WS_MSLAB)};
                  pg8::gemm_phase<pg8::EpiMoeSlab, pg8::MoeSplitOrder, true, true>(C.lds, g, S, E); } }
        }
        TOC(109);
        SEAM(base + 9);
        TOC(209);
    }
    if (PH_ON(11) && IN(PH_FINAL)) { PHASE_VARS norm_phase<2>(p, C, DEPTH, true, DEPTH - 1, false, MC, 0); }
#if PROBE_ID
    if (blockIdx.x == PROBE_BLOCK && threadIdx.x == 0) { const unsigned long long w = PROBE_ACC[0] * PROBE_MULT, t0 = __builtin_amdgcn_s_memrealtime(); while (__builtin_amdgcn_s_memrealtime() - t0 < w) __builtin_amdgcn_s_sleep(8); }
#endif
#undef IN
#undef SEAM
}

extern "C" void kernel_launch(void* const* d_in, const int* in_sizes, int n_in, void* d_out, int out_size, void* d_ws, size_t ws_size, hipStream_t stream) {
    static int grid = 0;
    if (grid == 0) {
        if (n_in != N_IN || out_size != MX * D || ws_size < WS_TOTAL) { fprintf(stderr, "kernel_launch: unexpected shapes (n_in %d out %d ws %zu, need %zu)\n", n_in, out_size, ws_size, (size_t)WS_TOTAL); grid = -1; return; }
        int dev = 0, cus = 0, per_cu = 0;
        if (hipGetDevice(&dev) != hipSuccess || hipDeviceGetAttribute(&cus, hipDeviceAttributeMultiprocessorCount, dev) != hipSuccess) { grid = -1; return; }
        if (hipFuncSetAttribute((const void*)mega_fwd, hipFuncAttributeMaxDynamicSharedMemorySize, LDS_BYTES) != hipSuccess) { fprintf(stderr, "kernel_launch: hipFuncSetAttribute failed\n"); grid = -1; return; }
        if (hipOccupancyMaxActiveBlocksPerMultiprocessor(&per_cu, (const void*)mega_fwd, NTHR, LDS_BYTES) != hipSuccess || per_cu < 1) { fprintf(stderr, "kernel_launch: occupancy query says %d\n", per_cu); }
        (void)hipGetLastError();
        grid = (cus == 256) ? 256 : -1;
        if (grid < 0) { fprintf(stderr, "kernel_launch: built for a 256-CU device, found %d\n", cus); return; }
    }
    if (grid < 0) return;
    if (hipMemsetAsync((char*)d_ws + WS_CTL, 0, CTL_BYTES, stream) != hipSuccess) return;
    Params p; memset(&p, 0, sizeof(p));
    for (int i = 0; i < N_IN; ++i) p.in[i] = (const float*)d_in[i];
    p.out = (float*)d_out; p.ws = (unsigned char*)d_ws;
#if MK_ONE_LAUNCH
    p.ph_lo = 0; p.ph_hi = N_PHASES;
    hipLaunchKernelGGL(mega_fwd, dim3(grid), dim3(NTHR), LDS_BYTES, stream, p);
#else
    for (int ph = 0; ph < N_PHASES; ++ph) {
        if (ph >= 1 && ph < PH_FINAL) { const int l = (ph - 1) / PH_PER_LAYER, k = (ph - 1) % PH_PER_LAYER; if (k == 7 && !(l & 1)) continue; }
        p.ph_lo = ph; p.ph_hi = ph + 1;
        hipLaunchKernelGGL(mega_fwd, dim3(grid), dim3(NTHR), LDS_BYTES, stream, p);
    }
#endif
}
```

```cpp
#include <hip/hip_runtime.h>
#include <cstdio>
#include <cstdint>
#include <cstring>

#ifndef MK_ONE_LAUNCH
#define MK_ONE_LAUNCH 1
#endif

#define LAS __attribute__((address_space(3)))
#define GAS __attribute__((address_space(1)))
typedef unsigned short bf16_t;
typedef short bf16x8 __attribute__((ext_vector_type(8)));
typedef float f32x4 __attribute__((ext_vector_type(4)));
typedef float f32x2 __attribute__((ext_vector_type(2)));
typedef float f32x16 __attribute__((ext_vector_type(16)));
typedef unsigned u32x4 __attribute__((ext_vector_type(4)));
typedef unsigned u32x2 __attribute__((ext_vector_type(2)));

constexpr int D = 1024, NB = 4, SEQ = 4096, CTX = 256, DEPTH = 4;
constexpr int MC = NB * CTX, MX = NB * SEQ, MT = MC + MX;
constexpr int DIN = 2992, DINP = 3072, DFF = 3584, NE = 8;
constexpr int NSU = 2 * NB * 4 * 68;
constexpr int PC_AQ = 0, PC_AK = 256, PC_AV = 384, PC_BQKV = 512, PC_BGATE = 1280, PC_BAB = 1536, PC_CQ = 1552, PC_CKV = 1808, PC_CKR = 1936,
              PC_DQ = 1968, PC_DK = 2224, PC_DV = 2480, PC_DGATE = 2736;
constexpr float EPS = 1e-6f, LOG2E = 1.4426950408889634f;
constexpr int MOE_ROWS = 36864, MOE_TILES = MOE_ROWS / 256;

constexpr size_t MiB = 1u << 20;
constexpr size_t WS_CTL = 0, CTL_BYTES = 1 * MiB;
constexpr int CW_BAR = 4096;
constexpr int CW_CNT = 16384;
constexpr int CW_RDY = 24576;
constexpr int CW_ROWIDX = 65536;
constexpr int CW_TILEE = 20480;
constexpr size_t WS_TAB = 1 * MiB;
constexpr size_t WS_MOD = WS_TAB + 65536;
constexpr size_t WS_ROUTE = 2 * MiB;
constexpr size_t WS_DEC = 3 * MiB;
constexpr size_t WS_WIN = 4 * MiB;
constexpr size_t WS_WINV = WS_WIN + 24 * MiB;
constexpr size_t WS_WOUT = WS_WINV + 2 * MiB;
constexpr size_t WS_WUP = WS_WOUT + 8 * MiB;
constexpr size_t WS_WUPV = WS_WUP + 4 * MiB;
constexpr size_t WS_WFF = WS_WUPV + 1 * MiB;
constexpr size_t FFW_BYTES = (size_t)(7168 * 1024 + 1024 * 3584) * 2;
constexpr size_t WS_WMOE = WS_WFF + 42 * MiB;
constexpr size_t WS_H = WS_WMOE + 168 * MiB;
constexpr size_t WS_U = WS_H + 68 * MiB;
constexpr size_t WS_OV = WS_U + 34 * MiB;
constexpr size_t WS_P = WS_OV;
constexpr size_t WS_VTS = WS_P + 102 * MiB;
constexpr size_t WS_AUP = WS_VTS + 9 * MiB;
constexpr size_t WS_QRAW = WS_AUP + 17 * MiB;
constexpr size_t WS_KFULL = WS_QRAW + 13 * MiB;
constexpr size_t WS_VTM = WS_KFULL + 13 * MiB;
constexpr size_t WS_QS = WS_VTM + 9 * MiB;
constexpr size_t WS_KS = WS_QS + 9 * MiB;
constexpr size_t WS_MIX = WS_KS + 5 * MiB;
constexpr size_t WS_REC = WS_MIX + 34 * MiB;
constexpr size_t REC_G_W = 0, REC_G_UT = 8192, REC_G_KDT = 24576, REC_G_QG = 32768, REC_G_ATT = 40960, REC_G_SP = 49152, REC_G_VN = 57344, REC_G_BYTES = 65536;
constexpr size_t REC_R_KV = 0, REC_R_QG = 16384, REC_R_ATT = 24576, REC_R_VF = 32768, REC_R_SP = 40960, REC_R_BYTES = 49152;
constexpr size_t WS_RECG = WS_REC, WS_RECR = WS_REC + (size_t)NSU * REC_G_BYTES;
constexpr size_t WS_OV_END_MIX = WS_RECR + (size_t)NSU * REC_R_BYTES;
constexpr size_t WS_YD = WS_OV + 112 * MiB;
constexpr size_t WS_ASORT = WS_YD + 72 * MiB;
constexpr size_t WS_HD = WS_ASORT + 72 * MiB;
constexpr size_t WS_OV_END_FFN = WS_HD + 252 * MiB;
constexpr size_t WS_END = (WS_OV_END_MIX > WS_OV_END_FFN ? WS_OV_END_MIX : WS_OV_END_FFN);
static_assert(WS_P + (size_t)MT * DINP * 2 <= WS_VTS && WS_VTS + (size_t)256 * MT * 2 <= WS_AUP && WS_AUP + (size_t)MT * 512 * 2 <= WS_QRAW && WS_QRAW + (size_t)MT * 384 * 2 <= WS_KFULL &&
              WS_KFULL + (size_t)MT * 384 * 2 <= WS_VTM && WS_VTM + (size_t)256 * MT * 2 <= WS_QS && WS_QS + (size_t)MT * 256 * 2 <= WS_KS && WS_KS + (size_t)MT * 128 * 2 <= WS_MIX &&
              WS_MIX + (size_t)MT * D * 2 <= WS_REC && WS_YD >= WS_VTS + 9 * MiB && WS_MOD + 491520 <= WS_ROUTE && WS_ROUTE + 417792 <= WS_DEC && WS_DEC + NSU * 4 <= WS_WIN, "ws map");
constexpr size_t WS_MSLAB = WS_P;
constexpr int MOE_SPLIT_TILE = 128, MOE_SPLIT_ROW = MOE_SPLIT_TILE * 256;
constexpr size_t WS_SLAB = ((WS_END + MiB - 1) / MiB) * MiB;
constexpr size_t WS_TOTAL = WS_SLAB + 28 * MiB;
static_assert(WS_TOTAL <= 900 * MiB, "ws budget");

constexpr int LDS_BYTES = 147456;
constexpr int LDS_MISC = 147456 - 256;
constexpr int NWAVES = 8, NTHR = 512;

#ifndef PROBE_ID
#define PROBE_ID 0
#endif
#ifndef PROBE_BLOCK
#define PROBE_BLOCK 100
#endif
#ifndef PROBE_MULT
#define PROBE_MULT 4
#endif
#if PROBE_ID
#define PROBE_ACC ((volatile LAS unsigned long long*)(lds_probe_base + 147456 - 256 + 64))
#define TIC(id) do { if ((id) == PROBE_ID && blockIdx.x == PROBE_BLOCK && threadIdx.x == 0) PROBE_ACC[1] = __builtin_amdgcn_s_memrealtime(); } while (0)
#define TOC(id) do { if ((id) == PROBE_ID && blockIdx.x == PROBE_BLOCK && threadIdx.x == 0) PROBE_ACC[0] += __builtin_amdgcn_s_memrealtime() - PROBE_ACC[1]; } while (0)
#else
#define TIC(id) do { } while (0)
#define TOC(id) do { } while (0)
#endif
#define lds_probe_base ((LAS unsigned char*)0)

__device__ __forceinline__ unsigned cvtpk(float lo, float hi) { unsigned r; asm volatile("v_cvt_pk_bf16_f32 %0, %1, %2" : "=v"(r) : "v"(lo), "v"(hi)); return r; }
__device__ __forceinline__ float bf_lo(unsigned u) { return __uint_as_float(u << 16); }
__device__ __forceinline__ float bf_hi(unsigned u) { return __uint_as_float(u & 0xffff0000u); }
__device__ __forceinline__ float bf2f(bf16_t h) { return __uint_as_float((unsigned)h << 16); }
__device__ __forceinline__ bf16_t f2bf(float f) { return (bf16_t)(cvtpk(f, 0.f) & 0xffffu); }
template <int CTRL> __device__ __forceinline__ float dppf(float x) { return __builtin_bit_cast(float, __builtin_amdgcn_update_dpp(0, __builtin_bit_cast(int, x), CTRL, 0xF, 0xF, true)); }
__device__ __forceinline__ float quad_sum(float v) { v += dppf<0xB1>(v); v += dppf<0x4E>(v); return v; }
__device__ __forceinline__ float wave_sum(float v) {
    v = quad_sum(v); v += dppf<0x141>(v); v += dppf<0x140>(v);
    const int b = __builtin_bit_cast(int, v);
    return (__builtin_bit_cast(float, __builtin_amdgcn_readlane(b, 0)) + __builtin_bit_cast(float, __builtin_amdgcn_readlane(b, 16)))
         + (__builtin_bit_cast(float, __builtin_amdgcn_readlane(b, 32)) + __builtin_bit_cast(float, __builtin_amdgcn_readlane(b, 48)));
}
__device__ __forceinline__ float half_swap(float x, float& other) {
    float a = x, b = x;
    asm volatile("v_nop\n\tv_nop\n\tv_permlane32_swap_b32 %0, %1" : "+v"(a), "+v"(b));
    other = b; return a;
}
__device__ __forceinline__ float xor32_sum(float x) { float o; const float s = half_swap(x, o); return s + o; }
__device__ __forceinline__ float xor32_max(float x) { float o; const float s = half_swap(x, o); return fmaxf(s, o); }
__device__ __forceinline__ float silu_f(float x) { return x * __builtin_amdgcn_rcpf(1.f + __expf(-x)); }
__device__ __forceinline__ float sigmoid_f(float x) { return __builtin_amdgcn_rcpf(1.f + __expf(-x)); }
__device__ __forceinline__ float softplus_f(float x) { return x > 20.f ? x : log1pf(__expf(x)); }
__device__ __forceinline__ int crow(int r, int hi) { return (r & 3) + 8 * (r >> 2) + 4 * hi; }
__device__ __forceinline__ f32x16 mfma32(bf16x8 a, bf16x8 b, f32x16 c) { return __builtin_amdgcn_mfma_f32_32x32x16_bf16(a, b, c, 0, 0, 0); }
__device__ __forceinline__ bf16x8 mk_frag(u32x2 lo, u32x2 hi) { u32x4 v; v.x = lo.x; v.y = lo.y; v.z = hi.x; v.w = hi.y; return __builtin_bit_cast(bf16x8, v); }
__device__ __forceinline__ bf16x8 mk_frag4(unsigned a, unsigned b, unsigned c, unsigned d) { u32x4 v; v.x = a; v.y = b; v.z = c; v.w = d; return __builtin_bit_cast(bf16x8, v); }
__device__ __forceinline__ int mod_row(int row) { return row < MC ? 4 : ((row - MC) >> 12); }

#define XB_TMO      128
#define XB_XCNT(j)  (256  + 64 * (j))
#define XB_XSUB(j)  (1280 + 64 * (j))
#define XB_XGEN(j)  (2304 + 64 * (j))
#define XB_TOP      3328
#define XB_TOPGEN   3392
#define XCD_BAR_WORDS 3456
#define XB_SPIN_CAP (1u << 18)
__device__ __forceinline__ unsigned xb_ld(unsigned* p)              { return __hip_atomic_load(p, __ATOMIC_RELAXED, __HIP_MEMORY_SCOPE_AGENT); }
__device__ __forceinline__ unsigned xb_add(unsigned* p, unsigned v) { return __hip_atomic_fetch_add(p, v, __ATOMIC_RELAXED, __HIP_MEMORY_SCOPE_AGENT); }
__device__ __forceinline__ unsigned xb_xcc_id() { return (unsigned)__builtin_amdgcn_s_getreg((3 << 11) | 20) & 0xFu; }
#define XB_SPIN(cond, bar) do { unsigned _sp = 0; while (cond) { __builtin_amdgcn_s_sleep(1); \
    if ((++_sp & 255u) == 0u) { if (xb_ld(&(bar)[XB_TMO])) break; if (_sp > XB_SPIN_CAP) { atomicAdd(&(bar)[XB_TMO], 1u); break; } } } } while (0)
struct XcdBarrier { unsigned* bar; unsigned x; volatile LAS unsigned* st; };
__device__ __forceinline__ XcdBarrier xcd_barrier_post(unsigned* bar, volatile LAS unsigned* st) {
    XcdBarrier b; b.bar = bar; b.x = xb_xcc_id(); b.st = st;
    if (threadIdx.x == 0) (void)xb_add(&bar[XB_XCNT(b.x)], 1u);
    return b;
}
__device__ __forceinline__ void xcd_barrier_complete(unsigned* bar, unsigned x, unsigned& nloc, unsigned& nx) {
    const unsigned G = gridDim.x * gridDim.y * gridDim.z;
    unsigned sum, cnt, mine, sp = 0u;
    for (;;) {
        sum = 0u; cnt = 0u; mine = 0u;
#pragma unroll
        for (unsigned j = 0; j < 16; ++j) { const unsigned c = xb_ld(&bar[XB_XCNT(j)]); sum += c; cnt += (c > 0u) ? 1u : 0u; mine = (j == x) ? c : mine; }
        if (sum == G) break;
        __builtin_amdgcn_s_sleep(1);
        if ((++sp & 255u) == 0u) { if (xb_ld(&bar[XB_TMO])) break; if (sp > XB_SPIN_CAP) { atomicAdd(&bar[XB_TMO], 1u); break; } }
    }
    nloc = mine > 0u ? mine : 1u; nx = cnt > 0u ? cnt : 1u;
}
__device__ __forceinline__ void xcd_barrier(const XcdBarrier& b) {
    asm volatile("s_waitcnt vmcnt(0)" ::: "memory");
    __syncthreads();
    if (threadIdx.x == 0) {
        unsigned* bar = b.bar;
        __builtin_amdgcn_s_waitcnt(0);
        unsigned nloc = b.st[0], nx = b.st[1];
        if (nloc == 0u) { xcd_barrier_complete(bar, b.x, nloc, nx); b.st[0] = nloc; b.st[1] = nx; }
        const unsigned old = xb_add(&bar[XB_XSUB(b.x)], 1u);
        const unsigned gen = old / nloc;
        if (old + 1u == (gen + 1u) * nloc) {
            __builtin_amdgcn_fence(__ATOMIC_RELEASE, "agent");
            asm volatile("s_waitcnt vmcnt(0)" ::: "memory");
            const unsigned og = xb_add(&bar[XB_TOP], 1u);
            const unsigned tg = og / nx;
            if (og + 1u == (tg + 1u) * nx) xb_add(&bar[XB_TOPGEN], 1u);
            else XB_SPIN(xb_ld(&bar[XB_TOPGEN]) == tg, bar);
            __builtin_amdgcn_fence(__ATOMIC_ACQUIRE, "agent");
            xb_add(&bar[XB_XGEN(b.x)], 1u);
            asm volatile("s_waitcnt vmcnt(0)" ::: "memory");
        } else {
            XB_SPIN(xb_ld(&bar[XB_XGEN(b.x)]) == gen, bar);
            __builtin_amdgcn_fence(__ATOMIC_ACQUIRE, "agent");
            asm volatile("s_waitcnt vmcnt(0)" ::: "memory");
        }
    }
    __syncthreads();
}
namespace pg8 {
#define PG8_LAS __attribute__((address_space(3)))
typedef unsigned short bf16_t;
typedef short bf16x8 __attribute__((ext_vector_type(8)));
typedef float f32x4 __attribute__((ext_vector_type(4)));
typedef unsigned u32x4 __attribute__((ext_vector_type(4)));
constexpr int BM = 256, BK = 64, HALF = 128, HTB = HALF * BK * 2  , STAGE_BYTES = 8 * HTB, NXCD = 8, WGM = 8;

__host__ __device__ __forceinline__ int lds_byte(int r, int c) { const int st = (r >> 4) * 2 + (c >> 5), rr = r & 15, cc = c & 31, ob = rr * 64 + cc * 2; return st * 1024 + (ob ^ (((ob >> 9) & 1) << 5)); }
__host__ __device__ __forceinline__ void stage_rc(int b, int& R, int& C) { const int st = b / 1024, sb = b % 1024, swz = sb ^ (((sb >> 9) & 1) << 5); R = (st >> 1) * 16 + swz / 64; C = (st & 1) * 32 + (swz % 64) / 2; }
__host__ __device__ __forceinline__ int perm32(int rho) { const int n = rho >> 4, i = rho & 15; return 8 * (i >> 2) + 4 * n + (i & 3); }

struct Unit { int pm, pn, ko; };
struct Gemm { const bf16_t* A; const bf16_t* Bt; int M, N, K, lda, ldb; };

struct StaticOrder {
    static constexpr bool GATHER = false;
    int nM, nN, nwg, G, c;
    __host__ __device__ void init(int M, int N, int G_, int c_) { nM = M / BM; nN = N / BM; nwg = nM * nN; G = G_; c = c_; }
    __host__ __device__ bool next(int i, Unit& u) const {
        const long L = (long)i * G + c; if (L >= nwg) return false;
        int wgid = (int)L; { const int q = nwg / NXCD, r = nwg % NXCD, xcd = wgid % NXCD, off = wgid / NXCD; wgid = (xcd < r ? xcd * (q + 1) : r * (q + 1) + (xcd - r) * q) + off; }
        const int nig = WGM * nN, gid = wgid / nig, fm = gid * WGM, gsz = (nM - fm) < WGM ? (nM - fm) : WGM;
        u.pm = fm + ((wgid % nig) % gsz); u.pn = (wgid % nig) / gsz; u.ko = 0; return true;
    }
    __device__ __forceinline__ void a_ready(const Unit&) const {}
    __device__ __forceinline__ void done(const Unit&) const {}
};
__device__ __forceinline__ unsigned cvt_pk_bf16(float lo, float hi) { unsigned r; asm volatile("v_cvt_pk_bf16_f32 %0, %1, %2" : "=v"(r) : "v"(lo), "v"(hi)); return r; }
template <class Epi, class Sched, bool ALIGN_EPI = false, bool SP2 = false>
__device__ __forceinline__ void gemm_phase(PG8_LAS unsigned char* lds, const Gemm g, const Sched& S, const Epi& E) {
    int tid_l = threadIdx.x; asm volatile("" : "+v"(tid_l));
    const int tid = tid_l, wid = __builtin_amdgcn_readfirstlane(tid >> 6), lane = tid & 63, wr = wid >> 2, wc = wid & 3, fr = lane & 15, fq = lane >> 4;
    const int K = g.K, nt = K / BK;
    constexpr bool GA = Sched::GATHER;
    unsigned voffA[2], voffB[2];
#pragma unroll
    for (int i = 0; i < 2; ++i) { int R, C; stage_rc(tid * 16 + i * 8192, R, C); const int Rb = Epi::PERM ? ((R & ~31) + perm32(R & 31)) : R;
        voffA[i] = (unsigned)(R * g.lda + C) * 2u; voffB[i] = (unsigned)(Rb * g.ldb + C) * 2u; }
    const size_t kstep = (size_t)(BK * 2);
    const size_t hstepA = GA ? (size_t)0 : (size_t)HALF * g.lda * 2, hstepB = (size_t)HALF * g.ldb * 2;
    const size_t tstepA = 2 * hstepA, tstepB = 2 * hstepB;
    const unsigned ldsw = (unsigned)wid * 1024u;
    const int aoff = lds_byte(wr * 64 + fr, fq * 8), boff = lds_byte(wc * 32 + fr, fq * 8);
#define PG8_SA(b, h) (((b) * 2 + (h)) * HTB)
#define PG8_SB(b, h) ((4 + (b) * 2 + (h)) * HTB)
#define PG8_STAGE(bufoff, gbase, voff) do { _Pragma("unroll") for (int _i = 0; _i < 2; ++_i) \
        __builtin_amdgcn_global_load_lds((const unsigned*)((const char*)(gbase) + (voff)[_i]), (PG8_LAS unsigned*)(lds + (bufoff) + ldsw + _i * 8192), 16, 0, 0); } while (0)
#define PG8_STAGE_A(bufoff, gbase, h, NX) do { _Pragma("unroll") for (int _i = 0; _i < 2; ++_i) { const unsigned _vo = GA ? ((NX) ? nvA[h][_i] : cvA[h][_i]) : voffA[_i]; \
        __builtin_amdgcn_global_load_lds((const unsigned*)((const char*)(gbase) + (h) * hstepA + _vo), (PG8_LAS unsigned*)(lds + (bufoff) + ldsw + _i * 8192), 16, 0, 0); } } while (0)
#define PG8_LDA(dst, b, h) do { _Pragma("unroll") for (int m = 0; m < 4; ++m) _Pragma("unroll") for (int k = 0; k < 2; ++k) dst[m][k] = *(const PG8_LAS bf16x8*)(lds + PG8_SA(b, h) + aoff + m * 2048 + k * 1024); } while (0)
#define PG8_LDB(dst, b, h) do { _Pragma("unroll") for (int n = 0; n < 2; ++n) _Pragma("unroll") for (int k = 0; k < 2; ++k) dst[n][k] = *(const PG8_LAS bf16x8*)(lds + PG8_SB(b, h) + boff + n * 2048 + k * 1024); } while (0)
#define PG8_MMA(ai, bj, At, Bt) do { __builtin_amdgcn_s_setprio(1); _Pragma("unroll") for (int m = 0; m < 4; ++m) _Pragma("unroll") for (int n = 0; n < 2; ++n) _Pragma("unroll") for (int k = 0; k < 2; ++k) \
        acc[ai][bj][m][n] = __builtin_amdgcn_mfma_f32_16x16x32_bf16(Bt[n][k], At[m][k], acc[ai][bj][m][n], 0, 0, 0); __builtin_amdgcn_s_setprio(0); } while (0)
#define PG8_WAIT_V(n) asm volatile("s_waitcnt vmcnt(" #n ")" ::: "memory")
#define PG8_WAIT_L(n) asm volatile("s_waitcnt lgkmcnt(" #n ")" ::: "memory")
#define PG8_BAR __builtin_amdgcn_s_barrier()
#define PG8_SCHED __builtin_amdgcn_sched_barrier(0)
    Unit cur, nxt; int ui = 0;
    if (!S.next(0, cur)) return;
    f32x4 acc[2][2][4][2];
#pragma unroll
    for (int a = 0; a < 2; ++a)
#pragma unroll
        for (int b = 0; b < 2; ++b)
#pragma unroll
            for (int m = 0; m < 4; ++m)
#pragma unroll
                for (int n = 0; n < 2; ++n) acc[a][b][m][n] = (f32x4){0.f, 0.f, 0.f, 0.f};
    bf16x8 At[4][2], B0[2][2], B1[2][2];
    const char* cA = (const char*)g.A + (size_t)cur.pm * tstepA + (size_t)cur.ko * 2; const char* cB = (const char*)g.Bt + (size_t)cur.pn * tstepB + (size_t)cur.ko * 2;
    unsigned cvA[2][2] = {{0u, 0u}, {0u, 0u}}, nvA[2][2] = {{0u, 0u}, {0u, 0u}};
    if constexpr (GA) {
#pragma unroll
        for (int h = 0; h < 2; ++h)
#pragma unroll
            for (int i = 0; i < 2; ++i) { int R, C; stage_rc(tid * 16 + i * 8192, R, C); const int src = S.rowidx[cur.pm * BM + h * HALF + R]; cvA[h][i] = (unsigned)(src * g.lda + C) * 2u; }
    }
    S.a_ready(cur);
    if constexpr (SP2) {
        PG8_STAGE(PG8_SB(0, 0), cB, voffB); PG8_STAGE(PG8_SB(0, 1), cB + hstepB, voffB); PG8_STAGE_A(PG8_SA(0, 0), cA, 0, false); PG8_STAGE_A(PG8_SA(0, 1), cA, 1, false);
        if (wr == 1) PG8_BAR;
        PG8_WAIT_V(2); PG8_BAR;
        PG8_STAGE(PG8_SB(1, 0), cB + kstep, voffB); PG8_STAGE_A(PG8_SA(1, 0), cA + kstep, 0, false); PG8_STAGE(PG8_SB(1, 1), cB + hstepB + kstep, voffB);
        PG8_WAIT_V(6); PG8_BAR;
    } else {
        PG8_STAGE(PG8_SB(0, 0), cB, voffB); PG8_STAGE_A(PG8_SA(0, 0), cA, 0, false); PG8_STAGE(PG8_SB(0, 1), cB + hstepB, voffB); PG8_STAGE_A(PG8_SA(0, 1), cA, 1, false);
        if (wr == 1) PG8_BAR;
        PG8_WAIT_V(4); PG8_BAR;
        PG8_STAGE(PG8_SB(1, 0), cB + kstep, voffB); PG8_STAGE_A(PG8_SA(1, 0), cA + kstep, 0, false); PG8_STAGE(PG8_SB(1, 1), cB + hstepB + kstep, voffB);
        PG8_WAIT_V(6); PG8_BAR;
    }
    for (;;) {
        const bool has_next = S.next(ui + 1, nxt);
        if constexpr (GA) {
            if (has_next && wid < 4) __builtin_amdgcn_global_load_lds((const unsigned*)(S.rowidx + nxt.pm * BM + tid), (PG8_LAS unsigned*)(lds + STAGE_BYTES + ((ui + 1) & 1) * 1024 + wid * 256), 4, 0, 0);
#pragma unroll
            for (int h = 0; h < 2; ++h)
#pragma unroll
                for (int i = 0; i < 2; ++i) nvA[h][i] = cvA[h][i];
        }
        const char* nA = has_next ? (const char*)g.A + (size_t)nxt.pm * tstepA + (size_t)nxt.ko * 2 : cA; const char* nB = has_next ? (const char*)g.Bt + (size_t)nxt.pn * tstepB + (size_t)nxt.ko * 2 : cB;
#pragma unroll 1
        for (int t = 0; t < nt; t += 2) {
            const bool last = (t == nt - 2);
            const char* a1 = cA + (size_t)(t + 1) * kstep;
            const char* a2 = last ? nA : cA + (size_t)(t + 2) * kstep; const char* b2 = last ? nB : cB + (size_t)(t + 2) * kstep;
            const char* a3 = a2 + kstep; const char* b3 = b2 + kstep;
            if (last && has_next) S.a_ready(nxt);
            if constexpr (GA) { if (last && has_next) {
#pragma unroll
                for (int h = 0; h < 2; ++h)
#pragma unroll
                    for (int i = 0; i < 2; ++i) { int R, C; stage_rc(tid * 16 + i * 8192, R, C); const int src = *(const PG8_LAS int*)(lds + STAGE_BYTES + ((ui + 1) & 1) * 1024 + (h * HALF + R) * 4); nvA[h][i] = (unsigned)(src * g.lda + C) * 2u; } } }
            if constexpr (SP2) {
            PG8_LDB(B0, 0, 0); PG8_LDB(B1, 0, 1); PG8_SCHED; PG8_LDA(At, 0, 0); PG8_STAGE_A(PG8_SA(1, 1), a1, 1, false);
            PG8_WAIT_V(8); PG8_WAIT_L(0); PG8_BAR; PG8_MMA(0, 0, At, B0); PG8_MMA(0, 1, At, B1); PG8_BAR; PG8_SCHED;
            PG8_LDA(At, 0, 1); PG8_STAGE(PG8_SB(0, 0), b2, voffB); PG8_STAGE(PG8_SB(0, 1), b2 + hstepB, voffB); PG8_STAGE_A(PG8_SA(0, 0), a2, 0, last);
            PG8_WAIT_V(8); PG8_WAIT_L(0); PG8_BAR; PG8_MMA(1, 0, At, B0); PG8_MMA(1, 1, At, B1); PG8_BAR; PG8_SCHED;
            PG8_LDB(B0, 1, 0); PG8_LDB(B1, 1, 1); PG8_SCHED; PG8_LDA(At, 1, 0); PG8_STAGE_A(PG8_SA(0, 1), a2, 1, last);
            PG8_WAIT_V(8); PG8_WAIT_L(0); PG8_BAR; PG8_MMA(0, 0, At, B0); PG8_MMA(0, 1, At, B1); PG8_BAR; PG8_SCHED;
            PG8_LDA(At, 1, 1); PG8_STAGE(PG8_SB(1, 0), b3, voffB); PG8_STAGE(PG8_SB(1, 1), b3 + hstepB, voffB); PG8_STAGE_A(PG8_SA(1, 0), a3, 0, last);
            PG8_WAIT_V(8); PG8_WAIT_L(0); PG8_BAR; PG8_MMA(1, 0, At, B0); PG8_MMA(1, 1, At, B1); PG8_BAR; PG8_SCHED;
            } else {
            PG8_LDB(B0, 0, 0); PG8_SCHED; PG8_LDA(At, 0, 0); PG8_STAGE_A(PG8_SA(1, 1), a1, 1, false);
            PG8_WAIT_L(8); PG8_BAR; PG8_WAIT_L(0); PG8_MMA(0, 0, At, B0); PG8_BAR; PG8_SCHED;
            PG8_LDB(B1, 0, 1); PG8_STAGE(PG8_SB(0, 0), b2, voffB);
            PG8_BAR; PG8_WAIT_L(0); PG8_MMA(0, 1, At, B1); PG8_BAR;
            PG8_LDA(At, 0, 1); PG8_STAGE_A(PG8_SA(0, 0), a2, 0, last);
            PG8_BAR; PG8_WAIT_L(0); PG8_MMA(1, 0, At, B0); PG8_BAR; PG8_SCHED;
            PG8_STAGE(PG8_SB(0, 1), b2 + hstepB, voffB);
            PG8_WAIT_V(6); PG8_BAR; PG8_MMA(1, 1, At, B1); PG8_BAR;
            PG8_LDB(B0, 1, 0); PG8_SCHED; PG8_LDA(At, 1, 0); PG8_STAGE_A(PG8_SA(0, 1), a2, 1, last);
            PG8_WAIT_L(8); PG8_BAR; PG8_WAIT_L(0); PG8_MMA(0, 0, At, B0); PG8_BAR; PG8_SCHED;
            PG8_LDB(B1, 1, 1); PG8_STAGE(PG8_SB(1, 0), b3, voffB);
            PG8_BAR; PG8_WAIT_L(0); PG8_MMA(0, 1, At, B1); PG8_BAR;
            PG8_LDA(At, 1, 1); PG8_STAGE_A(PG8_SA(1, 0), a3, 0, last);
            PG8_BAR; PG8_WAIT_L(0); PG8_MMA(1, 0, At, B0); PG8_BAR; PG8_SCHED;
            PG8_STAGE(PG8_SB(1, 1), b3 + hstepB, voffB);
            PG8_WAIT_V(6); PG8_BAR; PG8_MMA(1, 1, At, B1); PG8_BAR;
            }
        }
        if constexpr (ALIGN_EPI) { if (wr == 0) PG8_BAR; }
        if constexpr (!Epi::AFTER_DRAIN) { E(acc, cur, wr, wc, fr, fq); S.done(cur); }
        if (!has_next) break;
#pragma unroll
        for (int a = 0; a < 2; ++a)
#pragma unroll
            for (int b = 0; b < 2; ++b)
#pragma unroll
                for (int m = 0; m < 4; ++m)
#pragma unroll
                    for (int n = 0; n < 2; ++n) acc[a][b][m][n] = (f32x4){0.f, 0.f, 0.f, 0.f};
        cur = nxt; cA = nA; cB = nB; ++ui;
        if constexpr (GA) {
#pragma unroll
            for (int h = 0; h < 2; ++h)
#pragma unroll
                for (int i = 0; i < 2; ++i) cvA[h][i] = nvA[h][i];
        }
        if constexpr (ALIGN_EPI) { if (wr == 1) PG8_BAR; }
    }
    PG8_WAIT_V(0);
    if constexpr (!ALIGN_EPI) { if (wr == 0) PG8_BAR; }
    PG8_BAR;
    if constexpr (Epi::AFTER_DRAIN) { E.fused(acc, cur, wr, wc, fr, fq, lds, wid, lane); S.done(cur); }
#undef PG8_SA
#undef PG8_SB
#undef PG8_STAGE
#undef PG8_STAGE_A
#undef PG8_LDA
#undef PG8_LDB
#undef PG8_MMA
#undef PG8_WAIT_V
#undef PG8_WAIT_L
#undef PG8_BAR
#undef PG8_SCHED
}
}

namespace pg8 {
struct OrderPM : StaticOrder {
    int pm0;
    __device__ __forceinline__ bool next(int i, Unit& u) const { if (!StaticOrder::next(i, u)) return false; u.pm += pm0; return true; }
};
struct MoeOrder {
    static constexpr bool GATHER = false;
    int nN, G, c, ntiles; const unsigned* tile_e;
    __device__ __forceinline__ bool next(int i, Unit& u) const {
        const long L = (long)i * G + c; if (L >= (long)ntiles * nN) return false;
        const int pm = (int)(L / nN), pl = (int)(L % nN);
        const int e = (int)__hip_atomic_load(tile_e + pm, __ATOMIC_RELAXED, __HIP_MEMORY_SCOPE_AGENT);
        u.pm = pm; u.pn = __builtin_amdgcn_readfirstlane(e) * nN + pl; u.ko = 0; return true;
    }
    __device__ __forceinline__ void a_ready(const Unit&) const {}
    __device__ __forceinline__ void done(const Unit&) const {}
};
struct MoeGatherOrder : MoeOrder {
    static constexpr bool GATHER = true;
    const int* rowidx;
    __device__ __forceinline__ bool next(int i, Unit& u) const {
        const int x = c & 7, j = c >> 3, T = i * 8 + x, rg = T / 7, cg = T - rg * 7, pm = rg * 8 + (j & 7), pl = cg * 4 + (j >> 3);
        if (pm >= ntiles) return false;
        const int e = (int)__hip_atomic_load(tile_e + pm, __ATOMIC_RELAXED, __HIP_MEMORY_SCOPE_AGENT);
        u.pm = pm; u.pn = __builtin_amdgcn_readfirstlane(e) * nN + pl; u.ko = 0; return true;
    }
};

struct MoeDownOrder : MoeOrder {
    __device__ __forceinline__ bool next(int i, Unit& u) const {
        const int x = c & 7, k = c >> 3, pm = i * 64 + x * 8 + (k >> 2), pl = k & 3;
        if (pm >= ntiles) return false;
        const int e = (int)__hip_atomic_load(tile_e + pm, __ATOMIC_RELAXED, __HIP_MEMORY_SCOPE_AGENT);
        u.pm = pm; u.pn = __builtin_amdgcn_readfirstlane(e) * nN + pl; u.ko = 0; return true;
    }
};

struct MoeSplitOrder {
    static constexpr bool GATHER = false;
    int G, c, ntiles; const unsigned* tile_e;
    __device__ __forceinline__ bool next(int i, Unit& u) const {
        const int L = i * G + c; if (L >= (ntiles - MOE_SPLIT_TILE) * 28) return false;
        const int sl = L % 7, t = L / 7, pm = MOE_SPLIT_TILE + (t >> 2), pl = t & 3;
        const int e = (int)__hip_atomic_load(tile_e + pm, __ATOMIC_RELAXED, __HIP_MEMORY_SCOPE_AGENT);
        u.pm = pm; u.pn = __builtin_amdgcn_readfirstlane(e) * 4 + pl; u.ko = sl * 512; return true;
    }
    __device__ __forceinline__ void a_ready(const Unit&) const {}
    __device__ __forceinline__ void done(const Unit&) const {}
};
struct EpiMoeSlab {
    static constexpr bool PERM = true, AFTER_DRAIN = false;
    bf16_t* slab;
    __device__ __forceinline__ void operator()(const f32x4 (&acc)[2][2][4][2], const Unit& u, int wr, int wc, int fr, int fq) const {
        const int row0 = (u.pm - MOE_SPLIT_TILE) * BM + wr * 64 + fr, col0 = (u.pn & 3) * BM + wc * 32 + 8 * fq;
        bf16_t* sb = slab + (size_t)(u.ko / 512) * 4096 * D;
#pragma unroll
        for (int ai = 0; ai < 2; ++ai)
#pragma unroll
            for (int m = 0; m < 4; ++m) { bf16_t* rowp = sb + (size_t)(row0 + ai * HALF + m * 16) * D + col0;
#pragma unroll
                for (int bj = 0; bj < 2; ++bj) { const f32x4 v0 = acc[ai][bj][m][0], v1 = acc[ai][bj][m][1];
                    u32x4 w; w.x = cvt_pk_bf16(v0[0], v0[1]); w.y = cvt_pk_bf16(v0[2], v0[3]); w.z = cvt_pk_bf16(v1[0], v1[1]); w.w = cvt_pk_bf16(v1[2], v1[3]);
                    *(u32x4*)(rowp + bj * HALF) = w; } }
    }
};
struct SplitKOrder {
    static constexpr bool GATHER = false;
    int G, c, ns, kslice;
    __device__ __forceinline__ bool next(int i, Unit& u) const { const int L = i * G + c; if (L >= 16 * ns) return false; const int sl = L % ns, t = L / ns; u.pm = t & 3; u.pn = t >> 2; u.ko = sl * kslice; return true; }
    __device__ __forceinline__ void a_ready(const Unit&) const {}
    __device__ __forceinline__ void done(const Unit&) const {}
};
struct EpiStore {
    static constexpr bool PERM = true, AFTER_DRAIN = false;
    bf16_t* O; int ldc; int pn_mod;
    __device__ __forceinline__ void operator()(const f32x4 (&acc)[2][2][4][2], const Unit& u, int wr, int wc, int fr, int fq) const {
        const int row0 = u.pm * BM + wr * 64 + fr, col0 = (u.pn % pn_mod) * BM + wc * 32 + 8 * fq;
#pragma unroll
        for (int ai = 0; ai < 2; ++ai)
#pragma unroll
            for (int m = 0; m < 4; ++m) { bf16_t* rowp = O + (size_t)(row0 + ai * HALF + m * 16) * ldc + col0;
#pragma unroll
                for (int bj = 0; bj < 2; ++bj) { const f32x4 v0 = acc[ai][bj][m][0], v1 = acc[ai][bj][m][1];
                    u32x4 w; w.x = cvt_pk_bf16(v0[0], v0[1]); w.y = cvt_pk_bf16(v0[2], v0[3]); w.z = cvt_pk_bf16(v1[0], v1[1]); w.w = cvt_pk_bf16(v1[2], v1[3]);
                    *(u32x4*)(rowp + bj * HALF) = w; } }
    }
};
struct EpiUp {
    static constexpr bool PERM = true, AFTER_DRAIN = false;
    bf16_t* Q; bf16_t* K;
    __device__ __forceinline__ void operator()(const f32x4 (&acc)[2][2][4][2], const Unit& u, int wr, int wc, int fr, int fq) const {
        const int row0 = u.pm * BM + wr * 64 + fr;
#pragma unroll
        for (int bj = 0; bj < 2; ++bj) {
            const int col = u.pn * BM + bj * HALF + wc * 32 + 8 * fq;
            bf16_t* base;
            if (col < 384) base = Q + col; else if (col < 640) { const int c2 = col - 384; base = K + (c2 >> 6) * 96 + (c2 & 63); } else continue;
#pragma unroll
            for (int ai = 0; ai < 2; ++ai)
#pragma unroll
                for (int m = 0; m < 4; ++m) { const f32x4 v0 = acc[ai][bj][m][0], v1 = acc[ai][bj][m][1];
                    u32x4 w; w.x = cvt_pk_bf16(v0[0], v0[1]); w.y = cvt_pk_bf16(v0[2], v0[3]); w.z = cvt_pk_bf16(v1[0], v1[1]); w.w = cvt_pk_bf16(v1[2], v1[3]);
                    *(u32x4*)(base + (size_t)(row0 + ai * HALF + m * 16) * 384) = w; }
        }
    }
};
template <bool ATOMIC> struct EpiResT {
    static constexpr bool PERM = false, AFTER_DRAIN = false;
    float* H; const float* gate; const float* Hin;
    __device__ __forceinline__ void operator()(const f32x4 (&acc)[2][2][4][2], const Unit& u, int wr, int wc, int fr, int fq) const {
        const int row0 = u.pm * BM + wr * 64 + fr, col0 = u.pn * BM + wc * 32 + 4 * fq;
        const int mb = (u.pm < 4) ? 4 : ((u.pm - 4) >> 4);
        const float* gp = gate + (size_t)mb * 6144 + col0;
        f32x4 gv[2][2];
#pragma unroll
        for (int bj = 0; bj < 2; ++bj)
#pragma unroll
            for (int n = 0; n < 2; ++n) gv[bj][n] = *(const f32x4*)(gp + bj * HALF + n * 16);
#pragma unroll
        for (int ai = 0; ai < 2; ++ai)
#pragma unroll
            for (int m = 0; m < 4; ++m) { const size_t ro = (size_t)(row0 + ai * HALF + m * 16) * D + col0;
#pragma unroll
                for (int bj = 0; bj < 2; ++bj)
#pragma unroll
                    for (int n = 0; n < 2; ++n) { const size_t o = ro + bj * HALF + n * 16; *(f32x4*)(H + o) = *(const f32x4*)(Hin + o) + gv[bj][n] * acc[ai][bj][m][n]; } }
    }
};
typedef EpiResT<false> EpiRes;
struct EpiSlab {
    static constexpr bool PERM = false, AFTER_DRAIN = false;
    float* slab; const float* gate; int kslice;
    __device__ __forceinline__ void operator()(const f32x4 (&acc)[2][2][4][2], const Unit& u, int wr, int wc, int fr, int fq) const {
        const int row0 = u.pm * BM + wr * 64 + fr, col0 = u.pn * BM + wc * 32 + 4 * fq;
        const float* gp = gate + (size_t)4 * 6144 + col0; float* sb = slab + (size_t)(u.ko / kslice) * MC * D;
        f32x4 gv[2][2];
#pragma unroll
        for (int bj = 0; bj < 2; ++bj)
#pragma unroll
            for (int n = 0; n < 2; ++n) gv[bj][n] = *(const f32x4*)(gp + bj * HALF + n * 16);
#pragma unroll
        for (int ai = 0; ai < 2; ++ai)
#pragma unroll
            for (int m = 0; m < 4; ++m) { float* rowp = sb + (size_t)(row0 + ai * HALF + m * 16) * D + col0;
#pragma unroll
                for (int bj = 0; bj < 2; ++bj)
#pragma unroll
                    for (int n = 0; n < 2; ++n) *(f32x4*)(rowp + bj * HALF + n * 16) = gv[bj][n] * acc[ai][bj][m][n]; }
    }
};
struct EpiSwiGLU {
    static constexpr bool PERM = true, AFTER_DRAIN = false;
    bf16_t* Hd;
    __device__ __forceinline__ void operator()(const f32x4 (&acc)[2][2][4][2], const Unit& u, int wr, int wc, int fr, int fq) const {
        const int row0 = u.pm * BM + wr * 64 + fr, col0 = (u.pn % 28) * HALF + wc * 32 + 8 * fq;
#pragma unroll
        for (int ai = 0; ai < 2; ++ai)
#pragma unroll
            for (int m = 0; m < 4; ++m) {
                float o[8];
#pragma unroll
                for (int n = 0; n < 2; ++n)
#pragma unroll
                    for (int q = 0; q < 4; ++q) { const float g = acc[ai][0][m][n][q], up = acc[ai][1][m][n][q]; o[n * 4 + q] = g * __builtin_amdgcn_rcpf(1.f + __expf(-g)) * up; }
                u32x4 w; w.x = cvt_pk_bf16(o[0], o[1]); w.y = cvt_pk_bf16(o[2], o[3]); w.z = cvt_pk_bf16(o[4], o[5]); w.w = cvt_pk_bf16(o[6], o[7]);
                *(u32x4*)(Hd + (size_t)(row0 + ai * HALF + m * 16) * DFF + col0) = w; }
    }
};
}

enum { I_X = 0, I_C, I_CTX, I_CCTX, I_WMOD, I_BMOD, I_NORM1, I_NORM2, I_WIN, I_WOUT, I_SINK, I_GCONV, I_GALOG, I_GDTB, I_GNORM, I_QNORM, I_KVNORM, I_WQUP, I_WKVUP,
       I_RLOGD, I_RNORM, I_FGATE, I_FUP, I_FDOWN, I_ROUTER, I_MGATE, I_MUP, I_MDOWN, I_FNORM, N_IN };
struct Params { const float* in[N_IN]; float* out; unsigned char* ws; int ph_lo, ph_hi; };
typedef const __attribute__((address_space(4))) Params* KArg;
__device__ __forceinline__ KArg kp_get() { KArg k = (KArg)__builtin_amdgcn_kernarg_segment_ptr(); asm volatile("" : "+s"(k)); return k; }

struct Ctx {
    LAS unsigned char* lds; int tid, lane, wave, bid, G;
};

__device__ __forceinline__ void tr_item(const float* src, int ldsrc, int nvalid, int k0, int c0, bf16_t* dst, int ldd, int drow0, LAS float* scr, int lane) {
    const int cl = 4 * (lane & 15), rr = lane >> 4, cc = c0 + cl; const bool ok = cc < nvalid;
    f32x4 v[16];
#pragma unroll
    for (int i = 0; i < 16; ++i) v[i] = ok ? *(const f32x4*)(src + (size_t)(k0 + 4 * i + rr) * ldsrc + cc) : (f32x4){0.f, 0.f, 0.f, 0.f};
#pragma unroll
    for (int i = 0; i < 16; ++i) { LAS float* d = scr + (4 * i + rr) * 65 + cl; d[0] = v[i].x; d[1] = v[i].y; d[2] = v[i].z; d[3] = v[i].w; }
    asm volatile("s_waitcnt lgkmcnt(0)" ::: "memory");
    const int c = lane & 7;
#pragma unroll
    for (int j = 0; j < 8; ++j) { const int n = (lane >> 3) + 8 * j; const LAS float* s = scr + (8 * c) * 65 + n;
        u32x4 o; o.x = cvtpk(s[0 * 65], s[1 * 65]); o.y = cvtpk(s[2 * 65], s[3 * 65]); o.z = cvtpk(s[4 * 65], s[5 * 65]); o.w = cvtpk(s[6 * 65], s[7 * 65]);
        *(u32x4*)(dst + (size_t)(drow0 + n) * ldd + k0 + 8 * c) = o; }
    asm volatile("s_waitcnt lgkmcnt(0)" ::: "memory");
}
__device__ __forceinline__ void ffn_tr_item(const float* g, const float* u, const float* d, bf16_t* gu, bf16_t* dn, int it, LAS float* scr, int lane) {
    if (it < 1792) { const bool up = it >= 896; const int r = up ? it - 896 : it; const int kb = r / 56, cb = r % 56, c0 = 64 * cb;
        tr_item(up ? u : g, DFF, DFF, 64 * kb, c0, gu, 1024, 256 * (c0 >> 7) + (up ? 128 : 0) + (c0 & 127), scr, lane); }
    else { const int r = it - 1792; const int kb = r / 16, cb = r % 16; tr_item(d, 1024, 1024, 64 * kb, 64 * cb, dn, DFF, 64 * cb, scr, lane); }
}

__device__ __forceinline__ void cv_decode(KArg p, int ln, int it, const float*& src, bf16_t*& dst, int& ldsrc, int& nvalid, int& k0, int& c0, int& ldd, int& drow0) {
    unsigned char* ws = p->ws;
    constexpr int I_IN = 16 * 48, I_OUT = 16 * 16, I_FF = 2688;
    const bool moe = (ln & 1) != 0; const int i = ln >> 1;
    if (it < I_IN) { const int kb = it / 48, cb = it % 48;
        src = p->in[I_WIN] + (size_t)ln * D * DIN; ldsrc = DIN; nvalid = DIN; k0 = 64 * kb; c0 = 64 * cb; dst = (bf16_t*)(ws + WS_WIN) + (size_t)ln * DINP * D; ldd = D; drow0 = 64 * cb; }
    else if (it < I_IN + I_OUT) { const int r = it - I_IN, kb = r / 16, cb = r % 16;
        src = p->in[I_WOUT] + (size_t)ln * D * D; ldsrc = D; nvalid = D; k0 = 64 * kb; c0 = 64 * cb; dst = (bf16_t*)(ws + WS_WOUT) + (size_t)ln * D * D; ldd = D; drow0 = 64 * cb; }
    else {
        int r = it - I_IN - I_OUT;
        const int e = moe ? r / I_FF : 0; r -= e * I_FF; const size_t eo = (size_t)i * NE + e;
        bf16_t* gu = moe ? (bf16_t*)(ws + WS_WMOE) + (size_t)e * 7168 * 1024 : (bf16_t*)(ws + WS_WFF + (size_t)i * FFW_BYTES);
        bf16_t* dn = moe ? (bf16_t*)(ws + WS_WMOE) + (size_t)8 * 7168 * 1024 + (size_t)e * 1024 * DFF : gu + (size_t)7168 * 1024;
        if (r < 1792) { const bool up = r >= 896; const int r2 = up ? r - 896 : r; const int kb = r2 / 56, cb = r2 % 56, cc0 = 64 * cb;
            const float* g = moe ? p->in[I_MGATE] + eo * D * DFF : p->in[I_FGATE] + (size_t)i * D * DFF; const float* u = moe ? p->in[I_MUP] + eo * D * DFF : p->in[I_FUP] + (size_t)i * D * DFF;
            src = up ? u : g; ldsrc = DFF; nvalid = DFF; k0 = 64 * kb; c0 = cc0; dst = gu; ldd = 1024; drow0 = 256 * (cc0 >> 7) + (up ? 128 : 0) + (cc0 & 127); }
        else { const int r2 = r - 1792; const int kb = r2 / 16, cb = r2 % 16;
            src = moe ? p->in[I_MDOWN] + eo * DFF * D : p->in[I_FDOWN] + (size_t)i * DFF * D; ldsrc = 1024; nvalid = 1024; k0 = 64 * kb; c0 = 64 * cb; dst = dn; ldd = DFF; drow0 = 64 * cb; }
    }
}
__device__ __forceinline__ void tr_load(const float* src, int ldsrc, int nvalid, int k0, int c0, int lane, f32x4 (&v)[16]) {
    const int cl = 4 * (lane & 15), rr = lane >> 4, cc = c0 + cl; const bool ok = cc < nvalid;
#pragma unroll
    for (int i = 0; i < 16; ++i) v[i] = ok ? *(const f32x4*)(src + (size_t)(k0 + 4 * i + rr) * ldsrc + cc) : (f32x4){0.f, 0.f, 0.f, 0.f};
}
__device__ __forceinline__ void tr_lds_write(const f32x4 (&v)[16], LAS float* scr, int lane) {
    const int cl = 4 * (lane & 15), rr = lane >> 4;
#pragma unroll
    for (int i = 0; i < 16; ++i) { LAS float* d = scr + (4 * i + rr) * 65 + cl; d[0] = v[i].x; d[1] = v[i].y; d[2] = v[i].z; d[3] = v[i].w; }
    asm volatile("s_waitcnt lgkmcnt(0)" ::: "memory");
}
__device__ __forceinline__ void tr_lds_store(bf16_t* dst, int ldd, int drow0, int k0, LAS float* scr, int lane) {
    const int c = lane & 7;
#pragma unroll
    for (int j = 0; j < 8; ++j) { const int n = (lane >> 3) + 8 * j; const LAS float* s = scr + (8 * c) * 65 + n;
        u32x4 o; o.x = cvtpk(s[0 * 65], s[1 * 65]); o.y = cvtpk(s[2 * 65], s[3 * 65]); o.z = cvtpk(s[4 * 65], s[5 * 65]); o.w = cvtpk(s[6 * 65], s[7 * 65]);
        *(u32x4*)(dst + (size_t)(drow0 + n) * ldd + k0 + 8 * c) = o; }
    asm volatile("s_waitcnt lgkmcnt(0)" ::: "memory");
}
__device__ __forceinline__ void convert_layer_weights(KArg p, const Ctx& C, int ln, int gw, int NGW, int it_lo = 0, int it_hi = 1 << 30) {
    LAS float* scr = (LAS float*)(C.lds + C.wave * 16640);
    const int nit_all = 16 * 48 + 16 * 16 + ((ln & 1) ? 8 * 2688 : 2688), nit = nit_all < it_hi ? nit_all : it_hi;
    int it = it_lo + gw;
    if (it >= nit) return;
    const float* src; bf16_t* dst; int ldsrc, nvalid, k0, c0, ldd, drow0; f32x4 va[16];
    cv_decode(p, ln, it, src, dst, ldsrc, nvalid, k0, c0, ldd, drow0);
    tr_load(src, ldsrc, nvalid, k0, c0, C.lane, va);
    for (;;) {
        tr_lds_write(va, scr, C.lane);
        const int itn = it + NGW; const bool more = itn < nit;
        bf16_t* dst_n = dst; int ldd_n = ldd, drow0_n = drow0, k0_n = k0;
        if (more) { const float* src_n; int ldsrc_n, nvalid_n, c0_n; cv_decode(p, ln, itn, src_n, dst_n, ldsrc_n, nvalid_n, k0_n, c0_n, ldd_n, drow0_n); tr_load(src_n, ldsrc_n, nvalid_n, k0_n, c0_n, C.lane, va); }
        tr_lds_store(dst, ldd, drow0, k0, scr, C.lane);
        if (!more) break;
        dst = dst_n; ldd = ldd_n; drow0 = drow0_n; k0 = k0_n; it = itn;
    }
}

__device__ __forceinline__ void prologue_phase(KArg p, const Ctx& C) {
    unsigned char* ws = p->ws;
    const int gw = C.bid * NWAVES + C.wave, NGW = C.G * NWAVES, gt = C.bid * NTHR + C.tid, NGT = C.G * NTHR;
    convert_layer_weights(p, C, 0, gw, NGW);
    {
        constexpr int PER_L = 256 * 128 + 1024 * 64 + 256 * 64;
        for (int it = gt; it < 4 * PER_L; it += NGT) {
            const int l = it / PER_L; int r = it % PER_L;
            const float* win = p->in[I_WIN] + (size_t)l * D * DIN; const float* qup = p->in[I_WQUP] + (size_t)l * 256 * 384; const float* kvup = p->in[I_WKVUP] + (size_t)l * 128 * 512;
            float v[8]; bf16_t* dst;
            if (r < 256 * 128) { const int n = r % 256, kg = r / 256;
#pragma unroll
                for (int j = 0; j < 8; ++j) v[j] = (n < 128) ? win[(size_t)(8 * kg + j) * DIN + PC_AV + n] : 0.f;
                dst = (bf16_t*)(ws + WS_WINV) + ((size_t)l * 256 + n) * 1024 + 8 * kg; }
            else if ((r -= 256 * 128) < 1024 * 64) { const int n = r % 1024, kg = r / 1024;
#pragma unroll
                for (int j = 0; j < 8; ++j) { const int k = 8 * kg + j; float x = 0.f;
                    if (n < 384) { if (k < 256) x = qup[(size_t)k * 384 + n]; }
                    else if (n < 640) { const int c2 = n - 384; if (k >= 256 && k < 384) x = kvup[(size_t)(k - 256) * 512 + 128 * (c2 >> 6) + (c2 & 63)]; }
                    v[j] = x; }
                dst = (bf16_t*)(ws + WS_WUP) + ((size_t)l * 1024 + n) * 512 + 8 * kg; }
            else { r -= 1024 * 64; const int n = r % 256, kg = r / 256;
#pragma unroll
                for (int j = 0; j < 8; ++j) { const int k = 8 * kg + j; v[j] = (k >= 256 && k < 384) ? kvup[(size_t)(k - 256) * 512 + 128 * (n >> 6) + 64 + (n & 63)] : 0.f; }
                dst = (bf16_t*)(ws + WS_WUPV) + ((size_t)l * 256 + n) * 512 + 8 * kg; }
            u32x4 o; o.x = cvtpk(v[0], v[1]); o.y = cvtpk(v[2], v[3]); o.z = cvtpk(v[4], v[5]); o.w = cvtpk(v[6], v[7]);
            *(u32x4*)dst = o;
        }
    }
    {
        float* tab = (float*)(ws + WS_TAB);
        for (int it = gt; it < 64 * 16 + 64 * 8; it += NGT) {
            if (it < 1024) { const int pos = it >> 4, j = it & 15; const float inv = (float)pow(10000.0, -(double)j / 16.0); const float ang = (float)pos * inv;
                tab[it] = (float)cos((double)ang); tab[1024 + it] = (float)sin((double)ang); }
            else { const int r = it - 1024; const int pos = r >> 3, j = r & 7; const float inv = (float)pow(10000.0, -(double)j / 8.0); const float ang = (float)pos * inv;
                tab[2048 + r] = (float)cos((double)ang); tab[2560 + r] = (float)sin((double)ang); }
        }
    }
    {
        f32x4* H4 = (f32x4*)(ws + WS_H); const f32x4* x4 = (const f32x4*)p->in[I_X]; const f32x4* c4 = (const f32x4*)p->in[I_CTX];
        for (int it = gt; it < MC * 256; it += NGT) H4[it] = c4[it];
        (void)x4;
    }
    __syncthreads();
    if (C.bid < 192) {
        LAS float* sl = (LAS float*)C.lds;
        LAS float* red = (LAS float*)(C.lds + 20480);
        for (int i = C.tid; i < 5 * 1024; i += NTHR) { const int r = i >> 10, k = i & 1023; const float cv = (r < 4) ? p->in[I_C][r * 1024 + k] : p->in[I_CCTX][k]; sl[i] = silu_f(cv); }
        __syncthreads();
        for (int it = C.bid; it < 192; it += C.G) {
            const int l = it / 48, cb = it % 48, cl = C.tid & 127, kq = C.tid >> 7, col = cb * 128 + cl;
            const float* w = p->in[I_WMOD] + (size_t)l * D * 6144 + col;
            float a0 = 0.f, a1 = 0.f, a2 = 0.f, a3 = 0.f, a4 = 0.f;
#pragma unroll 32
            for (int k = 256 * kq; k < 256 * kq + 256; ++k) { const float wv = w[(size_t)k * 6144]; a0 += sl[k] * wv; a1 += sl[1024 + k] * wv; a2 += sl[2048 + k] * wv; a3 += sl[3072 + k] * wv; a4 += sl[4096 + k] * wv; }
            red[(kq * 5 + 0) * 128 + cl] = a0; red[(kq * 5 + 1) * 128 + cl] = a1; red[(kq * 5 + 2) * 128 + cl] = a2; red[(kq * 5 + 3) * 128 + cl] = a3; red[(kq * 5 + 4) * 128 + cl] = a4;
            __syncthreads();
            for (int i = C.tid; i < 5 * 128; i += NTHR) { const int r = i >> 7, c2 = i & 127; const int cc = cb * 128 + c2;
                const float s = red[(0 * 5 + r) * 128 + c2] + red[(1 * 5 + r) * 128 + c2] + red[(2 * 5 + r) * 128 + c2] + red[(3 * 5 + r) * 128 + c2] + p->in[I_BMOD][l * 6144 + cc];
                ((float*)(ws + WS_MOD))[((size_t)l * 5 + r) * 6144 + cc] = s; }
            __syncthreads();
        }
    }
}
template <int MODE>
__device__ __forceinline__ void norm_phase(KArg p, const Ctx& C, int l, bool comb, int lprev, bool moe, int row_min, int nslab) {
    unsigned char* ws = p->ws;
    float* H = (float*)(ws + WS_H); bf16_t* U = (bf16_t*)(ws + WS_U); const float* MOD = (const float*)(ws + WS_MOD);
    const float* Hlat = (MODE == 0 && l == 0) ? p->in[I_X] - (size_t)MC * D : H;
    int* RE = (int*)(ws + WS_ROUTE); float* RW = (float*)(ws + WS_ROUTE + (size_t)MT * 8); const int* RP = (const int*)(ws + WS_ROUTE + (size_t)MT * 16);
    const bf16_t* YD = (const bf16_t*)(ws + WS_YD);
    LAS unsigned* lcnt = (LAS unsigned*)C.lds;
    LAS f32x4* wl = (LAS f32x4*)(C.lds + 1024);
    if (MODE == 1 && moe) { if (C.tid < 8) lcnt[C.tid] = 0u;
        const f32x4* wr4 = (const f32x4*)(p->in[I_ROUTER] + (size_t)(l >> 1) * D * NE);
#pragma unroll
        for (int k = 0; k < 4; ++k) { const int s = C.tid + NTHR * k, e = s >> 1, hf = s & 1; wl[(((e >> 8) * 4 + (e & 3)) * 2 + hf) * 64 + ((e & 255) >> 2)] = wr4[s]; }
        __syncthreads(); }
    f32x4 nv[4], nw[4];
    { const int row0 = C.bid + 256 * C.wave;
#pragma unroll
      for (int j = 0; j < 4; ++j) nv[j] = *(const f32x4*)((row0 < MC ? (const float*)H : Hlat) + (size_t)row0 * D + 4 * C.lane + 256 * j);
#pragma unroll
      for (int j = 0; j < 4; ++j) nw[j] = *(const f32x4*)(Hlat + (size_t)(row0 + 256 * NWAVES) * D + 4 * C.lane + 256 * j); }
    int mb_cur = -1; f32x4 gs[4], s0v[4];
#pragma unroll
    for (int j = 0; j < 4; ++j) { gs[j] = (f32x4){0.f, 0.f, 0.f, 0.f}; s0v[j] = (f32x4){0.f, 0.f, 0.f, 0.f}; }
    if (MODE == 2) {
#pragma unroll
        for (int j = 0; j < 4; ++j) gs[j] = *(const f32x4*)(p->in[I_FNORM] + 4 * C.lane + 256 * j); }
    int p0l = 0, p1l = 0; float w0l = 0.f, w1l = 0.f; u32x2 yn[2][4]; int mb2_cur = -1; f32x4 g2v[4];
#pragma unroll
    for (int j = 0; j < 4; ++j) { yn[0][j] = (u32x2){0u, 0u}; yn[1][j] = (u32x2){0u, 0u}; g2v[j] = (f32x4){0.f, 0.f, 0.f, 0.f}; }
    if (comb) {
        const int rl = C.wave + NWAVES * C.lane;
        if (rl < MT / 256) { const int rr = C.bid + 256 * rl; p0l = RP[rr * 2]; p1l = RP[rr * 2 + 1]; w0l = RW[rr * 2]; w1l = RW[rr * 2 + 1]; }
        if (C.bid + 256 * C.wave >= row_min) { const int q0 = __builtin_amdgcn_readlane(p0l, 0), q1 = __builtin_amdgcn_readlane(p1l, 0);
            if (q0 < MOE_SPLIT_ROW) {
#pragma unroll
                for (int j = 0; j < 4; ++j) yn[0][j] = *(const u32x2*)(YD + (size_t)q0 * D + 4 * C.lane + 256 * j); }
            if (q1 < MOE_SPLIT_ROW) {
#pragma unroll
                for (int j = 0; j < 4; ++j) yn[1][j] = *(const u32x2*)(YD + (size_t)q1 * D + 4 * C.lane + 256 * j); } }
    }
    int kk = 0;
    for (int ri = C.wave; ri < MT / 256; ri += NWAVES, ++kk) {
        const int row = C.bid + 256 * ri;
        f32x4 v[4];
#pragma unroll
        for (int j = 0; j < 4; ++j) { v[j] = nv[j]; nv[j] = nw[j]; }
        int p0 = 0, p1 = 0; float w0 = 0.f, w1 = 0.f; u32x2 yc[2][4];
#pragma unroll
        for (int j = 0; j < 4; ++j) { yc[0][j] = yn[0][j]; yc[1][j] = yn[1][j]; }
        if (comb) {
            p0 = __builtin_amdgcn_readlane(p0l, kk); p1 = __builtin_amdgcn_readlane(p1l, kk);
            w0 = __builtin_bit_cast(float, __builtin_amdgcn_readlane(__builtin_bit_cast(int, w0l), kk)); w1 = __builtin_bit_cast(float, __builtin_amdgcn_readlane(__builtin_bit_cast(int, w1l), kk));
            if (ri + NWAVES < MT / 256) { const int q0 = __builtin_amdgcn_readlane(p0l, kk + 1), q1 = __builtin_amdgcn_readlane(p1l, kk + 1);
                if (q0 < MOE_SPLIT_ROW) {
#pragma unroll
                    for (int j = 0; j < 4; ++j) yn[0][j] = *(const u32x2*)(YD + (size_t)q0 * D + 4 * C.lane + 256 * j); }
                if (q1 < MOE_SPLIT_ROW) {
#pragma unroll
                    for (int j = 0; j < 4; ++j) yn[1][j] = *(const u32x2*)(YD + (size_t)q1 * D + 4 * C.lane + 256 * j); } }
        }
        if (ri + 2 * NWAVES < MT / 256) {
#pragma unroll
            for (int j = 0; j < 4; ++j) nw[j] = *(const f32x4*)(Hlat + (size_t)(row + 512 * NWAVES) * D + 4 * C.lane + 256 * j); }
        if (row < row_min) continue;
        const int mb = mod_row(row);
        if (comb) {
            if (mb != mb2_cur) { mb2_cur = mb; const float* g2 = MOD + ((size_t)lprev * 5 + mb) * 6144 + 5 * 1024;
#pragma unroll
                for (int j = 0; j < 4; ++j) g2v[j] = *(const f32x4*)(g2 + 4 * C.lane + 256 * j); }
            const bf16_t* MS = (const bf16_t*)(ws + WS_MSLAB);
            f32x4 ysum[4];
#pragma unroll
            for (int j = 0; j < 4; ++j) ysum[j] = (f32x4){0.f, 0.f, 0.f, 0.f};
#pragma unroll
            for (int k = 0; k < 2; ++k) { const int ps = k ? p1 : p0; const float wk = k ? w1 : w0;
                if (ps < MOE_SPLIT_ROW) {
#pragma unroll
                    for (int j = 0; j < 4; ++j) { const u32x2 t = yc[k][j]; ysum[j] += (f32x4){bf_lo(t.x), bf_hi(t.x), bf_lo(t.y), bf_hi(t.y)} * wk; }
                } else {
#pragma unroll
                    for (int j = 0; j < 4; ++j) { u32x2 t[7];
#pragma unroll
                        for (int s = 0; s < 7; ++s) t[s] = *(const u32x2*)(MS + ((size_t)s * 4096 + (ps - MOE_SPLIT_ROW)) * D + 4 * C.lane + 256 * j);
                        f32x4 a = (f32x4){0.f, 0.f, 0.f, 0.f};
#pragma unroll
                        for (int s = 0; s < 7; ++s) a += (f32x4){bf_lo(t[s].x), bf_hi(t[s].x), bf_lo(t[s].y), bf_hi(t[s].y)};
                        ysum[j] += a * wk; }
                } }
#pragma unroll
            for (int j = 0; j < 4; ++j) { const int e = 4 * C.lane + 256 * j;
                v[j] += g2v[j] * ysum[j];
                if (MODE != 2) *(f32x4*)(H + (size_t)row * D + e) = v[j]; }
        }
        if (nslab > 0 && row < MC) {
            const float* sl = (const float*)(ws + WS_SLAB) + (size_t)row * D + 4 * C.lane;
#pragma unroll
            for (int j = 0; j < 4; ++j) { f32x4 t[7];
#pragma unroll
                for (int s = 0; s < 7; ++s) t[s] = *(const f32x4*)(sl + (size_t)(s < nslab ? s : 0) * MC * D + 256 * j);
#pragma unroll
                for (int s = 0; s < 7; ++s) if (s < nslab) v[j] += t[s];
                *(f32x4*)(H + (size_t)row * D + 4 * C.lane + 256 * j) = v[j]; }
        }
        float ss = 0.f;
#pragma unroll
        for (int j = 0; j < 4; ++j) ss += (v[j].x * v[j].x + v[j].y * v[j].y) + (v[j].z * v[j].z + v[j].w * v[j].w);
        const float rstd = rsqrtf(wave_sum(ss) * (1.f / D) + EPS);
        if (MODE == 2) {
#pragma unroll
            for (int j = 0; j < 4; ++j) { const int e = 4 * C.lane + 256 * j; *(f32x4*)(p->out + (size_t)(row - MC) * D + e) = v[j] * rstd * gs[j]; }
        } else {
            const float* gam = p->in[MODE == 0 ? I_NORM1 : I_NORM2] + (size_t)l * D;
            const float* sh = MOD + ((size_t)l * 5 + mb) * 6144 + (MODE == 0 ? 0 : 3) * 1024; const float* sc = sh + 1024;
            if (mb != mb_cur) { mb_cur = mb;
#pragma unroll
                for (int j = 0; j < 4; ++j) { const int e = 4 * C.lane + 256 * j; const f32x4 g = *(const f32x4*)(gam + e), s1 = *(const f32x4*)(sc + e); gs[j] = g * (1.f + s1); s0v[j] = *(const f32x4*)(sh + e); } }
            f32x4 y[4];
#pragma unroll
            for (int j = 0; j < 4; ++j) { const int e = 4 * C.lane + 256 * j;
                y[j] = v[j] * rstd * gs[j] + s0v[j];
                u32x2 o; o.x = cvtpk(y[j].x, y[j].y); o.y = cvtpk(y[j].z, y[j].w); *(u32x2*)(U + (size_t)row * D + e) = o; }
            if (MODE == 1 && moe) {
                float lg[8];
#pragma unroll
                for (int e = 0; e < 8; ++e) lg[e] = 0.f;
#pragma unroll
                for (int j = 0; j < 4; ++j)
#pragma unroll
                    for (int q = 0; q < 4; ++q) { const f32x4 wa = wl[((j * 4 + q) * 2) * 64 + C.lane], wb = wl[((j * 4 + q) * 2 + 1) * 64 + C.lane]; const float yv = y[j][q];
                        lg[0] += yv * wa.x; lg[1] += yv * wa.y; lg[2] += yv * wa.z; lg[3] += yv * wa.w; lg[4] += yv * wb.x; lg[5] += yv * wb.y; lg[6] += yv * wb.z; lg[7] += yv * wb.w; }
#pragma unroll
                for (int e = 0; e < 8; ++e) lg[e] = wave_sum(lg[e]);
                int e0 = 0; float v0 = lg[0];
#pragma unroll
                for (int e = 1; e < 8; ++e) if (lg[e] > v0) { v0 = lg[e]; e0 = e; }
                int e1 = -1; float v1 = -3.0e38f;
#pragma unroll
                for (int e = 0; e < 8; ++e) if (e != e0 && lg[e] > v1) { v1 = lg[e]; e1 = e; }
                const float t = __expf(v1 - v0), w0 = 1.f / (1.f + t), w1 = t * w0;
                if (C.lane == 0) { RE[row * 2] = e0; RE[row * 2 + 1] = e1; RW[row * 2] = w0; RW[row * 2 + 1] = w1; atomicAdd((unsigned*)&lcnt[e0], 1u); atomicAdd((unsigned*)&lcnt[e1], 1u); }
            }
        }
    }
    if (MODE == 1 && moe) { __syncthreads(); if (C.tid < 8) __hip_atomic_store((unsigned*)(ws + WS_CTL) + CW_CNT + C.bid * 8 + C.tid, lcnt[C.tid], __ATOMIC_RELAXED, __HIP_MEMORY_SCOPE_AGENT); }
}

__device__ __forceinline__ void moe_gather_phase(KArg p, const Ctx& C, int row_min) {
    unsigned char* ws = p->ws;
    unsigned* ctl = (unsigned*)(ws + WS_CTL);
    const int* RE = (const int*)(ws + WS_ROUTE); int* RP = (int*)(ws + WS_ROUTE + (size_t)MT * 16);
    LAS unsigned* cn = (LAS unsigned*)C.lds;
    LAS int* myoff = (LAS int*)(C.lds + 8192);
    LAS int* base = (LAS int*)(C.lds + 8192 + 64);
    LAS int* pos = (LAS int*)(C.lds + 8192 + 128);
    LAS int* es = (LAS int*)(C.lds + 8192 + 1024);
    constexpr int NE = (MT / 256) * 2;
    for (int i = C.tid; i < 2048; i += NTHR) cn[i] = __hip_atomic_load(ctl + CW_CNT + i, __ATOMIC_RELAXED, __HIP_MEMORY_SCOPE_AGENT);
    if (C.tid < NE) { const int row = C.bid + 256 * (C.tid >> 1); es[C.tid] = row < row_min ? -1 : RE[row * 2 + (C.tid & 1)]; }
    __syncthreads();
    {
        const int e = C.wave; float mine = 0.f, tot = 0.f;
#pragma unroll
        for (int j = 0; j < 4; ++j) { const int b = C.lane * 4 + j; const float c = (float)cn[b * 8 + e]; tot += c; mine += (b < C.bid) ? c : 0.f; }
        tot = wave_sum(tot); mine = wave_sum(mine);
        if (C.lane == 0) { myoff[e] = (int)mine; base[e] = ((int)tot + 255) & ~255; }
    }
    __syncthreads();
    if (C.tid == 0) { int b0 = 0; for (int e = 0; e < 8; ++e) { const int t = base[e]; base[e] = b0; myoff[e] += b0; b0 += t; } base[8] = b0; }
    __syncthreads();
    if (C.tid < NE) {
        const int e = es[C.tid]; int ps = -1;
        if (e >= 0) { int rank = 0; for (int j = 0; j < C.tid; ++j) rank += (es[j] == e) ? 1 : 0; ps = myoff[e] + rank; RP[(C.bid + 256 * (C.tid >> 1)) * 2 + (C.tid & 1)] = ps; ((int*)ctl)[CW_ROWIDX + ps] = C.bid + 256 * (C.tid >> 1); }
        pos[C.tid] = ps;
    }
    __syncthreads();
    if (C.bid == 0) {
        const int ntiles = base[8] >> 8;
        if (C.tid < MOE_TILES) { int e = 0; for (int q = 1; q < 8; ++q) if (C.tid * 256 >= base[q]) e = q; __hip_atomic_store(ctl + CW_TILEE + C.tid, (unsigned)e, __ATOMIC_RELAXED, __HIP_MEMORY_SCOPE_AGENT); }
        if (C.tid == 0) __hip_atomic_store(ctl + CW_TILEE + 160, (unsigned)ntiles, __ATOMIC_RELAXED, __HIP_MEMORY_SCOPE_AGENT);
    }
}

__device__ __forceinline__ void prep_row(KArg p, int lane, int l, int row) {
    unsigned char* ws = p->ws;
    const bf16_t* P = (const bf16_t*)(ws + WS_P); bf16_t* QS = (bf16_t*)(ws + WS_QS); bf16_t* KS = (bf16_t*)(ws + WS_KS); bf16_t* AUP = (bf16_t*)(ws + WS_AUP); bf16_t* KF = (bf16_t*)(ws + WS_KFULL);
    const float* tab = (const float*)(ws + WS_TAB);
    const float* qg = p->in[I_QNORM] + (size_t)l * 256; const float* kvg = p->in[I_KVNORM] + (size_t)l * 128;
        const bf16_t* pr = P + (size_t)row * DINP;
        const bool lat = row >= MC; const int t = (row - MC) & 4095, prow = t >> 6, pcol = t & 63;
        {
            const int hd = lane >> 4, j = lane & 15;
            float c_r = 1.f, s_r = 0.f, c_c = 1.f, s_c = 0.f;
            if (lat) { c_r = tab[prow * 16 + j]; s_r = tab[1024 + prow * 16 + j]; c_c = tab[pcol * 16 + j]; s_c = tab[1024 + pcol * 16 + j]; }
            { const bf16_t* q = pr + PC_AQ + hd * 64; const float x1 = bf2f(q[j]), x2 = bf2f(q[16 + j]), x3 = bf2f(q[32 + j]), x4 = bf2f(q[48 + j]); const float qs = 0.125f * LOG2E;
              bf16_t* o = QS + (size_t)row * 256 + hd * 64;
              o[j] = f2bf((x1 * c_r - x2 * s_r) * qs); o[16 + j] = f2bf((x2 * c_r + x1 * s_r) * qs); o[32 + j] = f2bf((x3 * c_c - x4 * s_c) * qs); o[48 + j] = f2bf((x4 * c_c + x3 * s_c) * qs); }
            if (lane < 32) { const bf16_t* k = pr + PC_AK + hd * 64; const float x1 = bf2f(k[j]), x2 = bf2f(k[16 + j]), x3 = bf2f(k[32 + j]), x4 = bf2f(k[48 + j]);
              bf16_t* o = KS + (size_t)row * 128 + hd * 64;
              o[j] = f2bf(x1 * c_r - x2 * s_r); o[16 + j] = f2bf(x2 * c_r + x1 * s_r); o[32 + j] = f2bf(x3 * c_c - x4 * s_c); o[48 + j] = f2bf(x4 * c_c + x3 * s_c); }
        }
        {
            const u32x2 a = *(const u32x2*)(pr + PC_CQ + 4 * lane); const float q0 = bf_lo(a.x), q1 = bf_hi(a.x), q2 = bf_lo(a.y), q3 = bf_hi(a.y);
            const float rq = rsqrtf(wave_sum(q0 * q0 + q1 * q1 + q2 * q2 + q3 * q3) * (1.f / 256.f) + EPS);
            const f32x4 g = *(const f32x4*)(qg + 4 * lane);
            u32x2 o; o.x = cvtpk(q0 * rq * g.x, q1 * rq * g.y); o.y = cvtpk(q2 * rq * g.z, q3 * rq * g.w); *(u32x2*)(AUP + (size_t)row * 512 + 4 * lane) = o;
            const unsigned b = *(const unsigned*)(pr + PC_CKV + 2 * lane); const float k0 = bf_lo(b), k1 = bf_hi(b);
            const float rk = rsqrtf(wave_sum(k0 * k0 + k1 * k1) * (1.f / 128.f) + EPS);
            const f32x2 g2 = *(const f32x2*)(kvg + 2 * lane);
            *(unsigned*)(AUP + (size_t)row * 512 + 256 + 2 * lane) = cvtpk(k0 * rk * g2.x, k1 * rk * g2.y);
            *(unsigned*)(AUP + (size_t)row * 512 + 384 + 2 * lane) = 0u;
        }
        if (lane < 16) {
            const int part = lane >> 3, j = lane & 7; const float xa = bf2f(pr[PC_CKR + 16 * part + j]), xb = bf2f(pr[PC_CKR + 16 * part + 8 + j]);
            float cs = 1.f, sn = 0.f; if (lat) { const int ps = part ? pcol : prow; cs = tab[2048 + ps * 8 + j]; sn = tab[2560 + ps * 8 + j]; }
            const bf16_t oa = f2bf(xa * cs - xb * sn), ob = f2bf(xb * cs + xa * sn);
#pragma unroll
            for (int h = 0; h < 4; ++h) { bf16_t* o = KF + (size_t)row * 384 + h * 96 + 64 + 16 * part; o[j] = oa; o[8 + j] = ob; }
        }
    }

__device__ __forceinline__ void rope8(const u32x4 a, const u32x4 b, const f32x4 c0, const f32x4 c1, const f32x4 s0, const f32x4 s1, float sc, u32x4& oa, u32x4& ob) {
    const float av[8] = {bf_lo(a.x), bf_hi(a.x), bf_lo(a.y), bf_hi(a.y), bf_lo(a.z), bf_hi(a.z), bf_lo(a.w), bf_hi(a.w)};
    const float bv[8] = {bf_lo(b.x), bf_hi(b.x), bf_lo(b.y), bf_hi(b.y), bf_lo(b.z), bf_hi(b.z), bf_lo(b.w), bf_hi(b.w)};
    const float cc[8] = {c0.x, c0.y, c0.z, c0.w, c1.x, c1.y, c1.z, c1.w}, ss[8] = {s0.x, s0.y, s0.z, s0.w, s1.x, s1.y, s1.z, s1.w};
    float ra[8], rb[8];
#pragma unroll
    for (int i = 0; i < 8; ++i) { ra[i] = (av[i] * cc[i] - bv[i] * ss[i]) * sc; rb[i] = (bv[i] * cc[i] + av[i] * ss[i]) * sc; }
    oa.x = cvtpk(ra[0], ra[1]); oa.y = cvtpk(ra[2], ra[3]); oa.z = cvtpk(ra[4], ra[5]); oa.w = cvtpk(ra[6], ra[7]);
    ob.x = cvtpk(rb[0], rb[1]); ob.y = cvtpk(rb[2], rb[3]); ob.z = cvtpk(rb[4], rb[5]); ob.w = cvtpk(rb[6], rb[7]);
}
__device__ __forceinline__ void prep_rows4(KArg p, int lane, int l, int row_base) {
    unsigned char* ws = p->ws;
    const bf16_t* P = (const bf16_t*)(ws + WS_P); bf16_t* QS = (bf16_t*)(ws + WS_QS); bf16_t* KS = (bf16_t*)(ws + WS_KS); bf16_t* AUP = (bf16_t*)(ws + WS_AUP); bf16_t* KF = (bf16_t*)(ws + WS_KFULL);
    const float* tab = (const float*)(ws + WS_TAB);
    const float* qg = p->in[I_QNORM] + (size_t)l * 256; const float* kvg = p->in[I_KVNORM] + (size_t)l * 128;
    const int row = row_base + (lane >> 4), ln = lane & 15;
    const bf16_t* pr = P + (size_t)row * DINP;
    const bool lat = row >= MC; const int t = (row - MC) & 4095, prow = t >> 6, pcol = t & 63;
    const int hd = ln >> 2, part = (ln >> 1) & 1, jq = ln & 1, ps = lat ? (part ? pcol : prow) : 0;
    const float* cs16 = tab + ps * 16 + 8 * jq; const float* sn16 = tab + 1024 + ps * 16 + 8 * jq;
    const u32x4 qa = *(const u32x4*)(pr + PC_AQ + hd * 64 + 32 * part + 8 * jq), qb = *(const u32x4*)(pr + PC_AQ + hd * 64 + 32 * part + 16 + 8 * jq);
    u32x4 ka = qa, kb = qb, ra = qa, rb = qb;
    if (ln < 8) { ka = *(const u32x4*)(pr + PC_AK + hd * 64 + 32 * part + 8 * jq); kb = *(const u32x4*)(pr + PC_AK + hd * 64 + 32 * part + 16 + 8 * jq); }
    const u32x4 cq0 = *(const u32x4*)(pr + PC_CQ + 16 * ln), cq1 = *(const u32x4*)(pr + PC_CQ + 16 * ln + 8);
    const u32x4 ckv = *(const u32x4*)(pr + PC_CKV + 8 * ln);
    if (ln < 2) { ra = *(const u32x4*)(pr + PC_CKR + 16 * ln); rb = *(const u32x4*)(pr + PC_CKR + 16 * ln + 8); }
    const f32x4 tc0 = *(const f32x4*)cs16, tc1 = *(const f32x4*)(cs16 + 4), ts0 = *(const f32x4*)sn16, ts1 = *(const f32x4*)(sn16 + 4);
    const int ps2 = lat ? ((ln & 1) ? pcol : prow) : 0;
    const f32x4 uc0 = *(const f32x4*)(tab + 2048 + ps2 * 8), uc1 = *(const f32x4*)(tab + 2048 + ps2 * 8 + 4), us0 = *(const f32x4*)(tab + 2560 + ps2 * 8), us1 = *(const f32x4*)(tab + 2560 + ps2 * 8 + 4);
    f32x4 gq[4];
#pragma unroll
    for (int i4 = 0; i4 < 4; ++i4) gq[i4] = *(const f32x4*)(qg + 16 * ln + 4 * i4);
    const f32x4 g0 = *(const f32x4*)(kvg + 8 * ln), g1 = *(const f32x4*)(kvg + 8 * ln + 4);
    { u32x4 oa, ob; rope8(qa, qb, tc0, tc1, ts0, ts1, 0.125f * LOG2E, oa, ob);
      bf16_t* o = QS + (size_t)row * 256 + hd * 64 + 32 * part + 8 * jq; *(u32x4*)o = oa; *(u32x4*)(o + 16) = ob; }
    if (ln < 8) { u32x4 oa, ob; rope8(ka, kb, tc0, tc1, ts0, ts1, 1.f, oa, ob);
      bf16_t* o = KS + (size_t)row * 128 + hd * 64 + 32 * part + 8 * jq; *(u32x4*)o = oa; *(u32x4*)(o + 16) = ob; }
    {
        float qv[16] = {bf_lo(cq0.x), bf_hi(cq0.x), bf_lo(cq0.y), bf_hi(cq0.y), bf_lo(cq0.z), bf_hi(cq0.z), bf_lo(cq0.w), bf_hi(cq0.w),
                        bf_lo(cq1.x), bf_hi(cq1.x), bf_lo(cq1.y), bf_hi(cq1.y), bf_lo(cq1.z), bf_hi(cq1.z), bf_lo(cq1.w), bf_hi(cq1.w)};
        float sq = 0.f;
#pragma unroll
        for (int i = 0; i < 16; ++i) sq += qv[i] * qv[i];
        sq = quad_sum(sq); sq += dppf<0x141>(sq); sq += dppf<0x140>(sq);
        const float rq = rsqrtf(sq * (1.f / 256.f) + EPS);
        unsigned ow[8];
#pragma unroll
        for (int i4 = 0; i4 < 4; ++i4) { const f32x4 g = gq[i4];
            ow[2 * i4] = cvtpk(qv[4 * i4] * rq * g.x, qv[4 * i4 + 1] * rq * g.y); ow[2 * i4 + 1] = cvtpk(qv[4 * i4 + 2] * rq * g.z, qv[4 * i4 + 3] * rq * g.w); }
        u32x4 o0, o1; o0.x = ow[0]; o0.y = ow[1]; o0.z = ow[2]; o0.w = ow[3]; o1.x = ow[4]; o1.y = ow[5]; o1.z = ow[6]; o1.w = ow[7];
        *(u32x4*)(AUP + (size_t)row * 512 + 16 * ln) = o0; *(u32x4*)(AUP + (size_t)row * 512 + 16 * ln + 8) = o1;
    }
    {
        float kv[8] = {bf_lo(ckv.x), bf_hi(ckv.x), bf_lo(ckv.y), bf_hi(ckv.y), bf_lo(ckv.z), bf_hi(ckv.z), bf_lo(ckv.w), bf_hi(ckv.w)};
        float sk = 0.f;
#pragma unroll
        for (int i = 0; i < 8; ++i) sk += kv[i] * kv[i];
        sk = quad_sum(sk); sk += dppf<0x141>(sk); sk += dppf<0x140>(sk);
        const float rk = rsqrtf(sk * (1.f / 128.f) + EPS);
        u32x4 o2; o2.x = cvtpk(kv[0] * rk * g0.x, kv[1] * rk * g0.y); o2.y = cvtpk(kv[2] * rk * g0.z, kv[3] * rk * g0.w); o2.z = cvtpk(kv[4] * rk * g1.x, kv[5] * rk * g1.y); o2.w = cvtpk(kv[6] * rk * g1.z, kv[7] * rk * g1.w);
        *(u32x4*)(AUP + (size_t)row * 512 + 256 + 8 * ln) = o2;
        u32x4 z; z.x = z.y = z.z = z.w = 0u; *(u32x4*)(AUP + (size_t)row * 512 + 384 + 8 * ln) = z;
    }
    if (ln < 2) {
      u32x4 oa, ob; rope8(ra, rb, uc0, uc1, us0, us1, 1.f, oa, ob);
#pragma unroll
        for (int h = 0; h < 4; ++h) { bf16_t* o = KF + (size_t)row * 384 + h * 96 + 64 + 16 * ln; *(u32x4*)o = oa; *(u32x4*)(o + 8) = ob; } }
}

__device__ __forceinline__ void prep_phase(KArg p, const Ctx& C, int l) {
    const int gw = C.bid * NWAVES + C.wave, NGW = C.G * NWAVES;
    for (int it = gw; it < MT / 4; it += NGW) prep_rows4(p, C.lane, l, 4 * it);
}

struct AttnArgs {
    const bf16_t* Q; int q_pitch, q_col0, q_row0;
    const bf16_t* K; int k_pitch, k_col0;
    const bf16_t* Vt; int vt_row0;
    int seg_tok0, seg_nt0, seg_tok1, seg_nt1;
    int qpos0, kpos0;
    float m_init, l_init, qscale;
    bf16_t* O; int o_col0;
    const float* tab32; int qt0;
};
template <int DQK, bool MASK, bool ROPEQ>
__device__ __forceinline__ void attn_unit(const Ctx& C, const AttnArgs& a) {
    constexpr int KP = DQK + 8, NCH = DQK / 8, KT_BYTES = 64 * KP * 2, VP = 68, VT_BYTES = 64 * VP * 2, BUF = KT_BYTES + VT_BYTES, NKS = DQK / 16;
    LAS unsigned char* lds = C.lds;
    const int lane = C.lane, c = lane & 31, hi = lane >> 5, w = C.wave, tid = C.tid;
    const int qi = 32 * w + c;
    bf16x8 qf[NKS];
    {
        const bf16_t* qp = a.Q + (size_t)(a.q_row0 + qi) * a.q_pitch + a.q_col0;
#pragma unroll
        for (int ks = 0; ks < NKS; ++ks) {
            const u32x4 raw = *(const u32x4*)(qp + 16 * ks + 8 * hi);
            float f[8] = {bf_lo(raw.x), bf_hi(raw.x), bf_lo(raw.y), bf_hi(raw.y), bf_lo(raw.z), bf_hi(raw.z), bf_lo(raw.w), bf_hi(raw.w)};
            if (ROPEQ && ks >= 4) {
                const u32x4 ro = *(const u32x4*)(qp + 16 * ks + 8 * (1 - hi));
                const float g[8] = {bf_lo(ro.x), bf_hi(ro.x), bf_lo(ro.y), bf_hi(ro.y), bf_lo(ro.z), bf_hi(ro.z), bf_lo(ro.w), bf_hi(ro.w)};
                const int t = a.qt0 + qi, ps = (ks == 4) ? (t >> 6) : (t & 63);
#pragma unroll
                for (int j = 0; j < 8; ++j) { const float cs = a.tab32[ps * 8 + j], sn = a.tab32[512 + ps * 8 + j]; f[j] = hi ? (f[j] * cs + g[j] * sn) : (f[j] * cs - g[j] * sn); }
            }
            qf[ks] = mk_frag4(cvtpk(f[0] * a.qscale, f[1] * a.qscale), cvtpk(f[2] * a.qscale, f[3] * a.qscale), cvtpk(f[4] * a.qscale, f[5] * a.qscale), cvtpk(f[6] * a.qscale, f[7] * a.qscale));
        }
    }
    f32x16 o0, o1;
#pragma unroll
    for (int r = 0; r < 16; ++r) { o0[r] = 0.f; o1[r] = 0.f; }
    float m = a.m_init, l = a.l_init;
    const int NT = a.seg_nt0 + a.seg_nt1;
    u32x4 kst[2][2]; u32x4 vst[2];
    auto tile_tok = [&](int t) { return t < a.seg_nt0 ? a.seg_tok0 + 64 * t : a.seg_tok1 + 64 * (t - a.seg_nt0); };
    auto g_load = [&](int t, u32x4 (&ks_)[2], u32x4& vs_) {
        const int tk = tile_tok(t);
#pragma unroll
        for (int i = 0; i < 2; ++i) { const int ch = tid + 512 * i; if (ch < 64 * NCH) { const int r = ch / NCH, c8 = ch % NCH; ks_[i] = *(const u32x4*)(a.K + (size_t)(tk + r) * a.k_pitch + a.k_col0 + 8 * c8); } }
        { const int r = tid >> 3, c8 = tid & 7; vs_ = *(const u32x4*)(a.Vt + (size_t)(a.vt_row0 + r) * MT + tk + 8 * c8); }
    };
    auto l_store = [&](int b, const u32x4 (&ks_)[2], const u32x4& vs_) {
        LAS unsigned char* kb = lds + b * BUF; LAS unsigned char* vb = kb + KT_BYTES;
#pragma unroll
        for (int i = 0; i < 2; ++i) { const int ch = tid + 512 * i; if (ch < 64 * NCH) { const int r = ch / NCH, c8 = ch % NCH; *(LAS u32x4*)(kb + r * (KP * 2) + 16 * c8) = ks_[i]; } }
        { const int r = tid >> 3, c8 = tid & 7; LAS u32x2* d = (LAS u32x2*)(vb + r * (VP * 2) + 16 * c8); u32x2 lo, hi2; lo.x = vs_.x; lo.y = vs_.y; hi2.x = vs_.z; hi2.y = vs_.w; d[0] = lo; d[1] = hi2; }
    };
    __syncthreads();
    g_load(0, kst[0], vst[0]); if (NT > 1) g_load(1, kst[1], vst[1]);
    l_store(0, kst[0], vst[0]);
    __syncthreads();
    auto tile = [&](int t) {

        const int b = t & 1;
        LAS unsigned char* kb = lds + b * BUF; LAS unsigned char* vb = kb + KT_BYTES;
        f32x16 s0, s1;
        const float negm = -m;
#pragma unroll
        for (int r = 0; r < 16; ++r) { s0[r] = negm; s1[r] = negm; }
        bf16x8 kf0[NKS], kf1[NKS];
#pragma unroll
        for (int ks = 0; ks < NKS; ++ks) { kf0[ks] = *(const LAS bf16x8*)(kb + c * (KP * 2) + 32 * ks + 16 * hi); kf1[ks] = *(const LAS bf16x8*)(kb + (32 + c) * (KP * 2) + 32 * ks + 16 * hi); }
        asm volatile("s_waitcnt lgkmcnt(0)" ::: "memory"); __builtin_amdgcn_sched_barrier(0);
        bf16x8 vf0[2][2], vf1[2][2];
#pragma unroll
        for (int kt = 0; kt < 2; ++kt)
#pragma unroll
            for (int s2 = 0; s2 < 2; ++s2) {
                const int ko = (32 * kt + 16 * s2 + 4 * hi) * 2;
                const LAS unsigned char* v0p = vb + c * (VP * 2) + ko; const LAS unsigned char* v1p = vb + (32 + c) * (VP * 2) + ko;
                vf0[kt][s2] = mk_frag(*(const LAS u32x2*)v0p, *(const LAS u32x2*)(v0p + 16));
                vf1[kt][s2] = mk_frag(*(const LAS u32x2*)v1p, *(const LAS u32x2*)(v1p + 16));
            }
#pragma unroll
        for (int ks = 0; ks < NKS; ++ks) { s0 = mfma32(kf0[ks], qf[ks], s0); s1 = mfma32(kf1[ks], qf[ks], s1); }
        if (MASK && t >= a.seg_nt0) {
            const int qpos = a.qpos0 + qi, kbase = a.kpos0 + 64 * (t - a.seg_nt0);
#pragma unroll
            for (int r = 0; r < 16; ++r) { const int k0p = kbase + crow(r, hi), d0 = qpos - k0p, d1 = d0 - 32;
                if (d0 > 128 || d0 < -128) s0[r] = -1e30f; if (d1 > 128 || d1 < -128) s1[r] = -1e30f; }
        }
        float mx = s0[0];
#pragma unroll
        for (int r = 1; r < 16; ++r) mx = fmaxf(mx, s0[r]);
#pragma unroll
        for (int r = 0; r < 16; ++r) mx = fmaxf(mx, s1[r]);
        mx = xor32_max(mx);
        if (t == 0 || __builtin_amdgcn_ballot_w64(mx > 6.f) != 0ull) {
            const float delta = (t == 0) ? fmaxf(mx, -64.f) : fmaxf(mx, 0.f), alpha = __builtin_amdgcn_exp2f(-delta);
            m += delta; l *= alpha;
#pragma unroll
            for (int r = 0; r < 16; ++r) { o0[r] *= alpha; o1[r] *= alpha; s0[r] -= delta; s1[r] -= delta; }
        }
        float ls = 0.f;
#pragma unroll
        for (int r = 0; r < 16; ++r) { s0[r] = __builtin_amdgcn_exp2f(s0[r]); s1[r] = __builtin_amdgcn_exp2f(s1[r]); ls += s0[r] + s1[r]; }
        ls = xor32_sum(ls);
        l += ls;
        bf16x8 pf[2][2];
#pragma unroll
        for (int s2 = 0; s2 < 2; ++s2) {
            pf[0][s2] = mk_frag4(cvtpk(s0[8 * s2 + 0], s0[8 * s2 + 1]), cvtpk(s0[8 * s2 + 2], s0[8 * s2 + 3]), cvtpk(s0[8 * s2 + 4], s0[8 * s2 + 5]), cvtpk(s0[8 * s2 + 6], s0[8 * s2 + 7]));
            pf[1][s2] = mk_frag4(cvtpk(s1[8 * s2 + 0], s1[8 * s2 + 1]), cvtpk(s1[8 * s2 + 2], s1[8 * s2 + 3]), cvtpk(s1[8 * s2 + 4], s1[8 * s2 + 5]), cvtpk(s1[8 * s2 + 6], s1[8 * s2 + 7]));
        }
#pragma unroll
        for (int kt = 0; kt < 2; ++kt)
#pragma unroll
            for (int s2 = 0; s2 < 2; ++s2) { o0 = mfma32(vf0[kt][s2], pf[kt][s2], o0); o1 = mfma32(vf1[kt][s2], pf[kt][s2], o1); }
    };
    for (int t = 0; t < NT; t += 2) {
        if (t + 2 < NT) g_load(t + 2, kst[0], vst[0]);
        TIC(30); tile(t); TOC(30);
        TIC(31); l_store(1, kst[1], vst[1]); TOC(31);
        __syncthreads();
        if (t + 3 < NT) g_load(t + 3, kst[1], vst[1]);
        TIC(30); tile(t + 1); TOC(30);
        TIC(31); if (t + 2 < NT) l_store(0, kst[0], vst[0]); TOC(31);
        __syncthreads();
    }
    const float inv = __builtin_amdgcn_rcpf(l);
    bf16_t* op = a.O + (size_t)(a.q_row0 + qi) * D + a.o_col0;
#pragma unroll
    for (int g = 0; g < 4; ++g) {
        u32x2 w0, w1;
        w0.x = cvtpk(o0[4 * g] * inv, o0[4 * g + 1] * inv); w0.y = cvtpk(o0[4 * g + 2] * inv, o0[4 * g + 3] * inv);
        w1.x = cvtpk(o1[4 * g] * inv, o1[4 * g + 1] * inv); w1.y = cvtpk(o1[4 * g + 2] * inv, o1[4 * g + 3] * inv);
        *(u32x2*)(op + 8 * g + 4 * hi) = w0; *(u32x2*)(op + 32 + 8 * g + 4 * hi) = w1;
    }
}

__device__ __forceinline__ void attn_dispatch(KArg p, const Ctx& C, int l, int u) {
    unsigned char* ws = p->ws;
    AttnArgs a;
    a.tab32 = (const float*)(ws + WS_TAB) + 2048; a.O = (bf16_t*)(ws + WS_MIX);
    if (u < 256 || (u >= 512 && u < 528)) {
        const bool ctxq = u >= 512; const int v = ctxq ? u - 512 : u;
        const int b = ctxq ? (v >> 2) : (v >> 6), h = ctxq ? (v & 3) : ((v >> 4) & 3), qb = ctxq ? 0 : (v & 15);
        a.Q = (const bf16_t*)(ws + WS_QRAW); a.q_pitch = 384; a.q_col0 = 96 * h; a.q_row0 = ctxq ? 256 * b : MC + 4096 * b + 256 * qb;
        a.K = (const bf16_t*)(ws + WS_KFULL); a.k_pitch = 384; a.k_col0 = 96 * h; a.Vt = (const bf16_t*)(ws + WS_VTM); a.vt_row0 = 64 * h;
        a.seg_tok0 = 256 * b; a.seg_nt0 = 4; a.seg_tok1 = MC + 4096 * b; a.seg_nt1 = ctxq ? 0 : 64; a.qpos0 = 0; a.kpos0 = 0;
        a.m_init = 0.f; a.l_init = 0.f; a.qscale = 0.10206207261596575f * LOG2E; a.o_col0 = 512 + 64 * h; a.qt0 = 256 * qb;
        if (ctxq) attn_unit<96, false, false>(C, a); else attn_unit<96, false, true>(C, a);
    } else {
        const bool ctxq = u >= 528; const int v = ctxq ? u - 528 : u - 256;
        const int b = ctxq ? (v >> 2) : (v >> 6), hq = ctxq ? (v & 3) : ((v >> 4) & 3), qb = ctxq ? 0 : (v & 15), g = hq >> 1;
        a.Q = (const bf16_t*)(ws + WS_QS); a.q_pitch = 256; a.q_col0 = 64 * hq; a.q_row0 = ctxq ? 256 * b : MC + 4096 * b + 256 * qb;
        a.K = (const bf16_t*)(ws + WS_KS); a.k_pitch = 128; a.k_col0 = 64 * g; a.Vt = (const bf16_t*)(ws + WS_VTS); a.vt_row0 = 64 * g;
        const int q0 = 256 * qb, ks = q0 - 128 < 0 ? 0 : q0 - 128, ke = q0 + 384 > SEQ ? SEQ : q0 + 384;
        a.seg_tok0 = 256 * b; a.seg_nt0 = 4; a.seg_tok1 = MC + 4096 * b + ks; a.seg_nt1 = ctxq ? 0 : (ke - ks) >> 6; a.qpos0 = q0; a.kpos0 = ks;
        a.m_init = p->in[I_SINK][l * 4 + hq] * LOG2E; a.l_init = 1.f; a.qscale = 1.f; a.o_col0 = 64 * hq; a.qt0 = 0;
        if (ctxq) attn_unit<64, false, false>(C, a); else attn_unit<64, true, false>(C, a);
    }
}

template <class FA, class FB>
__device__ __forceinline__ f32x16 lds_mma64(int lane, FA fa, FB fb) {
    const int c = lane & 31, hi = lane >> 5;
    f32x16 acc;
#pragma unroll
    for (int r = 0; r < 16; ++r) acc[r] = 0.f;
#pragma unroll
    for (int s = 0; s < 4; ++s) {
        float av[8], bv[8];
#pragma unroll
        for (int j = 0; j < 8; ++j) { const int k = 16 * s + 8 * hi + j; av[j] = fa(c, k); bv[j] = fb(k, c); }
        acc = mfma32(mk_frag4(cvtpk(av[0], av[1]), cvtpk(av[2], av[3]), cvtpk(av[4], av[5]), cvtpk(av[6], av[7])),
                     mk_frag4(cvtpk(bv[0], bv[1]), cvtpk(bv[2], bv[3]), cvtpk(bv[4], bv[5]), cvtpk(bv[6], bv[7])), acc);
    }
    return acc;
}
__device__ __forceinline__ void frag_store(unsigned char* base, int r, int c8, u32x4 o) {
#pragma unroll
    for (int g = 0; g < 2; ++g) { const int g4 = 2 * c8 + g, T = g4 >> 3, rem = g4 & 7, ks = rem >> 2, jh = (rem >> 1) & 1, hi = rem & 1;
        u32x2 w; w.x = g ? o.z : o.x; w.y = g ? o.w : o.y;
        *(u32x2*)(base + (size_t)(((((r >> 5) * 2 + T) * 2 + ks) * 64 + (r & 31) + 32 * hi) * 16 + 8 * jh)) = w; }
}
__device__ __forceinline__ void lds_barrier() { asm volatile("s_waitcnt lgkmcnt(0)" ::: "memory"); __builtin_amdgcn_s_barrier(); asm volatile("" ::: "memory"); }
__device__ __forceinline__ int su_index(int d, int b, int h, int cg) {
    const int s = cg < 4 ? (d ? 3 - cg : cg) : 4 + (d ? 63 - (cg - 4) : (cg - 4));
    return ((d * 4 + b) * 4 + h) * 68 + s;
}
#ifndef PREP_IN_GDN
#define PREP_IN_GDN 0
#endif
#ifndef GSECT
#define GSECT 0
#endif
constexpr int XP = 65;

template <int I>
__device__ __forceinline__ void solve_rows(float (&x)[64], f32x4 (&Lc)[8], f32x4 (&Ln)[8], const LAS float* Ld) {
    if constexpr (I < 64) {
        f32x4 Lt[8];
#pragma unroll
        for (int q = 8; q < 16; ++q) if (4 * q < I) Lt[q - 8] = *(const LAS f32x4*)(Ld + I * 68 + 4 * q);
        if constexpr (I + 1 < 64) {
#pragma unroll
            for (int q = 0; q < 8; ++q) if (4 * q < I + 1) Ln[q] = *(const LAS f32x4*)(Ld + (I + 1) * 68 + 4 * q);
        }
        float s0 = 0.f, s1 = 0.f, s2 = 0.f, s3 = 0.f;
#pragma unroll
        for (int q = 0; q < 16; ++q) if (4 * q < I) { const f32x4 lv = q < 8 ? Lc[q & 7] : Lt[q & 7];
            s0 += lv.x * x[4 * q]; if (4 * q + 1 < I) s1 += lv.y * x[4 * q + 1]; if (4 * q + 2 < I) s2 += lv.z * x[4 * q + 2]; if (4 * q + 3 < I) s3 += lv.w * x[4 * q + 3]; }
        x[I] -= (s0 + s1) + (s2 + s3);
        solve_rows<I + 1>(x, Ln, Lc, Ld);
    }
}
__device__ __forceinline__ void gdn_chunk_unit(KArg p, const Ctx& C, int l, int b, int h, int cg, int ug) {
    unsigned char* ws = p->ws; const bf16_t* P = (const bf16_t*)(ws + WS_P);
    int tid_l = C.tid; asm volatile("" : "+v"(tid_l));
    const int tid = tid_l, lane = tid & 63, w = __builtin_amdgcn_readfirstlane(tid >> 6);
    LAS float* xq = (LAS float*)C.lds; LAS float* xk = xq + 64 * XP; LAS float* xv = xk + 64 * XP;
    LAS float* KK = xv + 64 * XP; LAS float* QK = KK + 64 * XP;
    LAS float* Lm = QK + 64 * XP;
    LAS float* gcs = Lm + 2 * 64 * 68; LAS float* bts = gcs + 128; LAS float* egs = bts + 128; LAS float* cw = egs + 128;
    LAS float* raw = KK;
    LAS float* Wst = KK;
    const int seq0 = cg < 4 ? 256 * b : MC + 4096 * b, seqlen = cg < 4 ? 256 : 4096, t0 = cg < 4 ? 64 * cg : 64 * (cg - 4);
    bf16_t ab_a = 0, ab_b = 0;
    if (w < 2) { const int tau = w ? 63 - lane : lane; const bf16_t* pr = P + (size_t)(seq0 + t0 + tau) * DINP + PC_BAB + w * 8 + h; ab_a = pr[0]; ab_b = pr[4]; }
    lds_barrier();
    TIC(1);
    for (int rr1 = 0; rr1 < ((GSECT == 1) ? 2 : 1); ++rr1) {
    if (rr1) lds_barrier();
    TIC(41);
    {
        u32x4 rv[4]; float cwv[2];
#pragma unroll
        for (int k = 0; k < 4; ++k) { const int it = tid + NTHR * k; const int r = it / 24, ch = it % 24, t = t0 - 2 + r; const int part = ch >> 3, c8 = ch & 7;
            rv[k].x = rv[k].y = rv[k].z = rv[k].w = 0u;
            if (it < 68 * 24 && t >= 0 && t < seqlen) rv[k] = *(const u32x4*)(P + (size_t)(seq0 + t) * DINP + PC_BQKV + 256 * part + 64 * h + 8 * c8); }
#pragma unroll
        for (int k = 0; k < 2; ++k) { const int it = tid + NTHR * k; const int j = it / 192, cc = it % 192; cwv[k] = (it < 5 * 192) ? p->in[I_GCONV][((size_t)l * 5 + j) * 768 + 256 * (cc >> 6) + 64 * h + (cc & 63)] : 0.f; }
#pragma unroll
        for (int k = 0; k < 4; ++k) { const int it = tid + NTHR * k; if (it < 68 * 24) { const int r = it / 24, ch = it % 24; const int part = ch >> 3, c8 = ch & 7; const u32x4 v = rv[k];
            LAS float* d = raw + r * 192 + 64 * part + 8 * c8;
            d[0] = bf_lo(v.x); d[1] = bf_hi(v.x); d[2] = bf_lo(v.y); d[3] = bf_hi(v.y); d[4] = bf_lo(v.z); d[5] = bf_hi(v.z); d[6] = bf_lo(v.w); d[7] = bf_hi(v.w); } }
#pragma unroll
        for (int k = 0; k < 2; ++k) { const int it = tid + NTHR * k; if (it < 5 * 192) cw[it] = cwv[k]; }
    }
    lds_barrier();
    TOC(41); TIC(42);
    if (tid < 384) {
        const int cc = tid % 192, th = tid / 192; LAS float* dst = (cc < 64) ? xq : (cc < 128 ? xk : xv);
        float wj[5], rw[36];
#pragma unroll
        for (int j = 0; j < 5; ++j) wj[j] = cw[j * 192 + cc];
#pragma unroll
        for (int r = 0; r < 36; ++r) rw[r] = raw[(32 * th + r) * 192 + cc];
#pragma unroll
        for (int t = 0; t < 32; ++t) { float y = rw[t] * wj[0];
#pragma unroll
            for (int j = 1; j < 5; ++j) y += rw[t + j] * wj[j];
            dst[(32 * th + t) * XP + (cc & 63)] = silu_f(y); }
    }
    lds_barrier();
    TOC(42); TIC(43);
    {
        const int mat = tid >> 8, r = (tid >> 2) & 63, q4 = tid & 3; LAS float* m = (mat ? xk : xq) + r * XP + 16 * q4; float v[16]; float ss = 0.f;
#pragma unroll
        for (int k = 0; k < 16; ++k) { v[k] = m[k]; ss += v[k] * v[k]; }
        ss = quad_sum(ss);
        const float sc = rsqrtf(ss + EPS) * (mat ? 1.f : 0.125f);
#pragma unroll
        for (int k = 0; k < 16; ++k) m[k] = v[k] * sc;
    }
    lds_barrier();
    TOC(43); TIC(44);
    {
        const int mat = w >> 2, rt = (w >> 1) & 1, ct = w & 1; LAS float* Am = mat ? xq : xk;
        const f32x16 acc = lds_mma64(lane, [&](int r, int k) { return Am[(32 * rt + r) * XP + k]; }, [&](int k, int c2) { return xk[(32 * ct + c2) * XP + k]; });
        LAS float* Om = mat ? QK : KK;
#pragma unroll
        for (int r = 0; r < 16; ++r) Om[(32 * rt + crow(r, lane >> 5)) * XP + 32 * ct + (lane & 31)] = acc[r];
    }
    }
    TOC(1); TIC(2);
    for (int rr2 = 0; rr2 < ((GSECT == 2) ? 2 : 1); ++rr2) {
    if (rr2) lds_barrier();
    TOC(44);
    TIC(48);
    if (w < 2) {
        const int d = w;
        const float a = bf2f(ab_a), bt = bf2f(ab_b);
        float g = -__expf(p->in[I_GALOG][(l * 2 + d) * 4 + h]) * softplus_f(a + p->in[I_GDTB][(l * 2 + d) * 4 + h]);
#pragma unroll
        for (int o = 1; o < 64; o <<= 1) { const float n = __shfl_up(g, o); if (lane >= o) g += n; }
        gcs[d * 64 + lane] = g; bts[d * 64 + lane] = sigmoid_f(bt); egs[d * 64 + lane] = __expf(g);
        if (lane == 63) ((float*)(ws + WS_DEC))[su_index(d, b, h, cg)] = __expf(g);
    }
    lds_barrier();
    TOC(48); TIC(49);
    {
        const int j = tid & 63, wq = tid >> 6;
#pragma unroll
        for (int d = 0; d < 2; ++d) { const int tj = d ? 63 - j : j; const float gj = gcs[d * 64 + j];
            float kkv[8], bi[8], gi[8];
#pragma unroll
            for (int k = 0; k < 8; ++k) { const int i = wq + 8 * k, ti = d ? 63 - i : i; kkv[k] = KK[ti * XP + tj]; bi[k] = bts[d * 64 + i]; gi[k] = gcs[d * 64 + i]; }
#pragma unroll
            for (int k = 0; k < 8; ++k) { const int i = wq + 8 * k; Lm[(d * 64 + i) * 68 + j] = (j < i) ? bi[k] * kkv[k] * __expf(gi[k] - gj) : 0.f; } }
    }
    TOC(49); TIC(50);
#pragma unroll
    for (int d = 0; d < 2; ++d) {
        unsigned char* rec = ws + WS_RECG + (size_t)su_index(d, b, h, cg) * REC_G_BYTES; const LAS float* gc = gcs + d * 64;
        const int r = tid >> 3, c8 = tid & 7, it_ = d ? 63 - r : r;
        { float v[8];
#pragma unroll
          for (int j = 0; j < 8; ++j) { const int i = 8 * c8 + j, ti = d ? 63 - i : i; v[j] = xk[ti * XP + r] * __expf(gc[63] - gc[i]); }
          u32x4 o; o.x = cvtpk(v[0], v[1]); o.y = cvtpk(v[2], v[3]); o.z = cvtpk(v[4], v[5]); o.w = cvtpk(v[6], v[7]); *(u32x4*)(rec + REC_G_KDT + (r * 64 + 8 * c8) * 2) = o; }
        { const float e = egs[d * 64 + it_]; float v[8];
#pragma unroll
          for (int j = 0; j < 8; ++j) v[j] = xq[r * XP + 8 * c8 + j] * e;
          u32x4 o; o.x = cvtpk(v[0], v[1]); o.y = cvtpk(v[2], v[3]); o.z = cvtpk(v[4], v[5]); o.w = cvtpk(v[6], v[7]); frag_store(rec + REC_G_QG, r, c8, o); }
        { float v[8];
#pragma unroll
          for (int j = 0; j < 8; ++j) { const int i = 8 * c8 + j, ti = d ? 63 - i : i; v[j] = (it_ >= i) ? QK[r * XP + ti] * __expf(gc[it_] - gc[i]) : 0.f; }
          u32x4 o; o.x = cvtpk(v[0], v[1]); o.y = cvtpk(v[2], v[3]); o.z = cvtpk(v[4], v[5]); o.w = cvtpk(v[6], v[7]); frag_store(rec + REC_G_ATT, r, c8, o); }
    }
    }
    TOC(50);
    lds_barrier();
    TOC(2); TIC(3);
    for (int rr3 = 0; rr3 < ((GSECT == 3) ? 2 : 1); ++rr3) {
    if (PREP_IN_GDN && tid >= 256) {
        prep_rows4(p, lane, l, 16 * ug + 4 * (w - 4));
    }
    if (tid < 256) {
        const int d = tid >> 7, col = tid & 127; const LAS float* Ld = Lm + d * 64 * 68; const LAS float* bt = bts + d * 64; const LAS float* eg = egs + d * 64;
        TIC(45);
        float x[64];
        {
            const LAS float* src = (col < 64) ? xv + col : xk + (col - 64);
#pragma unroll
            for (int i = 0; i < 64; ++i) { const int ti = d ? 63 - i : i; x[i] = src[ti * XP]; }
#pragma unroll
            for (int i4 = 0; i4 < 16; ++i4) { f32x4 bq = *(const LAS f32x4*)(bt + 4 * i4);
                if (col >= 64) bq *= *(const LAS f32x4*)(eg + 4 * i4);
                x[4 * i4] *= bq.x; x[4 * i4 + 1] *= bq.y; x[4 * i4 + 2] *= bq.z; x[4 * i4 + 3] *= bq.w; }
        }
        TOC(45); TIC(46);
        f32x4 La[8], Lb[8];
        La[0] = *(const LAS f32x4*)(Ld + 1 * 68);
        solve_rows<1>(x, La, Lb, Ld);
        TOC(46); TIC(47);
        unsigned char* rec = ws + WS_RECG + (size_t)su_index(d, b, h, cg) * REC_G_BYTES;
        if (col < 64) {
#pragma unroll
            for (int i4 = 0; i4 < 16; ++i4) { f32x4 o; o.x = x[4 * i4]; o.y = x[4 * i4 + 1]; o.z = x[4 * i4 + 2]; o.w = x[4 * i4 + 3]; *(f32x4*)(rec + REC_G_UT + (col * 64 + 4 * i4) * 4) = o; }
        } else {
#pragma unroll
            for (int i = 0; i < 64; ++i) Wst[(d * 64 + i) * XP + col - 64] = x[i];
        }
    }
    }
    lds_barrier();
#pragma unroll
    for (int d = 0; d < 2; ++d) { const int r = tid >> 3, c8 = tid & 7;
        unsigned char* rec = ws + WS_RECG + (size_t)su_index(d, b, h, cg) * REC_G_BYTES;
        u32x4 o; const LAS float* s = Wst + (d * 64 + r) * XP + 8 * c8; o.x = cvtpk(s[0], s[1]); o.y = cvtpk(s[2], s[3]); o.z = cvtpk(s[4], s[5]); o.w = cvtpk(s[6], s[7]);
        *(u32x4*)(rec + REC_G_W + (r * 64 + 8 * c8) * 2) = o; }
    TOC(3);
}

__device__ __forceinline__ void ret_chunk_unit(KArg p, const Ctx& C, int l, int b, int h, int cg) {
    unsigned char* ws = p->ws; const bf16_t* P = (const bf16_t*)(ws + WS_P); const float* tab = (const float*)(ws + WS_TAB);
    int tid_l = C.tid; asm volatile("" : "+v"(tid_l));
    const int tid = tid_l, lane = tid & 63, w = __builtin_amdgcn_readfirstlane(tid >> 6);
    LAS float* xq = (LAS float*)C.lds; LAS float* xk = xq + 64 * XP; LAS float* xv = xk + 64 * XP; LAS float* QK = xv + 64 * XP;
    const bool lat = cg >= 4;
    const int seq0 = lat ? MC + 4096 * b : 256 * b, t0 = lat ? 64 * (cg - 4) : 64 * cg;
    lds_barrier();
    TIC(51);
    {
        const int mat = tid >> 8, r = (tid >> 2) & 63, part = (tid >> 1) & 1, jq = tid & 1; const int t = t0 + r;
        const bf16_t* pr = P + (size_t)(seq0 + t) * DINP + (mat ? PC_DK : PC_DQ) + 64 * h + 32 * part + 8 * jq;
        const u32x4 va = *(const u32x4*)pr, vb = *(const u32x4*)(pr + 16);
        const int ps = lat ? (part ? (t & 63) : (t >> 6)) : 0;
        const f32x4 c0 = *(const f32x4*)(tab + ps * 16 + 8 * jq), c1 = *(const f32x4*)(tab + ps * 16 + 8 * jq + 4), s0 = *(const f32x4*)(tab + 1024 + ps * 16 + 8 * jq), s1 = *(const f32x4*)(tab + 1024 + ps * 16 + 8 * jq + 4);
        const float av[8] = {bf_lo(va.x), bf_hi(va.x), bf_lo(va.y), bf_hi(va.y), bf_lo(va.z), bf_hi(va.z), bf_lo(va.w), bf_hi(va.w)};
        const float bv[8] = {bf_lo(vb.x), bf_hi(vb.x), bf_lo(vb.y), bf_hi(vb.y), bf_lo(vb.z), bf_hi(vb.z), bf_lo(vb.w), bf_hi(vb.w)};
        const float cc[8] = {c0.x, c0.y, c0.z, c0.w, c1.x, c1.y, c1.z, c1.w}, ss[8] = {s0.x, s0.y, s0.z, s0.w, s1.x, s1.y, s1.z, s1.w};
        const float sc = mat ? 0.125f : 1.f; LAS float* m = (mat ? xk : xq) + r * XP + 32 * part + 8 * jq;
#pragma unroll
        for (int i = 0; i < 8; ++i) { m[i] = (av[i] * cc[i] - bv[i] * ss[i]) * sc; m[16 + i] = (bv[i] * cc[i] + av[i] * ss[i]) * sc; }
    }
    { const int r = tid >> 3, c8 = tid & 7; const u32x4 v = *(const u32x4*)(P + (size_t)(seq0 + t0 + r) * DINP + PC_DV + 64 * h + 8 * c8); LAS float* d = xv + r * XP + 8 * c8;
      d[0] = bf_lo(v.x); d[1] = bf_hi(v.x); d[2] = bf_lo(v.y); d[3] = bf_hi(v.y); d[4] = bf_lo(v.z); d[5] = bf_hi(v.z); d[6] = bf_lo(v.w); d[7] = bf_hi(v.w); }
    lds_barrier();
    TOC(51); TIC(52);
    if (w < 4) { const int rt = w >> 1, ct = w & 1;
        const f32x16 acc = lds_mma64(lane, [&](int r, int k) { return xq[(32 * rt + r) * XP + k]; }, [&](int k, int c2) { return xk[(32 * ct + c2) * XP + k]; });
#pragma unroll
        for (int r = 0; r < 16; ++r) QK[(32 * rt + crow(r, lane >> 5)) * XP + 32 * ct + (lane & 31)] = acc[r]; }
    lds_barrier();
    TOC(52); TIC(53);
    {
        const int d = w >> 2, T = (w >> 1) & 1, ct = w & 1; const float lg = -__expf(p->in[I_RLOGD][(l * 2 + d) * 4 + h]);
        const f32x16 acc = lds_mma64(lane, [&](int r, int k) { const int ti = d ? 63 - k : k; return xk[ti * XP + 32 * T + r] * __expf(lg * (float)(63 - k)); },
                                           [&](int k, int c2) { const int ti = d ? 63 - k : k; return xv[ti * XP + 32 * ct + c2]; });
        float* kv = (float*)(ws + WS_RECR + (size_t)su_index(d, b, h, cg) * REC_R_BYTES + REC_R_KV);
#pragma unroll
        for (int r = 0; r < 16; ++r) kv[(32 * T + crow(r, lane >> 5)) * 64 + 32 * ct + (lane & 31)] = acc[r];
    }
    TOC(53); TIC(54);
    for (int d = 0; d < 2; ++d) {
        unsigned char* rec = ws + WS_RECR + (size_t)su_index(d, b, h, cg) * REC_R_BYTES; const float lg = -__expf(p->in[I_RLOGD][(l * 2 + d) * 4 + h]);
        const int r = tid >> 3, c8 = tid & 7, it_ = d ? 63 - r : r;
        { const float e = __expf(lg * (float)(it_ + 1)); float v[8];
#pragma unroll
          for (int j = 0; j < 8; ++j) v[j] = xq[r * XP + 8 * c8 + j] * e;
          u32x4 o; o.x = cvtpk(v[0], v[1]); o.y = cvtpk(v[2], v[3]); o.z = cvtpk(v[4], v[5]); o.w = cvtpk(v[6], v[7]); frag_store(rec + REC_R_QG, r, c8, o); }
        { float v[8];
#pragma unroll
          for (int j = 0; j < 8; ++j) { const int i = 8 * c8 + j, ti = d ? 63 - i : i; v[j] = (it_ >= i) ? QK[r * XP + ti] * __expf(lg * (float)(it_ - i)) : 0.f; }
          u32x4 o; o.x = cvtpk(v[0], v[1]); o.y = cvtpk(v[2], v[3]); o.z = cvtpk(v[4], v[5]); o.w = cvtpk(v[6], v[7]); frag_store(rec + REC_R_ATT, r, c8, o); }
        { const int ln = tid & 63, s = (tid >> 6) & 1, T = (tid >> 7) & 1, ct = tid >> 8; float v[8];
#pragma unroll
          for (int j = 0; j < 8; ++j) { const int i = 32 * T + 16 * s + 8 * (j >> 2) + 4 * (ln >> 5) + (j & 3), ti = d ? 63 - i : i; v[j] = xv[ti * XP + 32 * ct + (ln & 31)]; }
          u32x4 o; o.x = cvtpk(v[0], v[1]); o.y = cvtpk(v[2], v[3]); o.z = cvtpk(v[4], v[5]); o.w = cvtpk(v[6], v[7]); *(u32x4*)(rec + REC_R_VF + (size_t)tid * 16) = o; }
    }
    TOC(54);
}

__device__ __forceinline__ void gdn_scan_chain(KArg p, const Ctx& C, int chain) {
    unsigned char* ws = p->ws; const int lane = C.lane, w = C.wave, c = lane & 31, hi = lane >> 5;
    constexpr int WP = 68, UP = 68, SB_W = 0, SB_K = 64 * WP * 2, SB_U = 2 * 64 * WP * 2, SB_D = SB_U + 64 * UP * 4, SBUF = SB_D + 16, NSLOT = 4, FL = NSLOT * SBUF;
    LAS unsigned char* lds = C.lds;
    volatile LAS unsigned* full = (volatile LAS unsigned*)(lds + FL); volatile LAS unsigned* done = full + NSLOT;
    __syncthreads();
    if (C.tid < 2 * NSLOT) full[C.tid] = 0u;
    __syncthreads();
    if (w >= 2) {
        const float* DEC = (const float*)(ws + WS_DEC);
        for (int s = w - 2; s < 68; s += 6) {
            const int slot = s & (NSLOT - 1); LAS unsigned char* sb = lds + slot * SBUF;
            const unsigned char* rec = ws + WS_RECG + (size_t)(chain * 68 + s) * REC_G_BYTES;
            u32x4 R[32];
#pragma unroll
            for (int i = 0; i < 32; ++i) R[i] = *(const u32x4*)(rec + (size_t)(lane + 64 * i) * 16);
            const float dr = DEC[chain * 68 + s];
            { const unsigned need = 2u * (unsigned)(s >> 2); unsigned sp = 0; while (done[slot] < need && ++sp < (1u << 22)) __builtin_amdgcn_s_sleep(1); }
            asm volatile("" ::: "memory");
#pragma unroll
            for (int i = 0; i < 32; ++i) { const int ch = lane + 64 * i; u32x2 lo, h2; lo.x = R[i].x; lo.y = R[i].y; h2.x = R[i].z; h2.y = R[i].w;
                if (i < 8) { const int r = ch >> 3, c8 = ch & 7; LAS u32x2* d = (LAS u32x2*)(sb + SB_W + r * (WP * 2) + 16 * c8); d[0] = lo; d[1] = h2; }
                else if (i < 24) { const int q = ch - 512, r = q >> 4, c4 = q & 15; *(LAS u32x4*)(sb + SB_U + r * (UP * 4) + 16 * c4) = R[i]; }
                else { const int q = ch - 1536, r = q >> 3, c8 = q & 7; LAS u32x2* d = (LAS u32x2*)(sb + SB_K + r * (WP * 2) + 16 * c8); d[0] = lo; d[1] = h2; } }
            if (lane == 0) *(LAS float*)(sb + SB_D) = dr;
            asm volatile("s_waitcnt lgkmcnt(0)" ::: "memory");
            if (lane == 0) full[slot] = (unsigned)(s + 1);
        }
    } else {
        const int ct = w;
        f32x16 S0, S1;
#pragma unroll
        for (int r = 0; r < 16; ++r) { S0[r] = 0.f; S1[r] = 0.f; }
        for (int s = 0; s < 68; ++s) {
            const int slot = s & (NSLOT - 1); LAS unsigned char* sb = lds + slot * SBUF;
            unsigned char* rec = ws + WS_RECG + (size_t)(chain * 68 + s) * REC_G_BYTES;
            TIC(24);
            { unsigned sp = 0; while (full[slot] != (unsigned)(s + 1) && ++sp < (1u << 22)) __builtin_amdgcn_s_sleep(1); }
            TOC(24);
            asm volatile("" ::: "memory");
            bf16x8 wf[2][2][2], kf[2][2][2]; f32x4 uf[2][4];
#pragma unroll
            for (int Ti = 0; Ti < 2; ++Ti)
#pragma unroll
                for (int T = 0; T < 2; ++T)
#pragma unroll
                    for (int ks = 0; ks < 2; ++ks) { const LAS unsigned char* ap = sb + SB_W + (32 * Ti + c) * (WP * 2) + (32 * T + 16 * ks + 4 * hi) * 2;
                        wf[Ti][T][ks] = mk_frag(*(const LAS u32x2*)ap, *(const LAS u32x2*)(ap + 16)); }
#pragma unroll
            for (int Ti = 0; Ti < 2; ++Ti)
#pragma unroll
                for (int g = 0; g < 4; ++g) uf[Ti][g] = *(const LAS f32x4*)(sb + SB_U + (32 * ct + c) * (UP * 4) + (32 * Ti + 8 * g + 4 * hi) * 4);
#pragma unroll
            for (int T = 0; T < 2; ++T)
#pragma unroll
                for (int Ti = 0; Ti < 2; ++Ti)
#pragma unroll
                    for (int ks = 0; ks < 2; ++ks) { const LAS unsigned char* a0 = sb + SB_K + (32 * T + c) * (WP * 2) + (32 * Ti + 16 * ks + 4 * hi) * 2;
                        kf[T][Ti][ks] = mk_frag(*(const LAS u32x2*)a0, *(const LAS u32x2*)(a0 + 16)); }
            const float dec = *(const LAS float*)(sb + SB_D);
            asm volatile("s_waitcnt lgkmcnt(0)" ::: "memory"); __builtin_amdgcn_sched_barrier(0);
            if (lane == 0) __hip_atomic_fetch_add((LAS unsigned*)(lds + FL) + NSLOT + slot, 1u, __ATOMIC_RELAXED, __HIP_MEMORY_SCOPE_WORKGROUP);
            bf16x8 sf[2][2];
#pragma unroll
            for (int ks = 0; ks < 2; ++ks) {
                sf[0][ks] = mk_frag4(cvtpk(S0[8 * ks], S0[8 * ks + 1]), cvtpk(S0[8 * ks + 2], S0[8 * ks + 3]), cvtpk(S0[8 * ks + 4], S0[8 * ks + 5]), cvtpk(S0[8 * ks + 6], S0[8 * ks + 7]));
                sf[1][ks] = mk_frag4(cvtpk(S1[8 * ks], S1[8 * ks + 1]), cvtpk(S1[8 * ks + 2], S1[8 * ks + 3]), cvtpk(S1[8 * ks + 4], S1[8 * ks + 5]), cvtpk(S1[8 * ks + 6], S1[8 * ks + 7]));
            }
            f32x16 vn[2];
#pragma unroll
            for (int Ti = 0; Ti < 2; ++Ti) {
                f32x16 acc;
#pragma unroll
                for (int r = 0; r < 16; ++r) acc[r] = 0.f;
#pragma unroll
                for (int T = 0; T < 2; ++T)
#pragma unroll
                    for (int ks = 0; ks < 2; ++ks) acc = mfma32(wf[Ti][T][ks], sf[T][ks], acc);
#pragma unroll
                for (int g = 0; g < 4; ++g) { const f32x4 u = uf[Ti][g];
                    vn[Ti][4 * g] = u.x - acc[4 * g]; vn[Ti][4 * g + 1] = u.y - acc[4 * g + 1]; vn[Ti][4 * g + 2] = u.z - acc[4 * g + 2]; vn[Ti][4 * g + 3] = u.w - acc[4 * g + 3]; }
            }
            bf16x8 vf[2][2];
#pragma unroll
            for (int Ti = 0; Ti < 2; ++Ti)
#pragma unroll
                for (int ks = 0; ks < 2; ++ks)
                    vf[Ti][ks] = mk_frag4(cvtpk(vn[Ti][8 * ks], vn[Ti][8 * ks + 1]), cvtpk(vn[Ti][8 * ks + 2], vn[Ti][8 * ks + 3]), cvtpk(vn[Ti][8 * ks + 4], vn[Ti][8 * ks + 5]), cvtpk(vn[Ti][8 * ks + 6], vn[Ti][8 * ks + 7]));
#pragma unroll
            for (int r = 0; r < 16; ++r) { S0[r] *= dec; S1[r] *= dec; }
#pragma unroll
            for (int Ti = 0; Ti < 2; ++Ti)
#pragma unroll
                for (int ks = 0; ks < 2; ++ks) { S0 = mfma32(kf[0][Ti][ks], vf[Ti][ks], S0); S1 = mfma32(kf[1][Ti][ks], vf[Ti][ks], S1); }
#pragma unroll
            for (int T = 0; T < 2; ++T)
#pragma unroll
                for (int ks = 0; ks < 2; ++ks) { *(bf16x8*)(rec + REC_G_SP + (size_t)((((ct * 2 + T) * 2 + ks) * 64 + lane) * 16)) = sf[T][ks];
                    *(bf16x8*)(rec + REC_G_VN + (size_t)((((ct * 2 + T) * 2 + ks) * 64 + lane) * 16)) = vf[T][ks]; }
        }
    }
    __syncthreads();
}
__device__ __forceinline__ void ret_scan_items(KArg p, const Ctx& C, int l, int item0, int nitems_total, int stride) {
    unsigned char* ws = p->ws;
    for (int it = item0; it < nitems_total; it += stride) {
        const int dbh = it >> 11, q = it & 2047; const int jp = q & 3, ln = (q >> 2) & 63, ks = (q >> 8) & 1, T = (q >> 9) & 1, ct = q >> 10;
        const int d = dbh >> 4, h = dbh & 3;
        const int j0 = 2 * jp, dk0 = 32 * T + 16 * ks + 8 * (j0 >> 2) + 4 * (ln >> 5) + (j0 & 3), dv = 32 * ct + (ln & 31);
        const float g64 = __expf(-__expf(p->in[I_RLOGD][(l * 2 + d) * 4 + h]) * 64.f);
        float s0 = 0.f, s1 = 0.f;
        unsigned char* rec0 = ws + WS_RECR + (size_t)(dbh * 68) * REC_R_BYTES;
        for (int s = 0; s < 68; s += 17) {
            float a[17], bq[17];
#pragma unroll
            for (int k = 0; k < 17; ++k) { const float* kv = (const float*)(rec0 + (size_t)(s + k) * REC_R_BYTES + REC_R_KV); a[k] = kv[dk0 * 64 + dv]; bq[k] = kv[(dk0 + 1) * 64 + dv]; }
#pragma unroll
            for (int k = 0; k < 17; ++k) { *(unsigned*)(rec0 + (size_t)(s + k) * REC_R_BYTES + REC_R_SP + (size_t)q * 4) = cvtpk(s0, s1); s0 = s0 * g64 + a[k]; s1 = s1 * g64 + bq[k]; }
        }
    }
}

__device__ __forceinline__ void rec_out_item(KArg p, int lane, int l, int mixer, int b, int h, int cg, int rt) {
    unsigned char* ws = p->ws; const int c = lane & 31, hi = lane >> 5;
    f32x16 acc[2];
#pragma unroll
    for (int r = 0; r < 16; ++r) { acc[0][r] = 0.f; acc[1][r] = 0.f; }
    const int row = (cg < 4 ? 256 * b + 64 * cg : MC + 4096 * b + 64 * (cg - 4)) + 32 * rt + c;
    const bf16_t* P = (const bf16_t*)(ws + WS_P) + (size_t)row * DINP + (mixer ? PC_DGATE : PC_BGATE) + 64 * h;
    u32x2 gt[2][4];
#pragma unroll
    for (int ct = 0; ct < 2; ++ct)
#pragma unroll
        for (int g = 0; g < 4; ++g) gt[ct][g] = *(const u32x2*)(P + 32 * ct + 8 * g + 4 * hi);
#pragma unroll
    for (int d = 0; d < 2; ++d) {
        const int su = su_index(d, b, h, cg);
        const unsigned char* rec = mixer ? ws + WS_RECR + (size_t)su * REC_R_BYTES : ws + WS_RECG + (size_t)su * REC_G_BYTES;
        const unsigned char* qg = rec + (mixer ? REC_R_QG : REC_G_QG); const unsigned char* at = rec + (mixer ? REC_R_ATT : REC_G_ATT);
        const unsigned char* sp = rec + (mixer ? REC_R_SP : REC_G_SP); const unsigned char* vn = rec + (mixer ? REC_R_VF : REC_G_VN);
        bf16x8 bq[4], ba[4], as_[2][4], av[2][4];
#pragma unroll
        for (int f = 0; f < 4; ++f) { const int T = f >> 1, ks = f & 1;
            const size_t ao = (size_t)((((rt * 2 + T) * 2 + ks) * 64 + lane) * 16);
            bq[f] = *(const bf16x8*)(qg + ao); ba[f] = *(const bf16x8*)(at + ao);
#pragma unroll
            for (int ct = 0; ct < 2; ++ct) { const size_t bo = (size_t)((((ct * 2 + T) * 2 + ks) * 64 + lane) * 16); as_[ct][f] = *(const bf16x8*)(sp + bo); av[ct][f] = *(const bf16x8*)(vn + bo); } }
        asm volatile("s_waitcnt vmcnt(0)" ::: "memory"); __builtin_amdgcn_sched_barrier(0);
#pragma unroll
        for (int f = 0; f < 4; ++f)
#pragma unroll
            for (int ct = 0; ct < 2; ++ct) { acc[ct] = mfma32(as_[ct][f], bq[f], acc[ct]); acc[ct] = mfma32(av[ct][f], ba[f], acc[ct]); }
    }
    float s = 0.f, ss = 0.f;
#pragma unroll
    for (int r = 0; r < 16; ++r) { s += acc[0][r] + acc[1][r]; ss += acc[0][r] * acc[0][r] + acc[1][r] * acc[1][r]; }
    s = xor32_sum(s); ss = xor32_sum(ss);
    float mu = 0.f, rs;
    if (mixer) { mu = s * (1.f / 64.f); const float var = ss * (1.f / 64.f) - mu * mu; rs = rsqrtf(fmaxf(var, 0.f) + EPS); } else rs = rsqrtf(ss * (1.f / 64.f) + EPS);
    const float* gn = mixer ? p->in[I_RNORM] + (size_t)l * 256 + 64 * h : p->in[I_GNORM] + (size_t)l * 64;
    bf16_t* dst = (bf16_t*)(ws + WS_MIX) + (size_t)row * D + (mixer ? 768 : 256) + 64 * h;
#pragma unroll
    for (int ct = 0; ct < 2; ++ct)
#pragma unroll
        for (int g = 0; g < 4; ++g) { const int dv0 = 32 * ct + 8 * g + 4 * hi;
            const u32x2 gtv = gt[ct][g]; const f32x4 gv = *(const f32x4*)(gn + dv0);
            const float y0 = (acc[ct][4 * g] - mu) * rs * gv.x * silu_f(bf_lo(gtv.x)), y1 = (acc[ct][4 * g + 1] - mu) * rs * gv.y * silu_f(bf_hi(gtv.x));
            const float y2 = (acc[ct][4 * g + 2] - mu) * rs * gv.z * silu_f(bf_lo(gtv.y)), y3 = (acc[ct][4 * g + 3] - mu) * rs * gv.w * silu_f(bf_hi(gtv.y));
            u32x2 o; o.x = cvtpk(y0, y1); o.y = cvtpk(y2, y3); *(u32x2*)(dst + dv0) = o; }
}

#ifndef ONLY_PHASE
#define ONLY_PHASE -1
#endif
#ifndef SUB3
#define SUB3 31
#endif
#ifndef DUP_K
#define DUP_K -1
#endif
#define NREP(k) ((DUP_K == (k)) ? 2 : 1)
#ifndef RET_DEAL_OLD
#define RET_DEAL_OLD 0
#endif
#ifndef DUP2
#define DUP2 0
#endif
#define PH_ON(k) (ONLY_PHASE < 0 || ONLY_PHASE == (k))
constexpr int PH_PER_LAYER = 10, PH_FINAL = 1 + PH_PER_LAYER * DEPTH, N_PHASES = PH_FINAL + 1;
__global__ void __launch_bounds__(NTHR, 2) mega_fwd(Params p_arg) {
    extern __shared__ __attribute__((aligned(16))) unsigned char lds_raw[];
    Ctx C0; C0.lds = (LAS unsigned char*)lds_raw; C0.tid = threadIdx.x; C0.lane = C0.tid & 63; C0.wave = __builtin_amdgcn_readfirstlane(C0.tid >> 6); C0.bid = blockIdx.x; C0.G = gridDim.x;
    const Ctx& C = C0;
    int lo, hi; unsigned* ctl0; { KArg p = kp_get(); lo = p->ph_lo; hi = p->ph_hi; ctl0 = (unsigned*)(p->ws + WS_CTL); }
    const bool fused = (hi - lo) > 1;
    if (C.tid < 64) ((LAS unsigned*)(C.lds + LDS_MISC))[C.tid] = 0u;
    __syncthreads();
    XcdBarrier bar; bar.bar = ctl0 + CW_BAR; bar.x = 0; bar.st = (volatile LAS unsigned*)(C.lds + LDS_MISC);
    if (fused) bar = xcd_barrier_post(ctl0 + CW_BAR, (volatile LAS unsigned*)(C.lds + LDS_MISC));
#define IN(k) (lo <= (k) && (k) < hi)
#define RET3_DENSE 384
#ifndef CV_P1
#define CV_P1 4608
#endif
#ifndef CV_P8
#define CV_P8 4608
#endif
#define RELAUNDER do { int t_ = C0.tid, b_ = C0.bid, g_ = C0.G; unsigned l_ = (unsigned)(size_t)C0.lds; asm volatile("" : "+v"(t_), "+s"(b_), "+s"(g_), "+s"(l_)); C.tid = t_; C.lane = t_ & 63; C.wave = __builtin_amdgcn_readfirstlane(t_ >> 6); C.bid = b_; C.G = g_; C.lds = (LAS unsigned char*)(size_t)l_; p = kp_get(); ws = p->ws; } while (0)
#define PHASE_VARS Ctx C; { int t_ = C0.tid, b_ = C0.bid, g_ = C0.G; unsigned l_ = (unsigned)(size_t)C0.lds; asm volatile("" : "+v"(t_), "+s"(b_), "+s"(g_), "+s"(l_)); C.tid = t_; C.lane = t_ & 63; C.wave = __builtin_amdgcn_readfirstlane(t_ >> 6); C.bid = b_; C.G = g_; C.lds = (LAS unsigned char*)(size_t)l_; } KArg p = kp_get(); unsigned char* ws = p->ws; unsigned* ctl = (unsigned*)(ws + WS_CTL); const float* MOD = (const float*)(ws + WS_MOD); bf16_t* U = (bf16_t*)(ws + WS_U); (void)ctl; (void)MOD; (void)U;
#define SEAM(k) do { if (IN(k) && IN((k) + 1)) xcd_barrier(bar); } while (0)

    TIC(300); TIC(301);
    if (PH_ON(10) && IN(0)) { PHASE_VARS prologue_phase(p, C); }
    TOC(300);
    SEAM(0);
    TOC(301);

    for (int l = 0; l < DEPTH; ++l) {
        const int base = 1 + PH_PER_LAYER * l;
        const bool moe = (l & 1) != 0, last = (l == DEPTH - 1);
        const int row_min = last ? MC : 0, pm0 = last ? 4 : 0, Meff = last ? MX : MT;
        const int cv_all = 1024 + (moe ? 2688 : 8 * 2688), cv1 = moe ? cv_all : CV_P1, cv2 = moe ? cv_all : cv_all - CV_P8;

        TIC(100); TIC(200);
        if (PH_ON(0) && IN(base + 0)) { PHASE_VARS
            norm_phase<0>(p, C, l, l == 2, l - 1, false, 0, (l == 1 || l == 3) ? 7 : 0);
        }
        TOC(100);
        SEAM(base + 0);
        TOC(200);
        TIC(101); TIC(201);
        if (PH_ON(1) && IN(base + 1)) { PHASE_VARS
            if (C.bid < 224) {
            { pg8::Gemm g{U, (const bf16_t*)(ws + WS_WIN) + (size_t)l * DINP * D, MT, DINP, D, D, D}; pg8::OrderPM S; S.init(MT, DINP, 224, C.bid); S.pm0 = 0;
              pg8::EpiStore E{(bf16_t*)(ws + WS_P), DINP, 1 << 20};
              pg8::gemm_phase<pg8::EpiStore, pg8::OrderPM, true, true>(C.lds, g, S, E); }
            { pg8::Gemm g{(const bf16_t*)(ws + WS_WINV) + (size_t)l * 256 * D, U, 256, MT, D, D, D}; pg8::OrderPM S; S.init(256, MT, 224, (C.bid + 80) % 224); S.pm0 = 0;
              pg8::EpiStore E{(bf16_t*)(ws + WS_VTS), MT, 1 << 20};
              pg8::gemm_phase<pg8::EpiStore, pg8::OrderPM, true, true>(C.lds, g, S, E); }
            } else if (!last) convert_layer_weights(p, C, l + 1, (C.bid - 224) * NWAVES + C.wave, 32 * NWAVES, 0, cv1);
        }
        TOC(101);
        SEAM(base + 1);
        TOC(201);
        TIC(102); TIC(202);
        if (PH_ON(2) && IN(base + 2)) for (int rep = 0; rep < NREP(2); ++rep) { PHASE_VARS
            if (!PREP_IN_GDN) prep_phase(p, C, l);
            for (int v = C.bid; v < 1088; v += C.G) { const int b = v / 272, h = (v / 68) & 3, cg = v % 68; gdn_chunk_unit(p, C, l, b, h, cg, v); }
            RELAUNDER;
            TIC(5);
#if RET_DEAL_OLD
            for (int v = C.bid; v < 1088; v += C.G) { const int b = v / 272, h = (v / 68) & 3, cg = v % 68; ret_chunk_unit(p, C, l, b, h, cg); }
#else
            if (C.bid >= 64) { for (int k = 0; k < 5; ++k) { const int v = (C.bid - 64) + 192 * k; const int b = v / 272, h = (v / 68) & 3, cg = v % 68; ret_chunk_unit(p, C, l, b, h, cg); } }
            else { for (int k = 0; k < 2; ++k) { const int v = 960 + C.bid + 64 * k; const int b = v / 272, h = (v / 68) & 3, cg = v % 68; ret_chunk_unit(p, C, l, b, h, cg); } }
#endif
            TOC(5);
        }
        TOC(102);
        SEAM(base + 2);
        TOC(202);
        TIC(103); TIC(203);
        if (PH_ON(3) && IN(base + 3)) for (int rep = 0; rep < NREP(3); ++rep) { PHASE_VARS
            if (SUB3 & 1) { if (C.bid < 32) { TIC(7); gdn_scan_chain(p, C, C.bid); TOC(7); } }
            RELAUNDER;
            if (C.bid >= 32) {
                const int G2 = C.G - 32, c2 = C.bid - 32;
                TIC(9);
                if (SUB3 & 8) ret_scan_items(p, C, l, c2 * NTHR + C.tid, 65536, G2 * NTHR);
                {
                    asm volatile("s_waitcnt vmcnt(0)" ::: "memory"); __syncthreads();
                    if (C.tid == 0) { __builtin_amdgcn_fence(__ATOMIC_RELEASE, "agent"); __hip_atomic_fetch_add(ctl + CW_RDY + l, 1u, __ATOMIC_RELAXED, __HIP_MEMORY_SCOPE_AGENT); } }
                RELAUNDER;
                TOC(9);
                TIC(8);
                if (SUB3 & 2) { pg8::Gemm g{(const bf16_t*)(ws + WS_AUP), (const bf16_t*)(ws + WS_WUP) + (size_t)l * 1024 * 512, MT, 768, 384, 512, 512}; pg8::OrderPM S; S.init(MT, 768, G2, c2); S.pm0 = 0;
                  pg8::EpiUp E{(bf16_t*)(ws + WS_QRAW), (bf16_t*)(ws + WS_KFULL)};
                  pg8::gemm_phase<pg8::EpiUp, pg8::OrderPM, true, true>(C.lds, g, S, E); }
                RELAUNDER;
                if (SUB3 & 4) { pg8::Gemm g{(const bf16_t*)(ws + WS_WUPV) + (size_t)l * 256 * 512, (const bf16_t*)(ws + WS_AUP), 256, MT, 384, 512, 512}; pg8::OrderPM S; S.init(256, MT, G2, (c2 + 176) % G2); S.pm0 = 0;
                  pg8::EpiStore E{(bf16_t*)(ws + WS_VTM), MT, 1 << 20};
                  pg8::gemm_phase<pg8::EpiStore, pg8::OrderPM, true, true>(C.lds, g, S, E); }
                RELAUNDER;
                TOC(8); TIC(10);
                if (SUB3 & 16) { for (int u = 256 + c2; u < 512; u += G2) attn_dispatch(p, C, l, u);
                if (!last && c2 >= 32 && c2 < 48) attn_dispatch(p, C, l, 528 + c2 - 32); }
                RELAUNDER;
                TOC(10); TIC(11);
                RELAUNDER;
                if (!last) { __syncthreads();
                    constexpr int NWK = 116 + 2 * 108;
                    if (c2 < 116) convert_layer_weights(p, C, l + 1, c2 * NWAVES + C.wave, NWK * NWAVES, cv1, cv2);
                    else { convert_layer_weights(p, C, l + 1, (116 + 2 * (c2 - 116)) * NWAVES + C.wave, NWK * NWAVES, cv1, cv2); convert_layer_weights(p, C, l + 1, (117 + 2 * (c2 - 116)) * NWAVES + C.wave, NWK * NWAVES, cv1, cv2); } }
                TOC(11);
                if (moe || (c2 >= 48 && c2 < 48 + RET3_DENSE / 8)) { RELAUNDER;
                    if (C.tid == 0) { unsigned sp = 0; while (__hip_atomic_load(ctl + CW_RDY + l, __ATOMIC_RELAXED, __HIP_MEMORY_SCOPE_AGENT) < (unsigned)(C.G - 32) && ++sp < (1u << 22)) __builtin_amdgcn_s_sleep(4);
                        __builtin_amdgcn_fence(__ATOMIC_ACQUIRE, "agent"); }
                    __syncthreads();
                    const int G3 = C.G - 32, c3 = C.bid - 32;
                    if (moe) { for (int j = (G3 - 1 - c3) * NWAVES + C.wave; j < 2 * 1088; j += G3 * NWAVES) { const int u = j >> 1, rt = j & 1; const int b = u / 272, h = (u / 68) & 3, cg = u % 68; if (last && cg < 4) continue; rec_out_item(p, C.lane, l, 1, b, h, cg, rt); } }
                    else { const int j = (c3 - 48) * NWAVES + C.wave; const int u = j >> 1, rt = j & 1; const int b = u / 272, h = (u / 68) & 3, cg = u % 68; rec_out_item(p, C.lane, l, 1, b, h, cg, rt); } }
            }
        }
        TOC(103);
        SEAM(base + 3);
        TOC(203);
        TIC(104); TIC(204);
        if (PH_ON(4) && IN(base + 4)) for (int rep = 0; rep < NREP(4); ++rep) { PHASE_VARS
            for (int pass = 0; pass < 2; ++pass) {
                if (((pass ^ C.bid) & 1) == 0) {
                    TIC(12);
                    for (int u = C.bid; u < 256; u += C.G) attn_dispatch(p, C, l, u);
                    if (!last && C.bid >= 32 && C.bid < 48) attn_dispatch(p, C, l, 512 + C.bid - 32);
                    TOC(12);
                } else {
                    TIC(13);
                    if (!moe) {
                        for (int r = 0; r < 2; ++r) { if (r == 1 && C.bid >= 32 && C.bid < 48) break;
                            const int t = r == 0 ? C.bid * NWAVES + C.wave : 2048 + (C.bid < 32 ? C.bid : C.bid - 16) * NWAVES + C.wave;
                            const int mixer = t < 2 * 1088 ? 0 : 1, j = mixer ? RET3_DENSE + (t - 2 * 1088) : t; const int u = j >> 1, rt = j & 1; const int b = u / 272, h = (u / 68) & 3, cg = u % 68;
                            rec_out_item(p, C.lane, l, mixer, b, h, cg, rt); } }
                    else { for (int j = C.bid * NWAVES + C.wave; j < 2 * 1088; j += C.G * NWAVES) { const int u = j >> 1, rt = j & 1; const int b = u / 272, h = (u / 68) & 3, cg = u % 68; if (last && cg < 4) continue; rec_out_item(p, C.lane, l, 0, b, h, cg, rt); } }
                    TOC(13);
                }
                __syncthreads(); RELAUNDER;
            }
        }
        TOC(104);
        SEAM(base + 4);
        TOC(204);
        TIC(105); TIC(205);
        if (PH_ON(5) && IN(base + 5)) { PHASE_VARS
            { pg8::Gemm g{(const bf16_t*)(ws + WS_MIX), (const bf16_t*)(ws + WS_WOUT) + (size_t)l * D * D, MX, D, D, D, D}; pg8::OrderPM S; S.init(MX, D, C.G, C.bid); S.pm0 = 4;
              pg8::EpiRes E{(float*)(ws + WS_H), MOD + (size_t)l * 5 * 6144 + 2 * 1024, l == 0 ? p->in[I_X] - (size_t)MC * D : (const float*)(ws + WS_H)};
              pg8::gemm_phase<pg8::EpiRes, pg8::OrderPM, true, true>(C.lds, g, S, E); }
            if (!last) { RELAUNDER;
              pg8::Gemm g{(const bf16_t*)(ws + WS_MIX), (const bf16_t*)(ws + WS_WOUT) + (size_t)l * D * D, MC, D, 256, D, D}; pg8::SplitKOrder S{C.G, C.bid, 4, 256};
              pg8::EpiSlab E{(float*)(ws + WS_SLAB), (const float*)(ws + WS_MOD) + (size_t)l * 5 * 6144 + 2 * 1024, 256};
              pg8::gemm_phase<pg8::EpiSlab, pg8::SplitKOrder, true, true>(C.lds, g, S, E); }
        }
        TOC(105);
        SEAM(base + 5);
        TOC(205);
        TIC(106); TIC(206);
        if (PH_ON(6) && IN(base + 6)) { PHASE_VARS
            if (moe) for (int i = C.bid * NTHR + C.tid; i < MOE_ROWS; i += C.G * NTHR) ((int*)ctl)[CW_ROWIDX + i] = 0;
            norm_phase<1>(p, C, l, false, 0, moe, row_min, last ? 0 : 4); }
        TOC(106);
        SEAM(base + 6);
        TOC(206);
        TIC(107); TIC(207);
        if (PH_ON(7) && IN(base + 7)) { PHASE_VARS if (moe) moe_gather_phase(p, C, row_min); }
        TOC(107);
        if (moe) SEAM(base + 7);
        TOC(207);
        TIC(108); TIC(208);
        if (PH_ON(8) && IN(base + 8)) { PHASE_VARS
            pg8::EpiSwiGLU E{(bf16_t*)(ws + WS_HD)};
            if (!moe) {
                if (C.bid < 240) { pg8::Gemm g{U, (const bf16_t*)(ws + WS_WFF + (size_t)(l >> 1) * FFW_BYTES), MT, 7168, D, D, D}; pg8::OrderPM S; S.init(MT, 7168, 240, C.bid); S.pm0 = 0;
                pg8::gemm_phase<pg8::EpiSwiGLU, pg8::OrderPM, true, true>(C.lds, g, S, E); }
                else convert_layer_weights(p, C, l + 1, (C.bid - 240) * NWAVES + C.wave, 16 * NWAVES, cv2, 1 << 30); }
            else { const int nt = (int)__hip_atomic_load(ctl + CW_TILEE + 160, __ATOMIC_RELAXED, __HIP_MEMORY_SCOPE_AGENT);
                pg8::Gemm g{U, (const bf16_t*)(ws + WS_WMOE), MT, 8 * 7168, D, D, D}; pg8::MoeGatherOrder S{{28, C.G, C.bid, __builtin_amdgcn_readfirstlane(nt), ctl + CW_TILEE}, (const int*)(ctl + CW_ROWIDX)};
                pg8::gemm_phase<pg8::EpiSwiGLU, pg8::MoeGatherOrder, true, true>(C.lds, g, S, E); }
        }
        TOC(108);
        SEAM(base + 8);
        TOC(208);
        TIC(109); TIC(209);
        if (PH_ON(9) && IN(base + 9)) { PHASE_VARS
            if (!moe) {
                const bf16_t* Wd = (const bf16_t*)(ws + WS_WFF + (size_t)(l >> 1) * FFW_BYTES) + (size_t)7168 * 1024;
                { pg8::Gemm g{(const bf16_t*)(ws + WS_HD), Wd, MX, D, DFF, DFF, DFF}; pg8::OrderPM S; S.init(MX, D, C.G, C.bid); S.pm0 = 4;
                  pg8::EpiRes E{(float*)(ws + WS_H), MOD + (size_t)l * 5 * 6144 + 5 * 1024, (const float*)(ws + WS_H)};
                  pg8::gemm_phase<pg8::EpiRes, pg8::OrderPM, true, true>(C.lds, g, S, E); }
                RELAUNDER;
                { pg8::Gemm g{(const bf16_t*)(ws + WS_HD), (const bf16_t*)(ws + WS_WFF + (size_t)(l >> 1) * FFW_BYTES) + (size_t)7168 * 1024, MC, D, 512, DFF, DFF}; pg8::SplitKOrder S{C.G, C.bid, 7, 512};
                  pg8::EpiSlab E{(float*)(ws + WS_SLAB), (const float*)(ws + WS_MOD) + (size_t)l * 5 * 6144 + 5 * 1024, 512};
                  pg8::gemm_phase<pg8::EpiSlab, pg8::SplitKOrder, true, true>(C.lds, g, S, E); } }
            else { const int nt = __builtin_amdgcn_readfirstlane((int)__hip_atomic_load(ctl + CW_TILEE + 160, __ATOMIC_RELAXED, __HIP_MEMORY_SCOPE_AGENT));
                { pg8::Gemm g{(const bf16_t*)(ws + WS_HD), (const bf16_t*)(ws + WS_WMOE) + (size_t)8 * 7168 * 1024, MOE_ROWS, 8 * 1024, DFF, DFF, DFF}; pg8::MoeDownOrder S{{4, C.G, C.bid, nt < MOE_SPLIT_TILE ? nt : MOE_SPLIT_TILE, ctl + CW_TILEE}};
                  pg8::EpiStore E{(bf16_t*)(ws + WS_YD), D, 4};
                  pg8::gemm_phase<pg8::EpiStore, pg8::MoeDownOrder, true, true>(C.lds, g, S, E); }
                RELAUNDER;
                if (nt > MOE_SPLIT_TILE) { pg8::Gemm g{(const bf16_t*)(ws + WS_HD), (const bf16_t*)(ws + WS_WMOE) + (size_t)8 * 7168 * 1024, MOE_ROWS, 8 * 1024, 512, DFF, DFF}; pg8::MoeSplitOrder S{C.G, C.bid, nt, (unsigned*)(ws + WS_CTL) + CW_TILEE};
                  pg8::EpiMoeSlab E{(bf16_t*)(ws + WS_MSLAB)};
                  pg8::gemm_phase<pg8::EpiMoeSlab, pg8::MoeSplitOrder, true, true>(C.lds, g, S, E); } }
        }
        TOC(109);
        SEAM(base + 9);
        TOC(209);
    }
    if (PH_ON(11) && IN(PH_FINAL)) { PHASE_VARS norm_phase<2>(p, C, DEPTH, true, DEPTH - 1, false, MC, 0); }
#if PROBE_ID
    if (blockIdx.x == PROBE_BLOCK && threadIdx.x == 0) { const unsigned long long w = PROBE_ACC[0] * PROBE_MULT, t0 = __builtin_amdgcn_s_memrealtime(); while (__builtin_amdgcn_s_memrealtime() - t0 < w) __builtin_amdgcn_s_sleep(8); }
#endif
#undef IN
#undef SEAM
}

extern "C" void kernel_launch(void* const* d_in, const int* in_sizes, int n_in, void* d_out, int out_size, void* d_ws, size_t ws_size, hipStream_t stream) {
    static int grid = 0;
    if (grid == 0) {
        if (n_in != N_IN || out_size != MX * D || ws_size < WS_TOTAL) { fprintf(stderr, "kernel_launch: unexpected shapes (n_in %d out %d ws %zu, need %zu)\n", n_in, out_size, ws_size, (size_t)WS_TOTAL); grid = -1; return; }
        int dev = 0, cus = 0, per_cu = 0;
        if (hipGetDevice(&dev) != hipSuccess || hipDeviceGetAttribute(&cus, hipDeviceAttributeMultiprocessorCount, dev) != hipSuccess) { grid = -1; return; }
        if (hipFuncSetAttribute((const void*)mega_fwd, hipFuncAttributeMaxDynamicSharedMemorySize, LDS_BYTES) != hipSuccess) { fprintf(stderr, "kernel_launch: hipFuncSetAttribute failed\n"); grid = -1; return; }
        if (hipOccupancyMaxActiveBlocksPerMultiprocessor(&per_cu, (const void*)mega_fwd, NTHR, LDS_BYTES) != hipSuccess || per_cu < 1) { fprintf(stderr, "kernel_launch: occupancy query says %d\n", per_cu); }
        (void)hipGetLastError();
        grid = (cus == 256) ? 256 : -1;
        if (grid < 0) { fprintf(stderr, "kernel_launch: built for a 256-CU device, found %d\n", cus); return; }
    }
    if (grid < 0) return;
    if (hipMemsetAsync((char*)d_ws + WS_CTL, 0, CTL_BYTES, stream) != hipSuccess) return;
    Params p; memset(&p, 0, sizeof(p));
    for (int i = 0; i < N_IN; ++i) p.in[i] = (const float*)d_in[i];
    p.out = (float*)d_out; p.ws = (unsigned char*)d_ws;
#if MK_ONE_LAUNCH
    p.ph_lo = 0; p.ph_hi = N_PHASES;
    hipLaunchKernelGGL(mega_fwd, dim3(grid), dim3(NTHR), LDS_BYTES, stream, p);
#else
    for (int ph = 0; ph < N_PHASES; ++ph) {
        if (ph >= 1 && ph < PH_FINAL) { const int l = (ph - 1) / PH_PER_LAYER, k = (ph - 1) % PH_PER_LAYER; if (k == 7 && !(l & 1)) continue; }
        p.ph_lo = ph; p.ph_hi = ph + 1;
        hipLaunchKernelGGL(mega_fwd, dim3(grid), dim3(NTHR), LDS_BYTES, stream, p);
    }
#endif
}
```
